# Optimizing an MI355X kernel written in HIP

```python
import math
import jax, jax.numpy as jnp
from jax import lax
import numpy as np

D_MODEL = 2048
BATCH = 8
SEQ = 2048
DEPTH = 1
DEC_BATCH = 8
DEC_SEQ = 16
PAST_LEN = 4096

CHUNK = 64
WINDOW = 128
N_HEADS = 16
N_KV_HEADS = 2
HEAD_DIM = 64
GQA_GROUP = N_HEADS // N_KV_HEADS
D_ATTN = N_HEADS * HEAD_DIM
D_KV = N_KV_HEADS * HEAD_DIM
N_BUCKETS = 32
MAX_DISTANCE = 128
SGU_BLOCK = 128
SGU_GROUPS = 8
SGU_GROUP_DIM = 128
D_SGU = SGU_GROUPS * SGU_GROUP_DIM
PEER_HEADS = 8
PEER_N_KEYS = 128
PEER_N_EXPERTS = PEER_N_KEYS * PEER_N_KEYS
PEER_QUERY_DIM = 256
PEER_HALF = PEER_QUERY_DIM // 2
PEER_TOPK = 16
PEER_TOKEN_BLOCK = 128
D_IN = D_ATTN + 2 * D_KV + 2 * D_SGU + 2 * D_MODEL
SPLIT_POINTS = tuple(int(s) for s in np.cumsum([D_ATTN, D_KV, D_KV, D_SGU, D_SGU, D_MODEL]))
EPS = 1e-6
NEG_INF = -1e30

kernel_name = 'hybrid_swa_sgu_peer_stream_step'


def rmsnorm(x, g):
    xf = x.astype(jnp.float32)
    r = lax.rsqrt(jnp.mean(xf * xf, axis=-1, keepdims=True) + EPS)
    return (xf * r * g.astype(jnp.float32)).astype(x.dtype)


def t5_bucket(rel):
    half = N_BUCKETS // 2
    max_exact = half // 2
    ret = jnp.where(rel > 0, half, 0)
    n = jnp.abs(rel)
    nf = jnp.maximum(n, 1).astype(jnp.float32)
    large = max_exact + (jnp.log(nf / max_exact) / math.log(MAX_DISTANCE / max_exact)
                         * (half - max_exact)).astype(jnp.int32)
    large = jnp.minimum(large, half - 1)
    return ret + jnp.where(n < max_exact, n, large)


def rel_bias(table, n_q, n_k):
    rel = jnp.arange(n_k, dtype=jnp.int32)[None, :] - WINDOW - jnp.arange(n_q, dtype=jnp.int32)[:, None]
    b = table[t5_bucket(rel)].astype(jnp.float32)
    return b.transpose(2, 0, 1).reshape(N_KV_HEADS, GQA_GROUP, n_q, n_k)


def attend(q, k, v, bias, mask, sinks):
    s = jnp.einsum('...qkgd,...skd->...kgqs', q, k, preferred_element_type=jnp.float32)
    s = s * (HEAD_DIM ** -0.5) + bias
    if mask is not None:
        s = jnp.where(mask, s, NEG_INF)
    sink = jnp.broadcast_to(sinks.astype(jnp.float32).reshape(N_KV_HEADS, GQA_GROUP, 1, 1),
                            s.shape[:-1] + (1,))
    p = jax.nn.softmax(jnp.concatenate([s, sink], axis=-1), axis=-1)[..., :-1]
    return jnp.einsum('...kgqs,...skd->...qkgd', p.astype(v.dtype), v)


def swa_prompt(q, k, v, bias, sinks):
    B, S = q.shape[:2]
    n_c = S // CHUNK
    n_back = WINDOW // CHUNK
    qb = q.reshape(B, n_c, CHUNK, N_KV_HEADS, GQA_GROUP, HEAD_DIM)
    pad = ((0, 0), (WINDOW, 0), (0, 0), (0, 0))
    kp = jnp.pad(k, pad).reshape(B, n_c + n_back, CHUNK, N_KV_HEADS, HEAD_DIM)
    vp = jnp.pad(v, pad).reshape(B, n_c + n_back, CHUNK, N_KV_HEADS, HEAD_DIM)
    kb = jnp.concatenate([kp[:, i:i + n_c] for i in range(n_back + 1)], axis=2)
    vb = jnp.concatenate([vp[:, i:i + n_c] for i in range(n_back + 1)], axis=2)
    key_pos = (jnp.arange(n_c)[:, None] * CHUNK - WINDOW + jnp.arange(WINDOW + CHUNK)[None, :])
    mask = (key_pos >= 0)[None, :, None, None, None, :]
    o = attend(qb, kb, vb, bias, mask, sinks)
    return o.reshape(B, S, D_ATTN)


def sgu(u, vn, w_s_masked, b_s):
    L = u.shape[2]
    mixed = jnp.einsum('gts,bnsgc->bntgc', w_s_masked[:, :L, :L], vn)
    return u * (mixed + b_s[:, :L].T[:, :, None].astype(mixed.dtype))


def split_in(z, sgu_g):
    lead = z.shape[:-1]
    q, k, v, u, vs, ga, gb = jnp.split(z, SPLIT_POINTS, axis=-1)
    q = q.reshape(*lead, N_KV_HEADS, GQA_GROUP, HEAD_DIM)
    k = k.reshape(*lead, N_KV_HEADS, HEAD_DIM)
    v = v.reshape(*lead, N_KV_HEADS, HEAD_DIM)
    u = jax.nn.gelu(u)
    vs = rmsnorm(jax.nn.gelu(vs), sgu_g)
    return q, k, v, u, vs, ga, gb


def merge(o_attn, s_sgu, ga, gb, w_pa, w_pb, w_out):
    h = jax.nn.sigmoid(ga) * (o_attn @ w_pa) + jax.nn.sigmoid(gb) * (s_sgu @ w_pb)
    return h @ w_out


def peer_tokens(xt, w_query, sub_keys, expert_u, expert_v):
    T = xt.shape[0]
    q = (xt @ w_query).reshape(T, PEER_HEADS, 2, PEER_HALF)
    s = jnp.einsum('thpd,hpnd->thpn', q, sub_keys, preferred_element_type=jnp.float32)
    sv, si = lax.top_k(s, PEER_TOPK)
    cand = sv[:, :, 0, :, None] + sv[:, :, 1, None, :]
    cand_idx = si[:, :, 0, :, None] * PEER_N_KEYS + si[:, :, 1, None, :]
    cv, ci = lax.top_k(cand.reshape(T, PEER_HEADS, PEER_TOPK * PEER_TOPK), PEER_TOPK)
    eidx = jnp.take_along_axis(cand_idx.reshape(T, PEER_HEADS, PEER_TOPK * PEER_TOPK), ci, axis=-1)
    g = jax.nn.softmax(cv, axis=-1)
    ue = expert_u[eidx]
    a = jax.nn.gelu(jnp.einsum('thkd,td->thk', ue, xt, preferred_element_type=jnp.float32))
    h = (g * a).astype(xt.dtype)
    ve = expert_v[eidx]
    return jnp.einsum('thk,thkd->td', h, ve)


def setup_inputs(seed: int = 0) -> dict:
    key = jax.random.key(seed)
    ks = jax.random.split(key, 20)
    nrm = lambda k, shape, scale: jax.random.normal(k, shape, jnp.float32) * scale
    return {
        'x_prompt': nrm(ks[0], (BATCH, SEQ, D_MODEL), 1.0),
        'x_sample': nrm(ks[1], (DEC_BATCH, DEC_SEQ, D_MODEL), 1.0),
        'cache_k_swa': nrm(ks[2], (DEPTH, DEC_BATCH, WINDOW, N_KV_HEADS, HEAD_DIM), 1.0),
        'cache_v_swa': nrm(ks[3], (DEPTH, DEC_BATCH, WINDOW, N_KV_HEADS, HEAD_DIM), 1.0),
        'norm_mix_g': 1.0 + nrm(ks[4], (DEPTH, D_MODEL), 0.02),
        'w_in': nrm(ks[5], (DEPTH, D_MODEL, D_IN), D_MODEL ** -0.5),
        'sgu_norm_g': 1.0 + nrm(ks[6], (DEPTH, D_SGU), 0.02),
        'sgu_w_s': nrm(ks[7], (DEPTH, SGU_GROUPS, SGU_BLOCK, SGU_BLOCK), 0.5 * SGU_BLOCK ** -0.5),
        'sgu_b_s': 1.0 + nrm(ks[8], (DEPTH, SGU_GROUPS, SGU_BLOCK), 0.01),
        'attn_sinks': nrm(ks[9], (DEPTH, N_HEADS), 0.5),
        'rel_bias_table': nrm(ks[10], (N_BUCKETS, N_HEADS), 0.1),
        'w_branch_attn': nrm(ks[11], (DEPTH, D_ATTN, D_MODEL), D_ATTN ** -0.5),
        'w_branch_sgu': nrm(ks[12], (DEPTH, D_SGU, D_MODEL), D_SGU ** -0.5),
        'w_out': nrm(ks[13], (DEPTH, D_MODEL, D_MODEL), D_MODEL ** -0.5),
        'norm_ffn_g': 1.0 + nrm(ks[14], (DEPTH, D_MODEL), 0.02),
        'peer_w_query': nrm(ks[15], (DEPTH, D_MODEL, PEER_HEADS * PEER_QUERY_DIM), D_MODEL ** -0.5),
        'peer_sub_keys': nrm(ks[16], (DEPTH, PEER_HEADS, 2, PEER_N_KEYS, PEER_HALF), PEER_HALF ** -0.5),
        'peer_expert_u': nrm(ks[17], (DEPTH, PEER_N_EXPERTS, D_MODEL), D_MODEL ** -0.5),
        'peer_expert_v': nrm(ks[18], (DEPTH, PEER_N_EXPERTS, D_MODEL), 0.1),
        'norm_final_g': 1.0 + nrm(ks[19], (D_MODEL,), 0.02),
    }


def reference(x_prompt, x_sample, cache_k_swa, cache_v_swa, norm_mix_g, w_in, sgu_norm_g,
              sgu_w_s, sgu_b_s, attn_sinks, rel_bias_table, w_branch_attn, w_branch_sgu,
              w_out, norm_ffn_g, peer_w_query, peer_sub_keys, peer_expert_u, peer_expert_v,
              norm_final_g):
    B, S = x_prompt.shape[:2]
    Bd, T = x_sample.shape[:2]
    tril = jnp.tril(jnp.ones((SGU_BLOCK, SGU_BLOCK), dtype=bool))
    bias_p = rel_bias(rel_bias_table, CHUNK, WINDOW + CHUNK)
    bias_s = rel_bias(rel_bias_table, T, WINDOW + T)

    xp, xs = x_prompt, x_sample
    nk_p, nv_p, nk_s, nv_s, nsgu_s = [], [], [], [], []
    for l in range(DEPTH):
        w_s_masked = jnp.where(tril, sgu_w_s[l], 0.0).astype(sgu_w_s.dtype)
        zp = rmsnorm(xp, norm_mix_g[l]) @ w_in[l]
        qp, kp, vp, up, vsp, gap, gbp = split_in(zp, sgu_norm_g[l])
        op = swa_prompt(qp, kp, vp, bias_p, attn_sinks[l])
        n_blk = S // SGU_BLOCK
        sp = sgu(up.reshape(B, n_blk, SGU_BLOCK, SGU_GROUPS, SGU_GROUP_DIM),
                 vsp.reshape(B, n_blk, SGU_BLOCK, SGU_GROUPS, SGU_GROUP_DIM),
                 w_s_masked, sgu_b_s[l]).reshape(B, S, D_SGU)
        xp = xp + merge(op, sp, gap, gbp, w_branch_attn[l], w_branch_sgu[l], w_out[l])
        zs = rmsnorm(xs, norm_mix_g[l]) @ w_in[l]
        qs, kss, vss, us, vs_sgu, gas, gbs = split_in(zs, sgu_norm_g[l])
        k_all = jnp.concatenate([cache_k_swa[l].astype(kss.dtype), kss], axis=1)
        v_all = jnp.concatenate([cache_v_swa[l].astype(vss.dtype), vss], axis=1)
        os_ = attend(qs, k_all, v_all, bias_s, None, attn_sinks[l]).reshape(Bd, T, D_ATTN)
        ss = sgu(us.reshape(Bd, 1, T, SGU_GROUPS, SGU_GROUP_DIM),
                 vs_sgu.reshape(Bd, 1, T, SGU_GROUPS, SGU_GROUP_DIM),
                 w_s_masked, sgu_b_s[l]).reshape(Bd, T, D_SGU)
        xs = xs + merge(os_, ss, gas, gbs, w_branch_attn[l], w_branch_sgu[l], w_out[l])
        nk_p.append(kp[:, S - WINDOW:])
        nv_p.append(vp[:, S - WINDOW:])
        nk_s.append(kss)
        nv_s.append(vss)
        nsgu_s.append(vs_sgu)
        peer = lambda t: peer_tokens(t, peer_w_query[l], peer_sub_keys[l], peer_expert_u[l], peer_expert_v[l])
        xnp = rmsnorm(xp, norm_ffn_g[l]).reshape(-1, PEER_TOKEN_BLOCK, D_MODEL)
        xp = xp + lax.map(peer, xnp).reshape(B, S, D_MODEL)
        xns = rmsnorm(xs, norm_ffn_g[l]).reshape(Bd * T, D_MODEL)
        xs = xs + peer(xns).reshape(Bd, T, D_MODEL)

    y_prompt = rmsnorm(xp, norm_final_g)
    y_sample = rmsnorm(xs, norm_final_g)
    new_k_swa_prompt = jnp.stack(nk_p)
    new_v_swa_prompt = jnp.stack(nv_p)
    new_k_swa_sample = jnp.stack(nk_s)
    new_v_swa_sample = jnp.stack(nv_s)
    new_sgu_v_sample = jnp.stack(nsgu_s)
    return (y_prompt, y_sample, new_k_swa_prompt, new_v_swa_prompt, new_k_swa_sample, new_v_swa_sample, new_sgu_v_sample)
```

```cpp
#include <hip/hip_runtime.h>
#include <cstdio>
#include <cstdint>
#define HAVE_P2
#define HAVE_P3
#define HAVE_P5
#define HAVE_P7
namespace pg8 {
#define PG8_LAS __attribute__((address_space(3)))
typedef unsigned short bf16_t;
typedef short bf16x8 __attribute__((ext_vector_type(8)));
typedef float f32x4 __attribute__((ext_vector_type(4)));
typedef unsigned u32x4 __attribute__((ext_vector_type(4)));
constexpr int BM = 256, BK = 64, HALF = 128, HTB = HALF * BK * 2  , STAGE_BYTES = 8 * HTB, NXCD = 8, WGM = 8;

__host__ __device__ __forceinline__ int lds_byte(int r, int c) { const int st = (r >> 4) * 2 + (c >> 5), rr = r & 15, cc = c & 31, ob = rr * 64 + cc * 2; return st * 1024 + (ob ^ (((ob >> 9) & 1) << 5)); }
__host__ __device__ __forceinline__ void stage_rc(int b, int& R, int& C) { const int st = b / 1024, sb = b % 1024, swz = sb ^ (((sb >> 9) & 1) << 5); R = (st >> 1) * 16 + swz / 64; C = (st & 1) * 32 + (swz % 64) / 2; }
__host__ __device__ __forceinline__ int perm32(int rho) { const int n = rho >> 4, i = rho & 15; return 8 * (i >> 2) + 4 * n + (i & 3); }

__device__ __forceinline__ int lane_id_v() { int l; asm volatile("v_mbcnt_lo_u32_b32 %0, -1, 0\n\tv_mbcnt_hi_u32_b32 %0, -1, %0" : "=v"(l)); return l; }
struct Unit { int pm, pn; };
struct Gemm { const bf16_t* A; const bf16_t* Bt; int M, N, K; };

struct StaticOrder {
    int nM, nN, nwg, G, c;
    __host__ __device__ void init(int M, int N, int G_, int c_) { nM = M / BM; nN = N / BM; nwg = nM * nN; G = G_; c = c_; }
    __host__ __device__ bool next(int i, Unit& u) const {
        const long L = (long)i * G + c; if (L >= nwg) return false;
        int wgid = (int)L; { const int q = nwg / NXCD, r = nwg % NXCD, xcd = wgid % NXCD, off = wgid / NXCD; wgid = (xcd < r ? xcd * (q + 1) : r * (q + 1) + (xcd - r) * q) + off; }
        const int nig = WGM * nN, gid = wgid / nig, fm = gid * WGM, gsz = (nM - fm) < WGM ? (nM - fm) : WGM;
        u.pm = fm + ((wgid % nig) % gsz); u.pn = (wgid % nig) / gsz; return true;
    }
    __device__ __forceinline__ void a_ready(const Unit&) const {}
    __device__ __forceinline__ void done(const Unit&) const {}
};

typedef float f32x2 __attribute__((ext_vector_type(2)));
typedef __bf16 bf16x2_t __attribute__((ext_vector_type(2)));
typedef _Float16 f16x2_t __attribute__((ext_vector_type(2)));
typedef _Float16 f16x8_t __attribute__((ext_vector_type(8)));
__device__ __forceinline__ unsigned pk_bf16(float lo, float hi) { f32x2 v = {lo, hi}; return __builtin_bit_cast(unsigned, __builtin_convertvector(v, bf16x2_t)); }
__device__ __forceinline__ unsigned pk_f16(float lo, float hi) { f32x2 v = {lo, hi}; return __builtin_bit_cast(unsigned, __builtin_convertvector(v, f16x2_t)); }
__device__ __forceinline__ float bf_lo(unsigned w) { return __builtin_bit_cast(float, w << 16); }
__device__ __forceinline__ float bf_hi(unsigned w) { return __builtin_bit_cast(float, w & 0xffff0000u); }
template <bool F16> __device__ __forceinline__ f32x4 mma16(bf16x8 a, bf16x8 b, f32x4 c) {
    if constexpr (F16) return __builtin_amdgcn_mfma_f32_16x16x32_f16(__builtin_bit_cast(f16x8_t, a), __builtin_bit_cast(f16x8_t, b), c, 0, 0, 0);
    else return __builtin_amdgcn_mfma_f32_16x16x32_bf16(a, b, c, 0, 0, 0);
}
__device__ __forceinline__ float gelu_tanh(float x) { const float y = x * (1.5957691216f + 0.0713548163f * x * x); return x * __builtin_amdgcn_rcpf(1.f + __builtin_amdgcn_exp2f(-1.4426950409f * y)); }
__device__ __forceinline__ float sigmoidf_(float x) { return __builtin_amdgcn_rcpf(1.f + __builtin_amdgcn_exp2f(-1.4426950409f * x)); }
__device__ __forceinline__ u32x4 pack8_bf16(const f32x4 a, const f32x4 b) { u32x4 w; w.x = pk_bf16(a[0], a[1]); w.y = pk_bf16(a[2], a[3]); w.z = pk_bf16(b[0], b[1]); w.w = pk_bf16(b[2], b[3]); return w; }
__device__ __forceinline__ u32x4 pack8_f16(const f32x4 a, const f32x4 b) { u32x4 w; w.x = pk_f16(a[0], a[1]); w.y = pk_f16(a[2], a[3]); w.z = pk_f16(b[0], b[1]); w.w = pk_f16(b[2], b[3]); return w; }
__device__ __forceinline__ float sq4(const f32x4 a) { return (a[0] * a[0] + a[1] * a[1]) + (a[2] * a[2] + a[3] * a[3]); }

constexpr float QSCALE = 0.125f * 1.4426950408889634f;
struct EpiIn {
    static constexpr bool PERM = true, AFTER_DRAIN = false, MID = false;
    bf16_t *Q, *KV, *U, *VS, *RATIO, *SB; float* SS1; float *outKp, *outVp, *outKs, *outVs;
    __device__ __forceinline__ void operator()(const f32x4 (&acc)[2][2][4][2], const Unit& u, int wr, int wc, int, int) const {
        const int lane_ = lane_id_v(), fr = lane_ & 15, fq = lane_ >> 4;
        const int pn = u.pn, rowb = u.pm * BM + wr * 64 + fr, cl = wc * 32 + 8 * fq;
        if (pn < 4) {
#pragma unroll
            for (int ai = 0; ai < 2; ++ai)
#pragma unroll
                for (int m = 0; m < 4; ++m) { bf16_t* rp = Q + (size_t)(rowb + ai * HALF + m * 16) * 1024 + pn * 256 + cl;
#pragma unroll
                    for (int bj = 0; bj < 2; ++bj) *(u32x4*)(rp + bj * HALF) = pack8_bf16(acc[ai][bj][m][0] * QSCALE, acc[ai][bj][m][1] * QSCALE); }
        } else if (pn == 4) {
#pragma unroll
            for (int ai = 0; ai < 2; ++ai)
#pragma unroll
                for (int m = 0; m < 4; ++m) { bf16_t* rp = KV + (size_t)(rowb + ai * HALF + m * 16) * 256 + cl;
#pragma unroll
                    for (int bj = 0; bj < 2; ++bj) *(u32x4*)(rp + bj * HALF) = pack8_bf16(acc[ai][bj][m][0], acc[ai][bj][m][1]); }
            if (u.pm < 64 && (u.pm & 7) == 7) {
#pragma unroll
                for (int m = 0; m < 4; ++m) { const size_t o = (size_t)((u.pm >> 3) * 128 + wr * 64 + m * 16 + fr) * 128 + cl;
                    *(f32x4*)(outKp + o) = acc[1][0][m][0]; *(f32x4*)(outKp + o + 4) = acc[1][0][m][1];
                    *(f32x4*)(outVp + o) = acc[1][1][m][0]; *(f32x4*)(outVp + o + 4) = acc[1][1][m][1]; }
            }
            if (u.pm == 64) {
#pragma unroll
                for (int m = 0; m < 4; ++m) { const size_t o = (size_t)(wr * 64 + m * 16 + fr) * 128 + cl;
                    *(f32x4*)(outKs + o) = acc[0][0][m][0]; *(f32x4*)(outKs + o + 4) = acc[0][0][m][1];
                    *(f32x4*)(outVs + o) = acc[0][1][m][0]; *(f32x4*)(outVs + o + 4) = acc[0][1][m][1]; }
            }
        } else if (pn < 13) {
            const bool isv = pn >= 9; bf16_t* base = isv ? VS : U; const int ct = (isv ? pn - 9 : pn - 5) * 256 + cl;
#pragma unroll
            for (int ai = 0; ai < 2; ++ai)
#pragma unroll
                for (int m = 0; m < 4; ++m) { const int row = rowb + ai * HALF + m * 16; bf16_t* rp = base + (size_t)row * 1024 + ct; float s = 0.f;
#pragma unroll
                    for (int bj = 0; bj < 2; ++bj) { f32x4 a = acc[ai][bj][m][0], b = acc[ai][bj][m][1];
#pragma unroll
                        for (int e = 0; e < 4; ++e) { a[e] = gelu_tanh(a[e]); b[e] = gelu_tanh(b[e]); }
                        s += sq4(a) + sq4(b); *(u32x4*)(rp + bj * HALF) = pack8_bf16(a, b); }
                    if (isv) { s += __shfl_xor(s, 16); s += __shfl_xor(s, 32); if (fq == 0) SS1[(size_t)row * 16 + (pn - 9) * 4 + wc] = s; } }
        } else {
            const int ct = (pn - 13) * 128 + cl;
#pragma unroll
            for (int ai = 0; ai < 2; ++ai)
#pragma unroll
                for (int m = 0; m < 4; ++m) { const size_t o = (size_t)(rowb + ai * HALF + m * 16) * 2048 + ct; f32x4 ra, rb, sa, sb2;
#pragma unroll
                    for (int e = 0; e < 4; ++e) { const float s0 = sigmoidf_(acc[ai][1][m][0][e]), s1 = sigmoidf_(acc[ai][1][m][1][e]);
                        sa[e] = s0; sb2[e] = s1; ra[e] = sigmoidf_(acc[ai][0][m][0][e]) * __builtin_amdgcn_rcpf(s0); rb[e] = sigmoidf_(acc[ai][0][m][1][e]) * __builtin_amdgcn_rcpf(s1); }
                    *(u32x4*)(RATIO + o) = pack8_bf16(ra, rb); *(u32x4*)(SB + o) = pack8_bf16(sa, sb2); }
        }
    }
};
struct EpiMerge {
    static constexpr bool PERM = true, AFTER_DRAIN = false, MID = true;
    const bf16_t *RATIO, *SB; bf16_t* H;
    __device__ __forceinline__ void mid(f32x4 (&acc)[2][2][4][2], const Unit& u, int wr, int wc, int, int) const {
        const int lane_ = lane_id_v(), fr = lane_ & 15, fq = lane_ >> 4;
        const int rowb = u.pm * BM + wr * 64 + fr, col = u.pn * 256 + wc * 32 + 8 * fq;
#pragma unroll
        for (int ai = 0; ai < 2; ++ai)
#pragma unroll
            for (int m = 0; m < 4; ++m)
#pragma unroll
                for (int bj = 0; bj < 2; ++bj) { const u32x4 w = *(const u32x4*)(RATIO + (size_t)(rowb + ai * HALF + m * 16) * 2048 + col + bj * HALF);
                    acc[ai][bj][m][0] *= (f32x4){bf_lo(w.x), bf_hi(w.x), bf_lo(w.y), bf_hi(w.y)}; acc[ai][bj][m][1] *= (f32x4){bf_lo(w.z), bf_hi(w.z), bf_lo(w.w), bf_hi(w.w)};
                    if (bj == 1 && (m & 1)) asm volatile("" ::: "memory"); }
    }
    __device__ __forceinline__ void operator()(const f32x4 (&acc)[2][2][4][2], const Unit& u, int wr, int wc, int, int) const {
        const int lane_ = lane_id_v(), fr = lane_ & 15, fq = lane_ >> 4;
        const int rowb = u.pm * BM + wr * 64 + fr, col = u.pn * 256 + wc * 32 + 8 * fq;
#pragma unroll
        for (int ai = 0; ai < 2; ++ai)
#pragma unroll
            for (int m = 0; m < 4; ++m)
#pragma unroll
                for (int bj = 0; bj < 2; ++bj) { const size_t o = (size_t)(rowb + ai * HALF + m * 16) * 2048 + col + bj * HALF; const u32x4 w = *(const u32x4*)(SB + o);
                    *(u32x4*)(H + o) = pack8_bf16(acc[ai][bj][m][0] * (f32x4){bf_lo(w.x), bf_hi(w.x), bf_lo(w.y), bf_hi(w.y)}, acc[ai][bj][m][1] * (f32x4){bf_lo(w.z), bf_hi(w.z), bf_lo(w.w), bf_hi(w.w)});
                    if (bj == 1 && (m & 1)) asm volatile("" ::: "memory"); }
    }
};
struct EpiOut {
    static constexpr bool PERM = true, AFTER_DRAIN = false, MID = false;
    const float *xp, *xs; bf16_t* XH; float* SS2;
    __device__ __forceinline__ void operator()(const f32x4 (&acc)[2][2][4][2], const Unit& u, int wr, int wc, int, int) const {
        const int lane_ = lane_id_v(), fr = lane_ & 15, fq = lane_ >> 4;
        const int rowb = u.pm * BM + wr * 64 + fr, col = u.pn * 256 + wc * 32 + 8 * fq;
#pragma unroll
        for (int ai = 0; ai < 2; ++ai)
#pragma unroll
            for (int m = 0; m < 4; ++m) { const int row = rowb + ai * HALF + m * 16; const float* xr = row < 16384 ? xp + (size_t)row * 2048 : (row < 16512 ? xs + (size_t)(row - 16384) * 2048 : nullptr); float s = 0.f;
#pragma unroll
                for (int bj = 0; bj < 2; ++bj) { f32x4 a = acc[ai][bj][m][0], b = acc[ai][bj][m][1];
#ifdef EPIOUT_XONLY
                    a = (f32x4){0.f, 0.f, 0.f, 0.f}; b = a;
#endif
                    if (xr) { a += *(const f32x4*)(xr + col + bj * HALF); b += *(const f32x4*)(xr + col + bj * HALF + 4); }
                    s += sq4(a) + sq4(b); *(u32x4*)(XH + (size_t)row * 2048 + col + bj * HALF) = pack8_f16(a, b); }
                s += __shfl_xor(s, 16); s += __shfl_xor(s, 32); if (fq == 0) SS2[(size_t)row * 32 + u.pn * 4 + wc] = s; }
    }
};
struct EpiQ {
    static constexpr bool PERM = true, AFTER_DRAIN = false, MID = false;
    bf16_t* QP;
    __device__ __forceinline__ void operator()(const f32x4 (&acc)[2][2][4][2], const Unit& u, int wr, int wc, int, int) const {
        const int lane_ = lane_id_v(), fr = lane_ & 15, fq = lane_ >> 4;
        const int rowb = u.pm * BM + wr * 64 + fr, col = u.pn * 256 + wc * 32 + 8 * fq;
#pragma unroll
        for (int ai = 0; ai < 2; ++ai)
#pragma unroll
            for (int m = 0; m < 4; ++m)
#pragma unroll
                for (int bj = 0; bj < 2; ++bj) *(u32x4*)(QP + (size_t)(rowb + ai * HALF + m * 16) * 2048 + col + bj * HALF) = pack8_f16(acc[ai][bj][m][0], acc[ai][bj][m][1]);
    }
};
template <class Epi, class Sched, bool ALIGN_EPI = false, bool SP2 = false, bool F16 = false>
__device__ __forceinline__ void gemm_phase(PG8_LAS unsigned char* lds, const Gemm g, const Sched& S, const Epi& E, const int wid_in) {
    const int lane = lane_id_v(), wid = wid_in, tid = wid * 64 + lane, wr = wid >> 2, wc = wid & 3, fr = lane & 15, fq = lane >> 4;
    const int K = g.K, nt = K / BK;
    unsigned voffA[2], voffB[2];
#pragma unroll
    for (int i = 0; i < 2; ++i) { int R, C; stage_rc(tid * 16 + i * 8192, R, C); const int Rb = Epi::PERM ? ((R & ~31) + perm32(R & 31)) : R;
        voffA[i] = (unsigned)(R * K + C) * 2u; voffB[i] = (unsigned)(Rb * K + C) * 2u; }
    const size_t kstep = (size_t)(BK * 2);
    const size_t hstep = (size_t)HALF * K * 2;
    const size_t tstep = 2 * hstep;
    const unsigned ldsw = (unsigned)wid * 1024u;
    const int aoff = lds_byte(wr * 64 + fr, fq * 8), boff = lds_byte(wc * 32 + fr, fq * 8);
#define PG8_SA(b, h) (((b) * 2 + (h)) * HTB)
#define PG8_SB(b, h) ((4 + (b) * 2 + (h)) * HTB)
#define PG8_STAGE(bufoff, gbase, voff) do { _Pragma("unroll") for (int _i = 0; _i < 2; ++_i) \
        __builtin_amdgcn_global_load_lds((const unsigned*)((const char*)(gbase) + (voff)[_i]), (PG8_LAS unsigned*)(lds + (bufoff) + ldsw + _i * 8192), 16, 0, 0); } while (0)
#define PG8_LDA(dst, b, h) do { _Pragma("unroll") for (int m = 0; m < 4; ++m) _Pragma("unroll") for (int k = 0; k < 2; ++k) dst[m][k] = *(const PG8_LAS bf16x8*)(lds + PG8_SA(b, h) + aoff + m * 2048 + k * 1024); } while (0)
#define PG8_LDB(dst, b, h) do { _Pragma("unroll") for (int n = 0; n < 2; ++n) _Pragma("unroll") for (int k = 0; k < 2; ++k) dst[n][k] = *(const PG8_LAS bf16x8*)(lds + PG8_SB(b, h) + boff + n * 2048 + k * 1024); } while (0)
#define PG8_MMA(ai, bj, At, Bt) do { __builtin_amdgcn_s_setprio(1); _Pragma("unroll") for (int m = 0; m < 4; ++m) _Pragma("unroll") for (int n = 0; n < 2; ++n) _Pragma("unroll") for (int k = 0; k < 2; ++k) \
        acc[ai][bj][m][n] = mma16<F16>(Bt[n][k], At[m][k], acc[ai][bj][m][n]); __builtin_amdgcn_s_setprio(0); } while (0)
#define PG8_WAIT_V(n) asm volatile("s_waitcnt vmcnt(" #n ")" ::: "memory")
#define PG8_WAIT_L(n) asm volatile("s_waitcnt lgkmcnt(" #n ")" ::: "memory")
#define PG8_BAR __builtin_amdgcn_s_barrier()
#define PG8_SCHED __builtin_amdgcn_sched_barrier(0)
    Unit cur, nxt; int ui = 0;
    if (!S.next(0, cur)) return;
    f32x4 acc[2][2][4][2];
#pragma unroll
    for (int a = 0; a < 2; ++a)
#pragma unroll
        for (int b = 0; b < 2; ++b)
#pragma unroll
            for (int m = 0; m < 4; ++m)
#pragma unroll
                for (int n = 0; n < 2; ++n) acc[a][b][m][n] = (f32x4){0.f, 0.f, 0.f, 0.f};
    bf16x8 At[4][2], B0[2][2], B1[2][2];
    const char* cA = (const char*)g.A + (size_t)cur.pm * tstep; const char* cB = (const char*)g.Bt + (size_t)cur.pn * tstep;
    S.a_ready(cur);
    if constexpr (SP2) {
        PG8_STAGE(PG8_SB(0, 0), cB, voffB); PG8_STAGE(PG8_SB(0, 1), cB + hstep, voffB); PG8_STAGE(PG8_SA(0, 0), cA, voffA); PG8_STAGE(PG8_SA(0, 1), cA + hstep, voffA);
        if (wr == 1) PG8_BAR;
        PG8_WAIT_V(2); PG8_BAR;
        PG8_STAGE(PG8_SB(1, 0), cB + kstep, voffB); PG8_STAGE(PG8_SA(1, 0), cA + kstep, voffA); PG8_STAGE(PG8_SB(1, 1), cB + hstep + kstep, voffB);
        PG8_WAIT_V(6); PG8_BAR;
    } else {
        PG8_STAGE(PG8_SB(0, 0), cB, voffB); PG8_STAGE(PG8_SA(0, 0), cA, voffA); PG8_STAGE(PG8_SB(0, 1), cB + hstep, voffB); PG8_STAGE(PG8_SA(0, 1), cA + hstep, voffA);
        if (wr == 1) PG8_BAR;
        PG8_WAIT_V(4); PG8_BAR;
        PG8_STAGE(PG8_SB(1, 0), cB + kstep, voffB); PG8_STAGE(PG8_SA(1, 0), cA + kstep, voffA); PG8_STAGE(PG8_SB(1, 1), cB + hstep + kstep, voffB);
        PG8_WAIT_V(6); PG8_BAR;
    }
    for (;;) {
        const bool has_next = S.next(ui + 1, nxt);
        const char* nA = has_next ? (const char*)g.A + (size_t)nxt.pm * tstep : cA; const char* nB = has_next ? (const char*)g.Bt + (size_t)nxt.pn * tstep : cB;
        for (int t = 0; t < nt; t += 2) {
            const bool last = (t == nt - 2);
            const char* a1 = cA + (size_t)(t + 1) * kstep;
            const char* a2 = last ? nA : cA + (size_t)(t + 2) * kstep; const char* b2 = last ? nB : cB + (size_t)(t + 2) * kstep;
            const char* a3 = a2 + kstep; const char* b3 = b2 + kstep;
            if (last && has_next) S.a_ready(nxt);
            if constexpr (Epi::MID) { if (t == (nt >> 1)) E.mid(acc, cur, wr, wc, fr, fq); }
            if constexpr (SP2) {
            PG8_LDB(B0, 0, 0); PG8_LDB(B1, 0, 1); PG8_SCHED; PG8_LDA(At, 0, 0); PG8_STAGE(PG8_SA(1, 1), a1 + hstep, voffA);
            PG8_WAIT_V(8); PG8_WAIT_L(0); PG8_BAR; PG8_MMA(0, 0, At, B0); PG8_MMA(0, 1, At, B1); PG8_BAR; PG8_SCHED;
            PG8_LDA(At, 0, 1); PG8_STAGE(PG8_SB(0, 0), b2, voffB); PG8_STAGE(PG8_SB(0, 1), b2 + hstep, voffB); PG8_STAGE(PG8_SA(0, 0), a2, voffA);
            PG8_WAIT_V(8); PG8_WAIT_L(0); PG8_BAR; PG8_MMA(1, 0, At, B0); PG8_MMA(1, 1, At, B1); PG8_BAR; PG8_SCHED;
            PG8_LDB(B0, 1, 0); PG8_LDB(B1, 1, 1); PG8_SCHED; PG8_LDA(At, 1, 0); PG8_STAGE(PG8_SA(0, 1), a2 + hstep, voffA);
            PG8_WAIT_V(8); PG8_WAIT_L(0); PG8_BAR; PG8_MMA(0, 0, At, B0); PG8_MMA(0, 1, At, B1); PG8_BAR; PG8_SCHED;
            PG8_LDA(At, 1, 1); PG8_STAGE(PG8_SB(1, 0), b3, voffB); PG8_STAGE(PG8_SB(1, 1), b3 + hstep, voffB); PG8_STAGE(PG8_SA(1, 0), a3, voffA);
            PG8_WAIT_V(8); PG8_WAIT_L(0); PG8_BAR; PG8_MMA(1, 0, At, B0); PG8_MMA(1, 1, At, B1); PG8_BAR; PG8_SCHED;
            } else {
            PG8_LDB(B0, 0, 0); PG8_SCHED; PG8_LDA(At, 0, 0); PG8_STAGE(PG8_SA(1, 1), a1 + hstep, voffA);
            PG8_WAIT_L(8); PG8_BAR; PG8_WAIT_L(0); PG8_MMA(0, 0, At, B0); PG8_BAR; PG8_SCHED;
            PG8_LDB(B1, 0, 1); PG8_STAGE(PG8_SB(0, 0), b2, voffB);
            PG8_BAR; PG8_WAIT_L(0); PG8_MMA(0, 1, At, B1); PG8_BAR;
            PG8_LDA(At, 0, 1); PG8_STAGE(PG8_SA(0, 0), a2, voffA);
            PG8_BAR; PG8_WAIT_L(0); PG8_MMA(1, 0, At, B0); PG8_BAR; PG8_SCHED;
            PG8_STAGE(PG8_SB(0, 1), b2 + hstep, voffB);
            PG8_WAIT_V(6); PG8_BAR; PG8_MMA(1, 1, At, B1); PG8_BAR;
            PG8_LDB(B0, 1, 0); PG8_SCHED; PG8_LDA(At, 1, 0); PG8_STAGE(PG8_SA(0, 1), a2 + hstep, voffA);
            PG8_WAIT_L(8); PG8_BAR; PG8_WAIT_L(0); PG8_MMA(0, 0, At, B0); PG8_BAR; PG8_SCHED;
            PG8_LDB(B1, 1, 1); PG8_STAGE(PG8_SB(1, 0), b3, voffB);
            PG8_BAR; PG8_WAIT_L(0); PG8_MMA(0, 1, At, B1); PG8_BAR;
            PG8_LDA(At, 1, 1); PG8_STAGE(PG8_SA(1, 0), a3, voffA);
            PG8_BAR; PG8_WAIT_L(0); PG8_MMA(1, 0, At, B0); PG8_BAR; PG8_SCHED;
            PG8_STAGE(PG8_SB(1, 1), b3 + hstep, voffB);
            PG8_WAIT_V(6); PG8_BAR; PG8_MMA(1, 1, At, B1); PG8_BAR;
            }
        }
        if constexpr (ALIGN_EPI) { if (wr == 0) PG8_BAR; }
        if constexpr (!Epi::AFTER_DRAIN) { E(acc, cur, wr, wc, fr, fq); S.done(cur); }
        if (!has_next) break;
#pragma unroll
        for (int a = 0; a < 2; ++a)
#pragma unroll
            for (int b = 0; b < 2; ++b)
#pragma unroll
                for (int m = 0; m < 4; ++m)
#pragma unroll
                    for (int n = 0; n < 2; ++n) acc[a][b][m][n] = (f32x4){0.f, 0.f, 0.f, 0.f};
        cur = nxt; cA = nA; cB = nB; ++ui;
        if constexpr (ALIGN_EPI) { if (wr == 1) PG8_BAR; }
    }
    PG8_WAIT_V(0);
    if constexpr (!ALIGN_EPI) { if (wr == 0) PG8_BAR; }
    PG8_BAR;
    if constexpr (Epi::AFTER_DRAIN) { E.fused(acc, cur, wr, wc, fr, fq, lds, wid, lane); S.done(cur); }
#undef PG8_SA
#undef PG8_SB
#undef PG8_STAGE
#undef PG8_LDA
#undef PG8_LDB
#undef PG8_MMA
#undef PG8_WAIT_V
#undef PG8_WAIT_L
#undef PG8_BAR
#undef PG8_SCHED
}
}
#define GAS __attribute__((address_space(1)))
#define LAS __attribute__((address_space(3)))
typedef unsigned short bf16;
typedef unsigned v4u __attribute__((ext_vector_type(4)));
typedef float f32x4 __attribute__((ext_vector_type(4)));
typedef short bf16x8 __attribute__((ext_vector_type(8)));
typedef GAS unsigned gu32;
typedef GAS unsigned long long gu64;
#define RLX_AGENT __ATOMIC_RELAXED, __HIP_MEMORY_SCOPE_AGENT
#define LDS_WAIT() asm volatile("s_waitcnt lgkmcnt(0)" ::: "memory")
#define VM_WAIT() asm volatile("s_waitcnt vmcnt(0)" ::: "memory")
__device__ __forceinline__ unsigned long long rt() { return __builtin_amdgcn_s_memrealtime(); }
__device__ __forceinline__ unsigned f2bf(float f) { unsigned u = __builtin_bit_cast(unsigned, f); return (u + 0x7fffu + ((u >> 16) & 1u)) >> 16; }
__device__ __forceinline__ unsigned pk2(float lo, float hi) { return f2bf(lo) | (f2bf(hi) << 16); }

#define XB_TMO      128
#define XB_XCNT(j)  (256  + 64 * (j))
#define XB_XSUB(j)  (1280 + 64 * (j))
#define XB_XGEN(j)  (2304 + 64 * (j))
#define XB_TOP      3328
#define XB_TOPGEN   3392
#define XCD_BAR_WORDS 3456
#define XB_SPIN_CAP (1u << 18)

__device__ __forceinline__ unsigned xb_ld(unsigned* p)              { return __hip_atomic_load(p, __ATOMIC_RELAXED, __HIP_MEMORY_SCOPE_AGENT); }
__device__ __forceinline__ unsigned xb_add(unsigned* p, unsigned v) { return __hip_atomic_fetch_add(p, v, __ATOMIC_RELAXED, __HIP_MEMORY_SCOPE_AGENT); }
__device__ __forceinline__ unsigned xb_xcc_id() { return (unsigned)__builtin_amdgcn_s_getreg((3 << 11) | 20) & 0xFu; }
#define XB_SPIN(cond, bar) do { unsigned _sp = 0; while (cond) { __builtin_amdgcn_s_sleep(1); \
    if ((++_sp & 255u) == 0u) { if (xb_ld(&(bar)[XB_TMO])) break; if (_sp > XB_SPIN_CAP) { atomicAdd(&(bar)[XB_TMO], 1u); break; } } } } while (0)

struct XcdBarrier {
    unsigned* bar; unsigned x;
    volatile LAS unsigned* st;
};

__device__ __forceinline__ XcdBarrier xcd_barrier_post(unsigned* bar, volatile LAS unsigned* st) {
    XcdBarrier b; b.bar = bar; b.x = xb_xcc_id(); b.st = st;
    if (threadIdx.x == 0) (void)xb_add(&bar[XB_XCNT(b.x)], 1u);
    return b;
}
__device__ __forceinline__ void xcd_barrier_complete(unsigned* bar, unsigned x, unsigned& nloc, unsigned& nx) {
    const unsigned G = gridDim.x * gridDim.y * gridDim.z;
    unsigned sum, cnt, mine, sp = 0u;
    for (;;) {
        sum = 0u; cnt = 0u; mine = 0u;
#pragma unroll
        for (unsigned j = 0; j < 16; ++j) { const unsigned c = xb_ld(&bar[XB_XCNT(j)]); sum += c; cnt += (c > 0u) ? 1u : 0u; mine = (j == x) ? c : mine; }
        if (sum == G) break;
        __builtin_amdgcn_s_sleep(1);
        if ((++sp & 255u) == 0u) { if (xb_ld(&bar[XB_TMO])) break; if (sp > XB_SPIN_CAP) { atomicAdd(&bar[XB_TMO], 1u); break; } }
    }
    nloc = mine > 0u ? mine : 1u; nx = cnt > 0u ? cnt : 1u;
}

__device__ __forceinline__ void xcd_barrier(const XcdBarrier& b) {
    asm volatile("s_waitcnt vmcnt(0)" ::: "memory");
    __syncthreads();
    if (threadIdx.x == 0) {
        unsigned* bar = b.bar;
        __builtin_amdgcn_s_waitcnt(0);
        unsigned nloc = b.st[0], nx = b.st[1];
        if (nloc == 0u) { xcd_barrier_complete(bar, b.x, nloc, nx); b.st[0] = nloc; b.st[1] = nx; }
        const unsigned old = xb_add(&bar[XB_XSUB(b.x)], 1u);
        const unsigned gen = old / nloc;
        if (old + 1u == (gen + 1u) * nloc) {
            __builtin_amdgcn_fence(__ATOMIC_RELEASE, "agent");
            asm volatile("s_waitcnt vmcnt(0)" ::: "memory");
            const unsigned og = xb_add(&bar[XB_TOP], 1u);
            const unsigned tg = og / nx;
            if (og + 1u == (tg + 1u) * nx) xb_add(&bar[XB_TOPGEN], 1u);
            else XB_SPIN(xb_ld(&bar[XB_TOPGEN]) == tg, bar);
            __builtin_amdgcn_fence(__ATOMIC_ACQUIRE, "agent");
            xb_add(&bar[XB_XGEN(b.x)], 1u);
            asm volatile("s_waitcnt vmcnt(0)" ::: "memory");
        } else {
            XB_SPIN(xb_ld(&bar[XB_XGEN(b.x)]) == gen, bar);
            __builtin_amdgcn_fence(__ATOMIC_ACQUIRE, "agent");
            asm volatile("s_waitcnt vmcnt(0)" ::: "memory");
        }
    }
    __syncthreads();
}
constexpr int NWAVES = 8, NTHR = 512;
constexpr int DM = 2048, SEQ = 2048, NBATCH = 8, TDEC = 16, MPROMPT = NBATCH * SEQ  , MSAMPLE = NBATCH * TDEC  , MREAL = MPROMPT + MSAMPLE  , MPAD = 16640  ;
constexpr int DIN = 7424, DATTN = 1024, DSGU = 1024, WINDOW = 128, CHUNK = 64, NHEADS = 16, HD = 64;
constexpr int NEXP = 16384, PEER_H = 8, PEER_K = 16;
constexpr float EPS = 1e-6f, LOG2E = 1.4426950408889634f;
constexpr size_t OUT_Y = 0, OUT_KP = (size_t)MREAL * DM, OUT_VP = OUT_KP + 131072, OUT_KS = OUT_VP + 131072, OUT_VS = OUT_KS + 16384, OUT_SGU = OUT_VS + 16384, OUT_TOTAL = OUT_SGU + 131072;
constexpr size_t MiB = 1u << 20;
constexpr size_t WS_CTL = 0, CTL_ZERO_BYTES = 1 * MiB;
constexpr size_t WS_WIN = 1 * MiB;
constexpr size_t WS_WAB = 30 * MiB;
constexpr size_t WS_WOUT = 38 * MiB;
constexpr size_t WS_WQ = 46 * MiB;
constexpr size_t WS_KEYS = 54 * MiB;
constexpr size_t WS_WSM = 54 * MiB + 512 * 1024;
constexpr size_t WS_SS1 = 55 * MiB;
constexpr size_t WS_SS2 = 57 * MiB;
constexpr size_t WS_EU = 60 * MiB, WS_EV = 124 * MiB;
constexpr size_t WS_RA = 188 * MiB;
constexpr size_t WS_RB = 253 * MiB;
constexpr size_t WS_Q = WS_RB, WS_KV = WS_Q + (size_t)MPAD * 1024 * 2, WS_U = WS_KV + (size_t)MPAD * 256 * 2, WS_VS = WS_U + (size_t)MPAD * 1024 * 2;
constexpr size_t WS_RC = 359 * MiB;
constexpr size_t WS_RATIO = WS_RC, WS_SB = WS_RC + 65 * MiB, WS_END = WS_RC + 130 * MiB;
static_assert(WS_VS + (size_t)MPAD * 1024 * 2 <= WS_RC && WS_END == 489 * MiB, "d_ws map");
constexpr int CW_BAR = 4096;
constexpr int RING_OFF = 0, RING_BYTES = 131072;
constexpr int LDSCTL_OFF = RING_BYTES, MISC_OFF = LDSCTL_OFF + 320;
constexpr int LDS_BYTES = 147456;
struct Frame {
    LAS unsigned char* lds; volatile LAS unsigned* MISC; gu32* ctl;
    int wave, vcu, G;
    const float *x_prompt, *x_sample, *cache_k, *cache_v, *norm_mix_g, *w_in, *sgu_norm_g, *sgu_w_s, *sgu_b_s, *sinks, *rel_tab, *w_pa, *w_pb, *w_out, *norm_ffn_g, *w_query, *sub_keys, *exp_u, *exp_v, *norm_final_g;
    float* out; unsigned char* ws;
};
__device__ __forceinline__ float wave_sum(float v) {
#pragma unroll
    for (int o = 1; o < 64; o <<= 1) v += __shfl_xor(v, o);
    return v;
}
__device__ __forceinline__ unsigned pkb(float lo, float hi) { return pg8::pk_bf16(lo, hi); }
__device__ __forceinline__ unsigned pkh(float lo, float hi) { return pg8::pk_f16(lo, hi); }
template <bool F16>
__device__ __forceinline__ void p0_transpose_item(const float* W, int N, bf16* WT, int kpitch, int koff, int drow0, int k0, int n0, const float* kscale, LAS float* scr, int lane) {
#pragma unroll 8
    for (int i = 0; i < 32; ++i) { const int kk = 2 * i + (lane >> 5); scr[kk * 33 + (lane & 31)] = W[(size_t)(k0 + kk) * N + n0 + (lane & 31)]; }
    LDS_WAIT(); asm volatile("" ::: "memory");
    const int c = lane & 7;
    float sc[8];
#pragma unroll
    for (int q = 0; q < 8; ++q) sc[q] = kscale ? kscale[k0 + 8 * c + q] : 1.f;
#pragma unroll
    for (int j = 0; j < 4; ++j) { const int n = (lane >> 3) + 8 * j; const LAS float* s = scr + (8 * c) * 33 + n;
        float v[8];
#pragma unroll
        for (int q = 0; q < 8; ++q) v[q] = s[q * 33] * sc[q];
        v4u o;
        if (F16) { o.x = pkh(v[0], v[1]); o.y = pkh(v[2], v[3]); o.z = pkh(v[4], v[5]); o.w = pkh(v[6], v[7]); }
        else     { o.x = pkb(v[0], v[1]); o.y = pkb(v[2], v[3]); o.z = pkb(v[4], v[5]); o.w = pkb(v[6], v[7]); }
        *(GAS v4u*)(WT + (size_t)(drow0 + n) * kpitch + koff + k0 + 8 * c) = o; }
    LDS_WAIT(); asm volatile("" ::: "memory");
}
__device__ __forceinline__ int win_row_of_col(int n) {
    if (n < 3328) return n;
    if (n < 5376) { const int q = n - 3328; return 3328 + (q >> 7) * 256 + (q & 127); }
    const int q = n - 5376; return 3328 + (q >> 7) * 256 + 128 + (q & 127);
}
__device__ __forceinline__ void rms_row_to_bf16(const float* xrow, const float* g, bf16* orow, int lane) {
    const GAS f32x4* xr = (const GAS f32x4*)xrow + lane; const GAS f32x4* gr = (const GAS f32x4*)g + lane;
    f32x4 v[8]; float s = 0.f;
#pragma unroll
    for (int j = 0; j < 8; ++j) { v[j] = xr[64 * j]; s += (v[j].x * v[j].x + v[j].y * v[j].y) + (v[j].z * v[j].z + v[j].w * v[j].w); }
    const float r = 1.0f / sqrtf(wave_sum(s) * (1.f / DM) + EPS);
    GAS unsigned long long* o8 = (GAS unsigned long long*)orow + lane;
#pragma unroll
    for (int j = 0; j < 8; ++j) { const f32x4 gg = gr[64 * j]; o8[64 * j] = (unsigned long long)pkb(v[j].x * r * gg.x, v[j].y * r * gg.y) | ((unsigned long long)pkb(v[j].z * r * gg.z, v[j].w * r * gg.w) << 32); }
}
__device__ __forceinline__ void p0_prologue(Frame& F) {
    const int lane = pg8::lane_id_v(), tid = F.wave * 64 + lane;
    LAS float* scr = (LAS float*)(F.lds + RING_OFF + F.wave * 16384);
    const int gw = F.vcu * NWAVES + F.wave, NGW = F.G * NWAVES;
    bf16* WIN = (bf16*)(F.ws + WS_WIN); bf16* WAB = (bf16*)(F.ws + WS_WAB); bf16* WOUT = (bf16*)(F.ws + WS_WOUT); bf16* WQ = (bf16*)(F.ws + WS_WQ);
    constexpr int I_IN = 32 * 232, I_PA = 16 * 64, I_OUT = 32 * 64;
    constexpr int NITEMS = I_IN + 2 * I_PA + 2 * I_OUT;
    for (int it = gw; it < NITEMS; it += NGW) {
        int r = it;
        if (r < I_IN) { const int kb = r / 232, nb = r % 232; p0_transpose_item<false>(F.w_in, DIN, WIN, 2048, 0, win_row_of_col(32 * nb), 64 * kb, 32 * nb, nullptr, scr, lane); continue; } r -= I_IN;
        if (r < I_PA) { const int kb = r / 64, nb = r % 64; p0_transpose_item<false>(F.w_pa, 2048, WAB, 2048, 0, 32 * nb, 64 * kb, 32 * nb, nullptr, scr, lane); continue; } r -= I_PA;
        if (r < I_PA) { const int kb = r / 64, nb = r % 64; p0_transpose_item<false>(F.w_pb, 2048, WAB, 2048, 1024, 32 * nb, 64 * kb, 32 * nb, nullptr, scr, lane); continue; } r -= I_PA;
        if (r < I_OUT) { const int kb = r / 64, nb = r % 64; p0_transpose_item<false>(F.w_out, 2048, WOUT, 2048, 0, 32 * nb, 64 * kb, 32 * nb, nullptr, scr, lane); continue; } r -= I_OUT;
        { const int kb = r / 64, nb = r % 64; p0_transpose_item<true>(F.w_query, 2048, WQ, 2048, 0, 32 * nb, 64 * kb, 32 * nb, F.norm_ffn_g, scr, lane); }
    }
    bf16* XN = (bf16*)(F.ws + WS_RA);
    for (int m = gw; m < MPAD; m += NGW) {
        if (m < MPROMPT) rms_row_to_bf16(F.x_prompt + (size_t)m * DM, F.norm_mix_g, XN + (size_t)m * DM, lane);
        else if (m < MREAL) rms_row_to_bf16(F.x_sample + (size_t)(m - MPROMPT) * DM, F.norm_mix_g, XN + (size_t)m * DM, lane);
        else { GAS v4u* o = (GAS v4u*)(XN + (size_t)m * DM) + lane;
#pragma unroll
            for (int j = 0; j < 4; ++j) o[64 * j] = (v4u){0u, 0u, 0u, 0u}; }
    }
    const size_t gt = (size_t)F.vcu * NTHR + tid, NT = (size_t)F.G * NTHR;
    { bf16* KH = (bf16*)(F.ws + WS_KEYS);
        for (size_t c = gt; c < 262144 / 8; c += NT) { const f32x4 a = *(const GAS f32x4*)(F.sub_keys + c * 8), b = *(const GAS f32x4*)(F.sub_keys + c * 8 + 4);
            *(GAS v4u*)(KH + c * 8) = (v4u){pkh(a.x, a.y), pkh(a.z, a.w), pkh(b.x, b.y), pkh(b.z, b.w)}; } }
    { bf16* WSM = (bf16*)(F.ws + WS_WSM);
        for (size_t c = gt; c < 131072 / 8; c += NT) { f32x4 a = *(const GAS f32x4*)(F.sgu_w_s + c * 8), b = *(const GAS f32x4*)(F.sgu_w_s + c * 8 + 4);
            const int t = (int)((c * 8) >> 7) & 127, s0 = (int)(c * 8) & 127;
#pragma unroll
            for (int e = 0; e < 4; ++e) { if (s0 + e > t) a[e] = 0.f; if (s0 + 4 + e > t) b[e] = 0.f; }
            *(GAS v4u*)(WSM + c * 8) = (v4u){pkb(a.x, a.y), pkb(a.z, a.w), pkb(b.x, b.y), pkb(b.z, b.w)}; } }
    { bf16* EU = (bf16*)(F.ws + WS_EU); bf16* EV = (bf16*)(F.ws + WS_EV);
        for (size_t c = gt; c < (size_t)NEXP * DM / 8; c += NT) { const int d0 = (int)((c * 8) & (DM - 1));
            f32x4 a = *(const GAS f32x4*)(F.exp_u + c * 8), b = *(const GAS f32x4*)(F.exp_u + c * 8 + 4); const f32x4 ga = *(const GAS f32x4*)(F.norm_ffn_g + d0), gb = *(const GAS f32x4*)(F.norm_ffn_g + d0 + 4);
            a *= ga; b *= gb;
            *(GAS v4u*)(EU + c * 8) = (v4u){pkh(a.x, a.y), pkh(a.z, a.w), pkh(b.x, b.y), pkh(b.z, b.w)};
            const f32x4 p = *(const GAS f32x4*)(F.exp_v + c * 8), q = *(const GAS f32x4*)(F.exp_v + c * 8 + 4);
            *(GAS v4u*)(EV + c * 8) = (v4u){pkh(p.x, p.y), pkh(p.z, p.w), pkh(q.x, q.y), pkh(q.z, q.w)}; } }
}
typedef float f32x16 __attribute__((ext_vector_type(16)));
typedef short s16x4 __attribute__((ext_vector_type(4)));
typedef short v4i16_t __attribute__((ext_vector_type(4)));
__device__ __forceinline__ int crow(int r, int hi) { return (r & 3) + 8 * (r >> 2) + 4 * hi; }
__device__ __forceinline__ s16x4 vtr(const LAS unsigned char* p) { return __builtin_bit_cast(s16x4, __builtin_amdgcn_ds_read_tr16_b64_v4i16((LAS v4i16_t*)p)); }
__device__ __forceinline__ bf16 bf1(float x) { return (bf16)(pkb(x, 0.f) & 0xffffu); }
__device__ __forceinline__ float bf2f(bf16 b) { return __builtin_bit_cast(float, (unsigned)b << 16); }
__device__ __forceinline__ float half_max(float m) { auto rr = __builtin_amdgcn_permlane32_swap(__builtin_bit_cast(unsigned, m), __builtin_bit_cast(unsigned, m), false, false); return fmaxf(__builtin_bit_cast(float, rr[0]), __builtin_bit_cast(float, rr[1])); }
__device__ __forceinline__ float half_sum(float m) { auto rr = __builtin_amdgcn_permlane32_swap(__builtin_bit_cast(unsigned, m), __builtin_bit_cast(unsigned, m), false, false); return __builtin_bit_cast(float, rr[0]) + __builtin_bit_cast(float, rr[1]); }
constexpr int P2_KL = 0, P2_VL = 24576, P2_BIAS = 49152, P2_OST = 65536, P2_GL = 0, P2_RL = 32768;
constexpr int N_ATT_UNITS = 512 + 16, N_SGU_UNITS = 1024 + 64;

__device__ __forceinline__ void attn_unit(Frame& F, int uid) {
    const int lane = pg8::lane_id_v(), w = F.wave, tid = w * 64 + lane, r = lane & 31, h = lane >> 5;
    LAS unsigned char* KL = F.lds + P2_KL; LAS unsigned char* VL = F.lds + P2_VL; const LAS float* BL = (const LAS float*)(F.lds + P2_BIAS); LAS unsigned char* OST = F.lds + P2_OST + w * 4096;
    const bf16* Q = (const bf16*)(F.ws + WS_Q); const bf16* KV = (const bf16*)(F.ws + WS_KV); bf16* OS = (bf16*)(F.ws + WS_RA);
    const bool sample = uid >= 512; int b, c = 0, kvh, qrow0, nqb, jlo, jhi;
    if (!sample) { b = uid >> 6; c = (uid >> 1) & 31; kvh = uid & 1; qrow0 = b * SEQ + c * CHUNK; nqb = 2; jlo = 128 - 64 * c; if (jlo < 0) jlo = 0; jhi = 192; }
    else { const int s = uid - 512; b = s >> 1; kvh = s & 1; qrow0 = MPROMPT + b * TDEC; nqb = 1; jlo = 0; jhi = 144; }
#pragma unroll
    for (int i = 0; i < 3; ++i) { const int idx = tid + 512 * i, key = idx >> 3, ch = idx & 7; v4u kq = (v4u){0u, 0u, 0u, 0u}, vq = (v4u){0u, 0u, 0u, 0u};
        if (!sample) { const int pos = c * CHUNK - WINDOW + key; if (pos >= 0) { const bf16* rp = KV + (size_t)(b * SEQ + pos) * 256 + kvh * 64 + ch * 8; kq = *(const GAS v4u*)rp; vq = *(const GAS v4u*)(rp + 128); } }
        else if (key < 128) { const size_t o = ((size_t)(b * WINDOW + key) * 2 + kvh) * 64 + ch * 8;
            const f32x4 a = *(const GAS f32x4*)(F.cache_k + o), a2 = *(const GAS f32x4*)(F.cache_k + o + 4), p = *(const GAS f32x4*)(F.cache_v + o), p2 = *(const GAS f32x4*)(F.cache_v + o + 4);
            kq = (v4u){pkb(a.x, a.y), pkb(a.z, a.w), pkb(a2.x, a2.y), pkb(a2.z, a2.w)}; vq = (v4u){pkb(p.x, p.y), pkb(p.z, p.w), pkb(p2.x, p2.y), pkb(p2.z, p2.w)}; }
        else if (key < 144) { const bf16* rp = KV + (size_t)(MPROMPT + b * TDEC + key - 128) * 256 + kvh * 64 + ch * 8; kq = *(const GAS v4u*)rp; vq = *(const GAS v4u*)(rp + 128); }
        *(LAS v4u*)(KL + ch * 3072 + key * 16) = kq; *(LAS v4u*)(VL + (ch >> 2) * 12288 + key * 64 + (ch & 3) * 16) = vq; }
    __syncthreads();
    const int hd = kvh * 8 + w; const float sink2 = F.sinks[hd] * LOG2E; const LAS float* bl = BL + hd * 256;
    const int vlane = (4 * h + ((lane & 15) >> 2)) * 64 + (((lane >> 4) & 1) * 16 + (lane & 3) * 4) * 2;
    for (int qb = 0; qb < nqb; ++qb) {
        const int qi = qb * 32 + r; const int qrow = qrow0 + (sample ? (r & 15) : qi);
        bf16x8 qr[4];
#pragma unroll
        for (int ks = 0; ks < 4; ++ks) qr[ks] = *(const GAS bf16x8*)(Q + (size_t)qrow * 1024 + hd * 64 + ks * 16 + h * 8);
        f32x16 S[6];
#pragma unroll
        for (int kb = 0; kb < 6; ++kb) { f32x16 a = {};
#pragma unroll
            for (int ks = 0; ks < 4; ++ks) { const bf16x8 kf = *(const LAS bf16x8*)(KL + (2 * ks + h) * 3072 + (kb * 32 + r) * 16); a = __builtin_amdgcn_mfma_f32_32x32x16_bf16(kf, qr[ks], a, 0, 0, 0); }
            S[kb] = a; asm volatile("" ::: "memory"); }
        float mx = -1e30f;
#pragma unroll
        for (int kb = 0; kb < 6; ++kb)
#pragma unroll
            for (int i = 0; i < 16; ++i) { const int j = kb * 32 + crow(i, h); float t = S[kb][i] + bl[j - qi + 63]; t = (j >= jlo && j < jhi) ? t : -1e30f; S[kb][i] = t; mx = fmaxf(mx, t); }
        mx = fmaxf(half_max(mx), sink2);
        float l = 0.f;
#pragma unroll
        for (int kb = 0; kb < 6; ++kb)
#pragma unroll
            for (int i = 0; i < 16; ++i) { const float e = __builtin_amdgcn_exp2f(S[kb][i] - mx); S[kb][i] = e; l += e; }
        l = half_sum(l) + __builtin_amdgcn_exp2f(sink2 - mx);
        const float inv = 1.0f / l;
        bf16x8 pa[6][2];
#pragma unroll
        for (int kb = 0; kb < 6; ++kb)
#pragma unroll
            for (int s = 0; s < 2; ++s) { v4u wv; wv.x = pkb(S[kb][8 * s + 0] * inv, S[kb][8 * s + 1] * inv); wv.y = pkb(S[kb][8 * s + 2] * inv, S[kb][8 * s + 3] * inv);
                wv.z = pkb(S[kb][8 * s + 4] * inv, S[kb][8 * s + 5] * inv); wv.w = pkb(S[kb][8 * s + 6] * inv, S[kb][8 * s + 7] * inv); pa[kb][s] = __builtin_bit_cast(bf16x8, wv); }
        f32x16 O[2];
#pragma unroll
        for (int db = 0; db < 2; ++db) { f32x16 o = {};
#pragma unroll
            for (int kb = 0; kb < 6; ++kb)
#pragma unroll
                for (int s = 0; s < 2; ++s) { const LAS unsigned char* vp = VL + db * 12288 + (kb * 32 + s * 16) * 64 + vlane; const s16x4 lo = vtr(vp), hi = vtr(vp + 8 * 64);
                    const bf16x8 vf = (bf16x8){lo[0], lo[1], lo[2], lo[3], hi[0], hi[1], hi[2], hi[3]}; o = __builtin_amdgcn_mfma_f32_32x32x16_bf16(pa[kb][s], vf, o, 0, 0, 0); }
            O[db] = o; }
#pragma unroll
        for (int db = 0; db < 2; ++db)
#pragma unroll
            for (int i = 0; i < 16; ++i) *(LAS bf16*)(OST + (crow(i, h) * 64 + db * 32 + r) * 2) = bf1(O[db][i]);
        LDS_WAIT(); asm volatile("" ::: "memory");
#pragma unroll
        for (int it = 0; it < 4; ++it) { const int row = it * 8 + (lane >> 3), ch = lane & 7; const v4u v = *(const LAS v4u*)(OST + row * 128 + ch * 16);
            if (!sample || row < TDEC) *(GAS v4u*)(OS + (size_t)(qrow0 + qb * 32 + row) * 2048 + hd * 64 + ch * 8) = v; }
        LDS_WAIT(); asm volatile("" ::: "memory");
    }
    __syncthreads();
}

__device__ __forceinline__ void sgu_unit(Frame& F, int uid) {
    const int lane = pg8::lane_id_v(), w = F.wave, tid = w * 64 + lane, r = lane & 31, h = lane >> 5;
    LAS unsigned char* GL = F.lds + P2_GL; LAS float* RL = (LAS float*)(F.lds + P2_RL);
    const bf16* VS = (const bf16*)(F.ws + WS_VS); const bf16* U = (const bf16*)(F.ws + WS_U); const bf16* WSM = (const bf16*)(F.ws + WS_WSM); const float* SS1 = (const float*)(F.ws + WS_SS1); bf16* OS = (bf16*)(F.ws + WS_RA);
    const bool sample = uid >= 1024; int b, g, row0, nv;
    if (!sample) { b = uid >> 7; const int blk = (uid >> 3) & 15; g = uid & 7; row0 = b * SEQ + blk * 128; nv = 128; }
    else { const int s = uid - 1024; b = s >> 3; g = s & 7; row0 = MPROMPT + b * TDEC; nv = TDEC; }
    if (tid < 128) { float rr = 0.f;
        if (tid < nv) { const GAS f32x4* p = (const GAS f32x4*)(SS1 + (size_t)(row0 + tid) * 16); const f32x4 a = p[0], a2 = p[1], a3 = p[2], a4 = p[3];
            const float s = ((a.x + a.y) + (a.z + a.w)) + ((a2.x + a2.y) + (a2.z + a2.w)) + ((a3.x + a3.y) + (a3.z + a3.w)) + ((a4.x + a4.y) + (a4.z + a4.w)); rr = 1.0f / sqrtf(s * (1.f / DSGU) + EPS); }
        RL[tid] = rr; }
    __syncthreads();
#pragma unroll
    for (int i = 0; i < 4; ++i) { const int idx = tid + 512 * i, s = idx >> 4, ch = idx & 15; v4u o = (v4u){0u, 0u, 0u, 0u};
        if (s < nv) { const v4u wv = *(const GAS v4u*)(VS + (size_t)(row0 + s) * 1024 + g * 128 + ch * 8); const float rr = RL[s];
            float f[8] = {pg8::bf_lo(wv.x) * rr, pg8::bf_hi(wv.x) * rr, pg8::bf_lo(wv.y) * rr, pg8::bf_hi(wv.y) * rr, pg8::bf_lo(wv.z) * rr, pg8::bf_hi(wv.z) * rr, pg8::bf_lo(wv.w) * rr, pg8::bf_hi(wv.w) * rr};
            o = (v4u){pkb(f[0], f[1]), pkb(f[2], f[3]), pkb(f[4], f[5]), pkb(f[6], f[7])};
            if (sample) { const f32x4 g0 = *(const GAS f32x4*)(F.sgu_norm_g + g * 128 + ch * 8), g1 = *(const GAS f32x4*)(F.sgu_norm_g + g * 128 + ch * 8 + 4); float* dst = F.out + OUT_SGU + (size_t)(b * TDEC + s) * 1024 + g * 128 + ch * 8;
                *(GAS f32x4*)dst = (f32x4){f[0] * g0.x, f[1] * g0.y, f[2] * g0.z, f[3] * g0.w}; *(GAS f32x4*)(dst + 4) = (f32x4){f[4] * g1.x, f[5] * g1.y, f[6] * g1.z, f[7] * g1.w}; } }
        *(LAS v4u*)(GL + (ch >> 2) * 8192 + s * 64 + (ch & 3) * 16) = o; }
    __syncthreads();
    const int wr = w >> 1, wc = w & 1;
    if (32 * wr < nv) {
        f32x16 acc[2]; acc[0] = f32x16{}; acc[1] = f32x16{};
        const int nks = 2 * (wr + 1);
        const int glane = (8 * h + ((lane & 15) >> 2)) * 64 + (((lane >> 4) & 1) * 16 + (lane & 3) * 4) * 2;
        for (int ks = 0; ks < nks; ++ks) { const bf16x8 a = *(const GAS bf16x8*)(WSM + (size_t)(g * 128 + 32 * wr + r) * 128 + 16 * ks + 8 * h);
#pragma unroll
            for (int cb = 0; cb < 2; ++cb) { const LAS unsigned char* gp = GL + (2 * wc + cb) * 8192 + (16 * ks) * 64 + glane; const s16x4 lo = vtr(gp), hi = vtr(gp + 4 * 64);
                const bf16x8 bb = (bf16x8){lo[0], lo[1], lo[2], lo[3], hi[0], hi[1], hi[2], hi[3]}; acc[cb] = __builtin_amdgcn_mfma_f32_32x32x16_bf16(a, bb, acc[cb], 0, 0, 0); } }
#pragma unroll
        for (int cb = 0; cb < 2; ++cb) { const int col = g * 128 + 32 * (2 * wc + cb) + r; const float sg = F.sgu_norm_g[col];
#pragma unroll
            for (int i = 0; i < 16; ++i) { const int t = 32 * wr + crow(i, h);
                if (t < nv) { const float uu = bf2f(U[(size_t)(row0 + t) * 1024 + col]); OS[(size_t)(row0 + t) * 2048 + 1024 + col] = bf1(uu * (acc[cb][i] * sg + F.sgu_b_s[g * 128 + t])); } } }
    }
    __syncthreads();
}

__device__ __forceinline__ void p2_mixers(Frame& F) {
    LAS float* BLw = (LAS float*)(F.lds + P2_BIAS);
    for (int e = F.wave * 64 + pg8::lane_id_v(); e < 16 * 256; e += NTHR) { const int hh = e >> 8, idx = e & 255, rel = idx - 191, n = rel < 0 ? -rel : rel;
        const int v = n < 8 ? n : (n < 12 ? 8 : n < 16 ? 9 : n < 23 ? 10 : n < 32 ? 11 : n < 46 ? 12 : n < 64 ? 13 : n < 91 ? 14 : 15);
        BLw[e] = (idx < 255) ? F.rel_tab[((rel > 0 ? 16 : 0) + v) * 16 + hh] * LOG2E : 0.f; }
    __syncthreads();
    for (int u = F.vcu; u < N_ATT_UNITS; u += F.G) attn_unit(F, u);
    for (int u = F.G - 1 - F.vcu; u < N_SGU_UNITS; u += F.G) sgu_unit(F, u);
}
typedef _Float16 f16x8v __attribute__((ext_vector_type(8)));
__device__ __forceinline__ int enc_f(float f) { const int b = __builtin_bit_cast(int, f); return b ^ ((b >> 31) & 0x7fffffff); }
__device__ __forceinline__ float dec_f(int k) { return __builtin_bit_cast(float, k ^ ((k >> 31) & 0x7fffffff)); }
__device__ __forceinline__ int imax_(int a, int b) { return a > b ? a : b; }
__device__ __forceinline__ int imin_(int a, int b) { return a < b ? a : b; }
#define P6_CE(a, b) do { const int mx_ = imax_(a, b), mn_ = imin_(a, b); a = mx_; b = mn_; } while (0)
__device__ __forceinline__ void sort16_desc(int (&v)[16]) {
#pragma unroll
    for (int k = 2; k <= 16; k <<= 1)
#pragma unroll
        for (int j = k >> 1; j > 0; j >>= 1)
#pragma unroll
            for (int i = 0; i < 16; ++i) { const int l = i ^ j; if (l > i) { if ((i & k) == 0) P6_CE(v[i], v[l]); else P6_CE(v[l], v[i]); } }
}
__device__ __forceinline__ void bitonic_merge16_desc(int (&v)[16]) {
#pragma unroll
    for (int j = 8; j > 0; j >>= 1)
#pragma unroll
        for (int i = 0; i < 16; ++i) { const int l = i ^ j; if (l > i) P6_CE(v[i], v[l]); }
}
__device__ __forceinline__ void merge_top16(int (&T)[16], const int (&N)[16]) {
#pragma unroll
    for (int i = 0; i < 16; ++i) T[i] = imax_(T[i], N[15 - i]);
    bitonic_merge16_desc(T);
}
__device__ __forceinline__ int half_partner(int x) { auto rr = __builtin_amdgcn_permlane32_swap((unsigned)x, (unsigned)x, false, false); return (int)(rr[0] ^ rr[1] ^ (unsigned)x); }
struct CandTab { int ci[64], cj[64]; };
__host__ __device__ constexpr CandTab make_cand() { CandTab t{}; int n = 0; for (int i = 0; i < 16; ++i) for (int j = 0; j < 16; ++j) if ((i + 1) * (j + 1) <= 16) { t.ci[n] = i; t.cj[n] = j; ++n; } for (; n < 64; ++n) { t.ci[n] = -1; t.cj[n] = -1; } return t; }
constexpr CandTab CAND = make_cand();
constexpr int P6_SC = 0;

__device__ __forceinline__ void p6_topk(Frame& F) {
    const int lane = pg8::lane_id_v(), w = F.wave, r = lane & 31, h = lane >> 5;
    const bf16* QP = (const bf16*)(F.ws + WS_SB); const bf16* KH = (const bf16*)(F.ws + WS_KEYS); const float* SS2 = (const float*)(F.ws + WS_SS2);
    unsigned long long* SEL = (unsigned long long*)(F.ws + WS_RA);
    LAS int* SC = (LAS int*)(F.lds + P6_SC + w * 8192);
    for (int tile = F.vcu; tile < MREAL / 32; tile += F.G) {
        const int t = tile * 32 + r;
        int AB[2][16];
#pragma unroll
        for (int p = 0; p < 2; ++p) {
            f16x8v qf[8];
#pragma unroll
            for (int ks = 0; ks < 8; ++ks) qf[ks] = *(const GAS f16x8v*)(QP + (size_t)t * 2048 + w * 256 + p * 128 + ks * 16 + h * 8);
            int T[16];
#pragma unroll
            for (int nb = 0; nb < 4; ++nb) {
                f32x16 acc = {};
                const bf16* kp = KH + ((size_t)((w * 2 + p) * 128 + nb * 32 + r)) * 128 + h * 8;
#pragma unroll
                for (int ks = 0; ks < 8; ++ks) { const f16x8v kf = *(const GAS f16x8v*)(kp + ks * 16); acc = __builtin_amdgcn_mfma_f32_32x32x16_f16(kf, qf[ks], acc, 0, 0, 0); }
                int N[16];
#pragma unroll
                for (int i = 0; i < 16; ++i) N[i] = (enc_f(acc[i]) & ~127) | (nb * 32 + crow(i, h));
                sort16_desc(N);
                if (nb == 0) {
#pragma unroll
                    for (int i = 0; i < 16; ++i) T[i] = N[i];
                } else merge_top16(T, N);
            }
            int P[16];
#pragma unroll
            for (int i = 0; i < 16; ++i) P[i] = half_partner(T[i]);
            merge_top16(T, P);
#pragma unroll
            for (int i = 0; i < 16; ++i) AB[p][i] = T[i];
        }
#pragma unroll
        for (int i = 0; i < 16; ++i) { SC[i * 64 + lane] = AB[0][i] & 127; SC[(16 + i) * 64 + lane] = AB[1][i] & 127; }
        float fa[16], fb[16];
#pragma unroll
        for (int i = 0; i < 16; ++i) { fa[i] = dec_f(AB[0][i] & ~127); fb[i] = dec_f(AB[1][i] & ~127); }
        int W[16];
#pragma unroll
        for (int g = 0; g < 4; ++g) {
            int N[16];
#pragma unroll
            for (int c = 0; c < 16; ++c) { const int ci = CAND.ci[g * 16 + c], cj = CAND.cj[g * 16 + c]; N[c] = ci >= 0 ? ((enc_f(fa[ci >= 0 ? ci : 0] + fb[cj >= 0 ? cj : 0]) & ~255) | (ci * 16 + cj)) : (int)0x80000000; }
            sort16_desc(N);
            if (g == 0) {
#pragma unroll
                for (int i = 0; i < 16; ++i) W[i] = N[i];
            } else merge_top16(W, N);
        }
        float ssum = 0.f;
        { const GAS f32x4* sp = (const GAS f32x4*)(SS2 + (size_t)t * 32);
#pragma unroll
            for (int i = 0; i < 8; ++i) { const f32x4 v = sp[i]; ssum += (v.x + v.y) + (v.z + v.w); } }
        const float rt = 1.0f / sqrtf(ssum * (1.f / DM) + EPS);
        LDS_WAIT(); asm volatile("" ::: "memory");
        float gk[16]; int ek[16]; float Z = 0.f; const float c0 = dec_f(W[0] & ~255);
#pragma unroll
        for (int k = 0; k < 16; ++k) { const int code = W[k] & 255, ii = code >> 4, jj = code & 15; const int n0 = SC[ii * 64 + lane], n1 = SC[(16 + jj) * 64 + lane];
            ek[k] = n0 * 128 + n1; gk[k] = __builtin_amdgcn_exp2f((dec_f(W[k] & ~255) - c0) * rt * LOG2E); Z += gk[k]; }
        const float iz = 1.0f / Z;
        unsigned long long* dst = SEL + ((size_t)t * 8 + w) * 16 + 8 * h;
#pragma unroll
        for (int k = 0; k < 8; k += 2) { const int e0 = h ? ek[k + 8] : ek[k], e1 = h ? ek[k + 9] : ek[k + 1]; const float g0 = (h ? gk[k + 8] : gk[k]) * iz, g1 = (h ? gk[k + 9] : gk[k + 1]) * iz;
            *(GAS v4u*)(dst + k) = (v4u){(unsigned)e0, __builtin_bit_cast(unsigned, g0), (unsigned)e1, __builtin_bit_cast(unsigned, g1)}; }
        LDS_WAIT(); asm volatile("" ::: "memory");
    }
}
typedef _Float16 h2v __attribute__((ext_vector_type(2)));
constexpr int P7_RED = 0, P7_PART = LDSCTL_OFF;
#ifndef P7_UNR
#define P7_UNR 4
#endif
template <int M> __device__ __forceinline__ float xor_lane(float x) {
    if constexpr (M == 32) { const unsigned u = __builtin_bit_cast(unsigned, x); auto rr = __builtin_amdgcn_permlane32_swap(u, u, false, false); return __builtin_bit_cast(float, rr[0] ^ rr[1] ^ u); }
    else return __builtin_bit_cast(float, __builtin_amdgcn_ds_swizzle(__builtin_bit_cast(int, x), (M << 10) | 0x1f));
}
__device__ __forceinline__ float wave_sum_sw(float v) { v += xor_lane<1>(v); v += xor_lane<2>(v); v += xor_lane<4>(v); v += xor_lane<8>(v); v += xor_lane<16>(v); v += xor_lane<32>(v); return v; }
__device__ __forceinline__ float dot8(const v4u a, const v4u b, float acc) {
    const unsigned ax = a.x, ay = a.y, az = a.z, aw = a.w, bx = b.x, by = b.y, bz = b.z, bw = b.w;
    acc = __builtin_amdgcn_fdot2(__builtin_bit_cast(h2v, ax), __builtin_bit_cast(h2v, bx), acc, false); acc = __builtin_amdgcn_fdot2(__builtin_bit_cast(h2v, ay), __builtin_bit_cast(h2v, by), acc, false);
    acc = __builtin_amdgcn_fdot2(__builtin_bit_cast(h2v, az), __builtin_bit_cast(h2v, bz), acc, false); acc = __builtin_amdgcn_fdot2(__builtin_bit_cast(h2v, aw), __builtin_bit_cast(h2v, bw), acc, false); return acc;
}
__device__ __forceinline__ void axpy8(float (&o)[8], const v4u a, float s) {
    const unsigned ax = a.x, ay = a.y, az = a.z, aw = a.w; const h2v p0 = __builtin_bit_cast(h2v, ax), p1 = __builtin_bit_cast(h2v, ay), p2 = __builtin_bit_cast(h2v, az), p3 = __builtin_bit_cast(h2v, aw);
    o[0] = __builtin_fmaf((float)p0[0], s, o[0]); o[1] = __builtin_fmaf((float)p0[1], s, o[1]); o[2] = __builtin_fmaf((float)p1[0], s, o[2]); o[3] = __builtin_fmaf((float)p1[1], s, o[3]);
    o[4] = __builtin_fmaf((float)p2[0], s, o[4]); o[5] = __builtin_fmaf((float)p2[1], s, o[5]); o[6] = __builtin_fmaf((float)p3[0], s, o[6]); o[7] = __builtin_fmaf((float)p3[1], s, o[7]);
}
__device__ __forceinline__ void p7_gather(Frame& F) {
    const int lane = pg8::lane_id_v(), w = F.wave;
    const bf16* XH = (const bf16*)(F.ws + WS_RATIO); const float* SS2 = (const float*)(F.ws + WS_SS2); const bf16* EU = (const bf16*)(F.ws + WS_EU); const bf16* EV = (const bf16*)(F.ws + WS_EV);
    const unsigned long long* SEL = (const unsigned long long*)(F.ws + WS_RA);
    int it = 0;
    for (int t = F.vcu; t < MREAL; t += F.G, ++it) {
        LAS float* RED = (LAS float*)(F.lds + P7_RED + (it & 1) * 65536); LAS float* PART = (LAS float*)(F.lds + P7_PART + (it & 1) * 32);
        const unsigned long long sel = SEL[((size_t)t * 8 + w) * 16 + (lane >> 2)];
        const int eidx = (int)(unsigned)sel; const float gate = __builtin_bit_cast(float, (unsigned)(sel >> 32));
        float ssum = (lane < 32) ? SS2[(size_t)t * 32 + lane] : 0.f; ssum = wave_sum_sw(ssum);
        const float rt = 1.0f / sqrtf(ssum * (1.f / DM) + EPS);
        v4u xr[4];
#pragma unroll
        for (int j = 0; j < 4; ++j) xr[j] = *(const GAS v4u*)(XH + (size_t)t * DM + j * 512 + lane * 8);
        float dp[16];
#pragma unroll
        for (int k0 = 0; k0 < 16; k0 += P7_UNR) {
            v4u ur[P7_UNR][4];
#pragma unroll
            for (int kk = 0; kk < P7_UNR; ++kk) { const int e = __builtin_amdgcn_readlane(eidx, 4 * (k0 + kk)); const bf16* rp = EU + (size_t)e * DM + lane * 8;
#pragma unroll
                for (int j = 0; j < 4; ++j) ur[kk][j] = *(const GAS v4u*)(rp + j * 512); }
#pragma unroll
            for (int kk = 0; kk < P7_UNR; ++kk) { float a = 0.f;
#pragma unroll
                for (int j = 0; j < 4; ++j) a = dot8(ur[kk][j], xr[j], a);
                dp[k0 + kk] = a; }
#pragma unroll
            for (int kk = 0; kk < P7_UNR; ++kk) asm volatile("" : "+v"(dp[k0 + kk]) :: "memory");
        }
#define P7_TR(C, M) do { const bool up_ = (lane & (M)) != 0; _Pragma("unroll") for (int i = 0; i < (C) / 2; ++i) { const float keep_ = up_ ? dp[i + (C) / 2] : dp[i], send_ = up_ ? dp[i] : dp[i + (C) / 2]; dp[i] = keep_ + xor_lane<(M)>(send_); } } while (0)
        P7_TR(16, 32); P7_TR(8, 16); P7_TR(4, 8); P7_TR(2, 4);
#undef P7_TR
        float dk = dp[0]; dk += xor_lane<2>(dk); dk += xor_lane<1>(dk);
        const float hval = gate * pg8::gelu_tanh(dk * rt);
        float o[4][8];
#pragma unroll
        for (int j = 0; j < 4; ++j)
#pragma unroll
            for (int e = 0; e < 8; ++e) o[j][e] = 0.f;
#pragma unroll
        for (int k0 = 0; k0 < 16; k0 += P7_UNR) {
            v4u vr[P7_UNR][4];
#pragma unroll
            for (int kk = 0; kk < P7_UNR; ++kk) { const int e = __builtin_amdgcn_readlane(eidx, 4 * (k0 + kk)); const bf16* rp = EV + (size_t)e * DM + lane * 8;
#pragma unroll
                for (int j = 0; j < 4; ++j) vr[kk][j] = *(const GAS v4u*)(rp + j * 512); }
#pragma unroll
            for (int kk = 0; kk < P7_UNR; ++kk) { const float hk = __builtin_bit_cast(float, __builtin_amdgcn_readlane(__builtin_bit_cast(int, hval), 4 * (k0 + kk)));
#pragma unroll
                for (int j = 0; j < 4; ++j) axpy8(o[j], vr[kk][j], hk); }
#pragma unroll
            for (int j = 0; j < 4; ++j) asm volatile("" : "+v"(o[j][0]), "+v"(o[j][1]), "+v"(o[j][2]), "+v"(o[j][3]), "+v"(o[j][4]), "+v"(o[j][5]), "+v"(o[j][6]), "+v"(o[j][7]) :: "memory");
        }
#pragma unroll
        for (int j = 0; j < 4; ++j) { LAS f32x4* rp = (LAS f32x4*)(RED + w * 2048 + j * 512 + lane * 8); rp[0] = (f32x4){o[j][0], o[j][1], o[j][2], o[j][3]}; rp[1] = (f32x4){o[j][4], o[j][5], o[j][6], o[j][7]}; }
        __syncthreads();
        const int col = w * 256 + lane * 4;
        f32x4 sum = *(const LAS f32x4*)(RED + col);
#pragma unroll
        for (int ww = 1; ww < 8; ++ww) sum += *(const LAS f32x4*)(RED + ww * 2048 + col);
        { const unsigned long long xw = *(const GAS unsigned long long*)(XH + (size_t)t * DM + col); const unsigned x0 = (unsigned)xw, x1 = (unsigned)(xw >> 32); const h2v p0 = __builtin_bit_cast(h2v, x0), p1 = __builtin_bit_cast(h2v, x1);
            sum += (f32x4){(float)p0[0], (float)p0[1], (float)p1[0], (float)p1[1]}; }
        float sq = (sum.x * sum.x + sum.y * sum.y) + (sum.z * sum.z + sum.w * sum.w); sq = wave_sum_sw(sq);
        if (lane == 0) PART[w] = sq;
        __syncthreads();
        float tot = 0.f;
#pragma unroll
        for (int ww = 0; ww < 8; ++ww) tot += PART[ww];
        const float rf = 1.0f / sqrtf(tot * (1.f / DM) + EPS);
        const f32x4 gf = *(const GAS f32x4*)(F.norm_final_g + col);
        *(GAS f32x4*)(F.out + OUT_Y + (size_t)t * DM + col) = sum * rf * gf;
    }
}
#ifdef DEBUG_ORACLE
constexpr int ONR = 320;
#ifndef OPB
#define OPB 0
#define OP0 0
#endif
constexpr int OROW0 = OPB * SEQ + OP0;
constexpr size_t WS_OZ = WS_END, WS_OOS = WS_OZ + (size_t)ONR * DIN * 4, WS_OH = WS_OOS + (size_t)ONR * 2048 * 4, WS_OX = WS_OH + (size_t)ONR * 2048 * 4, WS_ORS = WS_OX + (size_t)ONR * 2048 * 4, WS_OLG = WS_ORS + 4096, WS_DBG_END = WS_OLG + (size_t)ONR * 16 * 192 * 4;
__device__ __forceinline__ const float* orow_x(Frame& F, int i) { return i < 128 ? F.x_sample + (size_t)i * DM : F.x_prompt + (size_t)(OROW0 + i - 128) * DM; }
__device__ __forceinline__ int orow_fast(int i) { return i < 128 ? MPROMPT + i : (OROW0 + i - 128); }
__device__ __forceinline__ float o_gelu(float x) { return 0.5f * x * (1.f + tanhf(0.7978845608028654f * (x + 0.044715f * x * x * x))); }
__device__ __forceinline__ float o_sig(float x) { return 1.f / (1.f + expf(-x)); }
__device__ __forceinline__ int o_bucket(int rel) { const int n = rel < 0 ? -rel : rel; int v; if (n < 8) v = n; else { v = 8 + (int)(logf((float)n / 8.f) / logf(16.f) * 8.f); if (v > 15) v = 15; } return (rel > 0 ? 16 : 0) + v; }
template <class BarT> __device__ void dbg_oracle(Frame& F, BarT& bar, int upto) {
    float* OZ = (float*)(F.ws + WS_OZ); float* OOS = (float*)(F.ws + WS_OOS); float* OH = (float*)(F.ws + WS_OH); float* OX = (float*)(F.ws + WS_OX); float* ORS = (float*)(F.ws + WS_ORS);
    const int lane = pg8::lane_id_v(), tid = F.wave * 64 + lane; const size_t gt = (size_t)F.vcu * NTHR + tid, NT = (size_t)F.G * NTHR; const int gw = F.vcu * NWAVES + F.wave, NGW = F.G * NWAVES;
    for (int i = gw; i < ONR; i += NGW) { const float* x = orow_x(F, i); float s = 0.f; for (int d = lane; d < DM; d += 64) s += x[d] * x[d]; s = wave_sum(s); if (lane == 0) ORS[i] = 1.0f / sqrtf(s / DM + EPS); }
    xcd_barrier(bar);
    for (size_t e = gt; e < (size_t)ONR * DIN; e += NT) { const int i = (int)(e / DIN), c = (int)(e % DIN); const float* x = orow_x(F, i); const float rs = ORS[i]; float a = 0.f;
        for (int d = 0; d < DM; ++d) a += x[d] * rs * F.norm_mix_g[d] * F.w_in[(size_t)d * DIN + c]; OZ[e] = a; }
    xcd_barrier(bar);
    if (upto < 2) return;
    for (size_t e = gt; e < (size_t)ONR * 16; e += NT) { const int i = (int)(e >> 4), hd = (int)(e & 15), kvh = hd >> 3; float* lg = (float*)(F.ws + WS_OLG) + e * 192; int nk; float mx = F.sinks[hd];
        const float* q = OZ + (size_t)i * DIN + hd * 64;
        if (i < 128) { const int b = i >> 4, t = i & 15; nk = 144;
            for (int j = 0; j < 144; ++j) { float a = 0.f; for (int d = 0; d < 64; ++d) { const float kk = j < 128 ? F.cache_k[((size_t)(b * 128 + j) * 2 + kvh) * 64 + d] : OZ[(size_t)(b * 16 + j - 128) * DIN + 1024 + kvh * 64 + d]; a += q[d] * kk; }
                lg[j] = a * 0.125f + F.rel_tab[o_bucket(j - 128 - t) * 16 + hd]; mx = fmaxf(mx, lg[j]); }
            float l = expf(F.sinks[hd] - mx); for (int j = 0; j < nk; ++j) { lg[j] = expf(lg[j] - mx); l += lg[j]; }
            for (int d = 0; d < 64; ++d) { float o = 0.f; for (int j = 0; j < nk; ++j) { const float vv = j < 128 ? F.cache_v[((size_t)(b * 128 + j) * 2 + kvh) * 64 + d] : OZ[(size_t)(b * 16 + j - 128) * DIN + 1152 + kvh * 64 + d]; o += lg[j] * vv; } OOS[(size_t)i * 2048 + hd * 64 + d] = o / l; }
        } else { const int p = i - 128, c = p >> 6, k0 = c * 64 - 128 < 0 ? 0 : c * 64 - 128, k1 = c * 64 + 64; nk = k1 - k0;
            for (int j = 0; j < nk; ++j) { const int kp = k0 + j; float a = 0.f; for (int d = 0; d < 64; ++d) a += q[d] * OZ[(size_t)(128 + kp) * DIN + 1024 + kvh * 64 + d];
                lg[j] = a * 0.125f + F.rel_tab[o_bucket(kp - p) * 16 + hd]; mx = fmaxf(mx, lg[j]); }
            float l = expf(F.sinks[hd] - mx); for (int j = 0; j < nk; ++j) { lg[j] = expf(lg[j] - mx); l += lg[j]; }
            for (int d = 0; d < 64; ++d) { float o = 0.f; for (int j = 0; j < nk; ++j) o += lg[j] * OZ[(size_t)(128 + k0 + j) * DIN + 1152 + kvh * 64 + d]; OOS[(size_t)i * 2048 + hd * 64 + d] = o / l; } } }
    for (size_t e = gt; e < (size_t)ONR * 1024; e += NT) { const int i = (int)(e >> 10), cc = (int)(e & 1023), g = cc >> 7; int t, base;
        if (i < 128) { t = i & 15; base = i - t; } else { const int p = i - 128; t = p & 127; base = i - t; }
        float mixed = 0.f;
        for (int s = 0; s <= t; ++s) { const float* zr = OZ + (size_t)(base + s) * DIN + 2304; float ss = 0.f; for (int c2 = 0; c2 < 1024; ++c2) { const float gg = o_gelu(zr[c2]); ss += gg * gg; }
            mixed += F.sgu_w_s[(size_t)(g * 128 + t) * 128 + s] * o_gelu(zr[cc]) / sqrtf(ss / 1024.f + EPS) * F.sgu_norm_g[cc]; }
        OOS[(size_t)i * 2048 + 1024 + cc] = o_gelu(OZ[(size_t)i * DIN + 1280 + cc]) * (mixed + F.sgu_b_s[g * 128 + t]); }
    xcd_barrier(bar);
    if (upto < 4) return;
    for (size_t e = gt; e < (size_t)ONR * 2048; e += NT) { const int i = (int)(e >> 11), n = (int)(e & 2047); float a = 0.f, b2 = 0.f;
        for (int k = 0; k < 1024; ++k) { a += OOS[(size_t)i * 2048 + k] * F.w_pa[(size_t)k * 2048 + n]; b2 += OOS[(size_t)i * 2048 + 1024 + k] * F.w_pb[(size_t)k * 2048 + n]; }
        OH[e] = o_sig(OZ[(size_t)i * DIN + 3328 + n]) * a + o_sig(OZ[(size_t)i * DIN + 5376 + n]) * b2; }
    xcd_barrier(bar);
    for (size_t e = gt; e < (size_t)ONR * 2048; e += NT) { const int i = (int)(e >> 11), n = (int)(e & 2047); float a = 0.f; for (int k = 0; k < 2048; ++k) a += OH[(size_t)i * 2048 + k] * F.w_out[(size_t)k * 2048 + n]; OX[e] = orow_x(F, i)[n] + a; }
    xcd_barrier(bar);
}
__device__ __forceinline__ bool dbg_bad(float fast, float ref) { return !(fabsf(fast - ref) <= 0.03f + 0.03f * fabsf(ref)); }
__device__ __forceinline__ float h2f(bf16 b) { return (float)__builtin_bit_cast(_Float16, b); }
template <class BarT> __device__ void dbg_compare(Frame& F, BarT& bar, int stage) {
    const float* OZ = (const float*)(F.ws + WS_OZ); const float* OOS = (const float*)(F.ws + WS_OOS); const float* OH = (const float*)(F.ws + WS_OH); const float* OX = (const float*)(F.ws + WS_OX);
    const int lane = pg8::lane_id_v(), tid = F.wave * 64 + lane; const size_t gt = (size_t)F.vcu * NTHR + tid, NT = (size_t)F.G * NTHR;
    const bf16* Q = (const bf16*)(F.ws + WS_Q); const bf16* U = (const bf16*)(F.ws + WS_U); const bf16* VS = (const bf16*)(F.ws + WS_VS); const bf16* OS = (const bf16*)(F.ws + WS_RA); const bf16* H = (const bf16*)(F.ws + WS_RB); const bf16* XH = (const bf16*)(F.ws + WS_RATIO);
    for (size_t e = gt; e < OUT_TOTAL; e += NT) {
        bool bad = false;
        if (stage == 7) {
            const float* OXp = OX; const float cur = (e < 393216) ? F.out[OUT_Y + (size_t)OROW0 * DM + e] : F.out[e];
            if (e < 393216 || (e >= OUT_KP - 262144 && e < OUT_KP)) { const size_t k = e < 393216 ? e : e - (OUT_KP - 262144); const int i = (e < 393216 ? 128 : 0) + (int)(k >> 11), n = (int)(k & 2047);
                float ss = 0.f; for (int d = 0; d < 2048; ++d) ss += OXp[(size_t)i * 2048 + d] * OXp[(size_t)i * 2048 + d];
                bad = dbg_bad(cur, OXp[(size_t)i * 2048 + n] / sqrtf(ss / 2048.f + EPS) * F.norm_final_g[n]); }
            else if (e >= OUT_KP && e < OUT_VP) { const size_t k = e - OUT_KP; const int i = 128 + 64 + (int)(k >> 11), n = (int)(k & 2047); bad = dbg_bad(h2f(XH[(size_t)orow_fast(i) * 2048 + n]), OX[(size_t)i * 2048 + n]); }
            else if (e >= OUT_VP && e < OUT_KS) { const size_t k = e - OUT_VP; const int i = 128 + 128 + (int)(k >> 11), n = (int)(k & 2047); bad = dbg_bad(h2f(XH[(size_t)orow_fast(i) * 2048 + n]), OX[(size_t)i * 2048 + n]); }
            else if (e >= OUT_SGU) { const size_t k = e - OUT_SGU; const int i = 128 + 128 + (int)(k >> 11), n = (int)(k & 2047); bad = dbg_bad(bf2f(H[(size_t)orow_fast(i) * 2048 + n]), OH[(size_t)i * 2048 + n]); }
            else if (e >= OUT_KS && e < OUT_VS) { const size_t k = e - OUT_KS; const int i = 128 + 128 + (int)(k >> 10), n = (int)(k & 1023); bad = dbg_bad(bf2f(OS[(size_t)orow_fast(i) * 2048 + n]), OOS[(size_t)i * 2048 + n]); }
            else if (e >= OUT_VS && e < OUT_SGU) { const size_t k = e - OUT_VS; const int i = 128 + (int)(k >> 10), n = 1024 + (int)(k & 1023); bad = dbg_bad(bf2f(OS[(size_t)orow_fast(i) * 2048 + n]), OOS[(size_t)i * 2048 + n]); }
        } else if (stage == 2) {
            if (e < 196608) { const int i = 128 + (int)(e >> 10), n = (int)(e & 1023); bad = dbg_bad(bf2f(Q[(size_t)orow_fast(i) * 1024 + n]), OZ[(size_t)i * DIN + n] * pg8::QSCALE); }
            else if (e < 2 * 196608) { const size_t k = e - 196608; const int i = 128 + (int)(k >> 10), n = (int)(k & 1023); bad = dbg_bad(bf2f(U[(size_t)orow_fast(i) * 1024 + n]), o_gelu(OZ[(size_t)i * DIN + 1280 + n])); }
            else if (e < 3 * 196608) { const size_t k = e - 2 * 196608; const int i = 128 + (int)(k >> 10), n = (int)(k & 1023); bad = dbg_bad(bf2f(VS[(size_t)orow_fast(i) * 1024 + n]), o_gelu(OZ[(size_t)i * DIN + 2304 + n])); }
            else if (e >= OUT_KP - 262144 && e < OUT_KP - 262144 + 196608) { const size_t k = e - (OUT_KP - 262144); const int i = 128 + (int)(k >> 10), n = 1024 + (int)(k & 1023); bad = dbg_bad(bf2f(OS[(size_t)orow_fast(i) * 2048 + n]), OOS[(size_t)i * 2048 + n]); }
            else if (e >= OUT_KP && e < OUT_VP) { const size_t k = e - OUT_KP; const int i = (int)(k >> 10), n = (int)(k & 1023); bad = dbg_bad(bf2f(OS[(size_t)orow_fast(i) * 2048 + n]), OOS[(size_t)i * 2048 + n]); }
            else if (e >= OUT_VP && e < OUT_KS) { const size_t k = e - OUT_VP; const int i = (int)(k >> 10), n = 1024 + (int)(k & 1023); bad = dbg_bad(bf2f(OS[(size_t)orow_fast(i) * 2048 + n]), OOS[(size_t)i * 2048 + n]); }
            else if (e >= OUT_KS && e < OUT_VS) { const size_t k = e - OUT_KS; const int i = 128 + 160 + (int)(k >> 10), n = (int)(k & 1023); bad = dbg_bad(bf2f(OS[(size_t)orow_fast(i) * 2048 + n]), OOS[(size_t)i * 2048 + n]); }
            else if (e >= OUT_VS && e < OUT_SGU) { const size_t k = e - OUT_VS; const int i = 128 + 176 + (int)(k >> 10), n = (int)(k & 1023); bad = dbg_bad(bf2f(OS[(size_t)orow_fast(i) * 2048 + n]), OOS[(size_t)i * 2048 + n]); }
            else if (e >= OUT_SGU) { const size_t k = e - OUT_SGU; const int i = 128 + (int)(k >> 10), n = (int)(k & 1023); bad = dbg_bad(bf2f(OS[(size_t)orow_fast(i) * 2048 + n]), OOS[(size_t)i * 2048 + n]); }
        } else {
            if (e < 393216) { const int i = 128 + (int)(e >> 11), n = (int)(e & 2047); bad = dbg_bad(bf2f(H[(size_t)orow_fast(i) * 2048 + n]), OH[(size_t)i * 2048 + n]); }
            else if (e >= OUT_KP - 262144 && e < OUT_KP) { const size_t k = e - (OUT_KP - 262144); const int i = (int)(k >> 11), n = (int)(k & 2047); bad = dbg_bad(bf2f(H[(size_t)orow_fast(i) * 2048 + n]), OH[(size_t)i * 2048 + n]); }
            else if (e >= OUT_KP && e < OUT_VP) { const size_t k = e - OUT_KP; const int i = 128 + (int)(k >> 11), n = (int)(k & 2047); bad = dbg_bad(h2f(XH[(size_t)orow_fast(i) * 2048 + n]), OX[(size_t)i * 2048 + n]); }
            else if (e >= OUT_VP && e < OUT_KS) { const size_t k = e - OUT_VP; const int i = 128 + 64 + (int)(k >> 11), n = (int)(k & 2047); bad = dbg_bad(h2f(XH[(size_t)orow_fast(i) * 2048 + n]), OX[(size_t)i * 2048 + n]); }
            else if (e >= OUT_SGU) { const size_t k = e - OUT_SGU; const int i = 128 + 128 + (int)(k >> 11), n = (int)(k & 2047); bad = dbg_bad(h2f(XH[(size_t)orow_fast(i) * 2048 + n]), OX[(size_t)i * 2048 + n]); }
            else if (e >= OUT_KS && e < OUT_VS) { const size_t k = e - OUT_KS; const int i = (int)(k >> 11), n = (int)(k & 2047); bad = dbg_bad(h2f(XH[(size_t)orow_fast(i) * 2048 + n]), OX[(size_t)i * 2048 + n]); }
            else if (e >= OUT_VS && e < OUT_SGU) { const size_t k = e - OUT_VS; const int i = 8 + (int)(k >> 11), n = (int)(k & 2047); bad = dbg_bad(h2f(XH[(size_t)orow_fast(i) * 2048 + n]), OX[(size_t)i * 2048 + n]); }
        }
        F.out[e] = bad ? __builtin_bit_cast(float, 0xAAAAAAAAu) : 0.f;
    }
}
#endif
struct Args { const float* in[20]; float* out; unsigned char* ws; int ph_lo, ph_hi; };
__global__ void __launch_bounds__(NWAVES * 64, 2) hybrid_fwd(Args args) {
    extern __shared__ __attribute__((aligned(16))) unsigned char lds[];
    Frame F;
    F.lds = (LAS unsigned char*)lds;
    F.MISC = (volatile LAS unsigned*)(F.lds + MISC_OFF);
    F.wave = __builtin_amdgcn_readfirstlane(threadIdx.x >> 6);
    F.G = gridDim.x; { const int bx = blockIdx.x; F.vcu = (F.G % 8 == 0) ? (bx % 8) * (F.G / 8) + bx / 8 : bx; }
    F.ws = args.ws; F.out = args.out; F.ctl = (gu32*)(args.ws + WS_CTL);
    F.x_prompt = args.in[0]; F.x_sample = args.in[1]; F.cache_k = args.in[2]; F.cache_v = args.in[3]; F.norm_mix_g = args.in[4]; F.w_in = args.in[5]; F.sgu_norm_g = args.in[6];
    F.sgu_w_s = args.in[7]; F.sgu_b_s = args.in[8]; F.sinks = args.in[9]; F.rel_tab = args.in[10]; F.w_pa = args.in[11]; F.w_pb = args.in[12]; F.w_out = args.in[13]; F.norm_ffn_g = args.in[14];
    F.w_query = args.in[15]; F.sub_keys = args.in[16]; F.exp_u = args.in[17]; F.exp_v = args.in[18]; F.norm_final_g = args.in[19];
    for (int u = threadIdx.x; u < (LDS_BYTES - LDSCTL_OFF) / 4; u += NWAVES * 64) ((LAS unsigned*)(F.lds + LDSCTL_OFF))[u] = 0u;
    __syncthreads();
    XcdBarrier bar = xcd_barrier_post((unsigned*)(F.ctl + CW_BAR), F.MISC + 8);
    const int lo = args.ph_lo, hi = args.ph_hi;
#define IN(k) (lo <= (k) && (k) < hi)
#define SEAM(k) do { if (IN(k) && IN((k) + 1)) xcd_barrier(bar); } while (0)
    unsigned char* ws = args.ws;
#ifndef ONLY_P7
    if (IN(0)) { p0_prologue(F); } SEAM(0);
    if (IN(1)) {
        pg8::Gemm g{(const bf16*)(ws + WS_RA), (const bf16*)(ws + WS_WIN), MPAD, DIN, DM}; pg8::StaticOrder S; S.init(MPAD, DIN, F.G, (int)blockIdx.x);
        pg8::EpiIn E{(bf16*)(ws + WS_Q), (bf16*)(ws + WS_KV), (bf16*)(ws + WS_U), (bf16*)(ws + WS_VS), (bf16*)(ws + WS_RATIO), (bf16*)(ws + WS_SB), (float*)(ws + WS_SS1),
                     F.out + OUT_KP, F.out + OUT_VP, F.out + OUT_KS, F.out + OUT_VS};
        pg8::gemm_phase<pg8::EpiIn, pg8::StaticOrder, true, true, false>(F.lds + RING_OFF, g, S, E, F.wave);
    } SEAM(1);
#ifdef HAVE_P2
    if (IN(2)) { p2_mixers(F); } SEAM(2);
#endif
#ifdef HAVE_P3
    if (IN(3)) {
        pg8::Gemm g{(const bf16*)(ws + WS_RA), (const bf16*)(ws + WS_WAB), MPAD, DM, DM}; pg8::StaticOrder S; S.init(MPAD, DM, F.G, (int)blockIdx.x);
        pg8::EpiMerge E{(const bf16*)(ws + WS_RATIO), (const bf16*)(ws + WS_SB), (bf16*)(ws + WS_RB)};
        pg8::gemm_phase<pg8::EpiMerge, pg8::StaticOrder, true, true, false>(F.lds + RING_OFF, g, S, E, F.wave);
    } SEAM(3);
    if (IN(4)) {
        pg8::Gemm g{(const bf16*)(ws + WS_RB), (const bf16*)(ws + WS_WOUT), MPAD, DM, DM}; pg8::StaticOrder S; S.init(MPAD, DM, F.G, (int)blockIdx.x);
        pg8::EpiOut E{F.x_prompt, F.x_sample, (bf16*)(ws + WS_RATIO), (float*)(ws + WS_SS2)};
        pg8::gemm_phase<pg8::EpiOut, pg8::StaticOrder, true, true, false>(F.lds + RING_OFF, g, S, E, F.wave);
    } SEAM(4);
#endif
#ifdef HAVE_P5
    if (IN(5)) {
        pg8::Gemm g{(const bf16*)(ws + WS_RATIO), (const bf16*)(ws + WS_WQ), MPAD, DM, DM}; pg8::StaticOrder S; S.init(MPAD, DM, F.G, (int)blockIdx.x);
        pg8::EpiQ E{(bf16*)(ws + WS_SB)};
        pg8::gemm_phase<pg8::EpiQ, pg8::StaticOrder, true, true, true>(F.lds + RING_OFF, g, S, E, F.wave);
    } SEAM(5);
    if (IN(6)) { p6_topk(F); } SEAM(6);
#endif
#endif
#ifdef HAVE_P7
#ifdef CHECK_TMO
    if (xb_ld((unsigned*)(F.ctl + CW_BAR) + XB_TMO) != 0u) return;
#endif
#ifdef EXTRA_BAR
    xcd_barrier(bar); { const unsigned long long t0 = __builtin_amdgcn_s_memrealtime(); while (__builtin_amdgcn_s_memrealtime() - t0 < 100000ull) __builtin_amdgcn_s_sleep(8); } xcd_barrier(bar);
#endif
    if (IN(7)) { p7_gather(F); }
#endif
#ifdef DEBUG_ORACLE
    xcd_barrier(bar); dbg_oracle(F, bar, DEBUG_STAGE); dbg_compare(F, bar, DEBUG_STAGE);
#endif
#undef IN
#undef SEAM
}

extern "C" void kernel_launch(void* const* d_in, const int* in_sizes, int n_in, void* d_out, int out_size, void* d_ws, size_t ws_size, hipStream_t stream) {
    static int grid = 0;
    if (grid == 0) {
        if (n_in != 20 || in_sizes[0] != MPROMPT * DM || out_size != (int)OUT_TOTAL || ws_size < WS_END) {
            fprintf(stderr, "kernel_launch: shape mismatch: n_in %d, in0 %d, out %d (want %zu), ws %zu (want %zu); nothing launched\n", n_in, n_in > 0 ? in_sizes[0] : -1, out_size, (size_t)OUT_TOTAL, ws_size, (size_t)WS_END); grid = -1; return; }
        int dev = 0, cus = 0, per_cu = 0;
        if (hipGetDevice(&dev) != hipSuccess || hipDeviceGetAttribute(&cus, hipDeviceAttributeMultiprocessorCount, dev) != hipSuccess) { fprintf(stderr, "kernel_launch: device query failed\n"); grid = -1; return; }
        if (hipFuncSetAttribute((const void*)hybrid_fwd, hipFuncAttributeMaxDynamicSharedMemorySize, LDS_BYTES) != hipSuccess) { fprintf(stderr, "kernel_launch: hipFuncSetAttribute failed\n"); grid = -1; return; }
        if (hipOccupancyMaxActiveBlocksPerMultiprocessor(&per_cu, (const void*)hybrid_fwd, NWAVES * 64, LDS_BYTES) != hipSuccess || per_cu < 1)
            fprintf(stderr, "kernel_launch: note: occupancy query reports %d workgroups per CU\n", per_cu);
        (void)hipGetLastError();
        grid = cus;
    }
    if (grid < 0) return;
    if (hipMemsetAsync((char*)d_ws + WS_CTL, 0, CTL_ZERO_BYTES, stream) != hipSuccess) { fprintf(stderr, "kernel_launch: memset failed\n"); return; }
    Args a{};
    for (int i = 0; i < 20; ++i) a.in[i] = (const float*)d_in[i];
    a.out = (float*)d_out; a.ws = (unsigned char*)d_ws; a.ph_lo = 0; a.ph_hi = 8;
#ifdef DEBUG_ORACLE
    a.ph_hi = DEBUG_STAGE + 1; if (ws_size < WS_DBG_END) return;
#endif
    hipLaunchKernelGGL(hybrid_fwd, dim3(grid), dim3(NWAVES * 64), LDS_BYTES, stream, a);
    const hipError_t le = hipPeekAtLastError();
    if (le != hipSuccess) fprintf(stderr, "kernel_launch: launch failed: %s\n", hipGetErrorName(le));
}
```

```cpp
#include <hip/hip_runtime.h>
#include <cstdio>
#include <cstdint>

namespace pg8 {
#define PG8_LAS __attribute__((address_space(3)))
typedef unsigned short bf16_t;
typedef short bf16x8 __attribute__((ext_vector_type(8)));
typedef float f32x4 __attribute__((ext_vector_type(4)));
typedef unsigned u32x4 __attribute__((ext_vector_type(4)));
constexpr int BM = 256, BK = 64, HALF = 128, HTB = HALF * BK * 2  , STAGE_BYTES = 8 * HTB, NXCD = 8, WGM = 8;

__host__ __device__ __forceinline__ int lds_byte(int r, int c) { const int st = (r >> 4) * 2 + (c >> 5), rr = r & 15, cc = c & 31, ob = rr * 64 + cc * 2; return st * 1024 + (ob ^ (((ob >> 9) & 1) << 5)); }
__host__ __device__ __forceinline__ void stage_rc(int b, int& R, int& C) { const int st = b / 1024, sb = b % 1024, swz = sb ^ (((sb >> 9) & 1) << 5); R = (st >> 1) * 16 + swz / 64; C = (st & 1) * 32 + (swz % 64) / 2; }
__host__ __device__ __forceinline__ int perm32(int rho) { const int n = rho >> 4, i = rho & 15; return 8 * (i >> 2) + 4 * n + (i & 3); }

__device__ __forceinline__ int lane_id_v() { int l; asm volatile("v_mbcnt_lo_u32_b32 %0, -1, 0\n\tv_mbcnt_hi_u32_b32 %0, -1, %0" : "=v"(l)); return l; }
__device__ __forceinline__ unsigned partner32(unsigned x) { unsigned a = x, b = x; asm volatile("" : "+v"(a)); asm volatile("" : "+v"(b)); auto rr = __builtin_amdgcn_permlane32_swap(a, b, false, false); return rr[0] ^ rr[1] ^ x; }
struct Unit { int pm, pn; };
struct Gemm { const bf16_t* A; const bf16_t* Bt; int M, N, K; };

struct StaticOrder {
    int nM, nN, nwg, G, c;
    __host__ __device__ void init(int M, int N, int G_, int c_) { nM = M / BM; nN = N / BM; nwg = nM * nN; G = G_; c = c_; }
    __host__ __device__ bool next(int i, Unit& u) const {
        const long L = (long)i * G + c; if (L >= nwg) return false;
        int wgid = (int)L; { const int q = nwg / NXCD, r = nwg % NXCD, xcd = wgid % NXCD, off = wgid / NXCD; wgid = (xcd < r ? xcd * (q + 1) : r * (q + 1) + (xcd - r) * q) + off; }
        const int nig = WGM * nN, gid = wgid / nig, fm = gid * WGM, gsz = (nM - fm) < WGM ? (nM - fm) : WGM;
        u.pm = fm + ((wgid % nig) % gsz); u.pn = (wgid % nig) / gsz; return true;
    }
    __device__ __forceinline__ void a_ready(const Unit&) const {}
    __device__ __forceinline__ void done(const Unit&) const {}
};

typedef float f32x2 __attribute__((ext_vector_type(2)));
typedef __bf16 bf16x2_t __attribute__((ext_vector_type(2)));
typedef _Float16 f16x2_t __attribute__((ext_vector_type(2)));
typedef _Float16 f16x8_t __attribute__((ext_vector_type(8)));
__device__ __forceinline__ unsigned pk_bf16(float lo, float hi) { f32x2 v = {lo, hi}; return __builtin_bit_cast(unsigned, __builtin_convertvector(v, bf16x2_t)); }
__device__ __forceinline__ unsigned pk_f16(float lo, float hi) { f32x2 v = {lo, hi}; return __builtin_bit_cast(unsigned, __builtin_convertvector(v, f16x2_t)); }
__device__ __forceinline__ float bf_lo(unsigned w) { return __builtin_bit_cast(float, w << 16); }
__device__ __forceinline__ float bf_hi(unsigned w) { return __builtin_bit_cast(float, w & 0xffff0000u); }
template <bool F16> __device__ __forceinline__ f32x4 mma16(bf16x8 a, bf16x8 b, f32x4 c) {
    if constexpr (F16) return __builtin_amdgcn_mfma_f32_16x16x32_f16(__builtin_bit_cast(f16x8_t, a), __builtin_bit_cast(f16x8_t, b), c, 0, 0, 0);
    else return __builtin_amdgcn_mfma_f32_16x16x32_bf16(a, b, c, 0, 0, 0);
}
__device__ __forceinline__ float gelu_tanh(float x) { const float y = x * (-2.3022081981f - 0.1029432396f * (x * x)); return x * __builtin_amdgcn_rcpf(1.f + __builtin_amdgcn_exp2f(y)); }
__device__ __forceinline__ float sigmoidf_(float x) { return __builtin_amdgcn_rcpf(1.f + __builtin_amdgcn_exp2f(-1.4426950409f * x)); }
__device__ __forceinline__ u32x4 pack8_bf16(const f32x4 a, const f32x4 b) { u32x4 w; w.x = pk_bf16(a[0], a[1]); w.y = pk_bf16(a[2], a[3]); w.z = pk_bf16(b[0], b[1]); w.w = pk_bf16(b[2], b[3]); return w; }
__device__ __forceinline__ u32x4 pack8_f16(const f32x4 a, const f32x4 b) { u32x4 w; w.x = pk_f16(a[0], a[1]); w.y = pk_f16(a[2], a[3]); w.z = pk_f16(b[0], b[1]); w.w = pk_f16(b[2], b[3]); return w; }
__device__ __forceinline__ float sq4(const f32x4 a) { return (a[0] * a[0] + a[1] * a[1]) + (a[2] * a[2] + a[3] * a[3]); }

constexpr float QSCALE = 0.125f * 1.4426950408889634f;
struct EpiIn {
    static constexpr bool PERM = true, AFTER_DRAIN = false, MID = false;
    bf16_t *Q, *KV, *U, *VS, *RATIO, *SB; float* SS1; float *outKp, *outVp, *outKs, *outVs;
    __device__ __forceinline__ void operator()(const f32x4 (&acc)[2][2][4][2], const Unit& u, int wr, int wc, int, int) const {
        const int lane_ = lane_id_v(), fr = lane_ & 15, fq = lane_ >> 4;
        const int pn = u.pn, rowb = u.pm * BM + wr * 64 + fr, cl = wc * 32 + 8 * fq;
        if (pn < 4) {
#pragma unroll
            for (int ai = 0; ai < 2; ++ai)
#pragma unroll
                for (int m = 0; m < 4; ++m) { bf16_t* rp = Q + (size_t)(rowb + ai * HALF + m * 16) * 1024 + pn * 256 + cl;
#pragma unroll
                    for (int bj = 0; bj < 2; ++bj) *(u32x4*)(rp + bj * HALF) = pack8_bf16(acc[ai][bj][m][0] * QSCALE, acc[ai][bj][m][1] * QSCALE); }
        } else if (pn == 4) {
#pragma unroll
            for (int ai = 0; ai < 2; ++ai)
#pragma unroll
                for (int m = 0; m < 4; ++m) { bf16_t* rp = KV + (size_t)(rowb + ai * HALF + m * 16) * 256 + cl;
#pragma unroll
                    for (int bj = 0; bj < 2; ++bj) *(u32x4*)(rp + bj * HALF) = pack8_bf16(acc[ai][bj][m][0], acc[ai][bj][m][1]); }
            if (u.pm < 64 && (u.pm & 7) == 7) {
#pragma unroll
                for (int m = 0; m < 4; ++m) { const size_t o = (size_t)((u.pm >> 3) * 128 + wr * 64 + m * 16 + fr) * 128 + cl;
                    __builtin_nontemporal_store(acc[1][0][m][0], (f32x4*)(outKp + o)); __builtin_nontemporal_store(acc[1][0][m][1], (f32x4*)(outKp + o + 4));
                    __builtin_nontemporal_store(acc[1][1][m][0], (f32x4*)(outVp + o)); __builtin_nontemporal_store(acc[1][1][m][1], (f32x4*)(outVp + o + 4)); }
            }
            if (u.pm == 64) {
#pragma unroll
                for (int m = 0; m < 4; ++m) { const size_t o = (size_t)(wr * 64 + m * 16 + fr) * 128 + cl;
                    __builtin_nontemporal_store(acc[0][0][m][0], (f32x4*)(outKs + o)); __builtin_nontemporal_store(acc[0][0][m][1], (f32x4*)(outKs + o + 4));
                    __builtin_nontemporal_store(acc[0][1][m][0], (f32x4*)(outVs + o)); __builtin_nontemporal_store(acc[0][1][m][1], (f32x4*)(outVs + o + 4)); }
            }
        } else if (pn < 13) {
            const bool isv = pn >= 9; bf16_t* base = isv ? VS : U; const int ct = (isv ? pn - 9 : pn - 5) * 256 + cl;
#pragma unroll
            for (int ai = 0; ai < 2; ++ai)
#pragma unroll
                for (int m = 0; m < 4; ++m) { const int row = rowb + ai * HALF + m * 16; bf16_t* rp = base + (size_t)row * 1024 + ct; float s = 0.f;
#pragma unroll
                    for (int bj = 0; bj < 2; ++bj) { f32x4 a = acc[ai][bj][m][0], b = acc[ai][bj][m][1];
#pragma unroll
                        for (int e = 0; e < 4; ++e) { a[e] = gelu_tanh(a[e]); b[e] = gelu_tanh(b[e]); }
                        s += sq4(a) + sq4(b); *(u32x4*)(rp + bj * HALF) = pack8_bf16(a, b); }
                    if (isv) { s += __shfl_xor(s, 16); s += __shfl_xor(s, 32); if (fq == 0) SS1[(size_t)row * 16 + (pn - 9) * 4 + wc] = s; } }
        } else {
            const int ct = (pn - 13) * 128 + cl;
#pragma unroll
            for (int ai = 0; ai < 2; ++ai)
#pragma unroll
                for (int m = 0; m < 4; ++m) { const size_t o = (size_t)(rowb + ai * HALF + m * 16) * 2048 + ct; f32x4 ra, rb, sa, sb2;
#pragma unroll
                    for (int e = 0; e < 4; ++e) {
                        const float eb0 = 1.f + __builtin_amdgcn_exp2f(-1.4426950409f * acc[ai][1][m][0][e]), eb1 = 1.f + __builtin_amdgcn_exp2f(-1.4426950409f * acc[ai][1][m][1][e]);
                        const float ea0 = 1.f + __builtin_amdgcn_exp2f(-1.4426950409f * acc[ai][0][m][0][e]), ea1 = 1.f + __builtin_amdgcn_exp2f(-1.4426950409f * acc[ai][0][m][1][e]);
                        sa[e] = __builtin_amdgcn_rcpf(eb0); sb2[e] = __builtin_amdgcn_rcpf(eb1); ra[e] = eb0 * __builtin_amdgcn_rcpf(ea0); rb[e] = eb1 * __builtin_amdgcn_rcpf(ea1); }
                    *(u32x4*)(RATIO + o) = pack8_bf16(ra, rb); *(u32x4*)(SB + o) = pack8_bf16(sa, sb2); }
        }
    }
};
struct EpiMerge {
    static constexpr bool PERM = true, AFTER_DRAIN = false, MID = true;
    const bf16_t *RATIO, *SB; bf16_t* H;
    __device__ __forceinline__ void mid(f32x4 (&acc)[2][2][4][2], const Unit& u, int wr, int wc, int, int) const {
        const int lane_ = lane_id_v(), fr = lane_ & 15, fq = lane_ >> 4;
        const int rowb = u.pm * BM + wr * 64 + fr, col = u.pn * 256 + wc * 32 + 8 * fq;
        u32x4 w[2][4][2];
#pragma unroll
        for (int ai = 0; ai < 2; ++ai)
#pragma unroll
            for (int m = 0; m < 4; ++m)
#pragma unroll
                for (int bj = 0; bj < 2; ++bj) w[ai][m][bj] = __builtin_nontemporal_load((const u32x4*)(RATIO + (size_t)(rowb + ai * HALF + m * 16) * 2048 + col + bj * HALF));
        asm volatile("" ::: "memory");
#pragma unroll
        for (int ai = 0; ai < 2; ++ai)
#pragma unroll
            for (int m = 0; m < 4; ++m)
#pragma unroll
                for (int bj = 0; bj < 2; ++bj) { const u32x4 v = w[ai][m][bj];
                    acc[ai][bj][m][0] *= (f32x4){bf_lo(v.x), bf_hi(v.x), bf_lo(v.y), bf_hi(v.y)}; acc[ai][bj][m][1] *= (f32x4){bf_lo(v.z), bf_hi(v.z), bf_lo(v.w), bf_hi(v.w)}; }
        asm volatile("" ::: "memory");
    }
    __device__ __forceinline__ void operator()(const f32x4 (&acc)[2][2][4][2], const Unit& u, int wr, int wc, int, int) const {
        const int lane_ = lane_id_v(), fr = lane_ & 15, fq = lane_ >> 4;
        const int rowb = u.pm * BM + wr * 64 + fr, col = u.pn * 256 + wc * 32 + 8 * fq;
        u32x4 w[2][4][2];
#pragma unroll
        for (int ai = 0; ai < 2; ++ai)
#pragma unroll
            for (int m = 0; m < 4; ++m)
#pragma unroll
                for (int bj = 0; bj < 2; ++bj) w[ai][m][bj] = __builtin_nontemporal_load((const u32x4*)(SB + (size_t)(rowb + ai * HALF + m * 16) * 2048 + col + bj * HALF));
        asm volatile("" ::: "memory");
#pragma unroll
        for (int ai = 0; ai < 2; ++ai) {
#pragma unroll
            for (int m = 0; m < 4; ++m)
#pragma unroll
                for (int bj = 0; bj < 2; ++bj) { const size_t o = (size_t)(rowb + ai * HALF + m * 16) * 2048 + col + bj * HALF; const u32x4 v = w[ai][m][bj];
                    *(u32x4*)(H + o) = pack8_bf16(acc[ai][bj][m][0] * (f32x4){bf_lo(v.x), bf_hi(v.x), bf_lo(v.y), bf_hi(v.y)}, acc[ai][bj][m][1] * (f32x4){bf_lo(v.z), bf_hi(v.z), bf_lo(v.w), bf_hi(v.w)}); }
            asm volatile("" ::: "memory");
        }
    }
};
#ifndef EPI_OUT_ROWS
#define EPI_OUT_ROWS 4
#endif
struct EpiOut {
    static constexpr bool PERM = true, AFTER_DRAIN = false, MID = false;
    const float *xp, *xs; bf16_t* XH; float* SS2;
    __device__ __forceinline__ void operator()(const f32x4 (&acc)[2][2][4][2], const Unit& u, int wr, int wc, int, int) const {
        const int lane_ = lane_id_v(), fr = lane_ & 15, fq = lane_ >> 4;
        const int rowb = u.pm * BM + wr * 64 + fr, col = u.pn * 256 + wc * 32 + 8 * fq;
#pragma unroll
        for (int ai = 0; ai < 2; ++ai)
#pragma unroll
            for (int mp = 0; mp < 4; mp += EPI_OUT_ROWS) {
                f32x4 xv[EPI_OUT_ROWS][2][2];
#pragma unroll
                for (int mm = 0; mm < EPI_OUT_ROWS; ++mm) { const int row = rowb + ai * HALF + (mp + mm) * 16; const float* xr = row < 16384 ? xp + (size_t)row * 2048 : (row < 16512 ? xs + (size_t)(row - 16384) * 2048 : nullptr);
#pragma unroll
                    for (int bj = 0; bj < 2; ++bj) { if (xr) { xv[mm][bj][0] = __builtin_nontemporal_load((const f32x4*)(xr + col + bj * HALF)); xv[mm][bj][1] = __builtin_nontemporal_load((const f32x4*)(xr + col + bj * HALF + 4)); } else { xv[mm][bj][0] = (f32x4){0.f, 0.f, 0.f, 0.f}; xv[mm][bj][1] = (f32x4){0.f, 0.f, 0.f, 0.f}; } } }
                asm volatile("" ::: "memory");
#pragma unroll
                for (int mm = 0; mm < EPI_OUT_ROWS; ++mm) { const int m = mp + mm, row = rowb + ai * HALF + m * 16; float s = 0.f;
#pragma unroll
                    for (int bj = 0; bj < 2; ++bj) { const f32x4 a = acc[ai][bj][m][0] + xv[mm][bj][0], b = acc[ai][bj][m][1] + xv[mm][bj][1];
                        s += sq4(a) + sq4(b); *(u32x4*)(XH + (size_t)row * 2048 + col + bj * HALF) = pack8_f16(a, b); }
                    s += __shfl_xor(s, 16); s += __shfl_xor(s, 32); if (fq == 0) SS2[(size_t)row * 32 + u.pn * 4 + wc] = s; }
                asm volatile("" ::: "memory");
            }
    }
};
struct EpiQ {
    static constexpr bool PERM = true, AFTER_DRAIN = false, MID = false;
    bf16_t* QP;
    __device__ __forceinline__ void operator()(const f32x4 (&acc)[2][2][4][2], const Unit& u, int wr, int wc, int, int) const {
        const int lane_ = lane_id_v(), fr = lane_ & 15, fq = lane_ >> 4;
        const int rowb = u.pm * BM + wr * 64 + fr, col = u.pn * 256 + wc * 32 + 8 * fq;
#pragma unroll
        for (int ai = 0; ai < 2; ++ai)
#pragma unroll
            for (int m = 0; m < 4; ++m)
#pragma unroll
                for (int bj = 0; bj < 2; ++bj) *(u32x4*)(QP + (size_t)(rowb + ai * HALF + m * 16) * 2048 + col + bj * HALF) = pack8_f16(acc[ai][bj][m][0], acc[ai][bj][m][1]);
    }
};
template <class Epi, class Sched, bool ALIGN_EPI = false, bool SP2 = false, bool F16 = false>
__device__ __forceinline__ void gemm_phase(PG8_LAS unsigned char* lds, const Gemm g, const Sched& S, const Epi& E, const int wid_in) {
    const int lane = lane_id_v(), wid = wid_in, tid = wid * 64 + lane, wr = wid >> 2, wc = wid & 3, fr = lane & 15, fq = lane >> 4;
    const int K = g.K, nt = K / BK;
    unsigned voffA[2], voffB[2];
#pragma unroll
    for (int i = 0; i < 2; ++i) { int R, C; stage_rc(tid * 16 + i * 8192, R, C); const int Rb = Epi::PERM ? ((R & ~31) + perm32(R & 31)) : R;
        voffA[i] = (unsigned)(R * K + C) * 2u; voffB[i] = (unsigned)(Rb * K + C) * 2u; }
    const size_t kstep = (size_t)(BK * 2);
    const size_t hstep = (size_t)HALF * K * 2;
    const size_t tstep = 2 * hstep;
    const unsigned ldsw = (unsigned)wid * 1024u;
    const int aoff = lds_byte(wr * 64 + fr, fq * 8), boff = lds_byte(wc * 32 + fr, fq * 8);
#define PG8_SA(b, h) (((b) * 2 + (h)) * HTB)
#define PG8_SB(b, h) ((4 + (b) * 2 + (h)) * HTB)
#define PG8_STAGE(bufoff, gbase, voff) do { _Pragma("unroll") for (int _i = 0; _i < 2; ++_i) \
        __builtin_amdgcn_global_load_lds((const unsigned*)((const char*)(gbase) + (voff)[_i]), (PG8_LAS unsigned*)(lds + (bufoff) + ldsw + _i * 8192), 16, 0, 0); } while (0)
#define PG8_LDA(dst, b, h) do { _Pragma("unroll") for (int m = 0; m < 4; ++m) _Pragma("unroll") for (int k = 0; k < 2; ++k) dst[m][k] = *(const PG8_LAS bf16x8*)(lds + PG8_SA(b, h) + aoff + m * 2048 + k * 1024); } while (0)
#define PG8_LDB(dst, b, h) do { _Pragma("unroll") for (int n = 0; n < 2; ++n) _Pragma("unroll") for (int k = 0; k < 2; ++k) dst[n][k] = *(const PG8_LAS bf16x8*)(lds + PG8_SB(b, h) + boff + n * 2048 + k * 1024); } while (0)
#define PG8_MMA(ai, bj, At, Bt) do { __builtin_amdgcn_s_setprio(1); _Pragma("unroll") for (int m = 0; m < 4; ++m) _Pragma("unroll") for (int n = 0; n < 2; ++n) _Pragma("unroll") for (int k = 0; k < 2; ++k) \
        acc[ai][bj][m][n] = mma16<F16>(Bt[n][k], At[m][k], acc[ai][bj][m][n]); __builtin_amdgcn_s_setprio(0); } while (0)
#define PG8_WAIT_V(n) asm volatile("s_waitcnt vmcnt(" #n ")" ::: "memory")
#define PG8_WAIT_L(n) asm volatile("s_waitcnt lgkmcnt(" #n ")" ::: "memory")
#define PG8_BAR __builtin_amdgcn_s_barrier()
#define PG8_SCHED __builtin_amdgcn_sched_barrier(0)
    Unit cur, nxt; int ui = 0;
    if (!S.next(0, cur)) return;
    f32x4 acc[2][2][4][2];
#pragma unroll
    for (int a = 0; a < 2; ++a)
#pragma unroll
        for (int b = 0; b < 2; ++b)
#pragma unroll
            for (int m = 0; m < 4; ++m)
#pragma unroll
                for (int n = 0; n < 2; ++n) acc[a][b][m][n] = (f32x4){0.f, 0.f, 0.f, 0.f};
    bf16x8 At[4][2], B0[2][2], B1[2][2];
    const char* cA = (const char*)g.A + (size_t)cur.pm * tstep; const char* cB = (const char*)g.Bt + (size_t)cur.pn * tstep;
    S.a_ready(cur);
    if constexpr (SP2) {
        PG8_STAGE(PG8_SB(0, 0), cB, voffB); PG8_STAGE(PG8_SB(0, 1), cB + hstep, voffB); PG8_STAGE(PG8_SA(0, 0), cA, voffA); PG8_STAGE(PG8_SA(0, 1), cA + hstep, voffA);
        if (wr == 1) PG8_BAR;
        PG8_WAIT_V(2); PG8_BAR;
        PG8_STAGE(PG8_SB(1, 0), cB + kstep, voffB); PG8_STAGE(PG8_SA(1, 0), cA + kstep, voffA); PG8_STAGE(PG8_SB(1, 1), cB + hstep + kstep, voffB);
        PG8_WAIT_V(6); PG8_BAR;
    } else {
        PG8_STAGE(PG8_SB(0, 0), cB, voffB); PG8_STAGE(PG8_SA(0, 0), cA, voffA); PG8_STAGE(PG8_SB(0, 1), cB + hstep, voffB); PG8_STAGE(PG8_SA(0, 1), cA + hstep, voffA);
        if (wr == 1) PG8_BAR;
        PG8_WAIT_V(4); PG8_BAR;
        PG8_STAGE(PG8_SB(1, 0), cB + kstep, voffB); PG8_STAGE(PG8_SA(1, 0), cA + kstep, voffA); PG8_STAGE(PG8_SB(1, 1), cB + hstep + kstep, voffB);
        PG8_WAIT_V(6); PG8_BAR;
    }
    for (;;) {
        const bool has_next = S.next(ui + 1, nxt);
        const char* nA = has_next ? (const char*)g.A + (size_t)nxt.pm * tstep : cA; const char* nB = has_next ? (const char*)g.Bt + (size_t)nxt.pn * tstep : cB;
        for (int t = 0; t < nt; t += 2) {
            const bool last = (t == nt - 2);
            const char* a1 = cA + (size_t)(t + 1) * kstep;
            const char* a2 = last ? nA : cA + (size_t)(t + 2) * kstep; const char* b2 = last ? nB : cB + (size_t)(t + 2) * kstep;
            const char* a3 = a2 + kstep; const char* b3 = b2 + kstep;
            if (last && has_next) S.a_ready(nxt);
            if constexpr (Epi::MID) { if (t == (nt >> 1)) E.mid(acc, cur, wr, wc, fr, fq); }
            if constexpr (SP2) {
            PG8_LDB(B0, 0, 0); PG8_LDB(B1, 0, 1); PG8_SCHED; PG8_LDA(At, 0, 0); PG8_STAGE(PG8_SA(1, 1), a1 + hstep, voffA);
            PG8_WAIT_V(8); PG8_WAIT_L(0); PG8_BAR; PG8_MMA(0, 0, At, B0); PG8_MMA(0, 1, At, B1); PG8_BAR; PG8_SCHED;
            PG8_LDA(At, 0, 1); PG8_STAGE(PG8_SB(0, 0), b2, voffB); PG8_STAGE(PG8_SB(0, 1), b2 + hstep, voffB); PG8_STAGE(PG8_SA(0, 0), a2, voffA);
            PG8_WAIT_V(8); PG8_WAIT_L(0); PG8_BAR; PG8_MMA(1, 0, At, B0); PG8_MMA(1, 1, At, B1); PG8_BAR; PG8_SCHED;
            PG8_LDB(B0, 1, 0); PG8_LDB(B1, 1, 1); PG8_SCHED; PG8_LDA(At, 1, 0); PG8_STAGE(PG8_SA(0, 1), a2 + hstep, voffA);
            PG8_WAIT_V(8); PG8_WAIT_L(0); PG8_BAR; PG8_MMA(0, 0, At, B0); PG8_MMA(0, 1, At, B1); PG8_BAR; PG8_SCHED;
            PG8_LDA(At, 1, 1); PG8_STAGE(PG8_SB(1, 0), b3, voffB); PG8_STAGE(PG8_SB(1, 1), b3 + hstep, voffB); PG8_STAGE(PG8_SA(1, 0), a3, voffA);
            PG8_WAIT_V(8); PG8_WAIT_L(0); PG8_BAR; PG8_MMA(1, 0, At, B0); PG8_MMA(1, 1, At, B1); PG8_BAR; PG8_SCHED;
            } else {
            PG8_LDB(B0, 0, 0); PG8_SCHED; PG8_LDA(At, 0, 0); PG8_STAGE(PG8_SA(1, 1), a1 + hstep, voffA);
            PG8_WAIT_L(8); PG8_BAR; PG8_WAIT_L(0); PG8_MMA(0, 0, At, B0); PG8_BAR; PG8_SCHED;
            PG8_LDB(B1, 0, 1); PG8_STAGE(PG8_SB(0, 0), b2, voffB);
            PG8_BAR; PG8_WAIT_L(0); PG8_MMA(0, 1, At, B1); PG8_BAR;
            PG8_LDA(At, 0, 1); PG8_STAGE(PG8_SA(0, 0), a2, voffA);
            PG8_BAR; PG8_WAIT_L(0); PG8_MMA(1, 0, At, B0); PG8_BAR; PG8_SCHED;
            PG8_STAGE(PG8_SB(0, 1), b2 + hstep, voffB);
            PG8_WAIT_V(6); PG8_BAR; PG8_MMA(1, 1, At, B1); PG8_BAR;
            PG8_LDB(B0, 1, 0); PG8_SCHED; PG8_LDA(At, 1, 0); PG8_STAGE(PG8_SA(0, 1), a2 + hstep, voffA);
            PG8_WAIT_L(8); PG8_BAR; PG8_WAIT_L(0); PG8_MMA(0, 0, At, B0); PG8_BAR; PG8_SCHED;
            PG8_LDB(B1, 1, 1); PG8_STAGE(PG8_SB(1, 0), b3, voffB);
            PG8_BAR; PG8_WAIT_L(0); PG8_MMA(0, 1, At, B1); PG8_BAR;
            PG8_LDA(At, 1, 1); PG8_STAGE(PG8_SA(1, 0), a3, voffA);
            PG8_BAR; PG8_WAIT_L(0); PG8_MMA(1, 0, At, B0); PG8_BAR; PG8_SCHED;
            PG8_STAGE(PG8_SB(1, 1), b3 + hstep, voffB);
            PG8_WAIT_V(6); PG8_BAR; PG8_MMA(1, 1, At, B1); PG8_BAR;
            }
        }
        if constexpr (ALIGN_EPI) { if (wr == 0) PG8_BAR; }
        if constexpr (!Epi::AFTER_DRAIN) { E(acc, cur, wr, wc, fr, fq); S.done(cur); }
        if (!has_next) break;
#pragma unroll
        for (int a = 0; a < 2; ++a)
#pragma unroll
            for (int b = 0; b < 2; ++b)
#pragma unroll
                for (int m = 0; m < 4; ++m)
#pragma unroll
                    for (int n = 0; n < 2; ++n) acc[a][b][m][n] = (f32x4){0.f, 0.f, 0.f, 0.f};
        cur = nxt; cA = nA; cB = nB; ++ui;
        if constexpr (ALIGN_EPI) { if (wr == 1) PG8_BAR; }
    }
    PG8_WAIT_V(0);
    if constexpr (!ALIGN_EPI) { if (wr == 0) PG8_BAR; }
    PG8_BAR;
    if constexpr (Epi::AFTER_DRAIN) { E.fused(acc, cur, wr, wc, fr, fq, lds, wid, lane); S.done(cur); }
#undef PG8_SA
#undef PG8_SB
#undef PG8_STAGE
#undef PG8_LDA
#undef PG8_LDB
#undef PG8_MMA
#undef PG8_WAIT_V
#undef PG8_WAIT_L
#undef PG8_BAR
#undef PG8_SCHED
}
}
#define GAS __attribute__((address_space(1)))
#define LAS __attribute__((address_space(3)))
typedef unsigned short bf16;
typedef unsigned v4u __attribute__((ext_vector_type(4)));
typedef float f32x4 __attribute__((ext_vector_type(4)));
typedef short bf16x8 __attribute__((ext_vector_type(8)));
typedef GAS unsigned gu32;
typedef GAS unsigned long long gu64;
#define RLX_AGENT __ATOMIC_RELAXED, __HIP_MEMORY_SCOPE_AGENT
#define LDS_WAIT() asm volatile("s_waitcnt lgkmcnt(0)" ::: "memory")
#define VM_WAIT() asm volatile("s_waitcnt vmcnt(0)" ::: "memory")
__device__ __forceinline__ unsigned long long rt() { return __builtin_amdgcn_s_memrealtime(); }
__device__ __forceinline__ unsigned f2bf(float f) { unsigned u = __builtin_bit_cast(unsigned, f); return (u + 0x7fffu + ((u >> 16) & 1u)) >> 16; }
__device__ __forceinline__ unsigned pk2(float lo, float hi) { return f2bf(lo) | (f2bf(hi) << 16); }

#define XB_TMO      128
#define XB_XCNT(j)  (256  + 64 * (j))
#define XB_XSUB(j)  (1280 + 64 * (j))
#define XB_XGEN(j)  (2304 + 64 * (j))
#define XB_TOP      3328
#define XB_TOPGEN   3392
#define XCD_BAR_WORDS 3456
#ifdef DEBUG_ORACLE
#define XB_SPIN_CAP (1u << 27)
#else
#define XB_SPIN_CAP (1u << 18)
#endif

__device__ __forceinline__ unsigned xb_ld(unsigned* p)              { return __hip_atomic_load(p, __ATOMIC_RELAXED, __HIP_MEMORY_SCOPE_AGENT); }
__device__ __forceinline__ unsigned xb_add(unsigned* p, unsigned v) { return __hip_atomic_fetch_add(p, v, __ATOMIC_RELAXED, __HIP_MEMORY_SCOPE_AGENT); }
__device__ __forceinline__ unsigned xb_xcc_id() { return (unsigned)__builtin_amdgcn_s_getreg((3 << 11) | 20) & 0xFu; }
#define XB_SPIN(cond, bar) do { unsigned _sp = 0; while (cond) { __builtin_amdgcn_s_sleep(1); \
    if ((++_sp & 255u) == 0u) { if (xb_ld(&(bar)[XB_TMO])) break; if (_sp > XB_SPIN_CAP) { atomicAdd(&(bar)[XB_TMO], 1u); break; } } } } while (0)

struct XcdBarrier {
    unsigned* bar; unsigned x;
    volatile LAS unsigned* st;
};

__device__ __forceinline__ XcdBarrier xcd_barrier_post(unsigned* bar, volatile LAS unsigned* st) {
    XcdBarrier b; b.bar = bar; b.x = xb_xcc_id(); b.st = st;
    if (threadIdx.x == 0) (void)xb_add(&bar[XB_XCNT(b.x)], 1u);
    return b;
}
__device__ __forceinline__ void xcd_barrier_complete(unsigned* bar, unsigned x, unsigned& nloc, unsigned& nx) {
    const unsigned G = gridDim.x * gridDim.y * gridDim.z;
    unsigned sum, cnt, mine, sp = 0u;
    for (;;) {
        sum = 0u; cnt = 0u; mine = 0u;
#pragma unroll
        for (unsigned j = 0; j < 16; ++j) { const unsigned c = xb_ld(&bar[XB_XCNT(j)]); sum += c; cnt += (c > 0u) ? 1u : 0u; mine = (j == x) ? c : mine; }
        if (sum == G) break;
        __builtin_amdgcn_s_sleep(1);
        if ((++sp & 255u) == 0u) { if (xb_ld(&bar[XB_TMO])) break; if (sp > XB_SPIN_CAP) { atomicAdd(&bar[XB_TMO], 1u); break; } }
    }
    nloc = mine > 0u ? mine : 1u; nx = cnt > 0u ? cnt : 1u;
}

__device__ __forceinline__ void xcd_barrier(const XcdBarrier& b) {
    asm volatile("s_waitcnt vmcnt(0)" ::: "memory");
    __syncthreads();
    if (threadIdx.x == 0) {
        unsigned* bar = b.bar;
        __builtin_amdgcn_s_waitcnt(0);
        unsigned nloc = b.st[0], nx = b.st[1];
        if (nloc == 0u) { xcd_barrier_complete(bar, b.x, nloc, nx); b.st[0] = nloc; b.st[1] = nx; }
        const unsigned old = xb_add(&bar[XB_XSUB(b.x)], 1u);
        const unsigned gen = old / nloc;
        if (old + 1u == (gen + 1u) * nloc) {
            __builtin_amdgcn_fence(__ATOMIC_RELEASE, "agent");
            asm volatile("s_waitcnt vmcnt(0)" ::: "memory");
            const unsigned og = xb_add(&bar[XB_TOP], 1u);
            const unsigned tg = og / nx;
            if (og + 1u == (tg + 1u) * nx) xb_add(&bar[XB_TOPGEN], 1u);
            else XB_SPIN(xb_ld(&bar[XB_TOPGEN]) == tg, bar);
            __builtin_amdgcn_fence(__ATOMIC_ACQUIRE, "agent");
            xb_add(&bar[XB_XGEN(b.x)], 1u);
            asm volatile("s_waitcnt vmcnt(0)" ::: "memory");
        } else {
            XB_SPIN(xb_ld(&bar[XB_XGEN(b.x)]) == gen, bar);
            __builtin_amdgcn_fence(__ATOMIC_ACQUIRE, "agent");
            asm volatile("s_waitcnt vmcnt(0)" ::: "memory");
        }
    }
    __syncthreads();
}
constexpr int NWAVES = 8, NTHR = 512;
constexpr int DM = 2048, SEQ = 2048, NBATCH = 8, TDEC = 16, MPROMPT = NBATCH * SEQ  , MSAMPLE = NBATCH * TDEC  , MREAL = MPROMPT + MSAMPLE  , MPAD = 16640  ;
constexpr int DIN = 7424, DATTN = 1024, DSGU = 1024, WINDOW = 128, CHUNK = 64, NHEADS = 16, HD = 64;
constexpr int NEXP = 16384, PEER_H = 8, PEER_K = 16;
#ifndef PEER_FP4
#define PEER_FP4 1
#endif
#ifndef PEER_FP6
#define PEER_FP6 (!PEER_FP4)
#endif
constexpr float PEER_SU = 64.f, PEER_SV = 16.f;
constexpr float EPS = 1e-6f, LOG2E = 1.4426950408889634f;
constexpr size_t OUT_Y = 0, OUT_KP = (size_t)MREAL * DM, OUT_VP = OUT_KP + 131072, OUT_KS = OUT_VP + 131072, OUT_VS = OUT_KS + 16384, OUT_SGU = OUT_VS + 16384, OUT_TOTAL = OUT_SGU + 131072;
constexpr size_t MiB = 1u << 20;
constexpr size_t WS_CTL = 0, CTL_ZERO_BYTES = 64 * 1024;
constexpr size_t WS_WIN = 1 * MiB;
constexpr size_t WS_WAB = 30 * MiB;
constexpr size_t WS_WOUT = 38 * MiB;
constexpr size_t WS_WQ = 46 * MiB;
constexpr size_t WS_KEYS = 54 * MiB;
constexpr size_t WS_WSM = 54 * MiB + 512 * 1024;
constexpr size_t WS_SS1 = 55 * MiB;
constexpr size_t WS_SS2 = 57 * MiB;
constexpr size_t WS_EU = 60 * MiB, WS_EV = 124 * MiB;
constexpr size_t WS_RA = 188 * MiB;
constexpr size_t WS_RB = 253 * MiB;
constexpr size_t WS_Q = WS_RB, WS_KV = WS_Q + (size_t)MPAD * 1024 * 2, WS_U = WS_KV + (size_t)MPAD * 256 * 2, WS_VS = WS_U + (size_t)MPAD * 1024 * 2;
constexpr size_t WS_RC = 359 * MiB;
constexpr size_t WS_RATIO = WS_RC, WS_SB = WS_RC + 65 * MiB, WS_END = WS_RC + 130 * MiB;
static_assert(WS_VS + (size_t)MPAD * 1024 * 2 <= WS_RC && WS_END == 489 * MiB, "d_ws map");
constexpr int CW_BAR = 4096;
constexpr int RING_OFF = 0, RING_BYTES = 131072;
constexpr int LDSCTL_OFF = RING_BYTES, MISC_OFF = LDSCTL_OFF + 320;
constexpr int LDS_BYTES = 147456;
struct Frame {
    LAS unsigned char* lds; volatile LAS unsigned* MISC; gu32* ctl;
    int wave, vcu, G;
    const float *x_prompt, *x_sample, *cache_k, *cache_v, *norm_mix_g, *w_in, *sgu_norm_g, *sgu_w_s, *sgu_b_s, *sinks, *rel_tab, *w_pa, *w_pb, *w_out, *norm_ffn_g, *w_query, *sub_keys, *exp_u, *exp_v, *norm_final_g;
    float* out; unsigned char* ws;
};
__device__ __forceinline__ float wave_sum(float v) {
#pragma unroll
    for (int o = 1; o < 64; o <<= 1) v += __shfl_xor(v, o);
    return v;
}
__device__ __forceinline__ unsigned pkb(float lo, float hi) { return pg8::pk_bf16(lo, hi); }
__device__ __forceinline__ unsigned pkh(float lo, float hi) { return pg8::pk_f16(lo, hi); }
template <bool F16>
__device__ __forceinline__ void p0_transpose_item(const float* W, int N, bf16* WT, int kpitch, int koff, int drow0, int k0, int n0, const float* kscale, LAS float* scr, int lane) {
    float wv[32];
#pragma unroll
    for (int i = 0; i < 32; ++i) { const int kk = 2 * i + (lane >> 5); wv[i] = __builtin_nontemporal_load(W + (size_t)(k0 + kk) * N + n0 + (lane & 31)); }
#pragma unroll
    for (int i = 0; i < 32; ++i) { const int kk = 2 * i + (lane >> 5); scr[kk * 33 + (lane & 31)] = wv[i]; }
    LDS_WAIT(); asm volatile("" ::: "memory");
    const int c = lane & 7;
    float sc[8];
#pragma unroll
    for (int q = 0; q < 8; ++q) sc[q] = kscale ? kscale[k0 + 8 * c + q] : 1.f;
#pragma unroll
    for (int j = 0; j < 4; ++j) { const int n = (lane >> 3) + 8 * j; const LAS float* s = scr + (8 * c) * 33 + n;
        float v[8];
#pragma unroll
        for (int q = 0; q < 8; ++q) v[q] = s[q * 33] * sc[q];
        v4u o;
        if (F16) { o.x = pkh(v[0], v[1]); o.y = pkh(v[2], v[3]); o.z = pkh(v[4], v[5]); o.w = pkh(v[6], v[7]); }
        else     { o.x = pkb(v[0], v[1]); o.y = pkb(v[2], v[3]); o.z = pkb(v[4], v[5]); o.w = pkb(v[6], v[7]); }
        *(GAS v4u*)(WT + (size_t)(drow0 + n) * kpitch + koff + k0 + 8 * c) = o; }
    LDS_WAIT(); asm volatile("" ::: "memory");
}
__device__ __forceinline__ int win_row_of_col(int n) {
    if (n < 3328) return n;
    if (n < 5376) { const int q = n - 3328; return 3328 + (q >> 7) * 256 + (q & 127); }
    const int q = n - 5376; return 3328 + (q >> 7) * 256 + 128 + (q & 127);
}
__device__ __forceinline__ void rms_row_to_bf16(const float* xrow, const float* g, bf16* orow, int lane) {
    const GAS f32x4* xr = (const GAS f32x4*)xrow + lane; const GAS f32x4* gr = (const GAS f32x4*)g + lane;
    f32x4 v[8]; float s = 0.f;
#pragma unroll
    for (int j = 0; j < 8; ++j) { v[j] = xr[64 * j]; s += (v[j].x * v[j].x + v[j].y * v[j].y) + (v[j].z * v[j].z + v[j].w * v[j].w); }
    const float r = 1.0f / sqrtf(wave_sum(s) * (1.f / DM) + EPS);
    GAS unsigned long long* o8 = (GAS unsigned long long*)orow + lane;
#pragma unroll
    for (int j = 0; j < 8; ++j) { const f32x4 gg = gr[64 * j]; o8[64 * j] = (unsigned long long)pkb(v[j].x * r * gg.x, v[j].y * r * gg.y) | ((unsigned long long)pkb(v[j].z * r * gg.z, v[j].w * r * gg.w) << 32); }
}
__device__ __forceinline__ void p0_transposes(Frame& F, int first, int last, int gw, int NGW) {
    const int lane = pg8::lane_id_v();
    LAS float* scr = (LAS float*)(F.lds + RING_OFF + F.wave * 16384);
    bf16* WIN = (bf16*)(F.ws + WS_WIN); bf16* WAB = (bf16*)(F.ws + WS_WAB); bf16* WOUT = (bf16*)(F.ws + WS_WOUT); bf16* WQ = (bf16*)(F.ws + WS_WQ);
    constexpr int I_IN = 32 * 232, I_PA = 16 * 64, I_OUT = 32 * 64;
    for (int it = first + gw; it < last; it += NGW) {
        int r = it;
        if (r < I_IN) { const int kb = r / 232, nb = r % 232; p0_transpose_item<false>(F.w_in, DIN, WIN, 2048, 0, win_row_of_col(32 * nb), 64 * kb, 32 * nb, nullptr, scr, lane); continue; } r -= I_IN;
        if (r < I_PA) { const int kb = r / 64, nb = r % 64; p0_transpose_item<false>(F.w_pa, 2048, WAB, 2048, 0, 32 * nb, 64 * kb, 32 * nb, nullptr, scr, lane); continue; } r -= I_PA;
        if (r < I_PA) { const int kb = r / 64, nb = r % 64; p0_transpose_item<false>(F.w_pb, 2048, WAB, 2048, 1024, 32 * nb, 64 * kb, 32 * nb, nullptr, scr, lane); continue; } r -= I_PA;
        if (r < I_OUT) { const int kb = r / 64, nb = r % 64; p0_transpose_item<false>(F.w_out, 2048, WOUT, 2048, 0, 32 * nb, 64 * kb, 32 * nb, nullptr, scr, lane); continue; } r -= I_OUT;
        { const int kb = r / 64, nb = r % 64; p0_transpose_item<true>(F.w_query, 2048, WQ, 2048, 0, 32 * nb, 64 * kb, 32 * nb, F.norm_ffn_g, scr, lane); }
    }
}
__device__ __forceinline__ void p0_expert_tables(Frame& F, int rank, int nranks) {
    const int lane = pg8::lane_id_v(), tid = F.wave * 64 + lane;
    const size_t gt = (size_t)rank * NTHR + tid, NT = (size_t)nranks * NTHR;
#if PEER_FP4
    { unsigned char* EU4 = F.ws + WS_EU; float* EUS = (float*)(F.ws + WS_EU + 16 * MiB); unsigned char* EV4 = F.ws + WS_EU + 32 * MiB; float* EVS = (float*)(F.ws + WS_EU + 48 * MiB);
        const int gwv = rank * NWAVES + F.wave, nwv = nranks * NWAVES;
        for (int row = gwv; row < NEXP; row += nwv) { const size_t c = (size_t)row * 64 + lane; float fu[32], fv[32]; float mu = 0.f, mv = 0.f;
#pragma unroll
            for (int q = 0; q < 8; ++q) { const size_t eo = (size_t)row * DM + q * 256 + lane * 4;
                const f32x4 a = __builtin_nontemporal_load((const GAS f32x4*)(F.exp_u + eo)) * *(const GAS f32x4*)(F.norm_ffn_g + q * 256 + lane * 4); const f32x4 p = __builtin_nontemporal_load((const GAS f32x4*)(F.exp_v + eo));
#pragma unroll
                for (int e = 0; e < 4; ++e) { fu[4 * q + e] = a[e]; fv[4 * q + e] = p[e]; mu = fmaxf(mu, fabsf(a[e])); mv = fmaxf(mv, fabsf(p[e])); } }
#pragma unroll
            for (int o = 1; o < 64; o <<= 1) { mu = fmaxf(mu, __shfl_xor(mu, o)); mv = fmaxf(mv, __shfl_xor(mv, o)); }
            const float su = fmaxf(mu, 1e-30f) * (1.0f / 6.0f), sv = fmaxf(mv, 1e-30f) * (1.0f / 6.0f), iu = 1.0f / su, iv = 1.0f / sv;
            v4u wu, wv;
#pragma unroll
            for (int q = 0; q < 4; ++q) { unsigned a = 0u, b2 = 0u;
                a = __builtin_amdgcn_cvt_scalef32_pk_fp4_f32(a, fu[8 * q + 0] * iu, fu[8 * q + 1] * iu, 1.0f, 0); a = __builtin_amdgcn_cvt_scalef32_pk_fp4_f32(a, fu[8 * q + 2] * iu, fu[8 * q + 3] * iu, 1.0f, 1);
                a = __builtin_amdgcn_cvt_scalef32_pk_fp4_f32(a, fu[8 * q + 4] * iu, fu[8 * q + 5] * iu, 1.0f, 2); a = __builtin_amdgcn_cvt_scalef32_pk_fp4_f32(a, fu[8 * q + 6] * iu, fu[8 * q + 7] * iu, 1.0f, 3);
                b2 = __builtin_amdgcn_cvt_scalef32_pk_fp4_f32(b2, fv[8 * q + 0] * iv, fv[8 * q + 1] * iv, 1.0f, 0); b2 = __builtin_amdgcn_cvt_scalef32_pk_fp4_f32(b2, fv[8 * q + 2] * iv, fv[8 * q + 3] * iv, 1.0f, 1);
                b2 = __builtin_amdgcn_cvt_scalef32_pk_fp4_f32(b2, fv[8 * q + 4] * iv, fv[8 * q + 5] * iv, 1.0f, 2); b2 = __builtin_amdgcn_cvt_scalef32_pk_fp4_f32(b2, fv[8 * q + 6] * iv, fv[8 * q + 7] * iv, 1.0f, 3);
                wu[q] = a; wv[q] = b2; }
            *(GAS v4u*)(EU4 + c * 16) = wu; *(GAS v4u*)(EV4 + c * 16) = wv; if (lane == 0) { EUS[row] = su; EVS[row] = sv; } } }
#elif PEER_FP6
    { unsigned char* EU6 = F.ws + WS_EU; unsigned char* EV6 = F.ws + WS_EU + 32 * MiB;
        typedef _Float16 h32v __attribute__((ext_vector_type(32))); typedef unsigned u6v __attribute__((ext_vector_type(6)));
        for (size_t c = gt; c < (size_t)NEXP * 64; c += NT) { const int d0 = (int)((c * 32) & (DM - 1)); h32v hu, hv;
#pragma unroll
            for (int q = 0; q < 8; ++q) { const f32x4 a = *(const GAS f32x4*)(F.exp_u + c * 32 + q * 4) * *(const GAS f32x4*)(F.norm_ffn_g + d0 + q * 4) * PEER_SU; const f32x4 p = *(const GAS f32x4*)(F.exp_v + c * 32 + q * 4) * PEER_SV;
                hu[4 * q] = (_Float16)a.x; hu[4 * q + 1] = (_Float16)a.y; hu[4 * q + 2] = (_Float16)a.z; hu[4 * q + 3] = (_Float16)a.w; hv[4 * q] = (_Float16)p.x; hv[4 * q + 1] = (_Float16)p.y; hv[4 * q + 2] = (_Float16)p.z; hv[4 * q + 3] = (_Float16)p.w; }
            const u6v pu = __builtin_amdgcn_cvt_scalef32_pk32_fp6_f16(hu, 1.0f), pv = __builtin_amdgcn_cvt_scalef32_pk32_fp6_f16(hv, 1.0f);
            typedef unsigned u2v __attribute__((ext_vector_type(2)));
            GAS u2v* du = (GAS u2v*)(EU6 + c * 24); GAS u2v* dv = (GAS u2v*)(EV6 + c * 24);
            du[0] = (u2v){pu[0], pu[1]}; du[1] = (u2v){pu[2], pu[3]}; du[2] = (u2v){pu[4], pu[5]}; dv[0] = (u2v){pv[0], pv[1]}; dv[1] = (u2v){pv[2], pv[3]}; dv[2] = (u2v){pv[4], pv[5]}; } }
#endif
}
#ifndef P0_LATE_W
#define P0_LATE_W 1
#endif
#ifndef P0_PIPE
#define P0_PIPE 1
#endif
__device__ __forceinline__ void p0_prologue(Frame& F) {
    const int lane = pg8::lane_id_v(), tid = F.wave * 64 + lane;
    const int gw = F.vcu * NWAVES + F.wave, NGW = F.G * NWAVES;
#if P0_LATE_W
    p0_transposes(F, 0, 32 * 232, gw, NGW);
#else
    p0_transposes(F, 0, 32 * 232 + 2 * 16 * 64 + 2 * 32 * 64, gw, NGW);
#endif
    bf16* XN = (bf16*)(F.ws + WS_RA);
#if P0_PIPE
    {
        f32x4 v[8], nx[8];
        const GAS f32x4* gr = (const GAS f32x4*)F.norm_mix_g + lane;
        int m = gw;
        if (m < MREAL) { const GAS f32x4* xr = (const GAS f32x4*)((m < MPROMPT) ? F.x_prompt + (size_t)m * DM : F.x_sample + (size_t)(m - MPROMPT) * DM) + lane;
#pragma unroll
            for (int j = 0; j < 8; ++j) v[j] = xr[64 * j]; }
        for (; m < MPAD; m += NGW) {
            const int mn = m + NGW;
            if (mn < MREAL) { const GAS f32x4* xr = (const GAS f32x4*)((mn < MPROMPT) ? F.x_prompt + (size_t)mn * DM : F.x_sample + (size_t)(mn - MPROMPT) * DM) + lane;
#pragma unroll
                for (int j = 0; j < 8; ++j) nx[j] = xr[64 * j]; }
            if (m < MREAL) {
                float s = 0.f;
#pragma unroll
                for (int j = 0; j < 8; ++j) s += (v[j].x * v[j].x + v[j].y * v[j].y) + (v[j].z * v[j].z + v[j].w * v[j].w);
                const float r = 1.0f / sqrtf(wave_sum(s) * (1.f / DM) + EPS);
                GAS unsigned long long* o8 = (GAS unsigned long long*)(XN + (size_t)m * DM) + lane;
#pragma unroll
                for (int j = 0; j < 8; ++j) { const f32x4 gg = gr[64 * j]; o8[64 * j] = (unsigned long long)pkb(v[j].x * r * gg.x, v[j].y * r * gg.y) | ((unsigned long long)pkb(v[j].z * r * gg.z, v[j].w * r * gg.w) << 32); }
            } else { GAS v4u* o = (GAS v4u*)(XN + (size_t)m * DM) + lane;
#pragma unroll
                for (int j = 0; j < 4; ++j) o[64 * j] = (v4u){0u, 0u, 0u, 0u}; }
#pragma unroll
            for (int j = 0; j < 8; ++j) v[j] = nx[j];
        }
    }
#else
    for (int m = gw; m < MPAD; m += NGW) {
        if (m < MPROMPT) rms_row_to_bf16(F.x_prompt + (size_t)m * DM, F.norm_mix_g, XN + (size_t)m * DM, lane);
        else if (m < MREAL) rms_row_to_bf16(F.x_sample + (size_t)(m - MPROMPT) * DM, F.norm_mix_g, XN + (size_t)m * DM, lane);
        else { GAS v4u* o = (GAS v4u*)(XN + (size_t)m * DM) + lane;
#pragma unroll
            for (int j = 0; j < 4; ++j) o[64 * j] = (v4u){0u, 0u, 0u, 0u}; }
    }
#endif
    const size_t gt = (size_t)F.vcu * NTHR + tid, NT = (size_t)F.G * NTHR;
    { bf16* KH = (bf16*)(F.ws + WS_KEYS);
        for (size_t c = gt; c < 262144 / 8; c += NT) { const f32x4 a = *(const GAS f32x4*)(F.sub_keys + c * 8), b = *(const GAS f32x4*)(F.sub_keys + c * 8 + 4);
            *(GAS v4u*)(KH + c * 8) = (v4u){pkh(a.x, a.y), pkh(a.z, a.w), pkh(b.x, b.y), pkh(b.z, b.w)}; } }
    { bf16* WSM = (bf16*)(F.ws + WS_WSM);
        for (size_t c = gt; c < 131072 / 8; c += NT) { f32x4 a = *(const GAS f32x4*)(F.sgu_w_s + c * 8), b = *(const GAS f32x4*)(F.sgu_w_s + c * 8 + 4);
            const int t = (int)((c * 8) >> 7) & 127, s0 = (int)(c * 8) & 127;
#pragma unroll
            for (int e = 0; e < 4; ++e) { if (s0 + e > t) a[e] = 0.f; if (s0 + 4 + e > t) b[e] = 0.f; }
            *(GAS v4u*)(WSM + c * 8) = (v4u){pkb(a.x, a.y), pkb(a.z, a.w), pkb(b.x, b.y), pkb(b.z, b.w)}; } }
}
typedef float f32x16 __attribute__((ext_vector_type(16)));
typedef short s16x4 __attribute__((ext_vector_type(4)));
typedef short v4i16_t __attribute__((ext_vector_type(4)));
__device__ __forceinline__ int crow(int r, int hi) { return (r & 3) + 8 * (r >> 2) + 4 * hi; }
__device__ __forceinline__ s16x4 vtr(const LAS unsigned char* p) { return __builtin_bit_cast(s16x4, __builtin_amdgcn_ds_read_tr16_b64_v4i16((LAS v4i16_t*)p)); }
__device__ __forceinline__ bf16 bf1(float x) { return (bf16)(pkb(x, 0.f) & 0xffffu); }
__device__ __forceinline__ float bf2f(bf16 b) { return __builtin_bit_cast(float, (unsigned)b << 16); }
__device__ __forceinline__ float half_max(float m) { return fmaxf(m, __builtin_bit_cast(float, pg8::partner32(__builtin_bit_cast(unsigned, m)))); }
__device__ __forceinline__ float half_sum(float m) { return m + __builtin_bit_cast(float, pg8::partner32(__builtin_bit_cast(unsigned, m))); }
constexpr int P2_KL = 0, P2_VL = 24576, P2_BIAS = 49152, P2_OST = 65536, P2_GL = 0, P2_RL = 32768, P2_SST = 65536;
constexpr int N_ATT_UNITS = 512 + 16, N_SGU_UNITS = 1024 + 64;

struct AttnDesc { int b, c, kvh, qrow0, nqb, jlo, jhi; bool sample; };
__device__ __forceinline__ AttnDesc attn_desc(int uid) { AttnDesc d; d.sample = uid >= 512; d.c = 0;
    if (!d.sample) { d.b = uid >> 6; d.c = (uid >> 1) & 31; d.kvh = uid & 1; d.qrow0 = d.b * SEQ + d.c * CHUNK; d.nqb = 2; d.jlo = 128 - 64 * d.c; if (d.jlo < 0) d.jlo = 0; d.jhi = 192; }
    else { const int s = uid - 512; d.b = s >> 1; d.kvh = s & 1; d.qrow0 = MPROMPT + d.b * TDEC; d.nqb = 1; d.jlo = 0; d.jhi = 144; }
    return d; }
__device__ __forceinline__ void attn_kv_load(Frame& F, const AttnDesc& d, int, v4u (&kq)[3], v4u (&vq)[3]) {
    const int tid = F.wave * 64 + pg8::lane_id_v();
    const bf16* KV = (const bf16*)(F.ws + WS_KV);
#pragma unroll
    for (int i = 0; i < 3; ++i) { const int idx = tid + 512 * i, key = idx >> 3, ch = idx & 7; kq[i] = (v4u){0u, 0u, 0u, 0u}; vq[i] = (v4u){0u, 0u, 0u, 0u};
        if (!d.sample) { const int pos = d.c * CHUNK - WINDOW + key; if (pos >= 0) { const bf16* rp = KV + (size_t)(d.b * SEQ + pos) * 256 + d.kvh * 64 + ch * 8; kq[i] = *(const GAS v4u*)rp; vq[i] = *(const GAS v4u*)(rp + 128); } }
        else if (key < 128) { const size_t o = ((size_t)(d.b * WINDOW + key) * 2 + d.kvh) * 64 + ch * 8;
            const f32x4 a = *(const GAS f32x4*)(F.cache_k + o), a2 = *(const GAS f32x4*)(F.cache_k + o + 4), p = *(const GAS f32x4*)(F.cache_v + o), p2 = *(const GAS f32x4*)(F.cache_v + o + 4);
            kq[i] = (v4u){pkb(a.x, a.y), pkb(a.z, a.w), pkb(a2.x, a2.y), pkb(a2.z, a2.w)}; vq[i] = (v4u){pkb(p.x, p.y), pkb(p.z, p.w), pkb(p2.x, p2.y), pkb(p2.z, p2.w)}; }
        else if (key < 144) { const bf16* rp = KV + (size_t)(MPROMPT + d.b * TDEC + key - 128) * 256 + d.kvh * 64 + ch * 8; kq[i] = *(const GAS v4u*)rp; vq[i] = *(const GAS v4u*)(rp + 128); } }
}
__device__ __forceinline__ void attn_kv_store(Frame& F, int, const v4u (&kq)[3], const v4u (&vq)[3]) {
    const int tid = F.wave * 64 + pg8::lane_id_v();
    LAS unsigned char* KL = F.lds + P2_KL; LAS unsigned char* VL = F.lds + P2_VL;
#pragma unroll
    for (int i = 0; i < 3; ++i) { const int idx = tid + 512 * i, key = idx >> 3, ch = idx & 7; *(LAS v4u*)(KL + ch * 3072 + key * 16) = kq[i]; *(LAS v4u*)(VL + (ch >> 2) * 12288 + key * 64 + (ch & 3) * 16) = vq[i]; }
}
template <bool MASK> __device__ __forceinline__ void attn_compute(Frame& F, const AttnDesc& d, bf16x8 (&qr)[4]) {
    const int lane = pg8::lane_id_v();
    const int w = F.wave, r = lane & 31, h = lane >> 5;
    LAS unsigned char* KL = F.lds + P2_KL; LAS unsigned char* VL = F.lds + P2_VL; const LAS float* BL = (const LAS float*)(F.lds + P2_BIAS); LAS unsigned char* OST = F.lds + P2_OST + w * 4096;
    const bf16* Q = (const bf16*)(F.ws + WS_Q); bf16* OS = (bf16*)(F.ws + WS_RA);
    const int hd = d.kvh * 8 + w; const float sink2 = F.sinks[hd] * LOG2E; const LAS float* bl = BL + hd * 256;
    const int vlane = (4 * h + ((lane & 15) >> 2)) * 64 + (((lane >> 4) & 1) * 16 + (lane & 3) * 4) * 2;
    for (int qb = 0; qb < d.nqb; ++qb) {
        const int qi = qb * 32 + r;
        f32x16 S[6];
#pragma unroll
        for (int kb = 0; kb < 6; ++kb) { f32x16 a = {};
#pragma unroll
            for (int ks = 0; ks < 4; ++ks) { const bf16x8 kf = *(const LAS bf16x8*)(KL + (2 * ks + h) * 3072 + (kb * 32 + r) * 16); a = __builtin_amdgcn_mfma_f32_32x32x16_bf16(kf, qr[ks], a, 0, 0, 0); }
            S[kb] = a; asm volatile("" ::: "memory"); }
        if (qb + 1 < d.nqb) { const int qrow_n = d.qrow0 + (qb + 1) * 32 + r;
#pragma unroll
            for (int ks = 0; ks < 4; ++ks) qr[ks] = *(const GAS bf16x8*)(Q + (size_t)qrow_n * 1024 + hd * 64 + ks * 16 + h * 8); }
        float mx = -1e30f;
        const LAS float* blq = bl + (63 - qi + 4 * h);
        if (MASK) {
#pragma unroll
            for (int kb = 0; kb < 6; ++kb)
#pragma unroll
                for (int i = 0; i < 16; ++i) { const int j = kb * 32 + crow(i, h); float t = S[kb][i] + blq[kb * 32 + (i & 3) + 8 * (i >> 2)]; t = (j >= d.jlo && j < d.jhi) ? t : -1e30f; S[kb][i] = t; mx = fmaxf(mx, t); }
        } else {
#pragma unroll
            for (int kb = 0; kb < 6; ++kb)
#pragma unroll
                for (int i = 0; i < 16; ++i) { const float t = S[kb][i] + blq[kb * 32 + (i & 3) + 8 * (i >> 2)]; S[kb][i] = t; mx = fmaxf(mx, t); }
        }
        mx = fmaxf(half_max(mx), sink2);
        float l = 0.f;
#pragma unroll
        for (int kb = 0; kb < 6; ++kb)
#pragma unroll
            for (int i = 0; i < 16; ++i) { const float e = __builtin_amdgcn_exp2f(S[kb][i] - mx); S[kb][i] = e; l += e; }
        l = half_sum(l) + __builtin_amdgcn_exp2f(sink2 - mx);
        const float inv = 1.0f / l;
        f32x16 O[2]; O[0] = f32x16{}; O[1] = f32x16{};
#pragma unroll
        for (int kb = 0; kb < 6; ++kb)
#pragma unroll
            for (int s2 = 0; s2 < 2; ++s2) { v4u wv; wv.x = pkb(S[kb][8 * s2 + 0] * inv, S[kb][8 * s2 + 1] * inv); wv.y = pkb(S[kb][8 * s2 + 2] * inv, S[kb][8 * s2 + 3] * inv);
                wv.z = pkb(S[kb][8 * s2 + 4] * inv, S[kb][8 * s2 + 5] * inv); wv.w = pkb(S[kb][8 * s2 + 6] * inv, S[kb][8 * s2 + 7] * inv); const bf16x8 pa = __builtin_bit_cast(bf16x8, wv);
#pragma unroll
                for (int db = 0; db < 2; ++db) { const LAS unsigned char* vp = VL + db * 12288 + (kb * 32 + s2 * 16) * 64 + vlane; const s16x4 lo = vtr(vp), hi = vtr(vp + 8 * 64);
                    const bf16x8 vf = (bf16x8){lo[0], lo[1], lo[2], lo[3], hi[0], hi[1], hi[2], hi[3]}; O[db] = __builtin_amdgcn_mfma_f32_32x32x16_bf16(pa, vf, O[db], 0, 0, 0); } }
#pragma unroll
        for (int db = 0; db < 2; ++db)
#pragma unroll
            for (int i = 0; i < 16; ++i) *(LAS bf16*)(OST + (crow(i, h) * 64 + db * 32 + r) * 2) = bf1(O[db][i]);
        LDS_WAIT(); asm volatile("" ::: "memory");
#pragma unroll
        for (int it = 0; it < 4; ++it) { const int row = it * 8 + (lane >> 3), ch = lane & 7; const v4u v = *(const LAS v4u*)(OST + row * 128 + ch * 16);
            if (!d.sample || row < TDEC) *(GAS v4u*)(OS + (size_t)(d.qrow0 + qb * 32 + row) * 2048 + hd * 64 + ch * 8) = v; }
        LDS_WAIT(); asm volatile("" ::: "memory");
    }
}
__device__ __forceinline__ void attn_q_load0(Frame& F, const AttnDesc& d, bf16x8 (&qr)[4]) {
    const int lane = pg8::lane_id_v(), r = lane & 31, h = lane >> 5; const bf16* Q = (const bf16*)(F.ws + WS_Q); const int hd = d.kvh * 8 + F.wave;
    const int qrow = d.qrow0 + (d.sample ? (r & 15) : r);
#pragma unroll
    for (int ks = 0; ks < 4; ++ks) qr[ks] = *(const GAS bf16x8*)(Q + (size_t)qrow * 1024 + hd * 64 + ks * 16 + h * 8);
}
__device__ __forceinline__ void attn_units(Frame& F) {
    for (int u = F.vcu; u < N_ATT_UNITS; u += F.G) {
        bf16x8 qr[4];
        { v4u kq[3], vq[3]; const AttnDesc d0 = attn_desc(u); attn_kv_load(F, d0, 0, kq, vq); attn_q_load0(F, d0, qr); attn_kv_store(F, 0, kq, vq); }
        __syncthreads();
        { const AttnDesc d = attn_desc(u); if (d.jlo == 0 && d.jhi == 192) attn_compute<false>(F, d, qr); else attn_compute<true>(F, d, qr); }
        LDS_WAIT(); __builtin_amdgcn_s_barrier(); asm volatile("" ::: "memory");
    }
}

struct SguOps { v4u gvq[4]; float ssp[4]; bf16x8 af[8]; v4u uq[4]; float bs[4]; f32x4 sg0, sg1; };
__device__ __forceinline__ void sgu_load(Frame& F, const int uid, SguOps& R) {
    const int lane = pg8::lane_id_v(), w = F.wave, tid = w * 64 + lane, r = lane & 31, h = lane >> 5;
    LAS unsigned char* GL = F.lds + P2_GL;
    const bf16* VS = (const bf16*)(F.ws + WS_VS); const bf16* U = (const bf16*)(F.ws + WS_U); const bf16* WSM = (const bf16*)(F.ws + WS_WSM); const float* SS1 = (const float*)(F.ws + WS_SS1); bf16* OS = (bf16*)(F.ws + WS_RA);
    const bool sample = uid >= 1024; int b, g, row0, nv;
    if (!sample) { b = uid >> 7; const int blk = (uid >> 3) & 15; g = uid & 7; row0 = b * SEQ + blk * 128; nv = 128; }
    else { const int s = uid - 1024; b = s >> 3; g = s & 7; row0 = MPROMPT + b * TDEC; nv = TDEC; }
    const int wr = w >> 1, wc = w & 1; const bool active = 32 * wr < nv; const int nks = 2 * (wr + 1);
    const int er = lane >> 3, ec = (lane & 7) * 8;
    (void)GL; (void)VS; (void)U; (void)WSM; (void)SS1; (void)OS; (void)b; (void)r; (void)h; (void)tid; (void)nks; (void)er; (void)ec; (void)active;
#pragma unroll
    for (int i = 0; i < 4; ++i) { const int idx = tid + 512 * i, s = idx >> 4, ch = idx & 15; R.gvq[i] = (v4u){0u, 0u, 0u, 0u}; R.ssp[i] = 0.f;
        if (s < nv) { R.gvq[i] = *(const GAS v4u*)(VS + (size_t)(row0 + s) * 1024 + g * 128 + ch * 8); R.ssp[i] = SS1[(size_t)(row0 + s) * 16 + ch]; } }
    if (active) {
#pragma unroll
        for (int ks = 0; ks < 8; ++ks) { R.af[ks] = (bf16x8){0, 0, 0, 0, 0, 0, 0, 0}; if (ks < nks) R.af[ks] = *(const GAS bf16x8*)(WSM + (size_t)(g * 128 + 32 * wr + r) * 128 + 16 * ks + 8 * h); }
        R.sg0 = *(const GAS f32x4*)(F.sgu_norm_g + g * 128 + 64 * wc + ec); R.sg1 = *(const GAS f32x4*)(F.sgu_norm_g + g * 128 + 64 * wc + ec + 4);
#pragma unroll
        for (int c = 0; c < 4; ++c) { const int t = 32 * wr + 8 * c + er; R.uq[c] = (v4u){0u, 0u, 0u, 0u}; R.bs[c] = F.sgu_b_s[g * 128 + t];
            if (t < nv) R.uq[c] = *(const GAS v4u*)(U + (size_t)(row0 + t) * 1024 + g * 128 + 64 * wc + ec); }
    }
}
__device__ __forceinline__ void sgu_process(Frame& F, const int uid, SguOps& R) {
    const int lane = pg8::lane_id_v(), w = F.wave, tid = w * 64 + lane, r = lane & 31, h = lane >> 5;
    LAS unsigned char* GL = F.lds + P2_GL;
    const bf16* VS = (const bf16*)(F.ws + WS_VS); const bf16* U = (const bf16*)(F.ws + WS_U); const bf16* WSM = (const bf16*)(F.ws + WS_WSM); const float* SS1 = (const float*)(F.ws + WS_SS1); bf16* OS = (bf16*)(F.ws + WS_RA);
    const bool sample = uid >= 1024; int b, g, row0, nv;
    if (!sample) { b = uid >> 7; const int blk = (uid >> 3) & 15; g = uid & 7; row0 = b * SEQ + blk * 128; nv = 128; }
    else { const int s = uid - 1024; b = s >> 3; g = s & 7; row0 = MPROMPT + b * TDEC; nv = TDEC; }
    const int wr = w >> 1, wc = w & 1; const bool active = 32 * wr < nv; const int nks = 2 * (wr + 1);
    const int er = lane >> 3, ec = (lane & 7) * 8;
    (void)GL; (void)VS; (void)U; (void)WSM; (void)SS1; (void)OS; (void)b; (void)r; (void)h; (void)tid; (void)nks; (void)er; (void)ec; (void)active;
#pragma unroll
    for (int i = 0; i < 4; ++i) { const int idx = tid + 512 * i, s = idx >> 4, ch = idx & 15; v4u o = (v4u){0u, 0u, 0u, 0u};
        float ss = R.ssp[i];
        ss += __builtin_bit_cast(float, __builtin_amdgcn_ds_swizzle(__builtin_bit_cast(int, ss), (1 << 10) | 0x1f)); ss += __builtin_bit_cast(float, __builtin_amdgcn_ds_swizzle(__builtin_bit_cast(int, ss), (2 << 10) | 0x1f));
        ss += __builtin_bit_cast(float, __builtin_amdgcn_ds_swizzle(__builtin_bit_cast(int, ss), (4 << 10) | 0x1f)); ss += __builtin_bit_cast(float, __builtin_amdgcn_ds_swizzle(__builtin_bit_cast(int, ss), (8 << 10) | 0x1f));
        if (s < nv) {
            const float rr = 1.0f / sqrtf(ss * (1.f / DSGU) + EPS); const v4u wv = R.gvq[i];
            float f[8] = {pg8::bf_lo(wv.x) * rr, pg8::bf_hi(wv.x) * rr, pg8::bf_lo(wv.y) * rr, pg8::bf_hi(wv.y) * rr, pg8::bf_lo(wv.z) * rr, pg8::bf_hi(wv.z) * rr, pg8::bf_lo(wv.w) * rr, pg8::bf_hi(wv.w) * rr};
            o = (v4u){pkb(f[0], f[1]), pkb(f[2], f[3]), pkb(f[4], f[5]), pkb(f[6], f[7])};
            if (sample) { const f32x4 g0 = *(const GAS f32x4*)(F.sgu_norm_g + g * 128 + ch * 8), g1 = *(const GAS f32x4*)(F.sgu_norm_g + g * 128 + ch * 8 + 4); float* dst = F.out + OUT_SGU + (size_t)(b * TDEC + s) * 1024 + g * 128 + ch * 8;
                *(GAS f32x4*)dst = (f32x4){f[0] * g0.x, f[1] * g0.y, f[2] * g0.z, f[3] * g0.w}; *(GAS f32x4*)(dst + 4) = (f32x4){f[4] * g1.x, f[5] * g1.y, f[6] * g1.z, f[7] * g1.w}; } }
        *(LAS v4u*)(GL + (ch >> 2) * 8192 + s * 64 + (ch & 3) * 16) = o; }
    LDS_WAIT(); __builtin_amdgcn_s_barrier(); asm volatile("" ::: "memory");
    if (active) {
        f32x16 acc[2]; acc[0] = f32x16{}; acc[1] = f32x16{};
        const int glane = (8 * h + ((lane & 15) >> 2)) * 64 + (((lane >> 4) & 1) * 16 + (lane & 3) * 4) * 2;
#pragma unroll
        for (int ks = 0; ks < 8; ++ks) if (ks < nks) {
#pragma unroll
            for (int cb = 0; cb < 2; ++cb) { const LAS unsigned char* gp = GL + (2 * wc + cb) * 8192 + (16 * ks) * 64 + glane; const s16x4 lo = vtr(gp), hi = vtr(gp + 4 * 64);
                const bf16x8 bb = (bf16x8){lo[0], lo[1], lo[2], lo[3], hi[0], hi[1], hi[2], hi[3]}; acc[cb] = __builtin_amdgcn_mfma_f32_32x32x16_bf16(R.af[ks], bb, acc[cb], 0, 0, 0); } }
        LAS float* STG = (LAS float*)(F.lds + P2_SST + w * 8192);
#pragma unroll
        for (int cb = 0; cb < 2; ++cb)
#pragma unroll
            for (int i = 0; i < 16; ++i) STG[crow(i, h) * 64 + 32 * cb + r] = acc[cb][i];
        LDS_WAIT(); asm volatile("" ::: "memory");
#pragma unroll
        for (int c = 0; c < 4; ++c) { const int t = 32 * wr + 8 * c + er;
            const f32x4 a0 = *(const LAS f32x4*)(STG + (8 * c + er) * 64 + ec), a1 = *(const LAS f32x4*)(STG + (8 * c + er) * 64 + ec + 4); const v4u uw = R.uq[c]; const float bb = R.bs[c];
            const v4u o = {pkb(pg8::bf_lo(uw.x) * (a0.x * R.sg0.x + bb), pg8::bf_hi(uw.x) * (a0.y * R.sg0.y + bb)), pkb(pg8::bf_lo(uw.y) * (a0.z * R.sg0.z + bb), pg8::bf_hi(uw.y) * (a0.w * R.sg0.w + bb)),
                           pkb(pg8::bf_lo(uw.z) * (a1.x * R.sg1.x + bb), pg8::bf_hi(uw.z) * (a1.y * R.sg1.y + bb)), pkb(pg8::bf_lo(uw.w) * (a1.z * R.sg1.z + bb), pg8::bf_hi(uw.w) * (a1.w * R.sg1.w + bb))};
            if (t < nv) *(GAS v4u*)(OS + (size_t)(row0 + t) * 2048 + 1024 + g * 128 + 64 * wc + ec) = o; }
    }
    LDS_WAIT(); __builtin_amdgcn_s_barrier(); asm volatile("" ::: "memory");
}
__device__ __forceinline__ int sgu_uid(const Frame& F, const int k) {
    const int u0 = F.G - 1 - F.vcu;
    if (F.G == 256 && F.vcu < 16) return k < 3 ? u0 + k * 256 : -1;
    if (F.G == 256 && F.vcu < 32) return k < 4 ? u0 + k * 256 : (k == 4 ? 1023 - (F.vcu - 16) : -1);
    const int u = u0 + k * F.G; return u < N_SGU_UNITS ? u : -1;
}
__device__ __forceinline__ void sgu_units(Frame& F) {
    SguOps A, B; int k = 0, ua = sgu_uid(F, 0);
    if (ua >= 0) sgu_load(F, ua, A);
    while (ua >= 0) {
        const int ub = sgu_uid(F, k + 1); if (ub >= 0) sgu_load(F, ub, B);
        sgu_process(F, ua, A);
        if (ub < 0) break;
        ua = sgu_uid(F, k + 2); if (ua >= 0) sgu_load(F, ua, A);
        sgu_process(F, ub, B);
        k += 2;
    }
}


__device__ __forceinline__ void p2_mixers(Frame& F) {
    LAS float* BLw = (LAS float*)(F.lds + P2_BIAS);
    { const int e0 = F.wave * 64 + pg8::lane_id_v(); float bv[8];
#pragma unroll
        for (int i = 0; i < 8; ++i) { const int e = e0 + i * NTHR, hh = e >> 8, idx = e & 255, rel = idx - 191, n = rel < 0 ? -rel : rel;
            const int v = n < 8 ? n : (n < 12 ? 8 : n < 16 ? 9 : n < 23 ? 10 : n < 32 ? 11 : n < 46 ? 12 : n < 64 ? 13 : n < 91 ? 14 : 15);
            bv[i] = F.rel_tab[((rel > 0 ? 16 : 0) + v) * 16 + hh]; }
#pragma unroll
        for (int i = 0; i < 8; ++i) { const int e = e0 + i * NTHR; BLw[e] = ((e & 255) < 255) ? bv[i] * LOG2E : 0.f; } }
    __syncthreads();
    attn_units(F);
    sgu_units(F);
#if P0_LATE_W == 1
    __syncthreads();
    p0_transposes(F, 32 * 232, 32 * 232 + 2 * 16 * 64 + 2 * 32 * 64, F.vcu * NWAVES + F.wave, F.G * NWAVES);
#endif
}
constexpr size_t WS_SS2S = WS_SS2 + (size_t)MPROMPT * 32 * 4;
struct SkMerge { const bf16 *RATIO, *SB; bf16* H;
    __device__ __forceinline__ void mid(f32x4& acc, int row, int col) const { const unsigned long long w = *(const GAS unsigned long long*)(RATIO + (size_t)row * 2048 + col); const unsigned lo = (unsigned)w, hi = (unsigned)(w >> 32);
        acc *= (f32x4){pg8::bf_lo(lo), pg8::bf_hi(lo), pg8::bf_lo(hi), pg8::bf_hi(hi)}; }
    __device__ __forceinline__ void fin(const f32x4 acc, int row, int col, int, int) const { const unsigned long long w = *(const GAS unsigned long long*)(SB + (size_t)row * 2048 + col); const unsigned lo = (unsigned)w, hi = (unsigned)(w >> 32);
        const f32x4 v = acc * (f32x4){pg8::bf_lo(lo), pg8::bf_hi(lo), pg8::bf_lo(hi), pg8::bf_hi(hi)};
        *(GAS unsigned long long*)(H + (size_t)row * 2048 + col) = (unsigned long long)pkb(v.x, v.y) | ((unsigned long long)pkb(v.z, v.w) << 32); } };
struct SkOut { const float* xs; bf16* XH; float* SS2S;
    __device__ __forceinline__ void mid(f32x4&, int, int) const {}
    __device__ __forceinline__ void fin(const f32x4 acc, int row, int col, int part, int fq) const { const f32x4 v = acc + *(const GAS f32x4*)(xs + (size_t)(row - MPROMPT) * 2048 + col);
        *(GAS unsigned long long*)(XH + (size_t)row * 2048 + col) = (unsigned long long)pkh(v.x, v.y) | ((unsigned long long)pkh(v.z, v.w) << 32);
        float s = (v.x * v.x + v.y * v.y) + (v.z * v.z + v.w * v.w); s += __shfl_xor(s, 16); s += __shfl_xor(s, 32);
        if (fq == 0) SS2S[(size_t)(row - MPROMPT) * 128 + part] = s; } };
struct SkQ { bf16* QP;
    __device__ __forceinline__ void mid(f32x4&, int, int) const {}
    __device__ __forceinline__ void fin(const f32x4 acc, int row, int col, int, int) const { *(GAS unsigned long long*)(QP + (size_t)row * 2048 + col) = (unsigned long long)pkh(acc.x, acc.y) | ((unsigned long long)pkh(acc.z, acc.w) << 32); } };
template <bool F16, bool MID, class Epi>
__device__ __forceinline__ void skinny_gemm(Frame& F, const bf16* A, const bf16* Bt, const Epi& E) {
    const int lane = pg8::lane_id_v(), w = F.wave, fr = lane & 15, fq = lane >> 4;
    LAS f32x4* part = (LAS f32x4*)(F.lds + RING_OFF);
    for (int job = F.vcu; job < 256; job += F.G) {
        const int rb = job & 3, cb = job >> 2;
        const bf16* ap = A + (size_t)(MPROMPT + 32 * rb + fr) * 2048 + 256 * w + 8 * fq;
        const bf16* bp = Bt + (size_t)(32 * cb + fr) * 2048 + 256 * w + 8 * fq;
        bf16x8 a0[8], a1[8], b0[8], b1[8];
#pragma unroll
        for (int u = 0; u < 8; ++u) { a0[u] = *(const GAS bf16x8*)(ap + 32 * u); a1[u] = *(const GAS bf16x8*)(ap + 16 * 2048 + 32 * u); b0[u] = *(const GAS bf16x8*)(bp + 32 * u); b1[u] = *(const GAS bf16x8*)(bp + 16 * 2048 + 32 * u); }
        f32x4 c00 = {0.f, 0.f, 0.f, 0.f}, c01 = c00, c10 = c00, c11 = c00;
#pragma unroll
        for (int u = 0; u < 8; ++u) { c00 = pg8::mma16<F16>(b0[u], a0[u], c00); c01 = pg8::mma16<F16>(b1[u], a0[u], c01); c10 = pg8::mma16<F16>(b0[u], a1[u], c10); c11 = pg8::mma16<F16>(b1[u], a1[u], c11); }
        __syncthreads();
        part[(w * 4 + 0) * 64 + lane] = c00; part[(w * 4 + 1) * 64 + lane] = c01; part[(w * 4 + 2) * 64 + lane] = c10; part[(w * 4 + 3) * 64 + lane] = c11;
        __syncthreads();
        if (w < 4) {
            f32x4 s1 = part[(0 * 4 + w) * 64 + lane], s2 = part[(4 * 4 + w) * 64 + lane];
#pragma unroll
            for (int ww = 1; ww < 4; ++ww) { s1 += part[(ww * 4 + w) * 64 + lane]; s2 += part[((ww + 4) * 4 + w) * 64 + lane]; }
            const int row = MPROMPT + 32 * rb + 16 * (w >> 1) + fr, col = 32 * cb + 16 * (w & 1) + 4 * fq;
            if (MID) E.mid(s1, row, col);
            E.fin(s1 + s2, row, col, cb * 2 + (w & 1), fq);
        }
    }
}
typedef _Float16 f16x8v __attribute__((ext_vector_type(8)));
__device__ __forceinline__ int enc_f(float f) { const int b = __builtin_bit_cast(int, f); return b ^ ((b >> 31) & 0x7fffffff); }
__device__ __forceinline__ float dec_f(int k) { return __builtin_bit_cast(float, k ^ ((k >> 31) & 0x7fffffff)); }
__device__ __forceinline__ int imax_(int a, int b) { return a > b ? a : b; }
__device__ __forceinline__ int imin_(int a, int b) { return a < b ? a : b; }
#define P6_CE(a, b) do { const int mx_ = imax_(a, b), mn_ = imin_(a, b); a = mx_; b = mn_; } while (0)
__device__ __forceinline__ void sort16_desc(int (&v)[16]) {
#pragma unroll
    for (int k = 2; k <= 16; k <<= 1)
#pragma unroll
        for (int j = k >> 1; j > 0; j >>= 1)
#pragma unroll
            for (int i = 0; i < 16; ++i) { const int l = i ^ j; if (l > i) { if ((i & k) == 0) P6_CE(v[i], v[l]); else P6_CE(v[l], v[i]); } }
}
__device__ __forceinline__ void bitonic_merge16_desc(int (&v)[16]) {
#pragma unroll
    for (int j = 8; j > 0; j >>= 1)
#pragma unroll
        for (int i = 0; i < 16; ++i) { const int l = i ^ j; if (l > i) P6_CE(v[i], v[l]); }
}
__device__ __forceinline__ void merge_top16(int (&T)[16], const int (&N)[16]) {
#pragma unroll
    for (int i = 0; i < 16; ++i) T[i] = imax_(T[i], N[15 - i]);
    bitonic_merge16_desc(T);
}
__device__ __forceinline__ int half_partner(int x) { return (int)pg8::partner32((unsigned)x); }
struct CandTab { int ci[64], cj[64]; };
__host__ __device__ constexpr CandTab make_cand() { CandTab t{}; int n = 0; for (int i = 0; i < 16; ++i) for (int j = 0; j < 16; ++j) if ((i + 1) * (j + 1) <= 16) { t.ci[n] = i; t.cj[n] = j; ++n; } for (; n < 64; ++n) { t.ci[n] = -1; t.cj[n] = -1; } return t; }
constexpr CandTab CAND = make_cand();
constexpr int P6_SC = 0;

constexpr int P6_KEYS = 65536;
__device__ __forceinline__ void p6_job(Frame& F, const int job) {
    const int lane = pg8::lane_id_v(), w = F.wave, r = lane & 31, h = lane >> 5;
    const bf16* QP = (const bf16*)(F.ws + WS_SB); const bf16* KH = (const bf16*)(F.ws + WS_KEYS); const float* SS2 = (const float*)(F.ws + WS_SS2);
    unsigned long long* SEL = (unsigned long long*)(F.ws + WS_RA);
    LAS int* SC = (LAS int*)(F.lds + P6_SC + w * 8192);
    constexpr int NTILE = MREAL / 32, NGRP = (NTILE + 7) / 8, NJOB = NGRP * 8;
    {
        const int hq = job & 7, tile = (job >> 3) * 8 + w;
        { const int tid = w * 64 + lane;
#pragma unroll
            for (int i = 0; i < 8; ++i) { const int idx = tid + 512 * i, p = idx >> 11, n = (idx >> 4) & 127, c = idx & 15;
                *(LAS v4u*)(F.lds + P6_KEYS + p * 32768 + c * 2048 + n * 16) = *(const GAS v4u*)(KH + ((size_t)((hq * 2 + p) * 128 + n)) * 128 + c * 8); } }
        __syncthreads();
        if (tile < NTILE) {
        const int t = tile * 32 + r;
        int AB[2][16];
#pragma unroll
        for (int p = 0; p < 2; ++p) {
            f16x8v qf[8];
#pragma unroll
            for (int ks = 0; ks < 8; ++ks) qf[ks] = *(const GAS f16x8v*)(QP + (size_t)t * 2048 + hq * 256 + p * 128 + ks * 16 + h * 8);
            int T[16];
#pragma unroll
            for (int nb = 0; nb < 4; ++nb) {
                f32x16 acc = {};
                const LAS unsigned char* kp = F.lds + P6_KEYS + p * 32768 + h * 2048 + (nb * 32 + r) * 16;
#pragma unroll
                for (int ks = 0; ks < 8; ++ks) { const f16x8v kf = *(const LAS f16x8v*)(kp + ks * 4096); acc = __builtin_amdgcn_mfma_f32_32x32x16_f16(kf, qf[ks], acc, 0, 0, 0); }
                int N[16];
#pragma unroll
                for (int i = 0; i < 16; ++i) N[i] = (enc_f(acc[i]) & ~127) | (nb * 32 + crow(i, h));
                sort16_desc(N);
                if (nb == 0) {
#pragma unroll
                    for (int i = 0; i < 16; ++i) T[i] = N[i];
                } else merge_top16(T, N);
            }
            int P[16];
#pragma unroll
            for (int i = 0; i < 16; ++i) P[i] = half_partner(T[i]);
            merge_top16(T, P);
#pragma unroll
            for (int i = 0; i < 16; ++i) AB[p][i] = T[i];
        }
#pragma unroll
        for (int i = 0; i < 16; ++i) { SC[i * 64 + lane] = AB[0][i] & 127; SC[(16 + i) * 64 + lane] = AB[1][i] & 127; }
        float fa[16], fb[16];
#pragma unroll
        for (int i = 0; i < 16; ++i) { fa[i] = dec_f(AB[0][i] & ~127); fb[i] = dec_f(AB[1][i] & ~127); }
        int W[16];
#pragma unroll
        for (int g = 0; g < 4; ++g) {
            int N[16];
#pragma unroll
            for (int c = 0; c < 16; ++c) { const int ci = CAND.ci[g * 16 + c], cj = CAND.cj[g * 16 + c]; N[c] = ci >= 0 ? ((enc_f(fa[ci >= 0 ? ci : 0] + fb[cj >= 0 ? cj : 0]) & ~255) | (ci * 16 + cj)) : (int)0x80000000; }
            sort16_desc(N);
            if (g == 0) {
#pragma unroll
                for (int i = 0; i < 16; ++i) W[i] = N[i];
            } else merge_top16(W, N);
        }
        float ssum = 0.f;
        if (tile >= MPROMPT / 32) { const GAS f32x4* sp = (const GAS f32x4*)((const float*)(F.ws + WS_SS2S) + (size_t)(t - MPROMPT) * 128);
#pragma unroll 16
            for (int i = 0; i < 32; ++i) { const f32x4 v = sp[i]; ssum += (v.x + v.y) + (v.z + v.w); } }
        else { const GAS f32x4* sp = (const GAS f32x4*)(SS2 + (size_t)t * 32);
#pragma unroll
            for (int i = 0; i < 8; ++i) { const f32x4 v = sp[i]; ssum += (v.x + v.y) + (v.z + v.w); } }
        const float rt = 1.0f / sqrtf(ssum * (1.f / DM) + EPS);
        LDS_WAIT(); asm volatile("" ::: "memory");
        float gk[16]; int ek[16]; float Z = 0.f; const float c0 = dec_f(W[0] & ~255);
#pragma unroll
        for (int k = 0; k < 16; ++k) { const int code = W[k] & 255, ii = code >> 4, jj = code & 15; const int n0 = SC[ii * 64 + lane], n1 = SC[(16 + jj) * 64 + lane];
            ek[k] = n0 * 128 + n1; gk[k] = __builtin_amdgcn_exp2f((dec_f(W[k] & ~255) - c0) * rt * LOG2E); Z += gk[k]; }
        const float iz = 1.0f / Z;
        unsigned long long* dst = SEL + ((size_t)t * 8 + hq) * 16 + 8 * h;
#pragma unroll
        for (int k = 0; k < 8; k += 2) { const int e0 = h ? ek[k + 8] : ek[k], e1 = h ? ek[k + 9] : ek[k + 1]; const float g0 = (h ? gk[k + 8] : gk[k]) * iz, g1 = (h ? gk[k + 9] : gk[k + 1]) * iz;
            __hip_atomic_store(dst + k, (unsigned long long)(unsigned)e0 | ((unsigned long long)__builtin_bit_cast(unsigned, g0) << 32), RLX_AGENT);
            __hip_atomic_store(dst + k + 1, (unsigned long long)(unsigned)e1 | ((unsigned long long)__builtin_bit_cast(unsigned, g1) << 32), RLX_AGENT); }
        LDS_WAIT(); asm volatile("" ::: "memory");
        }
    }
}
__device__ __forceinline__ void p6_topk(Frame& F) {
    constexpr int NJOB = ((MREAL / 32 + 7) / 8) * 8;
    for (int job = F.vcu; job < NJOB; job += F.G) { p6_job(F, job); __syncthreads(); }
}
typedef _Float16 h2v __attribute__((ext_vector_type(2)));
constexpr int P7_RED = 0, P7_PART = LDSCTL_OFF;
#ifndef P7_UNR
#define P7_UNR (PEER_FP4 ? 16 : 8)
#endif
template <int M> __device__ __forceinline__ float xor_lane(float x) {
    if constexpr (M == 32) return __builtin_bit_cast(float, pg8::partner32(__builtin_bit_cast(unsigned, x)));
    else return __builtin_bit_cast(float, __builtin_amdgcn_ds_swizzle(__builtin_bit_cast(int, x), (M << 10) | 0x1f));
}
__device__ __forceinline__ float wave_sum_sw(float v) { v += xor_lane<1>(v); v += xor_lane<2>(v); v += xor_lane<4>(v); v += xor_lane<8>(v); v += xor_lane<16>(v); v += xor_lane<32>(v); return v; }
#if PEER_FP4
#ifndef P7_MFMA_U
#define P7_MFMA_U 1
#endif
typedef int v8i_t __attribute__((ext_vector_type(8)));
__device__ __forceinline__ void p7_gather(Frame& F) {
    const int lane = pg8::lane_id_v(), w = F.wave;
    const bf16* XH = (const bf16*)(F.ws + WS_RATIO); const unsigned char* EU4 = F.ws + WS_EU; const float* EUS = (const float*)(F.ws + WS_EU + 16 * MiB); const unsigned char* EV4 = F.ws + WS_EU + 32 * MiB; const float* EVS = (const float*)(F.ws + WS_EU + 48 * MiB);
    const unsigned long long* SEL = (const unsigned long long*)(F.ws + WS_RA);
    int it = 0;
#ifdef P7_ACTIVE_PER_XCD
    if ((F.vcu & 31) >= P7_ACTIVE_PER_XCD) return;
    const int rank_ = (F.vcu >> 5) * P7_ACTIVE_PER_XCD + (F.vcu & 31), nrank_ = 8 * P7_ACTIVE_PER_XCD;
#else
    const int rank_ = F.vcu, nrank_ = F.G;
#endif
    for (int t = rank_; t < MREAL; t += nrank_, ++it) {
        LAS float* RED = (LAS float*)(F.lds + P7_RED + (it & 1) * 65536); LAS float* PART = (LAS float*)(F.lds + P7_PART + (it & 1) * 32);
        const unsigned long long sel = SEL[((size_t)t * 8 + w) * 16 + (lane >> 2)];
        const int eidx = (int)(unsigned)sel; const float gate = __builtin_bit_cast(float, (unsigned)(sel >> 32));
        const float su_l = EUS[eidx], sv_l = EVS[eidx];
        unsigned xw[16];
#pragma unroll
        for (int q = 0; q < 8; ++q) { const unsigned long long v = *(const GAS unsigned long long*)(XH + (size_t)t * DM + q * 256 + lane * 4); xw[2 * q] = (unsigned)v; xw[2 * q + 1] = (unsigned)(v >> 32); }
#if P7_MFMA_U
        v8i_t xb;
        { typedef _Float16 h32x __attribute__((ext_vector_type(32))); typedef unsigned u6x __attribute__((ext_vector_type(6))); h32x hx;
#pragma unroll
          for (int i = 0; i < 16; ++i) { const h2v p = __builtin_bit_cast(h2v, xw[i]); hx[2 * i] = p[0]; hx[2 * i + 1] = p[1]; }
          const u6x px = __builtin_amdgcn_cvt_scalef32_pk32_fp6_f16(hx, 1.0f);
          xb = (v8i_t){(int)px[0], (int)px[1], (int)px[2], (int)px[3], (int)px[4], (int)px[5], 0, 0}; }
        float mk[4];
#pragma unroll
        for (int r4 = 0; r4 < 4; ++r4) mk[r4] = ((lane >> 4) == ((lane & 15) >> 2) && (lane & 3) == r4) ? 1.f : 0.f;
#endif
        float ssum = 0.f;
#pragma unroll
        for (int i = 0; i < 16; ++i) { const h2v hv = __builtin_bit_cast(h2v, xw[i]); ssum = __builtin_amdgcn_fdot2(hv, hv, ssum, false); }
        ssum = wave_sum_sw(ssum);
        const float rt = 1.0f / sqrtf(ssum * (1.f / DM) + EPS);
        float dp[16];
#pragma unroll
        for (int k0 = 0; k0 < 16; k0 += P7_UNR) {
            v4u ur[P7_UNR];
#pragma unroll
            for (int kk = 0; kk < P7_UNR; ++kk) { const int e = __builtin_amdgcn_readlane(eidx, 4 * (k0 + kk)); ur[kk] = *(const GAS v4u*)(EU4 + (size_t)e * 1024 + lane * 16); }
#if P7_MFMA_U
#pragma unroll
            for (int kk = 0; kk < P7_UNR; ++kk) { const v8i_t A = {(int)ur[kk].x, (int)ur[kk].y, (int)ur[kk].z, (int)ur[kk].w, 0, 0, 0, 0};
                const f32x4 d = __builtin_amdgcn_mfma_scale_f32_16x16x128_f8f6f4(A, xb, (f32x4){0.f, 0.f, 0.f, 0.f}, 4  , 2  , 0, 127, 0, 127);
                dp[k0 + kk] = (d[0] * mk[0] + d[1] * mk[1]) + (d[2] * mk[2] + d[3] * mk[3]); }
#else
#pragma unroll
            for (int kk = 0; kk < P7_UNR; ++kk) { float a = 0.f;
#pragma unroll
                for (int q = 0; q < 4; ++q) { const unsigned wq = ur[kk][q];
                    a = __builtin_amdgcn_fdot2(__builtin_amdgcn_cvt_scalef32_pk_f16_fp4(wq, 1.0f, 0), __builtin_bit_cast(h2v, xw[4 * q + 0]), a, false); a = __builtin_amdgcn_fdot2(__builtin_amdgcn_cvt_scalef32_pk_f16_fp4(wq, 1.0f, 1), __builtin_bit_cast(h2v, xw[4 * q + 1]), a, false);
                    a = __builtin_amdgcn_fdot2(__builtin_amdgcn_cvt_scalef32_pk_f16_fp4(wq, 1.0f, 2), __builtin_bit_cast(h2v, xw[4 * q + 2]), a, false); a = __builtin_amdgcn_fdot2(__builtin_amdgcn_cvt_scalef32_pk_f16_fp4(wq, 1.0f, 3), __builtin_bit_cast(h2v, xw[4 * q + 3]), a, false); }
                dp[k0 + kk] = a;
                }
#endif
#pragma unroll
            for (int kk = 0; kk < P7_UNR; ++kk) asm volatile("" : "+v"(dp[k0 + kk]) :: "memory");
        }
#define P7_TR(C, M) do { const bool up_ = (lane & (M)) != 0; _Pragma("unroll") for (int i = 0; i < (C) / 2; ++i) { const float keep_ = up_ ? dp[i + (C) / 2] : dp[i], send_ = up_ ? dp[i] : dp[i + (C) / 2]; dp[i] = keep_ + xor_lane<(M)>(send_); } } while (0)
        P7_TR(16, 32); P7_TR(8, 16); P7_TR(4, 8); P7_TR(2, 4);
#undef P7_TR
        float dk = dp[0]; dk += xor_lane<2>(dk); dk += xor_lane<1>(dk);
        const float hval = gate * pg8::gelu_tanh(dk * su_l * rt) * sv_l;
        h2v o2[16];
#pragma unroll
        for (int e = 0; e < 16; ++e) o2[e] = (h2v){(_Float16)0.f, (_Float16)0.f};
#pragma unroll
        for (int k0 = 0; k0 < 16; k0 += P7_UNR) {
            v4u vr[P7_UNR];
#pragma unroll
            for (int kk = 0; kk < P7_UNR; ++kk) { const int e = __builtin_amdgcn_readlane(eidx, 4 * (k0 + kk)); vr[kk] = *(const GAS v4u*)(EV4 + (size_t)e * 1024 + lane * 16); }
#pragma unroll
            for (int kk = 0; kk < P7_UNR; ++kk) { const float hk = __builtin_bit_cast(float, __builtin_amdgcn_readlane(__builtin_bit_cast(int, hval), 4 * (k0 + kk))) * 256.0f; const _Float16 hh = (_Float16)hk; const h2v hk2 = {hh, hh};
#pragma unroll
                for (int q = 0; q < 4; ++q) { const unsigned wq = vr[kk][q];
                    o2[4 * q + 0] = __builtin_elementwise_fma(__builtin_bit_cast(h2v, __builtin_amdgcn_cvt_scalef32_pk_f16_fp4(wq, 1.0f, 0)), hk2, o2[4 * q + 0]); o2[4 * q + 1] = __builtin_elementwise_fma(__builtin_bit_cast(h2v, __builtin_amdgcn_cvt_scalef32_pk_f16_fp4(wq, 1.0f, 1)), hk2, o2[4 * q + 1]);
                    o2[4 * q + 2] = __builtin_elementwise_fma(__builtin_bit_cast(h2v, __builtin_amdgcn_cvt_scalef32_pk_f16_fp4(wq, 1.0f, 2)), hk2, o2[4 * q + 2]); o2[4 * q + 3] = __builtin_elementwise_fma(__builtin_bit_cast(h2v, __builtin_amdgcn_cvt_scalef32_pk_f16_fp4(wq, 1.0f, 3)), hk2, o2[4 * q + 3]); } }
#pragma unroll
            for (int q = 0; q < 2; ++q) asm volatile("" : "+v"(o2[8 * q]), "+v"(o2[8 * q + 1]), "+v"(o2[8 * q + 2]), "+v"(o2[8 * q + 3]), "+v"(o2[8 * q + 4]), "+v"(o2[8 * q + 5]), "+v"(o2[8 * q + 6]), "+v"(o2[8 * q + 7]) :: "memory");
        }
#pragma unroll
        for (int q = 0; q < 8; ++q) *(LAS f32x4*)(RED + w * 2048 + q * 256 + lane * 4) = (f32x4){(float)o2[2 * q][0], (float)o2[2 * q][1], (float)o2[2 * q + 1][0], (float)o2[2 * q + 1][1]} * (1.0f / 256.0f);
        __syncthreads();
        const int col = w * 256 + lane * 4, soff = col;
        f32x4 sum = *(const LAS f32x4*)(RED + soff);
#pragma unroll
        for (int ww = 1; ww < 8; ++ww) sum += *(const LAS f32x4*)(RED + ww * 2048 + soff);
        { const unsigned long long xq = *(const GAS unsigned long long*)(XH + (size_t)t * DM + col); const unsigned x0 = (unsigned)xq, x1 = (unsigned)(xq >> 32); const h2v p0 = __builtin_bit_cast(h2v, x0), p1 = __builtin_bit_cast(h2v, x1);
            sum += (f32x4){(float)p0[0], (float)p0[1], (float)p1[0], (float)p1[1]}; }
        float sq = (sum.x * sum.x + sum.y * sum.y) + (sum.z * sum.z + sum.w * sum.w); sq = wave_sum_sw(sq);
        if (lane == 0) PART[w] = sq;
        __syncthreads();
        float tot = 0.f;
#pragma unroll
        for (int ww = 0; ww < 8; ++ww) tot += PART[ww];
        const float rf = 1.0f / sqrtf(tot * (1.f / DM) + EPS);
        const f32x4 gf = *(const GAS f32x4*)(F.norm_final_g + col);
        *(GAS f32x4*)(F.out + OUT_Y + (size_t)t * DM + col) = sum * rf * gf;
    }
}
#elif PEER_FP6
typedef _Float16 h32v __attribute__((ext_vector_type(32)));
typedef unsigned u6v __attribute__((ext_vector_type(6)));
typedef unsigned u2v __attribute__((ext_vector_type(2)));
__device__ __forceinline__ u6v ld_row6(const unsigned char* p) { const GAS u2v* q = (const GAS u2v*)p; const u2v a = q[0], b = q[1], c = q[2]; return (u6v){a.x, a.y, b.x, b.y, c.x, c.y}; }
__device__ __forceinline__ void p7_gather(Frame& F) {
    const int lane = pg8::lane_id_v(), w = F.wave;
    const bf16* XH = (const bf16*)(F.ws + WS_RATIO); const unsigned char* EU6 = F.ws + WS_EU; const unsigned char* EV6 = F.ws + WS_EU + 32 * MiB;
    const unsigned long long* SEL = (const unsigned long long*)(F.ws + WS_RA);
    int it = 0;
    for (int t = F.vcu; t < MREAL; t += F.G, ++it) {
        LAS float* RED = (LAS float*)(F.lds + P7_RED + (it & 1) * 65536); LAS float* PART = (LAS float*)(F.lds + P7_PART + (it & 1) * 32);
        const unsigned long long sel = SEL[((size_t)t * 8 + w) * 16 + (lane >> 2)];
        const int eidx = (int)(unsigned)sel; const float gate = __builtin_bit_cast(float, (unsigned)(sel >> 32));
        unsigned xw[16];
#pragma unroll
        for (int q = 0; q < 4; ++q) { const v4u v = *(const GAS v4u*)(XH + (size_t)t * DM + lane * 32 + q * 8); xw[4 * q] = v.x; xw[4 * q + 1] = v.y; xw[4 * q + 2] = v.z; xw[4 * q + 3] = v.w; }
        float ssum = 0.f;
#pragma unroll
        for (int i = 0; i < 16; ++i) { const h2v hv = __builtin_bit_cast(h2v, xw[i]); ssum = __builtin_amdgcn_fdot2(hv, hv, ssum, false); }
        ssum = wave_sum_sw(ssum);
        const float rt = 1.0f / sqrtf(ssum * (1.f / DM) + EPS);
        float dp[16];
#pragma unroll
        for (int k0 = 0; k0 < 16; k0 += P7_UNR) {
            u6v ur[P7_UNR];
#pragma unroll
            for (int kk = 0; kk < P7_UNR; ++kk) { const int e = __builtin_amdgcn_readlane(eidx, 4 * (k0 + kk)); ur[kk] = ld_row6(EU6 + (size_t)e * 1536 + lane * 24); }
#pragma unroll
            for (int kk = 0; kk < P7_UNR; ++kk) { const h32v d = __builtin_amdgcn_cvt_scalef32_pk32_f16_fp6(ur[kk], 1.0f); float a = 0.f;
#pragma unroll
                for (int i = 0; i < 16; ++i) { const h2v dd = {d[2 * i], d[2 * i + 1]}; a = __builtin_amdgcn_fdot2(dd, __builtin_bit_cast(h2v, xw[i]), a, false); }
                dp[k0 + kk] = a; }
#pragma unroll
            for (int kk = 0; kk < P7_UNR; ++kk) asm volatile("" : "+v"(dp[k0 + kk]) :: "memory");
        }
#define P7_TR(C, M) do { const bool up_ = (lane & (M)) != 0; _Pragma("unroll") for (int i = 0; i < (C) / 2; ++i) { const float keep_ = up_ ? dp[i + (C) / 2] : dp[i], send_ = up_ ? dp[i] : dp[i + (C) / 2]; dp[i] = keep_ + xor_lane<(M)>(send_); } } while (0)
        P7_TR(16, 32); P7_TR(8, 16); P7_TR(4, 8); P7_TR(2, 4);
#undef P7_TR
        float dk = dp[0]; dk += xor_lane<2>(dk); dk += xor_lane<1>(dk);
        const float hval = gate * pg8::gelu_tanh(dk * rt * (1.0f / PEER_SU)) * (1.0f / PEER_SV);
        float o[32];
#pragma unroll
        for (int e = 0; e < 32; ++e) o[e] = 0.f;
#pragma unroll
        for (int k0 = 0; k0 < 16; k0 += P7_UNR) {
            u6v vr[P7_UNR];
#pragma unroll
            for (int kk = 0; kk < P7_UNR; ++kk) { const int e = __builtin_amdgcn_readlane(eidx, 4 * (k0 + kk)); vr[kk] = ld_row6(EV6 + (size_t)e * 1536 + lane * 24); }
#pragma unroll
            for (int kk = 0; kk < P7_UNR; ++kk) { const float hk = __builtin_bit_cast(float, __builtin_amdgcn_readlane(__builtin_bit_cast(int, hval), 4 * (k0 + kk))); const h32v d = __builtin_amdgcn_cvt_scalef32_pk32_f16_fp6(vr[kk], 1.0f);
#pragma unroll
                for (int e = 0; e < 32; ++e) o[e] = __builtin_fmaf((float)d[e], hk, o[e]); }
#pragma unroll
            for (int q = 0; q < 4; ++q) asm volatile("" : "+v"(o[8 * q]), "+v"(o[8 * q + 1]), "+v"(o[8 * q + 2]), "+v"(o[8 * q + 3]), "+v"(o[8 * q + 4]), "+v"(o[8 * q + 5]), "+v"(o[8 * q + 6]), "+v"(o[8 * q + 7]) :: "memory");
        }
        { const int L = lane;
#pragma unroll
            for (int q = 0; q < 8; ++q) *(LAS f32x4*)(RED + w * 2048 + L * 32 + ((q + L) & 7) * 4) = (f32x4){o[4 * q], o[4 * q + 1], o[4 * q + 2], o[4 * q + 3]}; }
        __syncthreads();
        const int col = w * 256 + lane * 4; const int Lb = col >> 5, qb = (col >> 2) & 7, soff = Lb * 32 + ((qb + Lb) & 7) * 4;
        f32x4 sum = *(const LAS f32x4*)(RED + soff);
#pragma unroll
        for (int ww = 1; ww < 8; ++ww) sum += *(const LAS f32x4*)(RED + ww * 2048 + soff);
        { const unsigned long long xq = *(const GAS unsigned long long*)(XH + (size_t)t * DM + col); const unsigned x0 = (unsigned)xq, x1 = (unsigned)(xq >> 32); const h2v p0 = __builtin_bit_cast(h2v, x0), p1 = __builtin_bit_cast(h2v, x1);
            sum += (f32x4){(float)p0[0], (float)p0[1], (float)p1[0], (float)p1[1]}; }
        float sq = (sum.x * sum.x + sum.y * sum.y) + (sum.z * sum.z + sum.w * sum.w); sq = wave_sum_sw(sq);
        if (lane == 0) PART[w] = sq;
        __syncthreads();
        float tot = 0.f;
#pragma unroll
        for (int ww = 0; ww < 8; ++ww) tot += PART[ww];
        const float rf = 1.0f / sqrtf(tot * (1.f / DM) + EPS);
        const f32x4 gf = *(const GAS f32x4*)(F.norm_final_g + col);
        *(GAS f32x4*)(F.out + OUT_Y + (size_t)t * DM + col) = sum * rf * gf;
    }
}
#else
#error "PEER expert tables: PEER_FP4 or PEER_FP6"
#endif
#ifndef PQ_MERGE
#define PQ_MERGE PEER_FP4
#endif
#if PQ_MERGE
#ifndef PQ_JOBS_FIRST
#define PQ_JOBS_FIRST 1
#endif
#ifdef PQ_TOKENS_ONLY
#define PQ_RDY(p) 8u
#define PQ_RDY0 1
#else
#define PQ_RDY(p) xb_ld(p)
#define PQ_RDY0 0
#endif
constexpr int CW_QUEUE = 8192, CW_GCNT = 8256;
#ifdef PQ_TOKENS_ONLY
constexpr int Q_NITEM = MREAL;
#else
constexpr int Q_NITEM = 520 + MREAL;
#endif
static_assert(MREAL == 16512 && (CW_GCNT + 65) * 4 <= (int)CTL_ZERO_BYTES, "queue layout");
__device__ __forceinline__ int q_decode(const int idx) {
#ifdef PQ_TOKENS_ONLY
    return idx;
#endif
#if PQ_JOBS_FIRST
    return idx < 520 ? ~idx : idx - 520;
#endif
    if (idx < 256) return ~idx;
    const int r = idx - 256;
    if (r < 33 * 264) { const int i = r / 264, o = r - i * 264; return o < 8 ? ~((32 + i) * 8 + o) : 256 * i + o - 8; }
    return 256 * 33 + (r - 33 * 264);
}
__device__ __forceinline__ unsigned q_ready(unsigned* gcnt, const int g, int& upto, const int lane) {
#ifdef PQ_TOKENS_ONLY
    return 8u;
#else
    if (g >= upto) { const unsigned c = xb_ld(&gcnt[lane]), c64 = xb_ld(&gcnt[64]); const unsigned long long m = __ballot(c >= 8u);
        int n = (m == ~0ull) ? 64 : __builtin_ctzll(~m); if (n == 64 && c64 >= 8u) n = 65; upto = n; }
    return g < upto ? 8u : 0u;
#endif
}
__device__ __forceinline__ void p67_queue(Frame& F) {
    const int w = F.wave;
    unsigned* qctr = (unsigned*)(F.ctl + CW_QUEUE); unsigned* gcnt = (unsigned*)(F.ctl + CW_GCNT); unsigned* bar = (unsigned*)(F.ctl + CW_BAR);
    volatile LAS int* LQ = (volatile LAS int*)(F.lds + LDSCTL_OFF + 128);
    const bf16* XH = (const bf16*)(F.ws + WS_RATIO); const unsigned char* EU4 = F.ws + WS_EU; const float* EUS = (const float*)(F.ws + WS_EU + 16 * MiB); const unsigned char* EV4 = F.ws + WS_EU + 32 * MiB; const float* EVS = (const float*)(F.ws + WS_EU + 48 * MiB);
    unsigned long long* SEL = (unsigned long long*)(F.ws + WS_RA);
    int idx = F.vcu, slot = 0, ntok = 0, rdy_upto = 0; int ready = q_decode(idx) < 0 ? 1 : PQ_RDY0;
    while (idx < Q_NITEM) {
        const int lane = pg8::lane_id_v();
        unsigned nxr = 0u; if (w == 0 && lane == 0) nxr = xb_add(qctr, 1u);
        int nx = Q_NITEM; unsigned nrdy = 8u;
        const int item = q_decode(idx);
        if (item < 0) {
            const int job = ~item;
            p6_job(F, job);
            VM_WAIT();
            if (w == 0) { nx = (int)F.G + __builtin_amdgcn_readfirstlane((int)nxr); if (nx < Q_NITEM) { const int ni = q_decode(nx); if (ni >= 0) nrdy = q_ready(gcnt, ni >> 8, rdy_upto, lane); }
                if (lane == 0) { LQ[(slot ^ 1) * 2] = nx; LQ[(slot ^ 1) * 2 + 1] = nrdy >= 8u ? 1 : 0; } }
            __syncthreads();
            if (w == 0 && lane == 0) (void)xb_add(&gcnt[job >> 3], 1u);
        } else {
            const int t = item;
            if (!ready) { XB_SPIN(xb_ld(&gcnt[t >> 8]) < 8u, bar); }
            LAS float* RED = (LAS float*)(F.lds + P7_RED + (ntok & 1) * 65536); LAS float* PART = (LAS float*)(F.lds + P7_PART + (ntok & 1) * 32);
            const unsigned long long sel = __hip_atomic_load(SEL + ((size_t)t * 8 + w) * 16 + (lane >> 2), RLX_AGENT);
            const int eidx = (int)(unsigned)sel; const float gate = __builtin_bit_cast(float, (unsigned)(sel >> 32));
            const float su_l = EUS[eidx], sv_l = EVS[eidx];
            unsigned xw[16];
#pragma unroll
            for (int q = 0; q < 8; ++q) { const unsigned long long v = *(const GAS unsigned long long*)(XH + (size_t)t * DM + q * 256 + lane * 4); xw[2 * q] = (unsigned)v; xw[2 * q + 1] = (unsigned)(v >> 32); }
#if P7_MFMA_U
            v8i_t xb;
            { typedef _Float16 h32x __attribute__((ext_vector_type(32))); typedef unsigned u6x __attribute__((ext_vector_type(6))); h32x hx;
#pragma unroll
              for (int i = 0; i < 16; ++i) { const h2v p = __builtin_bit_cast(h2v, xw[i]); hx[2 * i] = p[0]; hx[2 * i + 1] = p[1]; }
              const u6x px = __builtin_amdgcn_cvt_scalef32_pk32_fp6_f16(hx, 1.0f);
              xb = (v8i_t){(int)px[0], (int)px[1], (int)px[2], (int)px[3], (int)px[4], (int)px[5], 0, 0}; }
            float mk[4];
#pragma unroll
            for (int r4 = 0; r4 < 4; ++r4) mk[r4] = ((lane >> 4) == ((lane & 15) >> 2) && (lane & 3) == r4) ? 1.f : 0.f;
#endif
            float ssum = 0.f;
#pragma unroll
            for (int i = 0; i < 16; ++i) { const h2v hv = __builtin_bit_cast(h2v, xw[i]); ssum = __builtin_amdgcn_fdot2(hv, hv, ssum, false); }
            ssum = wave_sum_sw(ssum);
            const float rt = 1.0f / sqrtf(ssum * (1.f / DM) + EPS);
            float dp[16];
#pragma unroll
            for (int k0 = 0; k0 < 16; k0 += P7_UNR) {
                v4u ur[P7_UNR];
#pragma unroll
                for (int kk = 0; kk < P7_UNR; ++kk) { const int e = __builtin_amdgcn_readlane(eidx, 4 * (k0 + kk)); ur[kk] = *(const GAS v4u*)(EU4 + (size_t)e * 1024 + lane * 16); }
#if P7_MFMA_U
#pragma unroll
                for (int kk = 0; kk < P7_UNR; ++kk) { const v8i_t A = {(int)ur[kk].x, (int)ur[kk].y, (int)ur[kk].z, (int)ur[kk].w, 0, 0, 0, 0};
                    const f32x4 d = __builtin_amdgcn_mfma_scale_f32_16x16x128_f8f6f4(A, xb, (f32x4){0.f, 0.f, 0.f, 0.f}, 4  , 2  , 0, 127, 0, 127);
                    dp[k0 + kk] = (d[0] * mk[0] + d[1] * mk[1]) + (d[2] * mk[2] + d[3] * mk[3]); }
#else
#pragma unroll
                for (int kk = 0; kk < P7_UNR; ++kk) { float a = 0.f;
#pragma unroll
                    for (int q = 0; q < 4; ++q) { const unsigned wq = ur[kk][q];
                        a = __builtin_amdgcn_fdot2(__builtin_amdgcn_cvt_scalef32_pk_f16_fp4(wq, 1.0f, 0), __builtin_bit_cast(h2v, xw[4 * q + 0]), a, false); a = __builtin_amdgcn_fdot2(__builtin_amdgcn_cvt_scalef32_pk_f16_fp4(wq, 1.0f, 1), __builtin_bit_cast(h2v, xw[4 * q + 1]), a, false);
                        a = __builtin_amdgcn_fdot2(__builtin_amdgcn_cvt_scalef32_pk_f16_fp4(wq, 1.0f, 2), __builtin_bit_cast(h2v, xw[4 * q + 2]), a, false); a = __builtin_amdgcn_fdot2(__builtin_amdgcn_cvt_scalef32_pk_f16_fp4(wq, 1.0f, 3), __builtin_bit_cast(h2v, xw[4 * q + 3]), a, false); }
                    dp[k0 + kk] = a;
                    }
#endif
#pragma unroll
                for (int kk = 0; kk < P7_UNR; ++kk) asm volatile("" : "+v"(dp[k0 + kk]) :: "memory");
            }
            if (w == 0) { nx = (int)F.G + __builtin_amdgcn_readfirstlane((int)nxr); if (nx < Q_NITEM) { const int ni = q_decode(nx); if (ni >= 0) nrdy = q_ready(gcnt, ni >> 8, rdy_upto, lane); } }
#define P7_TR(C, M) do { const bool up_ = (lane & (M)) != 0; _Pragma("unroll") for (int i = 0; i < (C) / 2; ++i) { const float keep_ = up_ ? dp[i + (C) / 2] : dp[i], send_ = up_ ? dp[i] : dp[i + (C) / 2]; dp[i] = keep_ + xor_lane<(M)>(send_); } } while (0)
            P7_TR(16, 32); P7_TR(8, 16); P7_TR(4, 8); P7_TR(2, 4);
#undef P7_TR
            float dk = dp[0]; dk += xor_lane<2>(dk); dk += xor_lane<1>(dk);
            const float hval = gate * pg8::gelu_tanh(dk * su_l * rt) * sv_l;
            unsigned long long xq = 0ull; f32x4 gf = {0.f, 0.f, 0.f, 0.f};
            h2v o2[16];
#pragma unroll
            for (int e = 0; e < 16; ++e) o2[e] = (h2v){(_Float16)0.f, (_Float16)0.f};
#pragma unroll
            for (int k0 = 0; k0 < 16; k0 += P7_UNR) {
                v4u vr[P7_UNR];
#pragma unroll
                for (int kk = 0; kk < P7_UNR; ++kk) { const int e = __builtin_amdgcn_readlane(eidx, 4 * (k0 + kk)); vr[kk] = *(const GAS v4u*)(EV4 + (size_t)e * 1024 + lane * 16); }
                if (k0 == 0) { xq = *(const GAS unsigned long long*)(XH + (size_t)t * DM + w * 256 + lane * 4); gf = *(const GAS f32x4*)(F.norm_final_g + w * 256 + lane * 4); }
#pragma unroll
                for (int kk = 0; kk < P7_UNR; ++kk) { const float hk = __builtin_bit_cast(float, __builtin_amdgcn_readlane(__builtin_bit_cast(int, hval), 4 * (k0 + kk))) * 256.0f; const _Float16 hh = (_Float16)hk; const h2v hk2 = {hh, hh};
#pragma unroll
                    for (int q = 0; q < 4; ++q) { const unsigned wq = vr[kk][q];
                        o2[4 * q + 0] = __builtin_elementwise_fma(__builtin_bit_cast(h2v, __builtin_amdgcn_cvt_scalef32_pk_f16_fp4(wq, 1.0f, 0)), hk2, o2[4 * q + 0]); o2[4 * q + 1] = __builtin_elementwise_fma(__builtin_bit_cast(h2v, __builtin_amdgcn_cvt_scalef32_pk_f16_fp4(wq, 1.0f, 1)), hk2, o2[4 * q + 1]);
                        o2[4 * q + 2] = __builtin_elementwise_fma(__builtin_bit_cast(h2v, __builtin_amdgcn_cvt_scalef32_pk_f16_fp4(wq, 1.0f, 2)), hk2, o2[4 * q + 2]); o2[4 * q + 3] = __builtin_elementwise_fma(__builtin_bit_cast(h2v, __builtin_amdgcn_cvt_scalef32_pk_f16_fp4(wq, 1.0f, 3)), hk2, o2[4 * q + 3]); } }
#pragma unroll
                for (int q = 0; q < 2; ++q) asm volatile("" : "+v"(o2[8 * q]), "+v"(o2[8 * q + 1]), "+v"(o2[8 * q + 2]), "+v"(o2[8 * q + 3]), "+v"(o2[8 * q + 4]), "+v"(o2[8 * q + 5]), "+v"(o2[8 * q + 6]), "+v"(o2[8 * q + 7]) :: "memory");
            }
#pragma unroll
            for (int q = 0; q < 8; ++q) *(LAS f32x4*)(RED + w * 2048 + q * 256 + lane * 4) = (f32x4){(float)o2[2 * q][0], (float)o2[2 * q][1], (float)o2[2 * q + 1][0], (float)o2[2 * q + 1][1]} * (1.0f / 256.0f);
            __syncthreads();
            const int col = w * 256 + lane * 4, soff = col;
            f32x4 sum = *(const LAS f32x4*)(RED + soff);
#pragma unroll
            for (int ww = 1; ww < 8; ++ww) sum += *(const LAS f32x4*)(RED + ww * 2048 + soff);
            { const unsigned x0 = (unsigned)xq, x1 = (unsigned)(xq >> 32); const h2v p0 = __builtin_bit_cast(h2v, x0), p1 = __builtin_bit_cast(h2v, x1);
                sum += (f32x4){(float)p0[0], (float)p0[1], (float)p1[0], (float)p1[1]}; }
            float sq = (sum.x * sum.x + sum.y * sum.y) + (sum.z * sum.z + sum.w * sum.w); sq = wave_sum_sw(sq);
            if (lane == 0) PART[w] = sq;
            if (w == 0 && lane == 0) { LQ[(slot ^ 1) * 2] = nx; LQ[(slot ^ 1) * 2 + 1] = nrdy >= 8u ? 1 : 0; }
            __syncthreads();
            float tot = 0.f;
#pragma unroll
            for (int ww = 0; ww < 8; ++ww) tot += PART[ww];
            const float rf = 1.0f / sqrtf(tot * (1.f / DM) + EPS);
            __builtin_nontemporal_store(sum * rf * gf, (GAS f32x4*)(F.out + OUT_Y + (size_t)t * DM + col));
        }
        slot ^= 1; ++ntok;
        idx = __builtin_amdgcn_readfirstlane(LQ[slot * 2]); ready = __builtin_amdgcn_readfirstlane(LQ[slot * 2 + 1]);
    }
}
#endif
struct Args { const float* in[20]; float* out; unsigned char* ws; };
__global__ void __launch_bounds__(NWAVES * 64, 2) hybrid_fwd(Args args) {
    extern __shared__ __attribute__((aligned(16))) unsigned char lds[];
    Frame F;
    F.lds = (LAS unsigned char*)lds;
    F.MISC = (volatile LAS unsigned*)(F.lds + MISC_OFF);
    F.wave = __builtin_amdgcn_readfirstlane(threadIdx.x >> 6);
    F.G = gridDim.x; { const int bx = blockIdx.x; F.vcu = (F.G % 8 == 0) ? (bx % 8) * (F.G / 8) + bx / 8 : bx; }
    F.ws = args.ws; F.out = args.out; F.ctl = (gu32*)(args.ws + WS_CTL);
    F.x_prompt = args.in[0]; F.x_sample = args.in[1]; F.cache_k = args.in[2]; F.cache_v = args.in[3]; F.norm_mix_g = args.in[4]; F.w_in = args.in[5]; F.sgu_norm_g = args.in[6];
    F.sgu_w_s = args.in[7]; F.sgu_b_s = args.in[8]; F.sinks = args.in[9]; F.rel_tab = args.in[10]; F.w_pa = args.in[11]; F.w_pb = args.in[12]; F.w_out = args.in[13]; F.norm_ffn_g = args.in[14];
    F.w_query = args.in[15]; F.sub_keys = args.in[16]; F.exp_u = args.in[17]; F.exp_v = args.in[18]; F.norm_final_g = args.in[19];
    for (int u = threadIdx.x; u < (LDS_BYTES - LDSCTL_OFF) / 4; u += NWAVES * 64) ((LAS unsigned*)(F.lds + LDSCTL_OFF))[u] = 0u;
    __syncthreads();
    XcdBarrier bar = xcd_barrier_post((unsigned*)(F.ctl + CW_BAR), F.MISC + 8);
    unsigned char* ws = args.ws;
    p0_prologue(F);
    xcd_barrier(bar);
    {
        pg8::Gemm g{(const bf16*)(ws + WS_RA), (const bf16*)(ws + WS_WIN), MPAD, DIN, DM}; pg8::StaticOrder S; S.init(MPAD, DIN, F.G, (int)blockIdx.x);
        pg8::EpiIn E{(bf16*)(ws + WS_Q), (bf16*)(ws + WS_KV), (bf16*)(ws + WS_U), (bf16*)(ws + WS_VS), (bf16*)(ws + WS_RATIO), (bf16*)(ws + WS_SB), (float*)(ws + WS_SS1),
                     F.out + OUT_KP, F.out + OUT_VP, F.out + OUT_KS, F.out + OUT_VS};
        pg8::gemm_phase<pg8::EpiIn, pg8::StaticOrder, true, true, false>(F.lds + RING_OFF, g, S, E, F.wave);
        constexpr int NU = (MPAD / 256) * (DIN / 256); const int full = NU % (int)F.G;
        constexpr int TW0 = 32 * 232, TW1 = 32 * 232 + 2 * 16 * 64 + 2 * 32 * 64;
        if (NU > (int)F.G && full > 0) { if ((int)blockIdx.x >= full) { const int rk = (int)blockIdx.x - full, nr = (int)F.G - full; p0_expert_tables(F, rk, nr);
                if (P0_LATE_W == 2) p0_transposes(F, TW0, TW1, rk * NWAVES + F.wave, nr * NWAVES); } }
        else { p0_expert_tables(F, F.vcu, F.G); if (P0_LATE_W == 2) p0_transposes(F, TW0, TW1, F.vcu * NWAVES + F.wave, F.G * NWAVES); }
    }
    xcd_barrier(bar);
    p2_mixers(F);
    xcd_barrier(bar);
    {
        pg8::Gemm g{(const bf16*)(ws + WS_RA), (const bf16*)(ws + WS_WAB), MPROMPT, DM, DM}; pg8::StaticOrder S; S.init(MPROMPT, DM, F.G, (int)blockIdx.x);
        pg8::EpiMerge E{(const bf16*)(ws + WS_RATIO), (const bf16*)(ws + WS_SB), (bf16*)(ws + WS_RB)};
        pg8::gemm_phase<pg8::EpiMerge, pg8::StaticOrder, true, true, false>(F.lds + RING_OFF, g, S, E, F.wave);
        const SkMerge SE{(const bf16*)(ws + WS_RATIO), (const bf16*)(ws + WS_SB), (bf16*)(ws + WS_RB)}; skinny_gemm<false, true>(F, (const bf16*)(ws + WS_RA), (const bf16*)(ws + WS_WAB), SE);
    }
    xcd_barrier(bar);
    {
        pg8::Gemm g{(const bf16*)(ws + WS_RB), (const bf16*)(ws + WS_WOUT), MPROMPT, DM, DM}; pg8::StaticOrder S; S.init(MPROMPT, DM, F.G, (int)blockIdx.x);
        pg8::EpiOut E{F.x_prompt, F.x_sample, (bf16*)(ws + WS_RATIO), (float*)(ws + WS_SS2)};
        pg8::gemm_phase<pg8::EpiOut, pg8::StaticOrder, true, true, false>(F.lds + RING_OFF, g, S, E, F.wave);
        const SkOut SE{F.x_sample, (bf16*)(ws + WS_RATIO), (float*)(ws + WS_SS2S)}; skinny_gemm<false, false>(F, (const bf16*)(ws + WS_RB), (const bf16*)(ws + WS_WOUT), SE);
    }
    xcd_barrier(bar);
    {
        pg8::Gemm g{(const bf16*)(ws + WS_RATIO), (const bf16*)(ws + WS_WQ), MPROMPT, DM, DM}; pg8::StaticOrder S; S.init(MPROMPT, DM, F.G, (int)blockIdx.x);
        pg8::EpiQ E{(bf16*)(ws + WS_SB)};
        pg8::gemm_phase<pg8::EpiQ, pg8::StaticOrder, true, true, true>(F.lds + RING_OFF, g, S, E, F.wave);
        const SkQ SE{(bf16*)(ws + WS_SB)}; skinny_gemm<true, false>(F, (const bf16*)(ws + WS_RATIO), (const bf16*)(ws + WS_WQ), SE);
    }
    xcd_barrier(bar);
#if PQ_MERGE
#ifdef PQ_TOKENS_ONLY
    p6_topk(F);
    xcd_barrier(bar);
#endif
    p67_queue(F);
#else
    p6_topk(F);
    xcd_barrier(bar);
    p7_gather(F);
#endif
}

extern "C" void kernel_launch(void* const* d_in, const int* in_sizes, int n_in, void* d_out, int out_size, void* d_ws, size_t ws_size, hipStream_t stream) {
    static int grid = 0;
    if (grid == 0) {
        if (n_in != 20 || in_sizes[0] != MPROMPT * DM || out_size != (int)OUT_TOTAL || ws_size < WS_END) {
            fprintf(stderr, "kernel_launch: shape mismatch: n_in %d, in0 %d, out %d (want %zu), ws %zu (want %zu); nothing launched\n", n_in, n_in > 0 ? in_sizes[0] : -1, out_size, (size_t)OUT_TOTAL, ws_size, (size_t)WS_END); grid = -1; return; }
        int dev = 0, cus = 0, per_cu = 0;
        if (hipGetDevice(&dev) != hipSuccess || hipDeviceGetAttribute(&cus, hipDeviceAttributeMultiprocessorCount, dev) != hipSuccess) { fprintf(stderr, "kernel_launch: device query failed\n"); grid = -1; return; }
        if (hipFuncSetAttribute((const void*)hybrid_fwd, hipFuncAttributeMaxDynamicSharedMemorySize, LDS_BYTES) != hipSuccess) { fprintf(stderr, "kernel_launch: hipFuncSetAttribute failed\n"); grid = -1; return; }
        if (hipOccupancyMaxActiveBlocksPerMultiprocessor(&per_cu, (const void*)hybrid_fwd, NWAVES * 64, LDS_BYTES) != hipSuccess || per_cu < 1)
            fprintf(stderr, "kernel_launch: note: occupancy query reports %d workgroups per CU\n", per_cu);
        (void)hipGetLastError();
        grid = cus;
    }
    if (grid < 0) return;
    if (hipMemsetAsync((char*)d_ws + WS_CTL, 0, CTL_ZERO_BYTES, stream) != hipSuccess) { fprintf(stderr, "kernel_launch: memset failed\n"); return; }
    Args a{};
    for (int i = 0; i < 20; ++i) a.in[i] = (const float*)d_in[i];
    a.out = (float*)d_out; a.ws = (unsigned char*)d_ws;

    hipLaunchKernelGGL(hybrid_fwd, dim3(grid), dim3(NWAVES * 64), LDS_BYTES, stream, a);
    const hipError_t le = hipPeekAtLastError();
    if (le != hipSuccess) fprintf(stderr, "kernel_launch: launch failed: %s\n", hipGetErrorName(le));
}
```

```cpp
#include <hip/hip_runtime.h>
#include <cstdio>
#include <cstdint>

namespace pg8 {
#define PG8_LAS __attribute__((address_space(3)))
typedef unsigned short bf16_t;
typedef short bf16x8 __attribute__((ext_vector_type(8)));
typedef float f32x4 __attribute__((ext_vector_type(4)));
typedef unsigned u32x4 __attribute__((ext_vector_type(4)));
constexpr int BM = 256, BK = 64, HALF = 128, HTB = HALF * BK * 2  , STAGE_BYTES = 8 * HTB, NXCD = 8, WGM = 8;

__host__ __device__ __forceinline__ int lds_byte(int r, int c) { const int st = (r >> 4) * 2 + (c >> 5), rr = r & 15, cc = c & 31, ob = rr * 64 + cc * 2; return st * 1024 + (ob ^ (((ob >> 9) & 1) << 5)); }
__host__ __device__ __forceinline__ void stage_rc(int b, int& R, int& C) { const int st = b / 1024, sb = b % 1024, swz = sb ^ (((sb >> 9) & 1) << 5); R = (st >> 1) * 16 + swz / 64; C = (st & 1) * 32 + (swz % 64) / 2; }
__host__ __device__ __forceinline__ int perm32(int rho) { const int n = rho >> 4, i = rho & 15; return 8 * (i >> 2) + 4 * n + (i & 3); }

__device__ __forceinline__ int lane_id_v() { int l; asm volatile("v_mbcnt_lo_u32_b32 %0, -1, 0\n\tv_mbcnt_hi_u32_b32 %0, -1, %0" : "=v"(l)); return l; }
__device__ __forceinline__ unsigned partner32(unsigned x) { unsigned a = x, b = x; asm volatile("" : "+v"(a)); asm volatile("" : "+v"(b)); auto rr = __builtin_amdgcn_permlane32_swap(a, b, false, false); return rr[0] ^ rr[1] ^ x; }
struct Unit { int pm, pn; };
struct Gemm { const bf16_t* A; const bf16_t* Bt; int M, N, K; };

struct StaticOrder {
    int nM, nN, nwg, G, c;
    __host__ __device__ void init(int M, int N, int G_, int c_) { nM = M / BM; nN = N / BM; nwg = nM * nN; G = G_; c = c_; }
    __host__ __device__ bool next(int i, Unit& u) const {
        const long L = (long)i * G + c; if (L >= nwg) return false;
        int wgid = (int)L; { const int q = nwg / NXCD, r = nwg % NXCD, xcd = wgid % NXCD, off = wgid / NXCD; wgid = (xcd < r ? xcd * (q + 1) : r * (q + 1) + (xcd - r) * q) + off; }
        const int nig = WGM * nN, gid = wgid / nig, fm = gid * WGM, gsz = (nM - fm) < WGM ? (nM - fm) : WGM;
        u.pm = fm + ((wgid % nig) % gsz); u.pn = (wgid % nig) / gsz; return true;
    }
    __device__ __forceinline__ void a_ready(const Unit&) const {}
    __device__ __forceinline__ void done(const Unit&) const {}
};

typedef float f32x2 __attribute__((ext_vector_type(2)));
typedef __bf16 bf16x2_t __attribute__((ext_vector_type(2)));
typedef _Float16 f16x2_t __attribute__((ext_vector_type(2)));
typedef _Float16 f16x8_t __attribute__((ext_vector_type(8)));
__device__ __forceinline__ unsigned pk_bf16(float lo, float hi) { f32x2 v = {lo, hi}; return __builtin_bit_cast(unsigned, __builtin_convertvector(v, bf16x2_t)); }
__device__ __forceinline__ unsigned pk_f16(float lo, float hi) { f32x2 v = {lo, hi}; return __builtin_bit_cast(unsigned, __builtin_convertvector(v, f16x2_t)); }
__device__ __forceinline__ float bf_lo(unsigned w) { return __builtin_bit_cast(float, w << 16); }
__device__ __forceinline__ float bf_hi(unsigned w) { return __builtin_bit_cast(float, w & 0xffff0000u); }
template <bool F16> __device__ __forceinline__ f32x4 mma16(bf16x8 a, bf16x8 b, f32x4 c) {
    if constexpr (F16) return __builtin_amdgcn_mfma_f32_16x16x32_f16(__builtin_bit_cast(f16x8_t, a), __builtin_bit_cast(f16x8_t, b), c, 0, 0, 0);
    else return __builtin_amdgcn_mfma_f32_16x16x32_bf16(a, b, c, 0, 0, 0);
}
__device__ __forceinline__ float gelu_tanh(float x) { const float y = x * (-2.3022081981f - 0.1029432396f * (x * x)); return x * __builtin_amdgcn_rcpf(1.f + __builtin_amdgcn_exp2f(y)); }
__device__ __forceinline__ float sigmoidf_(float x) { return __builtin_amdgcn_rcpf(1.f + __builtin_amdgcn_exp2f(-1.4426950409f * x)); }
__device__ __forceinline__ u32x4 pack8_bf16(const f32x4 a, const f32x4 b) { u32x4 w; w.x = pk_bf16(a[0], a[1]); w.y = pk_bf16(a[2], a[3]); w.z = pk_bf16(b[0], b[1]); w.w = pk_bf16(b[2], b[3]); return w; }
__device__ __forceinline__ u32x4 pack8_f16(const f32x4 a, const f32x4 b) { u32x4 w; w.x = pk_f16(a[0], a[1]); w.y = pk_f16(a[2], a[3]); w.z = pk_f16(b[0], b[1]); w.w = pk_f16(b[2], b[3]); return w; }
__device__ __forceinline__ float sq4(const f32x4 a) { return (a[0] * a[0] + a[1] * a[1]) + (a[2] * a[2] + a[3] * a[3]); }

constexpr float QSCALE = 0.125f * 1.4426950408889634f;
struct EpiIn {
    static constexpr bool PERM = true, AFTER_DRAIN = false, MID = false;
    bf16_t *Q, *KV, *U, *VS, *RATIO, *SB; float* SS1; float *outKp, *outVp, *outKs, *outVs;
    __device__ __forceinline__ void operator()(const f32x4 (&acc)[2][2][4][2], const Unit& u, int wr, int wc, int, int) const {
        const int lane_ = lane_id_v(), fr = lane_ & 15, fq = lane_ >> 4;
        const int pn = u.pn, rowb = u.pm * BM + wr * 64 + fr, cl = wc * 32 + 8 * fq;
        if (pn < 4) {
#pragma unroll
            for (int ai = 0; ai < 2; ++ai)
#pragma unroll
                for (int m = 0; m < 4; ++m) { bf16_t* rp = Q + (size_t)(rowb + ai * HALF + m * 16) * 1024 + pn * 256 + cl;
#pragma unroll
                    for (int bj = 0; bj < 2; ++bj) *(u32x4*)(rp + bj * HALF) = pack8_bf16(acc[ai][bj][m][0] * QSCALE, acc[ai][bj][m][1] * QSCALE); }
        } else if (pn == 4) {
#pragma unroll
            for (int ai = 0; ai < 2; ++ai)
#pragma unroll
                for (int m = 0; m < 4; ++m) { bf16_t* rp = KV + (size_t)(rowb + ai * HALF + m * 16) * 256 + cl;
#pragma unroll
                    for (int bj = 0; bj < 2; ++bj) *(u32x4*)(rp + bj * HALF) = pack8_bf16(acc[ai][bj][m][0], acc[ai][bj][m][1]); }
            if (u.pm < 64 && (u.pm & 7) == 7) {
#pragma unroll
                for (int m = 0; m < 4; ++m) { const size_t o = (size_t)((u.pm >> 3) * 128 + wr * 64 + m * 16 + fr) * 128 + cl;
                    __builtin_nontemporal_store(acc[1][0][m][0], (f32x4*)(outKp + o)); __builtin_nontemporal_store(acc[1][0][m][1], (f32x4*)(outKp + o + 4));
                    __builtin_nontemporal_store(acc[1][1][m][0], (f32x4*)(outVp + o)); __builtin_nontemporal_store(acc[1][1][m][1], (f32x4*)(outVp + o + 4)); }
            }
            if (u.pm == 64) {
#pragma unroll
                for (int m = 0; m < 4; ++m) { const size_t o = (size_t)(wr * 64 + m * 16 + fr) * 128 + cl;
                    __builtin_nontemporal_store(acc[0][0][m][0], (f32x4*)(outKs + o)); __builtin_nontemporal_store(acc[0][0][m][1], (f32x4*)(outKs + o + 4));
                    __builtin_nontemporal_store(acc[0][1][m][0], (f32x4*)(outVs + o)); __builtin_nontemporal_store(acc[0][1][m][1], (f32x4*)(outVs + o + 4)); }
            }
        } else if (pn < 13) {
            const bool isv = pn >= 9; bf16_t* base = isv ? VS : U; const int ct = (isv ? pn - 9 : pn - 5) * 256 + cl;
#pragma unroll
            for (int ai = 0; ai < 2; ++ai)
#pragma unroll
                for (int m = 0; m < 4; ++m) { const int row = rowb + ai * HALF + m * 16; bf16_t* rp = base + (size_t)row * 1024 + ct; float s = 0.f;
#pragma unroll
                    for (int bj = 0; bj < 2; ++bj) { f32x4 a = acc[ai][bj][m][0], b = acc[ai][bj][m][1];
#pragma unroll
                        for (int e = 0; e < 4; ++e) { a[e] = gelu_tanh(a[e]); b[e] = gelu_tanh(b[e]); }
                        s += sq4(a) + sq4(b); *(u32x4*)(rp + bj * HALF) = pack8_bf16(a, b); }
                    if (isv) { s += __shfl_xor(s, 16); s += __shfl_xor(s, 32); if (fq == 0) SS1[(size_t)row * 16 + (pn - 9) * 4 + wc] = s; } }
        } else {
            const int ct = (pn - 13) * 128 + cl;
#pragma unroll
            for (int ai = 0; ai < 2; ++ai)
#pragma unroll
                for (int m = 0; m < 4; ++m) { const size_t o = (size_t)(rowb + ai * HALF + m * 16) * 2048 + ct; f32x4 ra, rb, sa, sb2;
#pragma unroll
                    for (int e = 0; e < 4; ++e) {
                        const float eb0 = 1.f + __builtin_amdgcn_exp2f(-1.4426950409f * acc[ai][1][m][0][e]), eb1 = 1.f + __builtin_amdgcn_exp2f(-1.4426950409f * acc[ai][1][m][1][e]);
                        const float ea0 = 1.f + __builtin_amdgcn_exp2f(-1.4426950409f * acc[ai][0][m][0][e]), ea1 = 1.f + __builtin_amdgcn_exp2f(-1.4426950409f * acc[ai][0][m][1][e]);
                        sa[e] = __builtin_amdgcn_rcpf(eb0); sb2[e] = __builtin_amdgcn_rcpf(eb1); ra[e] = eb0 * __builtin_amdgcn_rcpf(ea0); rb[e] = eb1 * __builtin_amdgcn_rcpf(ea1); }
                    *(u32x4*)(RATIO + o) = pack8_bf16(ra, rb); *(u32x4*)(SB + o) = pack8_bf16(sa, sb2); }
        }
    }
};
struct EpiMerge {
    static constexpr bool PERM = true, AFTER_DRAIN = false, MID = true;
    const bf16_t *RATIO, *SB; bf16_t* H;
    __device__ __forceinline__ void mid(f32x4 (&acc)[2][2][4][2], const Unit& u, int wr, int wc, int, int) const {
        const int lane_ = lane_id_v(), fr = lane_ & 15, fq = lane_ >> 4;
        const int rowb = u.pm * BM + wr * 64 + fr, col = u.pn * 256 + wc * 32 + 8 * fq;
        u32x4 w[2][4][2];
#pragma unroll
        for (int ai = 0; ai < 2; ++ai)
#pragma unroll
            for (int m = 0; m < 4; ++m)
#pragma unroll
                for (int bj = 0; bj < 2; ++bj) w[ai][m][bj] = __builtin_nontemporal_load((const u32x4*)(RATIO + (size_t)(rowb + ai * HALF + m * 16) * 2048 + col + bj * HALF));
        asm volatile("" ::: "memory");
#pragma unroll
        for (int ai = 0; ai < 2; ++ai)
#pragma unroll
            for (int m = 0; m < 4; ++m)
#pragma unroll
                for (int bj = 0; bj < 2; ++bj) { const u32x4 v = w[ai][m][bj];
                    acc[ai][bj][m][0] *= (f32x4){bf_lo(v.x), bf_hi(v.x), bf_lo(v.y), bf_hi(v.y)}; acc[ai][bj][m][1] *= (f32x4){bf_lo(v.z), bf_hi(v.z), bf_lo(v.w), bf_hi(v.w)}; }
        asm volatile("" ::: "memory");
    }
    __device__ __forceinline__ void operator()(const f32x4 (&acc)[2][2][4][2], const Unit& u, int wr, int wc, int, int) const {
        const int lane_ = lane_id_v(), fr = lane_ & 15, fq = lane_ >> 4;
        const int rowb = u.pm * BM + wr * 64 + fr, col = u.pn * 256 + wc * 32 + 8 * fq;
        u32x4 w[2][4][2];
#pragma unroll
        for (int ai = 0; ai < 2; ++ai)
#pragma unroll
            for (int m = 0; m < 4; ++m)
#pragma unroll
                for (int bj = 0; bj < 2; ++bj) w[ai][m][bj] = __builtin_nontemporal_load((const u32x4*)(SB + (size_t)(rowb + ai * HALF + m * 16) * 2048 + col + bj * HALF));
        asm volatile("" ::: "memory");
#pragma unroll
        for (int ai = 0; ai < 2; ++ai) {
#pragma unroll
            for (int m = 0; m < 4; ++m)
#pragma unroll
                for (int bj = 0; bj < 2; ++bj) { const size_t o = (size_t)(rowb + ai * HALF + m * 16) * 2048 + col + bj * HALF; const u32x4 v = w[ai][m][bj];
                    *(u32x4*)(H + o) = pack8_bf16(acc[ai][bj][m][0] * (f32x4){bf_lo(v.x), bf_hi(v.x), bf_lo(v.y), bf_hi(v.y)}, acc[ai][bj][m][1] * (f32x4){bf_lo(v.z), bf_hi(v.z), bf_lo(v.w), bf_hi(v.w)}); }
            asm volatile("" ::: "memory");
        }
    }
};
#ifndef EPI_OUT_ROWS
#define EPI_OUT_ROWS 4
#endif
struct EpiOut {
    static constexpr bool PERM = true, AFTER_DRAIN = false, MID = false;
    const float *xp, *xs; bf16_t* XH; float* SS2;
    __device__ __forceinline__ void operator()(const f32x4 (&acc)[2][2][4][2], const Unit& u, int wr, int wc, int, int) const {
        const int lane_ = lane_id_v(), fr = lane_ & 15, fq = lane_ >> 4;
        const int rowb = u.pm * BM + wr * 64 + fr, col = u.pn * 256 + wc * 32 + 8 * fq;
#pragma unroll
        for (int ai = 0; ai < 2; ++ai)
#pragma unroll
            for (int mp = 0; mp < 4; mp += EPI_OUT_ROWS) {
                f32x4 xv[EPI_OUT_ROWS][2][2];
#pragma unroll
                for (int mm = 0; mm < EPI_OUT_ROWS; ++mm) { const int row = rowb + ai * HALF + (mp + mm) * 16; const float* xr = row < 16384 ? xp + (size_t)row * 2048 : (row < 16512 ? xs + (size_t)(row - 16384) * 2048 : nullptr);
#pragma unroll
                    for (int bj = 0; bj < 2; ++bj) { if (xr) { xv[mm][bj][0] = __builtin_nontemporal_load((const f32x4*)(xr + col + bj * HALF)); xv[mm][bj][1] = __builtin_nontemporal_load((const f32x4*)(xr + col + bj * HALF + 4)); } else { xv[mm][bj][0] = (f32x4){0.f, 0.f, 0.f, 0.f}; xv[mm][bj][1] = (f32x4){0.f, 0.f, 0.f, 0.f}; } } }
                asm volatile("" ::: "memory");
#pragma unroll
                for (int mm = 0; mm < EPI_OUT_ROWS; ++mm) { const int m = mp + mm, row = rowb + ai * HALF + m * 16; float s = 0.f;
#pragma unroll
                    for (int bj = 0; bj < 2; ++bj) { const f32x4 a = acc[ai][bj][m][0] + xv[mm][bj][0], b = acc[ai][bj][m][1] + xv[mm][bj][1];
                        s += sq4(a) + sq4(b); *(u32x4*)(XH + (size_t)row * 2048 + col + bj * HALF) = pack8_f16(a, b); }
                    s += __shfl_xor(s, 16); s += __shfl_xor(s, 32); if (fq == 0) SS2[(size_t)row * 32 + u.pn * 4 + wc] = s; }
                asm volatile("" ::: "memory");
            }
    }
};
struct EpiQ {
    static constexpr bool PERM = true, AFTER_DRAIN = false, MID = false;
    bf16_t* QP;
    __device__ __forceinline__ void operator()(const f32x4 (&acc)[2][2][4][2], const Unit& u, int wr, int wc, int, int) const {
        const int lane_ = lane_id_v(), fr = lane_ & 15, fq = lane_ >> 4;
        const int rowb = u.pm * BM + wr * 64 + fr, col = u.pn * 256 + wc * 32 + 8 * fq;
#pragma unroll
        for (int ai = 0; ai < 2; ++ai)
#pragma unroll
            for (int m = 0; m < 4; ++m)
#pragma unroll
                for (int bj = 0; bj < 2; ++bj) *(u32x4*)(QP + (size_t)(rowb + ai * HALF + m * 16) * 2048 + col + bj * HALF) = pack8_f16(acc[ai][bj][m][0], acc[ai][bj][m][1]);
    }
};
template <class Epi, class Sched, bool ALIGN_EPI = false, bool SP2 = false, bool F16 = false>
__device__ __forceinline__ void gemm_phase(PG8_LAS unsigned char* lds, const Gemm g, const Sched& S, const Epi& E, const int wid_in) {
    const int lane = lane_id_v(), wid = wid_in, tid = wid * 64 + lane, wr = wid >> 2, wc = wid & 3, fr = lane & 15, fq = lane >> 4;
    const int K = g.K, nt = K / BK;
    unsigned voffA[2], voffB[2];
#pragma unroll
    for (int i = 0; i < 2; ++i) { int R, C; stage_rc(tid * 16 + i * 8192, R, C); const int Rb = Epi::PERM ? ((R & ~31) + perm32(R & 31)) : R;
        voffA[i] = (unsigned)(R * K + C) * 2u; voffB[i] = (unsigned)(Rb * K + C) * 2u; }
    const size_t kstep = (size_t)(BK * 2);
    const size_t hstep = (size_t)HALF * K * 2;
    const size_t tstep = 2 * hstep;
    const unsigned ldsw = (unsigned)wid * 1024u;
    const int aoff = lds_byte(wr * 64 + fr, fq * 8), boff = lds_byte(wc * 32 + fr, fq * 8);
#define PG8_SA(b, h) (((b) * 2 + (h)) * HTB)
#define PG8_SB(b, h) ((4 + (b) * 2 + (h)) * HTB)
#define PG8_STAGE(bufoff, gbase, voff) do { _Pragma("unroll") for (int _i = 0; _i < 2; ++_i) \
        __builtin_amdgcn_global_load_lds((const unsigned*)((const char*)(gbase) + (voff)[_i]), (PG8_LAS unsigned*)(lds + (bufoff) + ldsw + _i * 8192), 16, 0, 0); } while (0)
#define PG8_LDA(dst, b, h) do { _Pragma("unroll") for (int m = 0; m < 4; ++m) _Pragma("unroll") for (int k = 0; k < 2; ++k) dst[m][k] = *(const PG8_LAS bf16x8*)(lds + PG8_SA(b, h) + aoff + m * 2048 + k * 1024); } while (0)
#define PG8_LDB(dst, b, h) do { _Pragma("unroll") for (int n = 0; n < 2; ++n) _Pragma("unroll") for (int k = 0; k < 2; ++k) dst[n][k] = *(const PG8_LAS bf16x8*)(lds + PG8_SB(b, h) + boff + n * 2048 + k * 1024); } while (0)
#define PG8_MMA(ai, bj, At, Bt) do { __builtin_amdgcn_s_setprio(1); _Pragma("unroll") for (int m = 0; m < 4; ++m) _Pragma("unroll") for (int n = 0; n < 2; ++n) _Pragma("unroll") for (int k = 0; k < 2; ++k) \
        acc[ai][bj][m][n] = mma16<F16>(Bt[n][k], At[m][k], acc[ai][bj][m][n]); __builtin_amdgcn_s_setprio(0); } while (0)
#define PG8_WAIT_V(n) asm volatile("s_waitcnt vmcnt(" #n ")" ::: "memory")
#define PG8_WAIT_L(n) asm volatile("s_waitcnt lgkmcnt(" #n ")" ::: "memory")
#define PG8_BAR __builtin_amdgcn_s_barrier()
#define PG8_SCHED __builtin_amdgcn_sched_barrier(0)
    Unit cur, nxt; int ui = 0;
    if (!S.next(0, cur)) return;
    f32x4 acc[2][2][4][2];
#pragma unroll
    for (int a = 0; a < 2; ++a)
#pragma unroll
        for (int b = 0; b < 2; ++b)
#pragma unroll
            for (int m = 0; m < 4; ++m)
#pragma unroll
                for (int n = 0; n < 2; ++n) acc[a][b][m][n] = (f32x4){0.f, 0.f, 0.f, 0.f};
    bf16x8 At[4][2], B0[2][2], B1[2][2];
    const char* cA = (const char*)g.A + (size_t)cur.pm * tstep; const char* cB = (const char*)g.Bt + (size_t)cur.pn * tstep;
    S.a_ready(cur);
    if constexpr (SP2) {
        PG8_STAGE(PG8_SB(0, 0), cB, voffB); PG8_STAGE(PG8_SB(0, 1), cB + hstep, voffB); PG8_STAGE(PG8_SA(0, 0), cA, voffA); PG8_STAGE(PG8_SA(0, 1), cA + hstep, voffA);
        if (wr == 1) PG8_BAR;
        PG8_WAIT_V(2); PG8_BAR;
        PG8_STAGE(PG8_SB(1, 0), cB + kstep, voffB); PG8_STAGE(PG8_SA(1, 0), cA + kstep, voffA); PG8_STAGE(PG8_SB(1, 1), cB + hstep + kstep, voffB);
        PG8_WAIT_V(6); PG8_BAR;
    } else {
        PG8_STAGE(PG8_SB(0, 0), cB, voffB); PG8_STAGE(PG8_SA(0, 0), cA, voffA); PG8_STAGE(PG8_SB(0, 1), cB + hstep, voffB); PG8_STAGE(PG8_SA(0, 1), cA + hstep, voffA);
        if (wr == 1) PG8_BAR;
        PG8_WAIT_V(4); PG8_BAR;
        PG8_STAGE(PG8_SB(1, 0), cB + kstep, voffB); PG8_STAGE(PG8_SA(1, 0), cA + kstep, voffA); PG8_STAGE(PG8_SB(1, 1), cB + hstep + kstep, voffB);
        PG8_WAIT_V(6); PG8_BAR;
    }
    for (;;) {
        const bool has_next = S.next(ui + 1, nxt);
        const char* nA = has_next ? (const char*)g.A + (size_t)nxt.pm * tstep : cA; const char* nB = has_next ? (const char*)g.Bt + (size_t)nxt.pn * tstep : cB;
        for (int t = 0; t < nt; t += 2) {
            const bool last = (t == nt - 2);
            const char* a1 = cA + (size_t)(t + 1) * kstep;
            const char* a2 = last ? nA : cA + (size_t)(t + 2) * kstep; const char* b2 = last ? nB : cB + (size_t)(t + 2) * kstep;
            const char* a3 = a2 + kstep; const char* b3 = b2 + kstep;
            if (last && has_next) S.a_ready(nxt);
            if constexpr (Epi::MID) { if (t == (nt >> 1)) E.mid(acc, cur, wr, wc, fr, fq); }
            if constexpr (SP2) {
            PG8_LDB(B0, 0, 0); PG8_LDB(B1, 0, 1); PG8_SCHED; PG8_LDA(At, 0, 0); PG8_STAGE(PG8_SA(1, 1), a1 + hstep, voffA);
            PG8_WAIT_V(8); PG8_WAIT_L(0); PG8_BAR; PG8_MMA(0, 0, At, B0); PG8_MMA(0, 1, At, B1); PG8_BAR; PG8_SCHED;
            PG8_LDA(At, 0, 1); PG8_STAGE(PG8_SB(0, 0), b2, voffB); PG8_STAGE(PG8_SB(0, 1), b2 + hstep, voffB); PG8_STAGE(PG8_SA(0, 0), a2, voffA);
            PG8_WAIT_V(8); PG8_WAIT_L(0); PG8_BAR; PG8_MMA(1, 0, At, B0); PG8_MMA(1, 1, At, B1); PG8_BAR; PG8_SCHED;
            PG8_LDB(B0, 1, 0); PG8_LDB(B1, 1, 1); PG8_SCHED; PG8_LDA(At, 1, 0); PG8_STAGE(PG8_SA(0, 1), a2 + hstep, voffA);
            PG8_WAIT_V(8); PG8_WAIT_L(0); PG8_BAR; PG8_MMA(0, 0, At, B0); PG8_MMA(0, 1, At, B1); PG8_BAR; PG8_SCHED;
            PG8_LDA(At, 1, 1); PG8_STAGE(PG8_SB(1, 0), b3, voffB); PG8_STAGE(PG8_SB(1, 1), b3 + hstep, voffB); PG8_STAGE(PG8_SA(1, 0), a3, voffA);
            PG8_WAIT_V(8); PG8_WAIT_L(0); PG8_BAR; PG8_MMA(1, 0, At, B0); PG8_MMA(1, 1, At, B1); PG8_BAR; PG8_SCHED;
            } else {
            PG8_LDB(B0, 0, 0); PG8_SCHED; PG8_LDA(At, 0, 0); PG8_STAGE(PG8_SA(1, 1), a1 + hstep, voffA);
            PG8_WAIT_L(8); PG8_BAR; PG8_WAIT_L(0); PG8_MMA(0, 0, At, B0); PG8_BAR; PG8_SCHED;
            PG8_LDB(B1, 0, 1); PG8_STAGE(PG8_SB(0, 0), b2, voffB);
            PG8_BAR; PG8_WAIT_L(0); PG8_MMA(0, 1, At, B1); PG8_BAR;
            PG8_LDA(At, 0, 1); PG8_STAGE(PG8_SA(0, 0), a2, voffA);
            PG8_BAR; PG8_WAIT_L(0); PG8_MMA(1, 0, At, B0); PG8_BAR; PG8_SCHED;
            PG8_STAGE(PG8_SB(0, 1), b2 + hstep, voffB);
            PG8_WAIT_V(6); PG8_BAR; PG8_MMA(1, 1, At, B1); PG8_BAR;
            PG8_LDB(B0, 1, 0); PG8_SCHED; PG8_LDA(At, 1, 0); PG8_STAGE(PG8_SA(0, 1), a2 + hstep, voffA);
            PG8_WAIT_L(8); PG8_BAR; PG8_WAIT_L(0); PG8_MMA(0, 0, At, B0); PG8_BAR; PG8_SCHED;
            PG8_LDB(B1, 1, 1); PG8_STAGE(PG8_SB(1, 0), b3, voffB);
            PG8_BAR; PG8_WAIT_L(0); PG8_MMA(0, 1, At, B1); PG8_BAR;
            PG8_LDA(At, 1, 1); PG8_STAGE(PG8_SA(1, 0), a3, voffA);
            PG8_BAR; PG8_WAIT_L(0); PG8_MMA(1, 0, At, B0); PG8_BAR; PG8_SCHED;
            PG8_STAGE(PG8_SB(1, 1), b3 + hstep, voffB);
            PG8_WAIT_V(6); PG8_BAR; PG8_MMA(1, 1, At, B1); PG8_BAR;
            }
        }
        if constexpr (ALIGN_EPI) { if (wr == 0) PG8_BAR; }
        if constexpr (!Epi::AFTER_DRAIN) { E(acc, cur, wr, wc, fr, fq); S.done(cur); }
        if (!has_next) break;
#pragma unroll
        for (int a = 0; a < 2; ++a)
#pragma unroll
            for (int b = 0; b < 2; ++b)
#pragma unroll
                for (int m = 0; m < 4; ++m)
#pragma unroll
                    for (int n = 0; n < 2; ++n) acc[a][b][m][n] = (f32x4){0.f, 0.f, 0.f, 0.f};
        cur = nxt; cA = nA; cB = nB; ++ui;
        if constexpr (ALIGN_EPI) { if (wr == 1) PG8_BAR; }
    }
    PG8_WAIT_V(0);
    if constexpr (!ALIGN_EPI) { if (wr == 0) PG8_BAR; }
    PG8_BAR;
    if constexpr (Epi::AFTER_DRAIN) { E.fused(acc, cur, wr, wc, fr, fq, lds, wid, lane); S.done(cur); }
#undef PG8_SA
#undef PG8_SB
#undef PG8_STAGE
#undef PG8_LDA
#undef PG8_LDB
#undef PG8_MMA
#undef PG8_WAIT_V
#undef PG8_WAIT_L
#undef PG8_BAR
#undef PG8_SCHED
}
}
#define GAS __attribute__((address_space(1)))
#define LAS __attribute__((address_space(3)))
typedef unsigned short bf16;
typedef unsigned v4u __attribute__((ext_vector_type(4)));
typedef float f32x4 __attribute__((ext_vector_type(4)));
typedef short bf16x8 __attribute__((ext_vector_type(8)));
typedef GAS unsigned gu32;
typedef GAS unsigned long long gu64;
#define RLX_AGENT __ATOMIC_RELAXED, __HIP_MEMORY_SCOPE_AGENT
#define LDS_WAIT() asm volatile("s_waitcnt lgkmcnt(0)" ::: "memory")
#define VM_WAIT() asm volatile("s_waitcnt vmcnt(0)" ::: "memory")
__device__ __forceinline__ unsigned long long rt() { return __builtin_amdgcn_s_memrealtime(); }
__device__ __forceinline__ unsigned f2bf(float f) { unsigned u = __builtin_bit_cast(unsigned, f); return (u + 0x7fffu + ((u >> 16) & 1u)) >> 16; }
__device__ __forceinline__ unsigned pk2(float lo, float hi) { return f2bf(lo) | (f2bf(hi) << 16); }

#define XB_TMO      128
#define XB_XCNT(j)  (256  + 64 * (j))
#define XB_XSUB(j)  (1280 + 64 * (j))
#define XB_XGEN(j)  (2304 + 64 * (j))
#define XB_TOP      3328
#define XB_TOPGEN   3392
#define XCD_BAR_WORDS 3456
#ifdef DEBUG_ORACLE
#define XB_SPIN_CAP (1u << 27)
#else
#define XB_SPIN_CAP (1u << 18)
#endif

__device__ __forceinline__ unsigned xb_ld(unsigned* p)              { return __hip_atomic_load(p, __ATOMIC_RELAXED, __HIP_MEMORY_SCOPE_AGENT); }
__device__ __forceinline__ unsigned xb_add(unsigned* p, unsigned v) { return __hip_atomic_fetch_add(p, v, __ATOMIC_RELAXED, __HIP_MEMORY_SCOPE_AGENT); }
__device__ __forceinline__ unsigned xb_xcc_id() { return (unsigned)__builtin_amdgcn_s_getreg((3 << 11) | 20) & 0xFu; }
#define XB_SPIN(cond, bar) do { unsigned _sp = 0; while (cond) { __builtin_amdgcn_s_sleep(1); \
    if ((++_sp & 255u) == 0u) { if (xb_ld(&(bar)[XB_TMO])) break; if (_sp > XB_SPIN_CAP) { atomicAdd(&(bar)[XB_TMO], 1u); break; } } } } while (0)

struct XcdBarrier {
    unsigned* bar; unsigned x;
    volatile LAS unsigned* st;
};

__device__ __forceinline__ XcdBarrier xcd_barrier_post(unsigned* bar, volatile LAS unsigned* st) {
    XcdBarrier b; b.bar = bar; b.x = xb_xcc_id(); b.st = st;
    if (threadIdx.x == 0) (void)xb_add(&bar[XB_XCNT(b.x)], 1u);
    return b;
}
__device__ __forceinline__ void xcd_barrier_complete(unsigned* bar, unsigned x, unsigned& nloc, unsigned& nx) {
    const unsigned G = gridDim.x * gridDim.y * gridDim.z;
    unsigned sum, cnt, mine, sp = 0u;
    for (;;) {
        sum = 0u; cnt = 0u; mine = 0u;
#pragma unroll
        for (unsigned j = 0; j < 16; ++j) { const unsigned c = xb_ld(&bar[XB_XCNT(j)]); sum += c; cnt += (c > 0u) ? 1u : 0u; mine = (j == x) ? c : mine; }
        if (sum == G) break;
        __builtin_amdgcn_s_sleep(1);
        if ((++sp & 255u) == 0u) { if (xb_ld(&bar[XB_TMO])) break; if (sp > XB_SPIN_CAP) { atomicAdd(&bar[XB_TMO], 1u); break; } }
    }
    nloc = mine > 0u ? mine : 1u; nx = cnt > 0u ? cnt : 1u;
}

__device__ __forceinline__ void xcd_barrier(const XcdBarrier& b) {
    asm volatile("s_waitcnt vmcnt(0)" ::: "memory");
    __syncthreads();
    if (threadIdx.x == 0) {
        unsigned* bar = b.bar;
        __builtin_amdgcn_s_waitcnt(0);
        unsigned nloc = b.st[0], nx = b.st[1];
        if (nloc == 0u) { xcd_barrier_complete(bar, b.x, nloc, nx); b.st[0] = nloc; b.st[1] = nx; }
        const unsigned old = xb_add(&bar[XB_XSUB(b.x)], 1u);
        const unsigned gen = old / nloc;
        if (old + 1u == (gen + 1u) * nloc) {
            __builtin_amdgcn_fence(__ATOMIC_RELEASE, "agent");
            asm volatile("s_waitcnt vmcnt(0)" ::: "memory");
            const unsigned og = xb_add(&bar[XB_TOP], 1u);
            const unsigned tg = og / nx;
            if (og + 1u == (tg + 1u) * nx) xb_add(&bar[XB_TOPGEN], 1u);
            else XB_SPIN(xb_ld(&bar[XB_TOPGEN]) == tg, bar);
            __builtin_amdgcn_fence(__ATOMIC_ACQUIRE, "agent");
            xb_add(&bar[XB_XGEN(b.x)], 1u);
            asm volatile("s_waitcnt vmcnt(0)" ::: "memory");
        } else {
            XB_SPIN(xb_ld(&bar[XB_XGEN(b.x)]) == gen, bar);
            __builtin_amdgcn_fence(__ATOMIC_ACQUIRE, "agent");
            asm volatile("s_waitcnt vmcnt(0)" ::: "memory");
        }
    }
    __syncthreads();
}
constexpr int NWAVES = 8, NTHR = 512;
constexpr int DM = 2048, SEQ = 2048, NBATCH = 8, TDEC = 16, MPROMPT = NBATCH * SEQ  , MSAMPLE = NBATCH * TDEC  , MREAL = MPROMPT + MSAMPLE  , MPAD = 16640  ;
constexpr int DIN = 7424, DATTN = 1024, DSGU = 1024, WINDOW = 128, CHUNK = 64, NHEADS = 16, HD = 64;
constexpr int NEXP = 16384, PEER_H = 8, PEER_K = 16;
#ifndef PEER_FP4
#define PEER_FP4 1
#endif
#ifndef PEER_FP6
#define PEER_FP6 (!PEER_FP4)
#endif
constexpr float PEER_SU = 64.f, PEER_SV = 16.f;
constexpr float EPS = 1e-6f, LOG2E = 1.4426950408889634f;
constexpr size_t OUT_Y = 0, OUT_KP = (size_t)MREAL * DM, OUT_VP = OUT_KP + 131072, OUT_KS = OUT_VP + 131072, OUT_VS = OUT_KS + 16384, OUT_SGU = OUT_VS + 16384, OUT_TOTAL = OUT_SGU + 131072;
constexpr size_t MiB = 1u << 20;
constexpr size_t WS_CTL = 0, CTL_ZERO_BYTES = 64 * 1024;
constexpr size_t WS_WIN = 1 * MiB;
constexpr size_t WS_WAB = 30 * MiB;
constexpr size_t WS_WOUT = 38 * MiB;
constexpr size_t WS_WQ = 46 * MiB;
constexpr size_t WS_KEYS = 54 * MiB;
constexpr size_t WS_WSM = 54 * MiB + 512 * 1024;
constexpr size_t WS_SS1 = 55 * MiB;
constexpr size_t WS_SS2 = 57 * MiB;
constexpr size_t WS_EU = 60 * MiB, WS_EV = 124 * MiB;
constexpr size_t WS_RA = 188 * MiB;
constexpr size_t WS_RB = 253 * MiB;
constexpr size_t WS_Q = WS_RB, WS_KV = WS_Q + (size_t)MPAD * 1024 * 2, WS_U = WS_KV + (size_t)MPAD * 256 * 2, WS_VS = WS_U + (size_t)MPAD * 1024 * 2;
constexpr size_t WS_RC = 359 * MiB;
constexpr size_t WS_RATIO = WS_RC, WS_SB = WS_RC + 65 * MiB, WS_END = WS_RC + 130 * MiB;
static_assert(WS_VS + (size_t)MPAD * 1024 * 2 <= WS_RC && WS_END == 489 * MiB, "d_ws map");
constexpr int CW_BAR = 4096;
constexpr int RING_OFF = 0, RING_BYTES = 131072;
constexpr int LDSCTL_OFF = RING_BYTES, MISC_OFF = LDSCTL_OFF + 320;
constexpr int LDS_BYTES = 147456;
struct Frame {
    LAS unsigned char* lds; volatile LAS unsigned* MISC; gu32* ctl;
    int wave, vcu, G;
    const float *x_prompt, *x_sample, *cache_k, *cache_v, *norm_mix_g, *w_in, *sgu_norm_g, *sgu_w_s, *sgu_b_s, *sinks, *rel_tab, *w_pa, *w_pb, *w_out, *norm_ffn_g, *w_query, *sub_keys, *exp_u, *exp_v, *norm_final_g;
    float* out; unsigned char* ws;
};
__device__ __forceinline__ float wave_sum(float v) {
#pragma unroll
    for (int o = 1; o < 64; o <<= 1) v += __shfl_xor(v, o);
    return v;
}
__device__ __forceinline__ unsigned pkb(float lo, float hi) { return pg8::pk_bf16(lo, hi); }
__device__ __forceinline__ unsigned pkh(float lo, float hi) { return pg8::pk_f16(lo, hi); }
template <bool F16>
__device__ __forceinline__ void p0_transpose_item(const float* W, int N, bf16* WT, int kpitch, int koff, int drow0, int k0, int n0, const float* kscale, LAS float* scr, int lane) {
    float wv[32];
#pragma unroll
    for (int i = 0; i < 32; ++i) { const int kk = 2 * i + (lane >> 5); wv[i] = __builtin_nontemporal_load(W + (size_t)(k0 + kk) * N + n0 + (lane & 31)); }
#pragma unroll
    for (int i = 0; i < 32; ++i) { const int kk = 2 * i + (lane >> 5); scr[kk * 33 + (lane & 31)] = wv[i]; }
    LDS_WAIT(); asm volatile("" ::: "memory");
    const int c = lane & 7;
    float sc[8];
#pragma unroll
    for (int q = 0; q < 8; ++q) sc[q] = kscale ? kscale[k0 + 8 * c + q] : 1.f;
#pragma unroll
    for (int j = 0; j < 4; ++j) { const int n = (lane >> 3) + 8 * j; const LAS float* s = scr + (8 * c) * 33 + n;
        float v[8];
#pragma unroll
        for (int q = 0; q < 8; ++q) v[q] = s[q * 33] * sc[q];
        v4u o;
        if (F16) { o.x = pkh(v[0], v[1]); o.y = pkh(v[2], v[3]); o.z = pkh(v[4], v[5]); o.w = pkh(v[6], v[7]); }
        else     { o.x = pkb(v[0], v[1]); o.y = pkb(v[2], v[3]); o.z = pkb(v[4], v[5]); o.w = pkb(v[6], v[7]); }
        *(GAS v4u*)(WT + (size_t)(drow0 + n) * kpitch + koff + k0 + 8 * c) = o; }
    LDS_WAIT(); asm volatile("" ::: "memory");
}
__device__ __forceinline__ int win_row_of_col(int n) {
    if (n < 3328) return n;
    if (n < 5376) { const int q = n - 3328; return 3328 + (q >> 7) * 256 + (q & 127); }
    const int q = n - 5376; return 3328 + (q >> 7) * 256 + 128 + (q & 127);
}
__device__ __forceinline__ void rms_row_to_bf16(const float* xrow, const float* g, bf16* orow, int lane) {
    const GAS f32x4* xr = (const GAS f32x4*)xrow + lane; const GAS f32x4* gr = (const GAS f32x4*)g + lane;
    f32x4 v[8]; float s = 0.f;
#pragma unroll
    for (int j = 0; j < 8; ++j) { v[j] = xr[64 * j]; s += (v[j].x * v[j].x + v[j].y * v[j].y) + (v[j].z * v[j].z + v[j].w * v[j].w); }
    const float r = 1.0f / sqrtf(wave_sum(s) * (1.f / DM) + EPS);
    GAS unsigned long long* o8 = (GAS unsigned long long*)orow + lane;
#pragma unroll
    for (int j = 0; j < 8; ++j) { const f32x4 gg = gr[64 * j]; o8[64 * j] = (unsigned long long)pkb(v[j].x * r * gg.x, v[j].y * r * gg.y) | ((unsigned long long)pkb(v[j].z * r * gg.z, v[j].w * r * gg.w) << 32); }
}
__device__ __forceinline__ void p0_transposes(Frame& F, int first, int last, int gw, int NGW) {
    const int lane = pg8::lane_id_v();
    LAS float* scr = (LAS float*)(F.lds + RING_OFF + F.wave * 16384);
    bf16* WIN = (bf16*)(F.ws + WS_WIN); bf16* WAB = (bf16*)(F.ws + WS_WAB); bf16* WOUT = (bf16*)(F.ws + WS_WOUT); bf16* WQ = (bf16*)(F.ws + WS_WQ);
    constexpr int I_IN = 32 * 232, I_PA = 16 * 64, I_OUT = 32 * 64;
    for (int it = first + gw; it < last; it += NGW) {
        int r = it;
        if (r < I_IN) { const int kb = r / 232, nb = r % 232; p0_transpose_item<false>(F.w_in, DIN, WIN, 2048, 0, win_row_of_col(32 * nb), 64 * kb, 32 * nb, nullptr, scr, lane); continue; } r -= I_IN;
        if (r < I_PA) { const int kb = r / 64, nb = r % 64; p0_transpose_item<false>(F.w_pa, 2048, WAB, 2048, 0, 32 * nb, 64 * kb, 32 * nb, nullptr, scr, lane); continue; } r -= I_PA;
        if (r < I_PA) { const int kb = r / 64, nb = r % 64; p0_transpose_item<false>(F.w_pb, 2048, WAB, 2048, 1024, 32 * nb, 64 * kb, 32 * nb, nullptr, scr, lane); continue; } r -= I_PA;
        if (r < I_OUT) { const int kb = r / 64, nb = r % 64; p0_transpose_item<false>(F.w_out, 2048, WOUT, 2048, 0, 32 * nb, 64 * kb, 32 * nb, nullptr, scr, lane); continue; } r -= I_OUT;
        { const int kb = r / 64, nb = r % 64; p0_transpose_item<true>(F.w_query, 2048, WQ, 2048, 0, 32 * nb, 64 * kb, 32 * nb, F.norm_ffn_g, scr, lane); }
    }
}
__device__ __forceinline__ void p0_expert_tables(Frame& F, int rank, int nranks) {
    const int lane = pg8::lane_id_v(), tid = F.wave * 64 + lane;
    const size_t gt = (size_t)rank * NTHR + tid, NT = (size_t)nranks * NTHR;
#if PEER_FP4
    { unsigned char* EU4 = F.ws + WS_EU; float* EUS = (float*)(F.ws + WS_EU + 16 * MiB); unsigned char* EV4 = F.ws + WS_EU + 32 * MiB; float* EVS = (float*)(F.ws + WS_EU + 48 * MiB);
        const int gwv = rank * NWAVES + F.wave, nwv = nranks * NWAVES;
        for (int row = gwv; row < NEXP; row += nwv) { const size_t c = (size_t)row * 64 + lane; float fu[32], fv[32]; float mu = 0.f, mv = 0.f;
#pragma unroll
            for (int q = 0; q < 8; ++q) { const size_t eo = (size_t)row * DM + q * 256 + lane * 4;
                const f32x4 a = __builtin_nontemporal_load((const GAS f32x4*)(F.exp_u + eo)) * *(const GAS f32x4*)(F.norm_ffn_g + q * 256 + lane * 4); const f32x4 p = __builtin_nontemporal_load((const GAS f32x4*)(F.exp_v + eo));
#pragma unroll
                for (int e = 0; e < 4; ++e) { fu[4 * q + e] = a[e]; fv[4 * q + e] = p[e]; mu = fmaxf(mu, fabsf(a[e])); mv = fmaxf(mv, fabsf(p[e])); } }
#pragma unroll
            for (int o = 1; o < 64; o <<= 1) { mu = fmaxf(mu, __shfl_xor(mu, o)); mv = fmaxf(mv, __shfl_xor(mv, o)); }
            const float su = fmaxf(mu, 1e-30f) * (1.0f / 6.0f), sv = fmaxf(mv, 1e-30f) * (1.0f / 6.0f), iu = 1.0f / su, iv = 1.0f / sv;
            v4u wu, wv;
#pragma unroll
            for (int q = 0; q < 4; ++q) { unsigned a = 0u, b2 = 0u;
                a = __builtin_amdgcn_cvt_scalef32_pk_fp4_f32(a, fu[8 * q + 0] * iu, fu[8 * q + 1] * iu, 1.0f, 0); a = __builtin_amdgcn_cvt_scalef32_pk_fp4_f32(a, fu[8 * q + 2] * iu, fu[8 * q + 3] * iu, 1.0f, 1);
                a = __builtin_amdgcn_cvt_scalef32_pk_fp4_f32(a, fu[8 * q + 4] * iu, fu[8 * q + 5] * iu, 1.0f, 2); a = __builtin_amdgcn_cvt_scalef32_pk_fp4_f32(a, fu[8 * q + 6] * iu, fu[8 * q + 7] * iu, 1.0f, 3);
                b2 = __builtin_amdgcn_cvt_scalef32_pk_fp4_f32(b2, fv[8 * q + 0] * iv, fv[8 * q + 1] * iv, 1.0f, 0); b2 = __builtin_amdgcn_cvt_scalef32_pk_fp4_f32(b2, fv[8 * q + 2] * iv, fv[8 * q + 3] * iv, 1.0f, 1);
                b2 = __builtin_amdgcn_cvt_scalef32_pk_fp4_f32(b2, fv[8 * q + 4] * iv, fv[8 * q + 5] * iv, 1.0f, 2); b2 = __builtin_amdgcn_cvt_scalef32_pk_fp4_f32(b2, fv[8 * q + 6] * iv, fv[8 * q + 7] * iv, 1.0f, 3);
                wu[q] = a; wv[q] = b2; }
            *(GAS v4u*)(EU4 + c * 16) = wu; *(GAS v4u*)(EV4 + c * 16) = wv; if (lane == 0) { EUS[row] = su; EVS[row] = sv; } } }
#elif PEER_FP6
    { unsigned char* EU6 = F.ws + WS_EU; unsigned char* EV6 = F.ws + WS_EU + 32 * MiB;
        typedef _Float16 h32v __attribute__((ext_vector_type(32))); typedef unsigned u6v __attribute__((ext_vector_type(6)));
        for (size_t c = gt; c < (size_t)NEXP * 64; c += NT) { const int d0 = (int)((c * 32) & (DM - 1)); h32v hu, hv;
#pragma unroll
            for (int q = 0; q < 8; ++q) { const f32x4 a = *(const GAS f32x4*)(F.exp_u + c * 32 + q * 4) * *(const GAS f32x4*)(F.norm_ffn_g + d0 + q * 4) * PEER_SU; const f32x4 p = *(const GAS f32x4*)(F.exp_v + c * 32 + q * 4) * PEER_SV;
                hu[4 * q] = (_Float16)a.x; hu[4 * q + 1] = (_Float16)a.y; hu[4 * q + 2] = (_Float16)a.z; hu[4 * q + 3] = (_Float16)a.w; hv[4 * q] = (_Float16)p.x; hv[4 * q + 1] = (_Float16)p.y; hv[4 * q + 2] = (_Float16)p.z; hv[4 * q + 3] = (_Float16)p.w; }
            const u6v pu = __builtin_amdgcn_cvt_scalef32_pk32_fp6_f16(hu, 1.0f), pv = __builtin_amdgcn_cvt_scalef32_pk32_fp6_f16(hv, 1.0f);
            typedef unsigned u2v __attribute__((ext_vector_type(2)));
            GAS u2v* du = (GAS u2v*)(EU6 + c * 24); GAS u2v* dv = (GAS u2v*)(EV6 + c * 24);
            du[0] = (u2v){pu[0], pu[1]}; du[1] = (u2v){pu[2], pu[3]}; du[2] = (u2v){pu[4], pu[5]}; dv[0] = (u2v){pv[0], pv[1]}; dv[1] = (u2v){pv[2], pv[3]}; dv[2] = (u2v){pv[4], pv[5]}; } }
#endif
}
#ifndef P0_LATE_W
#define P0_LATE_W 1
#endif
#ifndef P0_PIPE
#define P0_PIPE 1
#endif
__device__ __forceinline__ void p0_prologue(Frame& F) {
    const int lane = pg8::lane_id_v(), tid = F.wave * 64 + lane;
    const int gw = F.vcu * NWAVES + F.wave, NGW = F.G * NWAVES;
#if P0_LATE_W
    p0_transposes(F, 0, 32 * 232, gw, NGW);
#else
    p0_transposes(F, 0, 32 * 232 + 2 * 16 * 64 + 2 * 32 * 64, gw, NGW);
#endif
    bf16* XN = (bf16*)(F.ws + WS_RA);
#if P0_PIPE
    {
        f32x4 v[8], nx[8];
        const GAS f32x4* gr = (const GAS f32x4*)F.norm_mix_g + lane;
        int m = gw;
        if (m < MREAL) { const GAS f32x4* xr = (const GAS f32x4*)((m < MPROMPT) ? F.x_prompt + (size_t)m * DM : F.x_sample + (size_t)(m - MPROMPT) * DM) + lane;
#pragma unroll
            for (int j = 0; j < 8; ++j) v[j] = xr[64 * j]; }
        for (; m < MPAD; m += NGW) {
            const int mn = m + NGW;
            if (mn < MREAL) { const GAS f32x4* xr = (const GAS f32x4*)((mn < MPROMPT) ? F.x_prompt + (size_t)mn * DM : F.x_sample + (size_t)(mn - MPROMPT) * DM) + lane;
#pragma unroll
                for (int j = 0; j < 8; ++j) nx[j] = xr[64 * j]; }
            if (m < MREAL) {
                float s = 0.f;
#pragma unroll
                for (int j = 0; j < 8; ++j) s += (v[j].x * v[j].x + v[j].y * v[j].y) + (v[j].z * v[j].z + v[j].w * v[j].w);
                const float r = 1.0f / sqrtf(wave_sum(s) * (1.f / DM) + EPS);
                GAS unsigned long long* o8 = (GAS unsigned long long*)(XN + (size_t)m * DM) + lane;
#pragma unroll
                for (int j = 0; j < 8; ++j) { const f32x4 gg = gr[64 * j]; o8[64 * j] = (unsigned long long)pkb(v[j].x * r * gg.x, v[j].y * r * gg.y) | ((unsigned long long)pkb(v[j].z * r * gg.z, v[j].w * r * gg.w) << 32); }
            } else { GAS v4u* o = (GAS v4u*)(XN + (size_t)m * DM) + lane;
#pragma unroll
                for (int j = 0; j < 4; ++j) o[64 * j] = (v4u){0u, 0u, 0u, 0u}; }
#pragma unroll
            for (int j = 0; j < 8; ++j) v[j] = nx[j];
        }
    }
#else
    for (int m = gw; m < MPAD; m += NGW) {
        if (m < MPROMPT) rms_row_to_bf16(F.x_prompt + (size_t)m * DM, F.norm_mix_g, XN + (size_t)m * DM, lane);
        else if (m < MREAL) rms_row_to_bf16(F.x_sample + (size_t)(m - MPROMPT) * DM, F.norm_mix_g, XN + (size_t)m * DM, lane);
        else { GAS v4u* o = (GAS v4u*)(XN + (size_t)m * DM) + lane;
#pragma unroll
            for (int j = 0; j < 4; ++j) o[64 * j] = (v4u){0u, 0u, 0u, 0u}; }
    }
#endif
    const size_t gt = (size_t)F.vcu * NTHR + tid, NT = (size_t)F.G * NTHR;
    { bf16* KH = (bf16*)(F.ws + WS_KEYS);
        for (size_t c = gt; c < 262144 / 8; c += NT) { const f32x4 a = *(const GAS f32x4*)(F.sub_keys + c * 8), b = *(const GAS f32x4*)(F.sub_keys + c * 8 + 4);
            *(GAS v4u*)(KH + c * 8) = (v4u){pkh(a.x, a.y), pkh(a.z, a.w), pkh(b.x, b.y), pkh(b.z, b.w)}; } }
    { bf16* WSM = (bf16*)(F.ws + WS_WSM);
        for (size_t c = gt; c < 131072 / 8; c += NT) { f32x4 a = *(const GAS f32x4*)(F.sgu_w_s + c * 8), b = *(const GAS f32x4*)(F.sgu_w_s + c * 8 + 4);
            const int t = (int)((c * 8) >> 7) & 127, s0 = (int)(c * 8) & 127;
#pragma unroll
            for (int e = 0; e < 4; ++e) { if (s0 + e > t) a[e] = 0.f; if (s0 + 4 + e > t) b[e] = 0.f; }
            *(GAS v4u*)(WSM + c * 8) = (v4u){pkb(a.x, a.y), pkb(a.z, a.w), pkb(b.x, b.y), pkb(b.z, b.w)}; } }
}
typedef float f32x16 __attribute__((ext_vector_type(16)));
typedef short s16x4 __attribute__((ext_vector_type(4)));
typedef short v4i16_t __attribute__((ext_vector_type(4)));
__device__ __forceinline__ int crow(int r, int hi) { return (r & 3) + 8 * (r >> 2) + 4 * hi; }
__device__ __forceinline__ s16x4 vtr(const LAS unsigned char* p) { return __builtin_bit_cast(s16x4, __builtin_amdgcn_ds_read_tr16_b64_v4i16((LAS v4i16_t*)p)); }
__device__ __forceinline__ bf16 bf1(float x) { return (bf16)(pkb(x, 0.f) & 0xffffu); }
__device__ __forceinline__ float bf2f(bf16 b) { return __builtin_bit_cast(float, (unsigned)b << 16); }
__device__ __forceinline__ float half_max(float m) { return fmaxf(m, __builtin_bit_cast(float, pg8::partner32(__builtin_bit_cast(unsigned, m)))); }
__device__ __forceinline__ float half_sum(float m) { return m + __builtin_bit_cast(float, pg8::partner32(__builtin_bit_cast(unsigned, m))); }
constexpr int P2_KL = 0, P2_VL = 24576, P2_BIAS = 49152, P2_OST = 65536, P2_GL = 0, P2_RL = 32768, P2_SST = 65536;
constexpr int N_ATT_UNITS = 512 + 16, N_SGU_UNITS = 1024 + 64;

struct AttnDesc { int b, c, kvh, qrow0, nqb, jlo, jhi; bool sample; };
__device__ __forceinline__ AttnDesc attn_desc(int uid) { AttnDesc d; d.sample = uid >= 512; d.c = 0;
    if (!d.sample) { d.b = uid >> 6; d.c = (uid >> 1) & 31; d.kvh = uid & 1; d.qrow0 = d.b * SEQ + d.c * CHUNK; d.nqb = 2; d.jlo = 128 - 64 * d.c; if (d.jlo < 0) d.jlo = 0; d.jhi = 192; }
    else { const int s = uid - 512; d.b = s >> 1; d.kvh = s & 1; d.qrow0 = MPROMPT + d.b * TDEC; d.nqb = 1; d.jlo = 0; d.jhi = 144; }
    return d; }
__device__ __forceinline__ void attn_kv_load(Frame& F, const AttnDesc& d, int, v4u (&kq)[3], v4u (&vq)[3]) {
    const int tid = F.wave * 64 + pg8::lane_id_v();
    const bf16* KV = (const bf16*)(F.ws + WS_KV);
#pragma unroll
    for (int i = 0; i < 3; ++i) { const int idx = tid + 512 * i, key = idx >> 3, ch = idx & 7; kq[i] = (v4u){0u, 0u, 0u, 0u}; vq[i] = (v4u){0u, 0u, 0u, 0u};
        if (!d.sample) { const int pos = d.c * CHUNK - WINDOW + key; if (pos >= 0) { const bf16* rp = KV + (size_t)(d.b * SEQ + pos) * 256 + d.kvh * 64 + ch * 8; kq[i] = *(const GAS v4u*)rp; vq[i] = *(const GAS v4u*)(rp + 128); } }
        else if (key < 128) { const size_t o = ((size_t)(d.b * WINDOW + key) * 2 + d.kvh) * 64 + ch * 8;
            const f32x4 a = *(const GAS f32x4*)(F.cache_k + o), a2 = *(const GAS f32x4*)(F.cache_k + o + 4), p = *(const GAS f32x4*)(F.cache_v + o), p2 = *(const GAS f32x4*)(F.cache_v + o + 4);
            kq[i] = (v4u){pkb(a.x, a.y), pkb(a.z, a.w), pkb(a2.x, a2.y), pkb(a2.z, a2.w)}; vq[i] = (v4u){pkb(p.x, p.y), pkb(p.z, p.w), pkb(p2.x, p2.y), pkb(p2.z, p2.w)}; }
        else if (key < 144) { const bf16* rp = KV + (size_t)(MPROMPT + d.b * TDEC + key - 128) * 256 + d.kvh * 64 + ch * 8; kq[i] = *(const GAS v4u*)rp; vq[i] = *(const GAS v4u*)(rp + 128); } }
}
__device__ __forceinline__ void attn_kv_store(Frame& F, int, const v4u (&kq)[3], const v4u (&vq)[3]) {
    const int tid = F.wave * 64 + pg8::lane_id_v();
    LAS unsigned char* KL = F.lds + P2_KL; LAS unsigned char* VL = F.lds + P2_VL;
#pragma unroll
    for (int i = 0; i < 3; ++i) { const int idx = tid + 512 * i, key = idx >> 3, ch = idx & 7; *(LAS v4u*)(KL + ch * 3072 + key * 16) = kq[i]; *(LAS v4u*)(VL + (ch >> 2) * 12288 + key * 64 + (ch & 3) * 16) = vq[i]; }
}
template <bool MASK> __device__ __forceinline__ void attn_compute(Frame& F, const AttnDesc& d, bf16x8 (&qr)[4]) {
    const int lane = pg8::lane_id_v();
    const int w = F.wave, r = lane & 31, h = lane >> 5;
    LAS unsigned char* KL = F.lds + P2_KL; LAS unsigned char* VL = F.lds + P2_VL; const LAS float* BL = (const LAS float*)(F.lds + P2_BIAS); LAS unsigned char* OST = F.lds + P2_OST + w * 4096;
    const bf16* Q = (const bf16*)(F.ws + WS_Q); bf16* OS = (bf16*)(F.ws + WS_RA);
    const int hd = d.kvh * 8 + w; const float sink2 = F.sinks[hd] * LOG2E; const LAS float* bl = BL + hd * 256;
    const int vlane = (4 * h + ((lane & 15) >> 2)) * 64 + (((lane >> 4) & 1) * 16 + (lane & 3) * 4) * 2;
    for (int qb = 0; qb < d.nqb; ++qb) {
        const int qi = qb * 32 + r;
        f32x16 S[6];
#pragma unroll
        for (int kb = 0; kb < 6; ++kb) { f32x16 a = {};
#pragma unroll
            for (int ks = 0; ks < 4; ++ks) { const bf16x8 kf = *(const LAS bf16x8*)(KL + (2 * ks + h) * 3072 + (kb * 32 + r) * 16); a = __builtin_amdgcn_mfma_f32_32x32x16_bf16(kf, qr[ks], a, 0, 0, 0); }
            S[kb] = a; asm volatile("" ::: "memory"); }
        if (qb + 1 < d.nqb) { const int qrow_n = d.qrow0 + (qb + 1) * 32 + r;
#pragma unroll
            for (int ks = 0; ks < 4; ++ks) qr[ks] = *(const GAS bf16x8*)(Q + (size_t)qrow_n * 1024 + hd * 64 + ks * 16 + h * 8); }
        float mx = -1e30f;
        const LAS float* blq = bl + (63 - qi + 4 * h);
        if (MASK) {
#pragma unroll
            for (int kb = 0; kb < 6; ++kb)
#pragma unroll
                for (int i = 0; i < 16; ++i) { const int j = kb * 32 + crow(i, h); float t = S[kb][i] + blq[kb * 32 + (i & 3) + 8 * (i >> 2)]; t = (j >= d.jlo && j < d.jhi) ? t : -1e30f; S[kb][i] = t; mx = fmaxf(mx, t); }
        } else {
#pragma unroll
            for (int kb = 0; kb < 6; ++kb)
#pragma unroll
                for (int i = 0; i < 16; ++i) { const float t = S[kb][i] + blq[kb * 32 + (i & 3) + 8 * (i >> 2)]; S[kb][i] = t; mx = fmaxf(mx, t); }
        }
        mx = fmaxf(half_max(mx), sink2);
        float l = 0.f;
#pragma unroll
        for (int kb = 0; kb < 6; ++kb)
#pragma unroll
            for (int i = 0; i < 16; ++i) { const float e = __builtin_amdgcn_exp2f(S[kb][i] - mx); S[kb][i] = e; l += e; }
        l = half_sum(l) + __builtin_amdgcn_exp2f(sink2 - mx);
        const float inv = 1.0f / l;
        f32x16 O[2]; O[0] = f32x16{}; O[1] = f32x16{};
#pragma unroll
        for (int kb = 0; kb < 6; ++kb)
#pragma unroll
            for (int s2 = 0; s2 < 2; ++s2) { v4u wv; wv.x = pkb(S[kb][8 * s2 + 0] * inv, S[kb][8 * s2 + 1] * inv); wv.y = pkb(S[kb][8 * s2 + 2] * inv, S[kb][8 * s2 + 3] * inv);
                wv.z = pkb(S[kb][8 * s2 + 4] * inv, S[kb][8 * s2 + 5] * inv); wv.w = pkb(S[kb][8 * s2 + 6] * inv, S[kb][8 * s2 + 7] * inv); const bf16x8 pa = __builtin_bit_cast(bf16x8, wv);
#pragma unroll
                for (int db = 0; db < 2; ++db) { const LAS unsigned char* vp = VL + db * 12288 + (kb * 32 + s2 * 16) * 64 + vlane; const s16x4 lo = vtr(vp), hi = vtr(vp + 8 * 64);
                    const bf16x8 vf = (bf16x8){lo[0], lo[1], lo[2], lo[3], hi[0], hi[1], hi[2], hi[3]}; O[db] = __builtin_amdgcn_mfma_f32_32x32x16_bf16(pa, vf, O[db], 0, 0, 0); } }
#pragma unroll
        for (int db = 0; db < 2; ++db)
#pragma unroll
            for (int i = 0; i < 16; ++i) *(LAS bf16*)(OST + (crow(i, h) * 64 + db * 32 + r) * 2) = bf1(O[db][i]);
        LDS_WAIT(); asm volatile("" ::: "memory");
#pragma unroll
        for (int it = 0; it < 4; ++it) { const int row = it * 8 + (lane >> 3), ch = lane & 7; const v4u v = *(const LAS v4u*)(OST + row * 128 + ch * 16);
            if (!d.sample || row < TDEC) *(GAS v4u*)(OS + (size_t)(d.qrow0 + qb * 32 + row) * 2048 + hd * 64 + ch * 8) = v; }
        LDS_WAIT(); asm volatile("" ::: "memory");
    }
}
__device__ __forceinline__ void attn_q_load0(Frame& F, const AttnDesc& d, bf16x8 (&qr)[4]) {
    const int lane = pg8::lane_id_v(), r = lane & 31, h = lane >> 5; const bf16* Q = (const bf16*)(F.ws + WS_Q); const int hd = d.kvh * 8 + F.wave;
    const int qrow = d.qrow0 + (d.sample ? (r & 15) : r);
#pragma unroll
    for (int ks = 0; ks < 4; ++ks) qr[ks] = *(const GAS bf16x8*)(Q + (size_t)qrow * 1024 + hd * 64 + ks * 16 + h * 8);
}
__device__ __forceinline__ void attn_units(Frame& F) {
    for (int u = F.vcu; u < N_ATT_UNITS; u += F.G) {
        bf16x8 qr[4];
        { v4u kq[3], vq[3]; const AttnDesc d0 = attn_desc(u); attn_kv_load(F, d0, 0, kq, vq); attn_q_load0(F, d0, qr); attn_kv_store(F, 0, kq, vq); }
        __syncthreads();
        { const AttnDesc d = attn_desc(u); if (d.jlo == 0 && d.jhi == 192) attn_compute<false>(F, d, qr); else attn_compute<true>(F, d, qr); }
        LDS_WAIT(); __builtin_amdgcn_s_barrier(); asm volatile("" ::: "memory");
    }
}

struct SguOps { v4u gvq[4]; float ssp[4]; bf16x8 af[8]; v4u uq[4]; float bs[4]; f32x4 sg0, sg1; };
__device__ __forceinline__ void sgu_load(Frame& F, const int uid, SguOps& R) {
    const int lane = pg8::lane_id_v(), w = F.wave, tid = w * 64 + lane, r = lane & 31, h = lane >> 5;
    LAS unsigned char* GL = F.lds + P2_GL;
    const bf16* VS = (const bf16*)(F.ws + WS_VS); const bf16* U = (const bf16*)(F.ws + WS_U); const bf16* WSM = (const bf16*)(F.ws + WS_WSM); const float* SS1 = (const float*)(F.ws + WS_SS1); bf16* OS = (bf16*)(F.ws + WS_RA);
    const bool sample = uid >= 1024; int b, g, row0, nv;
    if (!sample) { b = uid >> 7; const int blk = (uid >> 3) & 15; g = uid & 7; row0 = b * SEQ + blk * 128; nv = 128; }
    else { const int s = uid - 1024; b = s >> 3; g = s & 7; row0 = MPROMPT + b * TDEC; nv = TDEC; }
    const int wr = w >> 1, wc = w & 1; const bool active = 32 * wr < nv; const int nks = 2 * (wr + 1);
    const int er = lane >> 3, ec = (lane & 7) * 8;
    (void)GL; (void)VS; (void)U; (void)WSM; (void)SS1; (void)OS; (void)b; (void)r; (void)h; (void)tid; (void)nks; (void)er; (void)ec; (void)active;
#pragma unroll
    for (int i = 0; i < 4; ++i) { const int idx = tid + 512 * i, s = idx >> 4, ch = idx & 15; R.gvq[i] = (v4u){0u, 0u, 0u, 0u}; R.ssp[i] = 0.f;
        if (s < nv) { R.gvq[i] = *(const GAS v4u*)(VS + (size_t)(row0 + s) * 1024 + g * 128 + ch * 8); R.ssp[i] = SS1[(size_t)(row0 + s) * 16 + ch]; } }
    if (active) {
#pragma unroll
        for (int ks = 0; ks < 8; ++ks) { R.af[ks] = (bf16x8){0, 0, 0, 0, 0, 0, 0, 0}; if (ks < nks) R.af[ks] = *(const GAS bf16x8*)(WSM + (size_t)(g * 128 + 32 * wr + r) * 128 + 16 * ks + 8 * h); }
        R.sg0 = *(const GAS f32x4*)(F.sgu_norm_g + g * 128 + 64 * wc + ec); R.sg1 = *(const GAS f32x4*)(F.sgu_norm_g + g * 128 + 64 * wc + ec + 4);
#pragma unroll
        for (int c = 0; c < 4; ++c) { const int t = 32 * wr + 8 * c + er; R.uq[c] = (v4u){0u, 0u, 0u, 0u}; R.bs[c] = F.sgu_b_s[g * 128 + t];
            if (t < nv) R.uq[c] = *(const GAS v4u*)(U + (size_t)(row0 + t) * 1024 + g * 128 + 64 * wc + ec); }
    }
}
__device__ __forceinline__ void sgu_process(Frame& F, const int uid, SguOps& R) {
    const int lane = pg8::lane_id_v(), w = F.wave, tid = w * 64 + lane, r = lane & 31, h = lane >> 5;
    LAS unsigned char* GL = F.lds + P2_GL;
    const bf16* VS = (const bf16*)(F.ws + WS_VS); const bf16* U = (const bf16*)(F.ws + WS_U); const bf16* WSM = (const bf16*)(F.ws + WS_WSM); const float* SS1 = (const float*)(F.ws + WS_SS1); bf16* OS = (bf16*)(F.ws + WS_RA);
    const bool sample = uid >= 1024; int b, g, row0, nv;
    if (!sample) { b = uid >> 7; const int blk = (uid >> 3) & 15; g = uid & 7; row0 = b * SEQ + blk * 128; nv = 128; }
    else { const int s = uid - 1024; b = s >> 3; g = s & 7; row0 = MPROMPT + b * TDEC; nv = TDEC; }
    const int wr = w >> 1, wc = w & 1; const bool active = 32 * wr < nv; const int nks = 2 * (wr + 1);
    const int er = lane >> 3, ec = (lane & 7) * 8;
    (void)GL; (void)VS; (void)U; (void)WSM; (void)SS1; (void)OS; (void)b; (void)r; (void)h; (void)tid; (void)nks; (void)er; (void)ec; (void)active;
#pragma unroll
    for (int i = 0; i < 4; ++i) { const int idx = tid + 512 * i, s = idx >> 4, ch = idx & 15; v4u o = (v4u){0u, 0u, 0u, 0u};
        float ss = R.ssp[i];
        ss += __builtin_bit_cast(float, __builtin_amdgcn_ds_swizzle(__builtin_bit_cast(int, ss), (1 << 10) | 0x1f)); ss += __builtin_bit_cast(float, __builtin_amdgcn_ds_swizzle(__builtin_bit_cast(int, ss), (2 << 10) | 0x1f));
        ss += __builtin_bit_cast(float, __builtin_amdgcn_ds_swizzle(__builtin_bit_cast(int, ss), (4 << 10) | 0x1f)); ss += __builtin_bit_cast(float, __builtin_amdgcn_ds_swizzle(__builtin_bit_cast(int, ss), (8 << 10) | 0x1f));
        if (s < nv) {
            const float rr = 1.0f / sqrtf(ss * (1.f / DSGU) + EPS); const v4u wv = R.gvq[i];
            float f[8] = {pg8::bf_lo(wv.x) * rr, pg8::bf_hi(wv.x) * rr, pg8::bf_lo(wv.y) * rr, pg8::bf_hi(wv.y) * rr, pg8::bf_lo(wv.z) * rr, pg8::bf_hi(wv.z) * rr, pg8::bf_lo(wv.w) * rr, pg8::bf_hi(wv.w) * rr};
            o = (v4u){pkb(f[0], f[1]), pkb(f[2], f[3]), pkb(f[4], f[5]), pkb(f[6], f[7])};
            if (sample) { const f32x4 g0 = *(const GAS f32x4*)(F.sgu_norm_g + g * 128 + ch * 8), g1 = *(const GAS f32x4*)(F.sgu_norm_g + g * 128 + ch * 8 + 4); float* dst = F.out + OUT_SGU + (size_t)(b * TDEC + s) * 1024 + g * 128 + ch * 8;
                *(GAS f32x4*)dst = (f32x4){f[0] * g0.x, f[1] * g0.y, f[2] * g0.z, f[3] * g0.w}; *(GAS f32x4*)(dst + 4) = (f32x4){f[4] * g1.x, f[5] * g1.y, f[6] * g1.z, f[7] * g1.w}; } }
        *(LAS v4u*)(GL + (ch >> 2) * 8192 + s * 64 + (ch & 3) * 16) = o; }
    LDS_WAIT(); __builtin_amdgcn_s_barrier(); asm volatile("" ::: "memory");
    if (active) {
        f32x16 acc[2]; acc[0] = f32x16{}; acc[1] = f32x16{};
        const int glane = (8 * h + ((lane & 15) >> 2)) * 64 + (((lane >> 4) & 1) * 16 + (lane & 3) * 4) * 2;
#pragma unroll
        for (int ks = 0; ks < 8; ++ks) if (ks < nks) {
#pragma unroll
            for (int cb = 0; cb < 2; ++cb) { const LAS unsigned char* gp = GL + (2 * wc + cb) * 8192 + (16 * ks) * 64 + glane; const s16x4 lo = vtr(gp), hi = vtr(gp + 4 * 64);
                const bf16x8 bb = (bf16x8){lo[0], lo[1], lo[2], lo[3], hi[0], hi[1], hi[2], hi[3]}; acc[cb] = __builtin_amdgcn_mfma_f32_32x32x16_bf16(R.af[ks], bb, acc[cb], 0, 0, 0); } }
        LAS float* STG = (LAS float*)(F.lds + P2_SST + w * 8192);
#pragma unroll
        for (int cb = 0; cb < 2; ++cb)
#pragma unroll
            for (int i = 0; i < 16; ++i) STG[crow(i, h) * 64 + 32 * cb + r] = acc[cb][i];
        LDS_WAIT(); asm volatile("" ::: "memory");
#pragma unroll
        for (int c = 0; c < 4; ++c) { const int t = 32 * wr + 8 * c + er;
            const f32x4 a0 = *(const LAS f32x4*)(STG + (8 * c + er) * 64 + ec), a1 = *(const LAS f32x4*)(STG + (8 * c + er) * 64 + ec + 4); const v4u uw = R.uq[c]; const float bb = R.bs[c];
            const v4u o = {pkb(pg8::bf_lo(uw.x) * (a0.x * R.sg0.x + bb), pg8::bf_hi(uw.x) * (a0.y * R.sg0.y + bb)), pkb(pg8::bf_lo(uw.y) * (a0.z * R.sg0.z + bb), pg8::bf_hi(uw.y) * (a0.w * R.sg0.w + bb)),
                           pkb(pg8::bf_lo(uw.z) * (a1.x * R.sg1.x + bb), pg8::bf_hi(uw.z) * (a1.y * R.sg1.y + bb)), pkb(pg8::bf_lo(uw.w) * (a1.z * R.sg1.z + bb), pg8::bf_hi(uw.w) * (a1.w * R.sg1.w + bb))};
            if (t < nv) *(GAS v4u*)(OS + (size_t)(row0 + t) * 2048 + 1024 + g * 128 + 64 * wc + ec) = o; }
    }
    LDS_WAIT(); __builtin_amdgcn_s_barrier(); asm volatile("" ::: "memory");
}
__device__ __forceinline__ int sgu_uid(const Frame& F, const int k) {
    const int u0 = F.G - 1 - F.vcu;
    if (F.G == 256 && F.vcu < 16) return k < 3 ? u0 + k * 256 : -1;
    if (F.G == 256 && F.vcu < 32) return k < 4 ? u0 + k * 256 : (k == 4 ? 1023 - (F.vcu - 16) : -1);
    const int u = u0 + k * F.G; return u < N_SGU_UNITS ? u : -1;
}
__device__ __forceinline__ void sgu_units(Frame& F) {
    SguOps A, B; int k = 0, ua = sgu_uid(F, 0);
    if (ua >= 0) sgu_load(F, ua, A);
    while (ua >= 0) {
        const int ub = sgu_uid(F, k + 1); if (ub >= 0) sgu_load(F, ub, B);
        sgu_process(F, ua, A);
        if (ub < 0) break;
        ua = sgu_uid(F, k + 2); if (ua >= 0) sgu_load(F, ua, A);
        sgu_process(F, ub, B);
        k += 2;
    }
}


__device__ __forceinline__ void p2_mixers(Frame& F) {
    LAS float* BLw = (LAS float*)(F.lds + P2_BIAS);
    { const int e0 = F.wave * 64 + pg8::lane_id_v(); float bv[8];
#pragma unroll
        for (int i = 0; i < 8; ++i) { const int e = e0 + i * NTHR, hh = e >> 8, idx = e & 255, rel = idx - 191, n = rel < 0 ? -rel : rel;
            const int v = n < 8 ? n : (n < 12 ? 8 : n < 16 ? 9 : n < 23 ? 10 : n < 32 ? 11 : n < 46 ? 12 : n < 64 ? 13 : n < 91 ? 14 : 15);
            bv[i] = F.rel_tab[((rel > 0 ? 16 : 0) + v) * 16 + hh]; }
#pragma unroll
        for (int i = 0; i < 8; ++i) { const int e = e0 + i * NTHR; BLw[e] = ((e & 255) < 255) ? bv[i] * LOG2E : 0.f; } }
    __syncthreads();
    attn_units(F);
    sgu_units(F);
#if P0_LATE_W
    __syncthreads();
    p0_transposes(F, 32 * 232, 32 * 232 + 2 * 16 * 64 + 2 * 32 * 64, F.vcu * NWAVES + F.wave, F.G * NWAVES);
#endif
}
constexpr size_t WS_SS2S = WS_SS2 + (size_t)MPROMPT * 32 * 4;
struct SkMerge { const bf16 *RATIO, *SB; bf16* H;
    __device__ __forceinline__ void mid(f32x4& acc, int row, int col) const { const unsigned long long w = *(const GAS unsigned long long*)(RATIO + (size_t)row * 2048 + col); const unsigned lo = (unsigned)w, hi = (unsigned)(w >> 32);
        acc *= (f32x4){pg8::bf_lo(lo), pg8::bf_hi(lo), pg8::bf_lo(hi), pg8::bf_hi(hi)}; }
    __device__ __forceinline__ void fin(const f32x4 acc, int row, int col, int, int) const { const unsigned long long w = *(const GAS unsigned long long*)(SB + (size_t)row * 2048 + col); const unsigned lo = (unsigned)w, hi = (unsigned)(w >> 32);
        const f32x4 v = acc * (f32x4){pg8::bf_lo(lo), pg8::bf_hi(lo), pg8::bf_lo(hi), pg8::bf_hi(hi)};
        *(GAS unsigned long long*)(H + (size_t)row * 2048 + col) = (unsigned long long)pkb(v.x, v.y) | ((unsigned long long)pkb(v.z, v.w) << 32); } };
struct SkOut { const float* xs; bf16* XH; float* SS2S;
    __device__ __forceinline__ void mid(f32x4&, int, int) const {}
    __device__ __forceinline__ void fin(const f32x4 acc, int row, int col, int part, int fq) const { const f32x4 v = acc + *(const GAS f32x4*)(xs + (size_t)(row - MPROMPT) * 2048 + col);
        *(GAS unsigned long long*)(XH + (size_t)row * 2048 + col) = (unsigned long long)pkh(v.x, v.y) | ((unsigned long long)pkh(v.z, v.w) << 32);
        float s = (v.x * v.x + v.y * v.y) + (v.z * v.z + v.w * v.w); s += __shfl_xor(s, 16); s += __shfl_xor(s, 32);
        if (fq == 0) SS2S[(size_t)(row - MPROMPT) * 128 + part] = s; } };
struct SkQ { bf16* QP;
    __device__ __forceinline__ void mid(f32x4&, int, int) const {}
    __device__ __forceinline__ void fin(const f32x4 acc, int row, int col, int, int) const { *(GAS unsigned long long*)(QP + (size_t)row * 2048 + col) = (unsigned long long)pkh(acc.x, acc.y) | ((unsigned long long)pkh(acc.z, acc.w) << 32); } };
template <bool F16, bool MID, class Epi>
__device__ __forceinline__ void skinny_gemm(Frame& F, const bf16* A, const bf16* Bt, const Epi& E) {
    const int lane = pg8::lane_id_v(), w = F.wave, fr = lane & 15, fq = lane >> 4;
    LAS f32x4* part = (LAS f32x4*)(F.lds + RING_OFF);
    for (int job = F.vcu; job < 256; job += F.G) {
        const int rb = job & 3, cb = job >> 2;
        const bf16* ap = A + (size_t)(MPROMPT + 32 * rb + fr) * 2048 + 256 * w + 8 * fq;
        const bf16* bp = Bt + (size_t)(32 * cb + fr) * 2048 + 256 * w + 8 * fq;
        bf16x8 a0[8], a1[8], b0[8], b1[8];
#pragma unroll
        for (int u = 0; u < 8; ++u) { a0[u] = *(const GAS bf16x8*)(ap + 32 * u); a1[u] = *(const GAS bf16x8*)(ap + 16 * 2048 + 32 * u); b0[u] = *(const GAS bf16x8*)(bp + 32 * u); b1[u] = *(const GAS bf16x8*)(bp + 16 * 2048 + 32 * u); }
        f32x4 c00 = {0.f, 0.f, 0.f, 0.f}, c01 = c00, c10 = c00, c11 = c00;
#pragma unroll
        for (int u = 0; u < 8; ++u) { c00 = pg8::mma16<F16>(b0[u], a0[u], c00); c01 = pg8::mma16<F16>(b1[u], a0[u], c01); c10 = pg8::mma16<F16>(b0[u], a1[u], c10); c11 = pg8::mma16<F16>(b1[u], a1[u], c11); }
        __syncthreads();
        part[(w * 4 + 0) * 64 + lane] = c00; part[(w * 4 + 1) * 64 + lane] = c01; part[(w * 4 + 2) * 64 + lane] = c10; part[(w * 4 + 3) * 64 + lane] = c11;
        __syncthreads();
        if (w < 4) {
            f32x4 s1 = part[(0 * 4 + w) * 64 + lane], s2 = part[(4 * 4 + w) * 64 + lane];
#pragma unroll
            for (int ww = 1; ww < 4; ++ww) { s1 += part[(ww * 4 + w) * 64 + lane]; s2 += part[((ww + 4) * 4 + w) * 64 + lane]; }
            const int row = MPROMPT + 32 * rb + 16 * (w >> 1) + fr, col = 32 * cb + 16 * (w & 1) + 4 * fq;
            if (MID) E.mid(s1, row, col);
            E.fin(s1 + s2, row, col, cb * 2 + (w & 1), fq);
        }
    }
}
typedef _Float16 f16x8v __attribute__((ext_vector_type(8)));
__device__ __forceinline__ int enc_f(float f) { const int b = __builtin_bit_cast(int, f); return b ^ ((b >> 31) & 0x7fffffff); }
__device__ __forceinline__ float dec_f(int k) { return __builtin_bit_cast(float, k ^ ((k >> 31) & 0x7fffffff)); }
__device__ __forceinline__ int imax_(int a, int b) { return a > b ? a : b; }
__device__ __forceinline__ int imin_(int a, int b) { return a < b ? a : b; }
#define P6_CE(a, b) do { const int mx_ = imax_(a, b), mn_ = imin_(a, b); a = mx_; b = mn_; } while (0)
__device__ __forceinline__ void sort16_desc(int (&v)[16]) {
#pragma unroll
    for (int k = 2; k <= 16; k <<= 1)
#pragma unroll
        for (int j = k >> 1; j > 0; j >>= 1)
#pragma unroll
            for (int i = 0; i < 16; ++i) { const int l = i ^ j; if (l > i) { if ((i & k) == 0) P6_CE(v[i], v[l]); else P6_CE(v[l], v[i]); } }
}
__device__ __forceinline__ void bitonic_merge16_desc(int (&v)[16]) {
#pragma unroll
    for (int j = 8; j > 0; j >>= 1)
#pragma unroll
        for (int i = 0; i < 16; ++i) { const int l = i ^ j; if (l > i) P6_CE(v[i], v[l]); }
}
__device__ __forceinline__ void merge_top16(int (&T)[16], const int (&N)[16]) {
#pragma unroll
    for (int i = 0; i < 16; ++i) T[i] = imax_(T[i], N[15 - i]);
    bitonic_merge16_desc(T);
}
__device__ __forceinline__ int half_partner(int x) { return (int)pg8::partner32((unsigned)x); }
struct CandTab { int ci[64], cj[64]; };
__host__ __device__ constexpr CandTab make_cand() { CandTab t{}; int n = 0; for (int i = 0; i < 16; ++i) for (int j = 0; j < 16; ++j) if ((i + 1) * (j + 1) <= 16) { t.ci[n] = i; t.cj[n] = j; ++n; } for (; n < 64; ++n) { t.ci[n] = -1; t.cj[n] = -1; } return t; }
constexpr CandTab CAND = make_cand();
constexpr int P6_SC = 0;

constexpr int P6_KEYS = 65536;
__device__ __forceinline__ void p6_job(Frame& F, const int job) {
    const int lane = pg8::lane_id_v(), w = F.wave, r = lane & 31, h = lane >> 5;
    const bf16* QP = (const bf16*)(F.ws + WS_SB); const bf16* KH = (const bf16*)(F.ws + WS_KEYS); const float* SS2 = (const float*)(F.ws + WS_SS2);
    unsigned long long* SEL = (unsigned long long*)(F.ws + WS_RA);
    LAS int* SC = (LAS int*)(F.lds + P6_SC + w * 8192);
    constexpr int NTILE = MREAL / 32, NGRP = (NTILE + 7) / 8, NJOB = NGRP * 8;
    {
        const int hq = job & 7, tile = (job >> 3) * 8 + w;
        { const int tid = w * 64 + lane;
#pragma unroll
            for (int i = 0; i < 8; ++i) { const int idx = tid + 512 * i, p = idx >> 11, n = (idx >> 4) & 127, c = idx & 15;
                *(LAS v4u*)(F.lds + P6_KEYS + p * 32768 + c * 2048 + n * 16) = *(const GAS v4u*)(KH + ((size_t)((hq * 2 + p) * 128 + n)) * 128 + c * 8); } }
        __syncthreads();
        if (tile < NTILE) {
        const int t = tile * 32 + r;
        int AB[2][16];
#pragma unroll
        for (int p = 0; p < 2; ++p) {
            f16x8v qf[8];
#pragma unroll
            for (int ks = 0; ks < 8; ++ks) qf[ks] = *(const GAS f16x8v*)(QP + (size_t)t * 2048 + hq * 256 + p * 128 + ks * 16 + h * 8);
            int T[16];
#pragma unroll
            for (int nb = 0; nb < 4; ++nb) {
                f32x16 acc = {};
                const LAS unsigned char* kp = F.lds + P6_KEYS + p * 32768 + h * 2048 + (nb * 32 + r) * 16;
#pragma unroll
                for (int ks = 0; ks < 8; ++ks) { const f16x8v kf = *(const LAS f16x8v*)(kp + ks * 4096); acc = __builtin_amdgcn_mfma_f32_32x32x16_f16(kf, qf[ks], acc, 0, 0, 0); }
                int N[16];
#pragma unroll
                for (int i = 0; i < 16; ++i) N[i] = (enc_f(acc[i]) & ~127) | (nb * 32 + crow(i, h));
                sort16_desc(N);
                if (nb == 0) {
#pragma unroll
                    for (int i = 0; i < 16; ++i) T[i] = N[i];
                } else merge_top16(T, N);
            }
            int P[16];
#pragma unroll
            for (int i = 0; i < 16; ++i) P[i] = half_partner(T[i]);
            merge_top16(T, P);
#pragma unroll
            for (int i = 0; i < 16; ++i) AB[p][i] = T[i];
        }
#pragma unroll
        for (int i = 0; i < 16; ++i) { SC[i * 64 + lane] = AB[0][i] & 127; SC[(16 + i) * 64 + lane] = AB[1][i] & 127; }
        float fa[16], fb[16];
#pragma unroll
        for (int i = 0; i < 16; ++i) { fa[i] = dec_f(AB[0][i] & ~127); fb[i] = dec_f(AB[1][i] & ~127); }
        int W[16];
#pragma unroll
        for (int g = 0; g < 4; ++g) {
            int N[16];
#pragma unroll
            for (int c = 0; c < 16; ++c) { const int ci = CAND.ci[g * 16 + c], cj = CAND.cj[g * 16 + c]; N[c] = ci >= 0 ? ((enc_f(fa[ci >= 0 ? ci : 0] + fb[cj >= 0 ? cj : 0]) & ~255) | (ci * 16 + cj)) : (int)0x80000000; }
            sort16_desc(N);
            if (g == 0) {
#pragma unroll
                for (int i = 0; i < 16; ++i) W[i] = N[i];
            } else merge_top16(W, N);
        }
        float ssum = 0.f;
        if (tile >= MPROMPT / 32) { const GAS f32x4* sp = (const GAS f32x4*)((const float*)(F.ws + WS_SS2S) + (size_t)(t - MPROMPT) * 128);
#pragma unroll 16
            for (int i = 0; i < 32; ++i) { const f32x4 v = sp[i]; ssum += (v.x + v.y) + (v.z + v.w); } }
        else { const GAS f32x4* sp = (const GAS f32x4*)(SS2 + (size_t)t * 32);
#pragma unroll
            for (int i = 0; i < 8; ++i) { const f32x4 v = sp[i]; ssum += (v.x + v.y) + (v.z + v.w); } }
        const float rt = 1.0f / sqrtf(ssum * (1.f / DM) + EPS);
        LDS_WAIT(); asm volatile("" ::: "memory");
        float gk[16]; int ek[16]; float Z = 0.f; const float c0 = dec_f(W[0] & ~255);
#pragma unroll
        for (int k = 0; k < 16; ++k) { const int code = W[k] & 255, ii = code >> 4, jj = code & 15; const int n0 = SC[ii * 64 + lane], n1 = SC[(16 + jj) * 64 + lane];
            ek[k] = n0 * 128 + n1; gk[k] = __builtin_amdgcn_exp2f((dec_f(W[k] & ~255) - c0) * rt * LOG2E); Z += gk[k]; }
        const float iz = 1.0f / Z;
        unsigned long long* dst = SEL + ((size_t)t * 8 + hq) * 16 + 8 * h;
#pragma unroll
        for (int k = 0; k < 8; k += 2) { const int e0 = h ? ek[k + 8] : ek[k], e1 = h ? ek[k + 9] : ek[k + 1]; const float g0 = (h ? gk[k + 8] : gk[k]) * iz, g1 = (h ? gk[k + 9] : gk[k + 1]) * iz;
            __hip_atomic_store(dst + k, (unsigned long long)(unsigned)e0 | ((unsigned long long)__builtin_bit_cast(unsigned, g0) << 32), RLX_AGENT);
            __hip_atomic_store(dst + k + 1, (unsigned long long)(unsigned)e1 | ((unsigned long long)__builtin_bit_cast(unsigned, g1) << 32), RLX_AGENT); }
        LDS_WAIT(); asm volatile("" ::: "memory");
        }
    }
}
__device__ __forceinline__ void p6_topk(Frame& F) {
    constexpr int NJOB = ((MREAL / 32 + 7) / 8) * 8;
    for (int job = F.vcu; job < NJOB; job += F.G) { p6_job(F, job); __syncthreads(); }
}
typedef _Float16 h2v __attribute__((ext_vector_type(2)));
constexpr int P7_RED = 0, P7_PART = LDSCTL_OFF;
#ifndef P7_UNR
#define P7_UNR (PEER_FP4 ? 16 : 8)
#endif
template <int M> __device__ __forceinline__ float xor_lane(float x) {
    if constexpr (M == 32) return __builtin_bit_cast(float, pg8::partner32(__builtin_bit_cast(unsigned, x)));
    else return __builtin_bit_cast(float, __builtin_amdgcn_ds_swizzle(__builtin_bit_cast(int, x), (M << 10) | 0x1f));
}
__device__ __forceinline__ float wave_sum_sw(float v) { v += xor_lane<1>(v); v += xor_lane<2>(v); v += xor_lane<4>(v); v += xor_lane<8>(v); v += xor_lane<16>(v); v += xor_lane<32>(v); return v; }
#if PEER_FP4
#ifndef P7_MFMA_U
#define P7_MFMA_U 1
#endif
typedef int v8i_t __attribute__((ext_vector_type(8)));
__device__ __forceinline__ void p7_gather(Frame& F) {
    const int lane = pg8::lane_id_v(), w = F.wave;
    const bf16* XH = (const bf16*)(F.ws + WS_RATIO); const unsigned char* EU4 = F.ws + WS_EU; const float* EUS = (const float*)(F.ws + WS_EU + 16 * MiB); const unsigned char* EV4 = F.ws + WS_EU + 32 * MiB; const float* EVS = (const float*)(F.ws + WS_EU + 48 * MiB);
    const unsigned long long* SEL = (const unsigned long long*)(F.ws + WS_RA);
    int it = 0;
#ifdef P7_ACTIVE_PER_XCD
    if ((F.vcu & 31) >= P7_ACTIVE_PER_XCD) return;
    const int rank_ = (F.vcu >> 5) * P7_ACTIVE_PER_XCD + (F.vcu & 31), nrank_ = 8 * P7_ACTIVE_PER_XCD;
#else
    const int rank_ = F.vcu, nrank_ = F.G;
#endif
    for (int t = rank_; t < MREAL; t += nrank_, ++it) {
        LAS float* RED = (LAS float*)(F.lds + P7_RED + (it & 1) * 65536); LAS float* PART = (LAS float*)(F.lds + P7_PART + (it & 1) * 32);
        const unsigned long long sel = SEL[((size_t)t * 8 + w) * 16 + (lane >> 2)];
        const int eidx = (int)(unsigned)sel; const float gate = __builtin_bit_cast(float, (unsigned)(sel >> 32));
        const float su_l = EUS[eidx], sv_l = EVS[eidx];
        unsigned xw[16];
#pragma unroll
        for (int q = 0; q < 8; ++q) { const unsigned long long v = *(const GAS unsigned long long*)(XH + (size_t)t * DM + q * 256 + lane * 4); xw[2 * q] = (unsigned)v; xw[2 * q + 1] = (unsigned)(v >> 32); }
#if P7_MFMA_U
        v8i_t xb;
        { typedef _Float16 h32x __attribute__((ext_vector_type(32))); typedef unsigned u6x __attribute__((ext_vector_type(6))); h32x hx;
#pragma unroll
          for (int i = 0; i < 16; ++i) { const h2v p = __builtin_bit_cast(h2v, xw[i]); hx[2 * i] = p[0]; hx[2 * i + 1] = p[1]; }
          const u6x px = __builtin_amdgcn_cvt_scalef32_pk32_fp6_f16(hx, 1.0f);
          xb = (v8i_t){(int)px[0], (int)px[1], (int)px[2], (int)px[3], (int)px[4], (int)px[5], 0, 0}; }
        float mk[4];
#pragma unroll
        for (int r4 = 0; r4 < 4; ++r4) mk[r4] = ((lane >> 4) == ((lane & 15) >> 2) && (lane & 3) == r4) ? 1.f : 0.f;
#endif
        float ssum = 0.f;
#pragma unroll
        for (int i = 0; i < 16; ++i) { const h2v hv = __builtin_bit_cast(h2v, xw[i]); ssum = __builtin_amdgcn_fdot2(hv, hv, ssum, false); }
        ssum = wave_sum_sw(ssum);
        const float rt = 1.0f / sqrtf(ssum * (1.f / DM) + EPS);
        float dp[16];
#pragma unroll
        for (int k0 = 0; k0 < 16; k0 += P7_UNR) {
            v4u ur[P7_UNR];
#pragma unroll
            for (int kk = 0; kk < P7_UNR; ++kk) { const int e = __builtin_amdgcn_readlane(eidx, 4 * (k0 + kk)); ur[kk] = *(const GAS v4u*)(EU4 + (size_t)e * 1024 + lane * 16); }
#if P7_MFMA_U
#pragma unroll
            for (int kk = 0; kk < P7_UNR; ++kk) { const v8i_t A = {(int)ur[kk].x, (int)ur[kk].y, (int)ur[kk].z, (int)ur[kk].w, 0, 0, 0, 0};
                const f32x4 d = __builtin_amdgcn_mfma_scale_f32_16x16x128_f8f6f4(A, xb, (f32x4){0.f, 0.f, 0.f, 0.f}, 4  , 2  , 0, 127, 0, 127);
                dp[k0 + kk] = (d[0] * mk[0] + d[1] * mk[1]) + (d[2] * mk[2] + d[3] * mk[3]); }
#else
#pragma unroll
            for (int kk = 0; kk < P7_UNR; ++kk) { float a = 0.f;
#pragma unroll
                for (int q = 0; q < 4; ++q) { const unsigned wq = ur[kk][q];
                    a = __builtin_amdgcn_fdot2(__builtin_amdgcn_cvt_scalef32_pk_f16_fp4(wq, 1.0f, 0), __builtin_bit_cast(h2v, xw[4 * q + 0]), a, false); a = __builtin_amdgcn_fdot2(__builtin_amdgcn_cvt_scalef32_pk_f16_fp4(wq, 1.0f, 1), __builtin_bit_cast(h2v, xw[4 * q + 1]), a, false);
                    a = __builtin_amdgcn_fdot2(__builtin_amdgcn_cvt_scalef32_pk_f16_fp4(wq, 1.0f, 2), __builtin_bit_cast(h2v, xw[4 * q + 2]), a, false); a = __builtin_amdgcn_fdot2(__builtin_amdgcn_cvt_scalef32_pk_f16_fp4(wq, 1.0f, 3), __builtin_bit_cast(h2v, xw[4 * q + 3]), a, false); }
                dp[k0 + kk] = a;
                }
#endif
#pragma unroll
            for (int kk = 0; kk < P7_UNR; ++kk) asm volatile("" : "+v"(dp[k0 + kk]) :: "memory");
        }
#define P7_TR(C, M) do { const bool up_ = (lane & (M)) != 0; _Pragma("unroll") for (int i = 0; i < (C) / 2; ++i) { const float keep_ = up_ ? dp[i + (C) / 2] : dp[i], send_ = up_ ? dp[i] : dp[i + (C) / 2]; dp[i] = keep_ + xor_lane<(M)>(send_); } } while (0)
        P7_TR(16, 32); P7_TR(8, 16); P7_TR(4, 8); P7_TR(2, 4);
#undef P7_TR
        float dk = dp[0]; dk += xor_lane<2>(dk); dk += xor_lane<1>(dk);
        const float hval = gate * pg8::gelu_tanh(dk * su_l * rt) * sv_l;
        h2v o2[16];
#pragma unroll
        for (int e = 0; e < 16; ++e) o2[e] = (h2v){(_Float16)0.f, (_Float16)0.f};
#pragma unroll
        for (int k0 = 0; k0 < 16; k0 += P7_UNR) {
            v4u vr[P7_UNR];
#pragma unroll
            for (int kk = 0; kk < P7_UNR; ++kk) { const int e = __builtin_amdgcn_readlane(eidx, 4 * (k0 + kk)); vr[kk] = *(const GAS v4u*)(EV4 + (size_t)e * 1024 + lane * 16); }
#pragma unroll
            for (int kk = 0; kk < P7_UNR; ++kk) { const float hk = __builtin_bit_cast(float, __builtin_amdgcn_readlane(__builtin_bit_cast(int, hval), 4 * (k0 + kk))) * 256.0f; const _Float16 hh = (_Float16)hk; const h2v hk2 = {hh, hh};
#pragma unroll
                for (int q = 0; q < 4; ++q) { const unsigned wq = vr[kk][q];
                    o2[4 * q + 0] = __builtin_elementwise_fma(__builtin_bit_cast(h2v, __builtin_amdgcn_cvt_scalef32_pk_f16_fp4(wq, 1.0f, 0)), hk2, o2[4 * q + 0]); o2[4 * q + 1] = __builtin_elementwise_fma(__builtin_bit_cast(h2v, __builtin_amdgcn_cvt_scalef32_pk_f16_fp4(wq, 1.0f, 1)), hk2, o2[4 * q + 1]);
                    o2[4 * q + 2] = __builtin_elementwise_fma(__builtin_bit_cast(h2v, __builtin_amdgcn_cvt_scalef32_pk_f16_fp4(wq, 1.0f, 2)), hk2, o2[4 * q + 2]); o2[4 * q + 3] = __builtin_elementwise_fma(__builtin_bit_cast(h2v, __builtin_amdgcn_cvt_scalef32_pk_f16_fp4(wq, 1.0f, 3)), hk2, o2[4 * q + 3]); } }
#pragma unroll
            for (int q = 0; q < 2; ++q) asm volatile("" : "+v"(o2[8 * q]), "+v"(o2[8 * q + 1]), "+v"(o2[8 * q + 2]), "+v"(o2[8 * q + 3]), "+v"(o2[8 * q + 4]), "+v"(o2[8 * q + 5]), "+v"(o2[8 * q + 6]), "+v"(o2[8 * q + 7]) :: "memory");
        }
#pragma unroll
        for (int q = 0; q < 8; ++q) *(LAS f32x4*)(RED + w * 2048 + q * 256 + lane * 4) = (f32x4){(float)o2[2 * q][0], (float)o2[2 * q][1], (float)o2[2 * q + 1][0], (float)o2[2 * q + 1][1]} * (1.0f / 256.0f);
        __syncthreads();
        const int col = w * 256 + lane * 4, soff = col;
        f32x4 sum = *(const LAS f32x4*)(RED + soff);
#pragma unroll
        for (int ww = 1; ww < 8; ++ww) sum += *(const LAS f32x4*)(RED + ww * 2048 + soff);
        { const unsigned long long xq = *(const GAS unsigned long long*)(XH + (size_t)t * DM + col); const unsigned x0 = (unsigned)xq, x1 = (unsigned)(xq >> 32); const h2v p0 = __builtin_bit_cast(h2v, x0), p1 = __builtin_bit_cast(h2v, x1);
            sum += (f32x4){(float)p0[0], (float)p0[1], (float)p1[0], (float)p1[1]}; }
        float sq = (sum.x * sum.x + sum.y * sum.y) + (sum.z * sum.z + sum.w * sum.w); sq = wave_sum_sw(sq);
        if (lane == 0) PART[w] = sq;
        __syncthreads();
        float tot = 0.f;
#pragma unroll
        for (int ww = 0; ww < 8; ++ww) tot += PART[ww];
        const float rf = 1.0f / sqrtf(tot * (1.f / DM) + EPS);
        const f32x4 gf = *(const GAS f32x4*)(F.norm_final_g + col);
        *(GAS f32x4*)(F.out + OUT_Y + (size_t)t * DM + col) = sum * rf * gf;
    }
}
#elif PEER_FP6
typedef _Float16 h32v __attribute__((ext_vector_type(32)));
typedef unsigned u6v __attribute__((ext_vector_type(6)));
typedef unsigned u2v __attribute__((ext_vector_type(2)));
__device__ __forceinline__ u6v ld_row6(const unsigned char* p) { const GAS u2v* q = (const GAS u2v*)p; const u2v a = q[0], b = q[1], c = q[2]; return (u6v){a.x, a.y, b.x, b.y, c.x, c.y}; }
__device__ __forceinline__ void p7_gather(Frame& F) {
    const int lane = pg8::lane_id_v(), w = F.wave;
    const bf16* XH = (const bf16*)(F.ws + WS_RATIO); const unsigned char* EU6 = F.ws + WS_EU; const unsigned char* EV6 = F.ws + WS_EU + 32 * MiB;
    const unsigned long long* SEL = (const unsigned long long*)(F.ws + WS_RA);
    int it = 0;
    for (int t = F.vcu; t < MREAL; t += F.G, ++it) {
        LAS float* RED = (LAS float*)(F.lds + P7_RED + (it & 1) * 65536); LAS float* PART = (LAS float*)(F.lds + P7_PART + (it & 1) * 32);
        const unsigned long long sel = SEL[((size_t)t * 8 + w) * 16 + (lane >> 2)];
        const int eidx = (int)(unsigned)sel; const float gate = __builtin_bit_cast(float, (unsigned)(sel >> 32));
        unsigned xw[16];
#pragma unroll
        for (int q = 0; q < 4; ++q) { const v4u v = *(const GAS v4u*)(XH + (size_t)t * DM + lane * 32 + q * 8); xw[4 * q] = v.x; xw[4 * q + 1] = v.y; xw[4 * q + 2] = v.z; xw[4 * q + 3] = v.w; }
        float ssum = 0.f;
#pragma unroll
        for (int i = 0; i < 16; ++i) { const h2v hv = __builtin_bit_cast(h2v, xw[i]); ssum = __builtin_amdgcn_fdot2(hv, hv, ssum, false); }
        ssum = wave_sum_sw(ssum);
        const float rt = 1.0f / sqrtf(ssum * (1.f / DM) + EPS);
        float dp[16];
#pragma unroll
        for (int k0 = 0; k0 < 16; k0 += P7_UNR) {
            u6v ur[P7_UNR];
#pragma unroll
            for (int kk = 0; kk < P7_UNR; ++kk) { const int e = __builtin_amdgcn_readlane(eidx, 4 * (k0 + kk)); ur[kk] = ld_row6(EU6 + (size_t)e * 1536 + lane * 24); }
#pragma unroll
            for (int kk = 0; kk < P7_UNR; ++kk) { const h32v d = __builtin_amdgcn_cvt_scalef32_pk32_f16_fp6(ur[kk], 1.0f); float a = 0.f;
#pragma unroll
                for (int i = 0; i < 16; ++i) { const h2v dd = {d[2 * i], d[2 * i + 1]}; a = __builtin_amdgcn_fdot2(dd, __builtin_bit_cast(h2v, xw[i]), a, false); }
                dp[k0 + kk] = a; }
#pragma unroll
            for (int kk = 0; kk < P7_UNR; ++kk) asm volatile("" : "+v"(dp[k0 + kk]) :: "memory");
        }
#define P7_TR(C, M) do { const bool up_ = (lane & (M)) != 0; _Pragma("unroll") for (int i = 0; i < (C) / 2; ++i) { const float keep_ = up_ ? dp[i + (C) / 2] : dp[i], send_ = up_ ? dp[i] : dp[i + (C) / 2]; dp[i] = keep_ + xor_lane<(M)>(send_); } } while (0)
        P7_TR(16, 32); P7_TR(8, 16); P7_TR(4, 8); P7_TR(2, 4);
#undef P7_TR
        float dk = dp[0]; dk += xor_lane<2>(dk); dk += xor_lane<1>(dk);
        const float hval = gate * pg8::gelu_tanh(dk * rt * (1.0f / PEER_SU)) * (1.0f / PEER_SV);
        float o[32];
#pragma unroll
        for (int e = 0; e < 32; ++e) o[e] = 0.f;
#pragma unroll
        for (int k0 = 0; k0 < 16; k0 += P7_UNR) {
            u6v vr[P7_UNR];
#pragma unroll
            for (int kk = 0; kk < P7_UNR; ++kk) { const int e = __builtin_amdgcn_readlane(eidx, 4 * (k0 + kk)); vr[kk] = ld_row6(EV6 + (size_t)e * 1536 + lane * 24); }
#pragma unroll
            for (int kk = 0; kk < P7_UNR; ++kk) { const float hk = __builtin_bit_cast(float, __builtin_amdgcn_readlane(__builtin_bit_cast(int, hval), 4 * (k0 + kk))); const h32v d = __builtin_amdgcn_cvt_scalef32_pk32_f16_fp6(vr[kk], 1.0f);
#pragma unroll
                for (int e = 0; e < 32; ++e) o[e] = __builtin_fmaf((float)d[e], hk, o[e]); }
#pragma unroll
            for (int q = 0; q < 4; ++q) asm volatile("" : "+v"(o[8 * q]), "+v"(o[8 * q + 1]), "+v"(o[8 * q + 2]), "+v"(o[8 * q + 3]), "+v"(o[8 * q + 4]), "+v"(o[8 * q + 5]), "+v"(o[8 * q + 6]), "+v"(o[8 * q + 7]) :: "memory");
        }
        { const int L = lane;
#pragma unroll
            for (int q = 0; q < 8; ++q) *(LAS f32x4*)(RED + w * 2048 + L * 32 + ((q + L) & 7) * 4) = (f32x4){o[4 * q], o[4 * q + 1], o[4 * q + 2], o[4 * q + 3]}; }
        __syncthreads();
        const int col = w * 256 + lane * 4; const int Lb = col >> 5, qb = (col >> 2) & 7, soff = Lb * 32 + ((qb + Lb) & 7) * 4;
        f32x4 sum = *(const LAS f32x4*)(RED + soff);
#pragma unroll
        for (int ww = 1; ww < 8; ++ww) sum += *(const LAS f32x4*)(RED + ww * 2048 + soff);
        { const unsigned long long xq = *(const GAS unsigned long long*)(XH + (size_t)t * DM + col); const unsigned x0 = (unsigned)xq, x1 = (unsigned)(xq >> 32); const h2v p0 = __builtin_bit_cast(h2v, x0), p1 = __builtin_bit_cast(h2v, x1);
            sum += (f32x4){(float)p0[0], (float)p0[1], (float)p1[0], (float)p1[1]}; }
        float sq = (sum.x * sum.x + sum.y * sum.y) + (sum.z * sum.z + sum.w * sum.w); sq = wave_sum_sw(sq);
        if (lane == 0) PART[w] = sq;
        __syncthreads();
        float tot = 0.f;
#pragma unroll
        for (int ww = 0; ww < 8; ++ww) tot += PART[ww];
        const float rf = 1.0f / sqrtf(tot * (1.f / DM) + EPS);
        const f32x4 gf = *(const GAS f32x4*)(F.norm_final_g + col);
        *(GAS f32x4*)(F.out + OUT_Y + (size_t)t * DM + col) = sum * rf * gf;
    }
}
#else
#error "PEER expert tables: PEER_FP4 or PEER_FP6"
#endif
#ifndef PQ_MERGE
#define PQ_MERGE PEER_FP4
#endif
#if PQ_MERGE
constexpr int CW_QUEUE = 8192, CW_GCNT = 8256;
constexpr int Q_NITEM = 520 + MREAL;
static_assert(MREAL == 16512 && (CW_GCNT + 65) * 4 <= (int)CTL_ZERO_BYTES, "queue layout");
__device__ __forceinline__ int q_decode(const int idx) { return idx < 520 ? ~idx : idx - 520; }
__device__ __forceinline__ unsigned q_ready(unsigned* gcnt, const int g, int& upto, const int lane) {
    if (g >= upto) { const unsigned c = xb_ld(&gcnt[lane]), c64 = xb_ld(&gcnt[64]); const unsigned long long m = __ballot(c >= 8u);
        int n = (m == ~0ull) ? 64 : __builtin_ctzll(~m); if (n == 64 && c64 >= 8u) n = 65; upto = n; }
    return g < upto ? 8u : 0u;
}
__device__ __forceinline__ void p67_queue(Frame& F) {
    const int w = F.wave;
    unsigned* qctr = (unsigned*)(F.ctl + CW_QUEUE); unsigned* gcnt = (unsigned*)(F.ctl + CW_GCNT); unsigned* bar = (unsigned*)(F.ctl + CW_BAR);
    volatile LAS int* LQ = (volatile LAS int*)(F.lds + LDSCTL_OFF + 128);
    const bf16* XH = (const bf16*)(F.ws + WS_RATIO); const unsigned char* EU4 = F.ws + WS_EU; const float* EUS = (const float*)(F.ws + WS_EU + 16 * MiB); const unsigned char* EV4 = F.ws + WS_EU + 32 * MiB; const float* EVS = (const float*)(F.ws + WS_EU + 48 * MiB);
    unsigned long long* SEL = (unsigned long long*)(F.ws + WS_RA);
    int idx = F.vcu, slot = 0, ntok = 0, rdy_upto = 0; int ready = q_decode(idx) < 0 ? 1 : 0;
    while (idx < Q_NITEM) {
        const int lane = pg8::lane_id_v();
        unsigned nxr = 0u; if (w == 0 && lane == 0) nxr = xb_add(qctr, 1u);
        int nx = Q_NITEM; unsigned nrdy = 8u;
        const int item = q_decode(idx);
        if (item < 0) {
            const int job = ~item;
            p6_job(F, job);
            VM_WAIT();
            if (w == 0) { nx = (int)F.G + __builtin_amdgcn_readfirstlane((int)nxr); if (nx < Q_NITEM) { const int ni = q_decode(nx); if (ni >= 0) nrdy = q_ready(gcnt, ni >> 8, rdy_upto, lane); }
                if (lane == 0) { LQ[(slot ^ 1) * 2] = nx; LQ[(slot ^ 1) * 2 + 1] = nrdy >= 8u ? 1 : 0; } }
            __syncthreads();
            if (w == 0 && lane == 0) (void)xb_add(&gcnt[job >> 3], 1u);
        } else {
            const int t = item;
            if (!ready) { XB_SPIN(xb_ld(&gcnt[t >> 8]) < 8u, bar); }
            LAS float* RED = (LAS float*)(F.lds + P7_RED + (ntok & 1) * 65536); LAS float* PART = (LAS float*)(F.lds + P7_PART + (ntok & 1) * 32);
            const unsigned long long sel = __hip_atomic_load(SEL + ((size_t)t * 8 + w) * 16 + (lane >> 2), RLX_AGENT);
            const int eidx = (int)(unsigned)sel; const float gate = __builtin_bit_cast(float, (unsigned)(sel >> 32));
            const float su_l = EUS[eidx], sv_l = EVS[eidx];
            unsigned xw[16];
#pragma unroll
            for (int q = 0; q < 8; ++q) { const unsigned long long v = *(const GAS unsigned long long*)(XH + (size_t)t * DM + q * 256 + lane * 4); xw[2 * q] = (unsigned)v; xw[2 * q + 1] = (unsigned)(v >> 32); }
#if P7_MFMA_U
            v8i_t xb;
            { typedef _Float16 h32x __attribute__((ext_vector_type(32))); typedef unsigned u6x __attribute__((ext_vector_type(6))); h32x hx;
#pragma unroll
              for (int i = 0; i < 16; ++i) { const h2v p = __builtin_bit_cast(h2v, xw[i]); hx[2 * i] = p[0]; hx[2 * i + 1] = p[1]; }
              const u6x px = __builtin_amdgcn_cvt_scalef32_pk32_fp6_f16(hx, 1.0f);
              xb = (v8i_t){(int)px[0], (int)px[1], (int)px[2], (int)px[3], (int)px[4], (int)px[5], 0, 0}; }
            float mk[4];
#pragma unroll
            for (int r4 = 0; r4 < 4; ++r4) mk[r4] = ((lane >> 4) == ((lane & 15) >> 2) && (lane & 3) == r4) ? 1.f : 0.f;
#endif
            float ssum = 0.f;
#pragma unroll
            for (int i = 0; i < 16; ++i) { const h2v hv = __builtin_bit_cast(h2v, xw[i]); ssum = __builtin_amdgcn_fdot2(hv, hv, ssum, false); }
            ssum = wave_sum_sw(ssum);
            const float rt = 1.0f / sqrtf(ssum * (1.f / DM) + EPS);
            float dp[16];
#pragma unroll
            for (int k0 = 0; k0 < 16; k0 += P7_UNR) {
                v4u ur[P7_UNR];
#pragma unroll
                for (int kk = 0; kk < P7_UNR; ++kk) { const int e = __builtin_amdgcn_readlane(eidx, 4 * (k0 + kk)); ur[kk] = *(const GAS v4u*)(EU4 + (size_t)e * 1024 + lane * 16); }
#if P7_MFMA_U
#pragma unroll
                for (int kk = 0; kk < P7_UNR; ++kk) { const v8i_t A = {(int)ur[kk].x, (int)ur[kk].y, (int)ur[kk].z, (int)ur[kk].w, 0, 0, 0, 0};
                    const f32x4 d = __builtin_amdgcn_mfma_scale_f32_16x16x128_f8f6f4(A, xb, (f32x4){0.f, 0.f, 0.f, 0.f}, 4  , 2  , 0, 127, 0, 127);
                    dp[k0 + kk] = (d[0] * mk[0] + d[1] * mk[1]) + (d[2] * mk[2] + d[3] * mk[3]); }
#else
#pragma unroll
                for (int kk = 0; kk < P7_UNR; ++kk) { float a = 0.f;
#pragma unroll
                    for (int q = 0; q < 4; ++q) { const unsigned wq = ur[kk][q];
                        a = __builtin_amdgcn_fdot2(__builtin_amdgcn_cvt_scalef32_pk_f16_fp4(wq, 1.0f, 0), __builtin_bit_cast(h2v, xw[4 * q + 0]), a, false); a = __builtin_amdgcn_fdot2(__builtin_amdgcn_cvt_scalef32_pk_f16_fp4(wq, 1.0f, 1), __builtin_bit_cast(h2v, xw[4 * q + 1]), a, false);
                        a = __builtin_amdgcn_fdot2(__builtin_amdgcn_cvt_scalef32_pk_f16_fp4(wq, 1.0f, 2), __builtin_bit_cast(h2v, xw[4 * q + 2]), a, false); a = __builtin_amdgcn_fdot2(__builtin_amdgcn_cvt_scalef32_pk_f16_fp4(wq, 1.0f, 3), __builtin_bit_cast(h2v, xw[4 * q + 3]), a, false); }
                    dp[k0 + kk] = a;
                    }
#endif
#pragma unroll
                for (int kk = 0; kk < P7_UNR; ++kk) asm volatile("" : "+v"(dp[k0 + kk]) :: "memory");
            }
            if (w == 0) { nx = (int)F.G + __builtin_amdgcn_readfirstlane((int)nxr); if (nx < Q_NITEM) { const int ni = q_decode(nx); if (ni >= 0) nrdy = q_ready(gcnt, ni >> 8, rdy_upto, lane); } }
#define P7_TR(C, M) do { const bool up_ = (lane & (M)) != 0; _Pragma("unroll") for (int i = 0; i < (C) / 2; ++i) { const float keep_ = up_ ? dp[i + (C) / 2] : dp[i], send_ = up_ ? dp[i] : dp[i + (C) / 2]; dp[i] = keep_ + xor_lane<(M)>(send_); } } while (0)
            P7_TR(16, 32); P7_TR(8, 16); P7_TR(4, 8); P7_TR(2, 4);
#undef P7_TR
            float dk = dp[0]; dk += xor_lane<2>(dk); dk += xor_lane<1>(dk);
            const float hval = gate * pg8::gelu_tanh(dk * su_l * rt) * sv_l;
            unsigned long long xq = 0ull; f32x4 gf = {0.f, 0.f, 0.f, 0.f};
            h2v o2[16];
#pragma unroll
            for (int e = 0; e < 16; ++e) o2[e] = (h2v){(_Float16)0.f, (_Float16)0.f};
#pragma unroll
            for (int k0 = 0; k0 < 16; k0 += P7_UNR) {
                v4u vr[P7_UNR];
#pragma unroll
                for (int kk = 0; kk < P7_UNR; ++kk) { const int e = __builtin_amdgcn_readlane(eidx, 4 * (k0 + kk)); vr[kk] = *(const GAS v4u*)(EV4 + (size_t)e * 1024 + lane * 16); }
                if (k0 == 0) { xq = *(const GAS unsigned long long*)(XH + (size_t)t * DM + w * 256 + lane * 4); gf = *(const GAS f32x4*)(F.norm_final_g + w * 256 + lane * 4); }
#pragma unroll
                for (int kk = 0; kk < P7_UNR; ++kk) { const float hk = __builtin_bit_cast(float, __builtin_amdgcn_readlane(__builtin_bit_cast(int, hval), 4 * (k0 + kk))) * 256.0f; const _Float16 hh = (_Float16)hk; const h2v hk2 = {hh, hh};
#pragma unroll
                    for (int q = 0; q < 4; ++q) { const unsigned wq = vr[kk][q];
                        o2[4 * q + 0] = __builtin_elementwise_fma(__builtin_bit_cast(h2v, __builtin_amdgcn_cvt_scalef32_pk_f16_fp4(wq, 1.0f, 0)), hk2, o2[4 * q + 0]); o2[4 * q + 1] = __builtin_elementwise_fma(__builtin_bit_cast(h2v, __builtin_amdgcn_cvt_scalef32_pk_f16_fp4(wq, 1.0f, 1)), hk2, o2[4 * q + 1]);
                        o2[4 * q + 2] = __builtin_elementwise_fma(__builtin_bit_cast(h2v, __builtin_amdgcn_cvt_scalef32_pk_f16_fp4(wq, 1.0f, 2)), hk2, o2[4 * q + 2]); o2[4 * q + 3] = __builtin_elementwise_fma(__builtin_bit_cast(h2v, __builtin_amdgcn_cvt_scalef32_pk_f16_fp4(wq, 1.0f, 3)), hk2, o2[4 * q + 3]); } }
#pragma unroll
                for (int q = 0; q < 2; ++q) asm volatile("" : "+v"(o2[8 * q]), "+v"(o2[8 * q + 1]), "+v"(o2[8 * q + 2]), "+v"(o2[8 * q + 3]), "+v"(o2[8 * q + 4]), "+v"(o2[8 * q + 5]), "+v"(o2[8 * q + 6]), "+v"(o2[8 * q + 7]) :: "memory");
            }
#pragma unroll
            for (int q = 0; q < 8; ++q) *(LAS f32x4*)(RED + w * 2048 + q * 256 + lane * 4) = (f32x4){(float)o2[2 * q][0], (float)o2[2 * q][1], (float)o2[2 * q + 1][0], (float)o2[2 * q + 1][1]} * (1.0f / 256.0f);
            __syncthreads();
            const int col = w * 256 + lane * 4, soff = col;
            f32x4 sum = *(const LAS f32x4*)(RED + soff);
#pragma unroll
            for (int ww = 1; ww < 8; ++ww) sum += *(const LAS f32x4*)(RED + ww * 2048 + soff);
            { const unsigned x0 = (unsigned)xq, x1 = (unsigned)(xq >> 32); const h2v p0 = __builtin_bit_cast(h2v, x0), p1 = __builtin_bit_cast(h2v, x1);
                sum += (f32x4){(float)p0[0], (float)p0[1], (float)p1[0], (float)p1[1]}; }
            float sq = (sum.x * sum.x + sum.y * sum.y) + (sum.z * sum.z + sum.w * sum.w); sq = wave_sum_sw(sq);
            if (lane == 0) PART[w] = sq;
            if (w == 0 && lane == 0) { LQ[(slot ^ 1) * 2] = nx; LQ[(slot ^ 1) * 2 + 1] = nrdy >= 8u ? 1 : 0; }
            __syncthreads();
            float tot = 0.f;
#pragma unroll
            for (int ww = 0; ww < 8; ++ww) tot += PART[ww];
            const float rf = 1.0f / sqrtf(tot * (1.f / DM) + EPS);
            __builtin_nontemporal_store(sum * rf * gf, (GAS f32x4*)(F.out + OUT_Y + (size_t)t * DM + col));
        }
        slot ^= 1; ++ntok;
        idx = __builtin_amdgcn_readfirstlane(LQ[slot * 2]); ready = __builtin_amdgcn_readfirstlane(LQ[slot * 2 + 1]);
    }
}
#endif
struct Args { const float* in[20]; float* out; unsigned char* ws; };
__global__ void __launch_bounds__(NWAVES * 64, 2) hybrid_fwd(Args args) {
    extern __shared__ __attribute__((aligned(16))) unsigned char lds[];
    Frame F;
    F.lds = (LAS unsigned char*)lds;
    F.MISC = (volatile LAS unsigned*)(F.lds + MISC_OFF);
    F.wave = __builtin_amdgcn_readfirstlane(threadIdx.x >> 6);
    F.G = gridDim.x; { const int bx = blockIdx.x; F.vcu = (F.G % 8 == 0) ? (bx % 8) * (F.G / 8) + bx / 8 : bx; }
    F.ws = args.ws; F.out = args.out; F.ctl = (gu32*)(args.ws + WS_CTL);
    F.x_prompt = args.in[0]; F.x_sample = args.in[1]; F.cache_k = args.in[2]; F.cache_v = args.in[3]; F.norm_mix_g = args.in[4]; F.w_in = args.in[5]; F.sgu_norm_g = args.in[6];
    F.sgu_w_s = args.in[7]; F.sgu_b_s = args.in[8]; F.sinks = args.in[9]; F.rel_tab = args.in[10]; F.w_pa = args.in[11]; F.w_pb = args.in[12]; F.w_out = args.in[13]; F.norm_ffn_g = args.in[14];
    F.w_query = args.in[15]; F.sub_keys = args.in[16]; F.exp_u = args.in[17]; F.exp_v = args.in[18]; F.norm_final_g = args.in[19];
    for (int u = threadIdx.x; u < (LDS_BYTES - LDSCTL_OFF) / 4; u += NWAVES * 64) ((LAS unsigned*)(F.lds + LDSCTL_OFF))[u] = 0u;
    __syncthreads();
    XcdBarrier bar = xcd_barrier_post((unsigned*)(F.ctl + CW_BAR), F.MISC + 8);
    unsigned char* ws = args.ws;
    p0_prologue(F);
    xcd_barrier(bar);
    {
        pg8::Gemm g{(const bf16*)(ws + WS_RA), (const bf16*)(ws + WS_WIN), MPAD, DIN, DM}; pg8::StaticOrder S; S.init(MPAD, DIN, F.G, (int)blockIdx.x);
        pg8::EpiIn E{(bf16*)(ws + WS_Q), (bf16*)(ws + WS_KV), (bf16*)(ws + WS_U), (bf16*)(ws + WS_VS), (bf16*)(ws + WS_RATIO), (bf16*)(ws + WS_SB), (float*)(ws + WS_SS1),
                     F.out + OUT_KP, F.out + OUT_VP, F.out + OUT_KS, F.out + OUT_VS};
        pg8::gemm_phase<pg8::EpiIn, pg8::StaticOrder, true, true, false>(F.lds + RING_OFF, g, S, E, F.wave);
        constexpr int NU = (MPAD / 256) * (DIN / 256); const int full = NU % (int)F.G;
        if (NU > (int)F.G && full > 0) { if ((int)blockIdx.x >= full) p0_expert_tables(F, (int)blockIdx.x - full, (int)F.G - full); }
        else p0_expert_tables(F, F.vcu, F.G);
    }
    xcd_barrier(bar);
    p2_mixers(F);
    xcd_barrier(bar);
    {
        pg8::Gemm g{(const bf16*)(ws + WS_RA), (const bf16*)(ws + WS_WAB), MPROMPT, DM, DM}; pg8::StaticOrder S; S.init(MPROMPT, DM, F.G, (int)blockIdx.x);
        pg8::EpiMerge E{(const bf16*)(ws + WS_RATIO), (const bf16*)(ws + WS_SB), (bf16*)(ws + WS_RB)};
        pg8::gemm_phase<pg8::EpiMerge, pg8::StaticOrder, true, true, false>(F.lds + RING_OFF, g, S, E, F.wave);
        const SkMerge SE{(const bf16*)(ws + WS_RATIO), (const bf16*)(ws + WS_SB), (bf16*)(ws + WS_RB)}; skinny_gemm<false, true>(F, (const bf16*)(ws + WS_RA), (const bf16*)(ws + WS_WAB), SE);
    }
    xcd_barrier(bar);
    {
        pg8::Gemm g{(const bf16*)(ws + WS_RB), (const bf16*)(ws + WS_WOUT), MPROMPT, DM, DM}; pg8::StaticOrder S; S.init(MPROMPT, DM, F.G, (int)blockIdx.x);
        pg8::EpiOut E{F.x_prompt, F.x_sample, (bf16*)(ws + WS_RATIO), (float*)(ws + WS_SS2)};
        pg8::gemm_phase<pg8::EpiOut, pg8::StaticOrder, true, true, false>(F.lds + RING_OFF, g, S, E, F.wave);
        const SkOut SE{F.x_sample, (bf16*)(ws + WS_RATIO), (float*)(ws + WS_SS2S)}; skinny_gemm<false, false>(F, (const bf16*)(ws + WS_RB), (const bf16*)(ws + WS_WOUT), SE);
    }
    xcd_barrier(bar);
    {
        pg8::Gemm g{(const bf16*)(ws + WS_RATIO), (const bf16*)(ws + WS_WQ), MPROMPT, DM, DM}; pg8::StaticOrder S; S.init(MPROMPT, DM, F.G, (int)blockIdx.x);
        pg8::EpiQ E{(bf16*)(ws + WS_SB)};
        pg8::gemm_phase<pg8::EpiQ, pg8::StaticOrder, true, true, true>(F.lds + RING_OFF, g, S, E, F.wave);
        const SkQ SE{(bf16*)(ws + WS_SB)}; skinny_gemm<true, false>(F, (const bf16*)(ws + WS_RATIO), (const bf16*)(ws + WS_WQ), SE);
    }
    xcd_barrier(bar);
#if PQ_MERGE
    p67_queue(F);
#else
    p6_topk(F);
    xcd_barrier(bar);
    p7_gather(F);
#endif
}

extern "C" void kernel_launch(void* const* d_in, const int* in_sizes, int n_in, void* d_out, int out_size, void* d_ws, size_t ws_size, hipStream_t stream) {
    static int grid = 0;
    if (grid == 0) {
        if (n_in != 20 || in_sizes[0] != MPROMPT * DM || out_size != (int)OUT_TOTAL || ws_size < WS_END) {
            fprintf(stderr, "kernel_launch: shape mismatch: n_in %d, in0 %d, out %d (want %zu), ws %zu (want %zu); nothing launched\n", n_in, n_in > 0 ? in_sizes[0] : -1, out_size, (size_t)OUT_TOTAL, ws_size, (size_t)WS_END); grid = -1; return; }
        int dev = 0, cus = 0, per_cu = 0;
        if (hipGetDevice(&dev) != hipSuccess || hipDeviceGetAttribute(&cus, hipDeviceAttributeMultiprocessorCount, dev) != hipSuccess) { fprintf(stderr, "kernel_launch: device query failed\n"); grid = -1; return; }
        if (hipFuncSetAttribute((const void*)hybrid_fwd, hipFuncAttributeMaxDynamicSharedMemorySize, LDS_BYTES) != hipSuccess) { fprintf(stderr, "kernel_launch: hipFuncSetAttribute failed\n"); grid = -1; return; }
        if (hipOccupancyMaxActiveBlocksPerMultiprocessor(&per_cu, (const void*)hybrid_fwd, NWAVES * 64, LDS_BYTES) != hipSuccess || per_cu < 1)
            fprintf(stderr, "kernel_launch: note: occupancy query reports %d workgroups per CU\n", per_cu);
        (void)hipGetLastError();
        grid = cus;
    }
    if (grid < 0) return;
    if (hipMemsetAsync((char*)d_ws + WS_CTL, 0, CTL_ZERO_BYTES, stream) != hipSuccess) { fprintf(stderr, "kernel_launch: memset failed\n"); return; }
    Args a{};
    for (int i = 0; i < 20; ++i) a.in[i] = (const float*)d_in[i];
    a.out = (float*)d_out; a.ws = (unsigned char*)d_ws;

    hipLaunchKernelGGL(hybrid_fwd, dim3(grid), dim3(NWAVES * 64), LDS_BYTES, stream, a);
    const hipError_t le = hipPeekAtLastError();
    if (le != hipSuccess) fprintf(stderr, "kernel_launch: launch failed: %s\n", hipGetErrorName(le));
}
```

```cpp
#include <hip/hip_runtime.h>
#include <cstdio>
#include <cstdint>

namespace pg8 {
#define PG8_LAS __attribute__((address_space(3)))
typedef unsigned short bf16_t;
typedef short bf16x8 __attribute__((ext_vector_type(8)));
typedef float f32x4 __attribute__((ext_vector_type(4)));
typedef unsigned u32x4 __attribute__((ext_vector_type(4)));
constexpr int BM = 256, BK = 64, HALF = 128, HTB = HALF * BK * 2  , STAGE_BYTES = 8 * HTB, NXCD = 8, WGM = 8;

__host__ __device__ __forceinline__ int lds_byte(int r, int c) { const int st = (r >> 4) * 2 + (c >> 5), rr = r & 15, cc = c & 31, ob = rr * 64 + cc * 2; return st * 1024 + (ob ^ (((ob >> 9) & 1) << 5)); }
__host__ __device__ __forceinline__ void stage_rc(int b, int& R, int& C) { const int st = b / 1024, sb = b % 1024, swz = sb ^ (((sb >> 9) & 1) << 5); R = (st >> 1) * 16 + swz / 64; C = (st & 1) * 32 + (swz % 64) / 2; }
__host__ __device__ __forceinline__ int perm32(int rho) { const int n = rho >> 4, i = rho & 15; return 8 * (i >> 2) + 4 * n + (i & 3); }

__device__ __forceinline__ int lane_id_v() { int l; asm volatile("v_mbcnt_lo_u32_b32 %0, -1, 0\n\tv_mbcnt_hi_u32_b32 %0, -1, %0" : "=v"(l)); return l; }
__device__ __forceinline__ unsigned partner32(unsigned x) { unsigned a = x, b = x; asm volatile("" : "+v"(a)); asm volatile("" : "+v"(b)); auto rr = __builtin_amdgcn_permlane32_swap(a, b, false, false); return rr[0] ^ rr[1] ^ x; }
struct Unit { int pm, pn; };
struct Gemm { const bf16_t* A; const bf16_t* Bt; int M, N, K; };

struct StaticOrder {
    int nM, nN, nwg, G, c;
    __host__ __device__ void init(int M, int N, int G_, int c_) { nM = M / BM; nN = N / BM; nwg = nM * nN; G = G_; c = c_; }
    __host__ __device__ bool next(int i, Unit& u) const {
        const long L = (long)i * G + c; if (L >= nwg) return false;
        int wgid = (int)L; { const int q = nwg / NXCD, r = nwg % NXCD, xcd = wgid % NXCD, off = wgid / NXCD; wgid = (xcd < r ? xcd * (q + 1) : r * (q + 1) + (xcd - r) * q) + off; }
        const int nig = WGM * nN, gid = wgid / nig, fm = gid * WGM, gsz = (nM - fm) < WGM ? (nM - fm) : WGM;
        u.pm = fm + ((wgid % nig) % gsz); u.pn = (wgid % nig) / gsz; return true;
    }
    __device__ __forceinline__ void a_ready(const Unit&) const {}
    __device__ __forceinline__ void done(const Unit&) const {}
};

typedef float f32x2 __attribute__((ext_vector_type(2)));
typedef __bf16 bf16x2_t __attribute__((ext_vector_type(2)));
typedef _Float16 f16x2_t __attribute__((ext_vector_type(2)));
typedef _Float16 f16x8_t __attribute__((ext_vector_type(8)));
__device__ __forceinline__ unsigned pk_bf16(float lo, float hi) { f32x2 v = {lo, hi}; return __builtin_bit_cast(unsigned, __builtin_convertvector(v, bf16x2_t)); }
__device__ __forceinline__ unsigned pk_f16(float lo, float hi) { f32x2 v = {lo, hi}; return __builtin_bit_cast(unsigned, __builtin_convertvector(v, f16x2_t)); }
__device__ __forceinline__ float bf_lo(unsigned w) { return __builtin_bit_cast(float, w << 16); }
__device__ __forceinline__ float bf_hi(unsigned w) { return __builtin_bit_cast(float, w & 0xffff0000u); }
template <bool F16> __device__ __forceinline__ f32x4 mma16(bf16x8 a, bf16x8 b, f32x4 c) {
    if constexpr (F16) return __builtin_amdgcn_mfma_f32_16x16x32_f16(__builtin_bit_cast(f16x8_t, a), __builtin_bit_cast(f16x8_t, b), c, 0, 0, 0);
    else return __builtin_amdgcn_mfma_f32_16x16x32_bf16(a, b, c, 0, 0, 0);
}
__device__ __forceinline__ float gelu_tanh(float x) { const float y = x * (-2.3022081981f - 0.1029432396f * (x * x)); return x * __builtin_amdgcn_rcpf(1.f + __builtin_amdgcn_exp2f(y)); }
__device__ __forceinline__ float sigmoidf_(float x) { return __builtin_amdgcn_rcpf(1.f + __builtin_amdgcn_exp2f(-1.4426950409f * x)); }
__device__ __forceinline__ u32x4 pack8_bf16(const f32x4 a, const f32x4 b) { u32x4 w; w.x = pk_bf16(a[0], a[1]); w.y = pk_bf16(a[2], a[3]); w.z = pk_bf16(b[0], b[1]); w.w = pk_bf16(b[2], b[3]); return w; }
__device__ __forceinline__ u32x4 pack8_f16(const f32x4 a, const f32x4 b) { u32x4 w; w.x = pk_f16(a[0], a[1]); w.y = pk_f16(a[2], a[3]); w.z = pk_f16(b[0], b[1]); w.w = pk_f16(b[2], b[3]); return w; }
__device__ __forceinline__ float sq4(const f32x4 a) { return (a[0] * a[0] + a[1] * a[1]) + (a[2] * a[2] + a[3] * a[3]); }

constexpr float QSCALE = 0.125f * 1.4426950408889634f;
struct EpiIn {
    static constexpr bool PERM = true, AFTER_DRAIN = false, MID = false;
    bf16_t *Q, *KV, *U, *VS, *RATIO, *SB; float* SS1; float *outKp, *outVp, *outKs, *outVs;
    __device__ __forceinline__ void operator()(const f32x4 (&acc)[2][2][4][2], const Unit& u, int wr, int wc, int, int) const {
        const int lane_ = lane_id_v(), fr = lane_ & 15, fq = lane_ >> 4;
        const int pn = u.pn, rowb = u.pm * BM + wr * 64 + fr, cl = wc * 32 + 8 * fq;
        if (pn < 4) {
#pragma unroll
            for (int ai = 0; ai < 2; ++ai)
#pragma unroll
                for (int m = 0; m < 4; ++m) { bf16_t* rp = Q + (size_t)(rowb + ai * HALF + m * 16) * 1024 + pn * 256 + cl;
#pragma unroll
                    for (int bj = 0; bj < 2; ++bj) *(u32x4*)(rp + bj * HALF) = pack8_bf16(acc[ai][bj][m][0] * QSCALE, acc[ai][bj][m][1] * QSCALE); }
        } else if (pn == 4) {
#pragma unroll
            for (int ai = 0; ai < 2; ++ai)
#pragma unroll
                for (int m = 0; m < 4; ++m) { bf16_t* rp = KV + (size_t)(rowb + ai * HALF + m * 16) * 256 + cl;
#pragma unroll
                    for (int bj = 0; bj < 2; ++bj) *(u32x4*)(rp + bj * HALF) = pack8_bf16(acc[ai][bj][m][0], acc[ai][bj][m][1]); }
            if (u.pm < 64 && (u.pm & 7) == 7) {
#pragma unroll
                for (int m = 0; m < 4; ++m) { const size_t o = (size_t)((u.pm >> 3) * 128 + wr * 64 + m * 16 + fr) * 128 + cl;
                    __builtin_nontemporal_store(acc[1][0][m][0], (f32x4*)(outKp + o)); __builtin_nontemporal_store(acc[1][0][m][1], (f32x4*)(outKp + o + 4));
                    __builtin_nontemporal_store(acc[1][1][m][0], (f32x4*)(outVp + o)); __builtin_nontemporal_store(acc[1][1][m][1], (f32x4*)(outVp + o + 4)); }
            }
            if (u.pm == 64) {
#pragma unroll
                for (int m = 0; m < 4; ++m) { const size_t o = (size_t)(wr * 64 + m * 16 + fr) * 128 + cl;
                    __builtin_nontemporal_store(acc[0][0][m][0], (f32x4*)(outKs + o)); __builtin_nontemporal_store(acc[0][0][m][1], (f32x4*)(outKs + o + 4));
                    __builtin_nontemporal_store(acc[0][1][m][0], (f32x4*)(outVs + o)); __builtin_nontemporal_store(acc[0][1][m][1], (f32x4*)(outVs + o + 4)); }
            }
        } else if (pn < 13) {
            const bool isv = pn >= 9; bf16_t* base = isv ? VS : U; const int ct = (isv ? pn - 9 : pn - 5) * 256 + cl;
#pragma unroll
            for (int ai = 0; ai < 2; ++ai)
#pragma unroll
                for (int m = 0; m < 4; ++m) { const int row = rowb + ai * HALF + m * 16; bf16_t* rp = base + (size_t)row * 1024 + ct; float s = 0.f;
#pragma unroll
                    for (int bj = 0; bj < 2; ++bj) { f32x4 a = acc[ai][bj][m][0], b = acc[ai][bj][m][1];
#pragma unroll
                        for (int e = 0; e < 4; ++e) { a[e] = gelu_tanh(a[e]); b[e] = gelu_tanh(b[e]); }
                        s += sq4(a) + sq4(b); *(u32x4*)(rp + bj * HALF) = pack8_bf16(a, b); }
                    if (isv) { s += __shfl_xor(s, 16); s += __shfl_xor(s, 32); if (fq == 0) SS1[(size_t)row * 16 + (pn - 9) * 4 + wc] = s; } }
        } else {
            const int ct = (pn - 13) * 128 + cl;
#pragma unroll
            for (int ai = 0; ai < 2; ++ai)
#pragma unroll
                for (int m = 0; m < 4; ++m) { const size_t o = (size_t)(rowb + ai * HALF + m * 16) * 2048 + ct; f32x4 ra, rb, sa, sb2;
#pragma unroll
                    for (int e = 0; e < 4; ++e) {
                        const float eb0 = 1.f + __builtin_amdgcn_exp2f(-1.4426950409f * acc[ai][1][m][0][e]), eb1 = 1.f + __builtin_amdgcn_exp2f(-1.4426950409f * acc[ai][1][m][1][e]);
                        const float ea0 = 1.f + __builtin_amdgcn_exp2f(-1.4426950409f * acc[ai][0][m][0][e]), ea1 = 1.f + __builtin_amdgcn_exp2f(-1.4426950409f * acc[ai][0][m][1][e]);
                        sa[e] = __builtin_amdgcn_rcpf(eb0); sb2[e] = __builtin_amdgcn_rcpf(eb1); ra[e] = eb0 * __builtin_amdgcn_rcpf(ea0); rb[e] = eb1 * __builtin_amdgcn_rcpf(ea1); }
                    *(u32x4*)(RATIO + o) = pack8_bf16(ra, rb); *(u32x4*)(SB + o) = pack8_bf16(sa, sb2); }
        }
    }
};
struct EpiMerge {
    static constexpr bool PERM = true, AFTER_DRAIN = false, MID = true;
    const bf16_t *RATIO, *SB; bf16_t* H;
    __device__ __forceinline__ void mid(f32x4 (&acc)[2][2][4][2], const Unit& u, int wr, int wc, int, int) const {
        const int lane_ = lane_id_v(), fr = lane_ & 15, fq = lane_ >> 4;
        const int rowb = u.pm * BM + wr * 64 + fr, col = u.pn * 256 + wc * 32 + 8 * fq;
        u32x4 w[2][4][2];
#pragma unroll
        for (int ai = 0; ai < 2; ++ai)
#pragma unroll
            for (int m = 0; m < 4; ++m)
#pragma unroll
                for (int bj = 0; bj < 2; ++bj) w[ai][m][bj] = __builtin_nontemporal_load((const u32x4*)(RATIO + (size_t)(rowb + ai * HALF + m * 16) * 2048 + col + bj * HALF));
        asm volatile("" ::: "memory");
#pragma unroll
        for (int ai = 0; ai < 2; ++ai)
#pragma unroll
            for (int m = 0; m < 4; ++m)
#pragma unroll
                for (int bj = 0; bj < 2; ++bj) { const u32x4 v = w[ai][m][bj];
                    acc[ai][bj][m][0] *= (f32x4){bf_lo(v.x), bf_hi(v.x), bf_lo(v.y), bf_hi(v.y)}; acc[ai][bj][m][1] *= (f32x4){bf_lo(v.z), bf_hi(v.z), bf_lo(v.w), bf_hi(v.w)}; }
        asm volatile("" ::: "memory");
    }
    __device__ __forceinline__ void operator()(const f32x4 (&acc)[2][2][4][2], const Unit& u, int wr, int wc, int, int) const {
        const int lane_ = lane_id_v(), fr = lane_ & 15, fq = lane_ >> 4;
        const int rowb = u.pm * BM + wr * 64 + fr, col = u.pn * 256 + wc * 32 + 8 * fq;
        u32x4 w[2][4][2];
#pragma unroll
        for (int ai = 0; ai < 2; ++ai)
#pragma unroll
            for (int m = 0; m < 4; ++m)
#pragma unroll
                for (int bj = 0; bj < 2; ++bj) w[ai][m][bj] = __builtin_nontemporal_load((const u32x4*)(SB + (size_t)(rowb + ai * HALF + m * 16) * 2048 + col + bj * HALF));
        asm volatile("" ::: "memory");
#pragma unroll
        for (int ai = 0; ai < 2; ++ai) {
#pragma unroll
            for (int m = 0; m < 4; ++m)
#pragma unroll
                for (int bj = 0; bj < 2; ++bj) { const size_t o = (size_t)(rowb + ai * HALF + m * 16) * 2048 + col + bj * HALF; const u32x4 v = w[ai][m][bj];
                    *(u32x4*)(H + o) = pack8_bf16(acc[ai][bj][m][0] * (f32x4){bf_lo(v.x), bf_hi(v.x), bf_lo(v.y), bf_hi(v.y)}, acc[ai][bj][m][1] * (f32x4){bf_lo(v.z), bf_hi(v.z), bf_lo(v.w), bf_hi(v.w)}); }
            asm volatile("" ::: "memory");
        }
    }
};
#ifndef EPI_OUT_ROWS
#define EPI_OUT_ROWS 4
#endif
struct EpiOut {
    static constexpr bool PERM = true, AFTER_DRAIN = false, MID = false;
    const float *xp, *xs; bf16_t* XH; float* SS2;
    __device__ __forceinline__ void operator()(const f32x4 (&acc)[2][2][4][2], const Unit& u, int wr, int wc, int, int) const {
        const int lane_ = lane_id_v(), fr = lane_ & 15, fq = lane_ >> 4;
        const int rowb = u.pm * BM + wr * 64 + fr, col = u.pn * 256 + wc * 32 + 8 * fq;
#pragma unroll
        for (int ai = 0; ai < 2; ++ai)
#pragma unroll
            for (int mp = 0; mp < 4; mp += EPI_OUT_ROWS) {
                f32x4 xv[EPI_OUT_ROWS][2][2];
#pragma unroll
                for (int mm = 0; mm < EPI_OUT_ROWS; ++mm) { const int row = rowb + ai * HALF + (mp + mm) * 16; const float* xr = row < 16384 ? xp + (size_t)row * 2048 : (row < 16512 ? xs + (size_t)(row - 16384) * 2048 : nullptr);
#pragma unroll
                    for (int bj = 0; bj < 2; ++bj) { if (xr) { xv[mm][bj][0] = __builtin_nontemporal_load((const f32x4*)(xr + col + bj * HALF)); xv[mm][bj][1] = __builtin_nontemporal_load((const f32x4*)(xr + col + bj * HALF + 4)); } else { xv[mm][bj][0] = (f32x4){0.f, 0.f, 0.f, 0.f}; xv[mm][bj][1] = (f32x4){0.f, 0.f, 0.f, 0.f}; } } }
                asm volatile("" ::: "memory");
#pragma unroll
                for (int mm = 0; mm < EPI_OUT_ROWS; ++mm) { const int m = mp + mm, row = rowb + ai * HALF + m * 16; float s = 0.f;
#pragma unroll
                    for (int bj = 0; bj < 2; ++bj) { const f32x4 a = acc[ai][bj][m][0] + xv[mm][bj][0], b = acc[ai][bj][m][1] + xv[mm][bj][1];
                        s += sq4(a) + sq4(b); *(u32x4*)(XH + (size_t)row * 2048 + col + bj * HALF) = pack8_f16(a, b); }
                    s += __shfl_xor(s, 16); s += __shfl_xor(s, 32); if (fq == 0) SS2[(size_t)row * 32 + u.pn * 4 + wc] = s; }
                asm volatile("" ::: "memory");
            }
    }
};
struct EpiQ {
    static constexpr bool PERM = true, AFTER_DRAIN = false, MID = false;
    bf16_t* QP;
    __device__ __forceinline__ void operator()(const f32x4 (&acc)[2][2][4][2], const Unit& u, int wr, int wc, int, int) const {
        const int lane_ = lane_id_v(), fr = lane_ & 15, fq = lane_ >> 4;
        const int rowb = u.pm * BM + wr * 64 + fr, col = u.pn * 256 + wc * 32 + 8 * fq;
#pragma unroll
        for (int ai = 0; ai < 2; ++ai)
#pragma unroll
            for (int m = 0; m < 4; ++m)
#pragma unroll
                for (int bj = 0; bj < 2; ++bj) *(u32x4*)(QP + (size_t)(rowb + ai * HALF + m * 16) * 2048 + col + bj * HALF) = pack8_f16(acc[ai][bj][m][0], acc[ai][bj][m][1]);
    }
};
template <class Epi, class Sched, bool ALIGN_EPI = false, bool SP2 = false, bool F16 = false>
__device__ __forceinline__ void gemm_phase(PG8_LAS unsigned char* lds, const Gemm g, const Sched& S, const Epi& E, const int wid_in) {
    const int lane = lane_id_v(), wid = wid_in, tid = wid * 64 + lane, wr = wid >> 2, wc = wid & 3, fr = lane & 15, fq = lane >> 4;
    const int K = g.K, nt = K / BK;
    unsigned voffA[2], voffB[2];
#pragma unroll
    for (int i = 0; i < 2; ++i) { int R, C; stage_rc(tid * 16 + i * 8192, R, C); const int Rb = Epi::PERM ? ((R & ~31) + perm32(R & 31)) : R;
        voffA[i] = (unsigned)(R * K + C) * 2u; voffB[i] = (unsigned)(Rb * K + C) * 2u; }
    const size_t kstep = (size_t)(BK * 2);
    const size_t hstep = (size_t)HALF * K * 2;
    const size_t tstep = 2 * hstep;
    const unsigned ldsw = (unsigned)wid * 1024u;
    const int aoff = lds_byte(wr * 64 + fr, fq * 8), boff = lds_byte(wc * 32 + fr, fq * 8);
#define PG8_SA(b, h) (((b) * 2 + (h)) * HTB)
#define PG8_SB(b, h) ((4 + (b) * 2 + (h)) * HTB)
#define PG8_STAGE(bufoff, gbase, voff) do { _Pragma("unroll") for (int _i = 0; _i < 2; ++_i) \
        __builtin_amdgcn_global_load_lds((const unsigned*)((const char*)(gbase) + (voff)[_i]), (PG8_LAS unsigned*)(lds + (bufoff) + ldsw + _i * 8192), 16, 0, 0); } while (0)
#define PG8_LDA(dst, b, h) do { _Pragma("unroll") for (int m = 0; m < 4; ++m) _Pragma("unroll") for (int k = 0; k < 2; ++k) dst[m][k] = *(const PG8_LAS bf16x8*)(lds + PG8_SA(b, h) + aoff + m * 2048 + k * 1024); } while (0)
#define PG8_LDB(dst, b, h) do { _Pragma("unroll") for (int n = 0; n < 2; ++n) _Pragma("unroll") for (int k = 0; k < 2; ++k) dst[n][k] = *(const PG8_LAS bf16x8*)(lds + PG8_SB(b, h) + boff + n * 2048 + k * 1024); } while (0)
#define PG8_MMA(ai, bj, At, Bt) do { __builtin_amdgcn_s_setprio(1); _Pragma("unroll") for (int m = 0; m < 4; ++m) _Pragma("unroll") for (int n = 0; n < 2; ++n) _Pragma("unroll") for (int k = 0; k < 2; ++k) \
        acc[ai][bj][m][n] = mma16<F16>(Bt[n][k], At[m][k], acc[ai][bj][m][n]); __builtin_amdgcn_s_setprio(0); } while (0)
#define PG8_WAIT_V(n) asm volatile("s_waitcnt vmcnt(" #n ")" ::: "memory")
#define PG8_WAIT_L(n) asm volatile("s_waitcnt lgkmcnt(" #n ")" ::: "memory")
#define PG8_BAR __builtin_amdgcn_s_barrier()
#define PG8_SCHED __builtin_amdgcn_sched_barrier(0)
    Unit cur, nxt; int ui = 0;
    if (!S.next(0, cur)) return;
    f32x4 acc[2][2][4][2];
#pragma unroll
    for (int a = 0; a < 2; ++a)
#pragma unroll
        for (int b = 0; b < 2; ++b)
#pragma unroll
            for (int m = 0; m < 4; ++m)
#pragma unroll
                for (int n = 0; n < 2; ++n) acc[a][b][m][n] = (f32x4){0.f, 0.f, 0.f, 0.f};
    bf16x8 At[4][2], B0[2][2], B1[2][2];
    const char* cA = (const char*)g.A + (size_t)cur.pm * tstep; const char* cB = (const char*)g.Bt + (size_t)cur.pn * tstep;
    S.a_ready(cur);
    if constexpr (SP2) {
        PG8_STAGE(PG8_SB(0, 0), cB, voffB); PG8_STAGE(PG8_SB(0, 1), cB + hstep, voffB); PG8_STAGE(PG8_SA(0, 0), cA, voffA); PG8_STAGE(PG8_SA(0, 1), cA + hstep, voffA);
        if (wr == 1) PG8_BAR;
        PG8_WAIT_V(2); PG8_BAR;
        PG8_STAGE(PG8_SB(1, 0), cB + kstep, voffB); PG8_STAGE(PG8_SA(1, 0), cA + kstep, voffA); PG8_STAGE(PG8_SB(1, 1), cB + hstep + kstep, voffB);
        PG8_WAIT_V(6); PG8_BAR;
    } else {
        PG8_STAGE(PG8_SB(0, 0), cB, voffB); PG8_STAGE(PG8_SA(0, 0), cA, voffA); PG8_STAGE(PG8_SB(0, 1), cB + hstep, voffB); PG8_STAGE(PG8_SA(0, 1), cA + hstep, voffA);
        if (wr == 1) PG8_BAR;
        PG8_WAIT_V(4); PG8_BAR;
        PG8_STAGE(PG8_SB(1, 0), cB + kstep, voffB); PG8_STAGE(PG8_SA(1, 0), cA + kstep, voffA); PG8_STAGE(PG8_SB(1, 1), cB + hstep + kstep, voffB);
        PG8_WAIT_V(6); PG8_BAR;
    }
    for (;;) {
        const bool has_next = S.next(ui + 1, nxt);
        const char* nA = has_next ? (const char*)g.A + (size_t)nxt.pm * tstep : cA; const char* nB = has_next ? (const char*)g.Bt + (size_t)nxt.pn * tstep : cB;
        for (int t = 0; t < nt; t += 2) {
            const bool last = (t == nt - 2);
            const char* a1 = cA + (size_t)(t + 1) * kstep;
            const char* a2 = last ? nA : cA + (size_t)(t + 2) * kstep; const char* b2 = last ? nB : cB + (size_t)(t + 2) * kstep;
            const char* a3 = a2 + kstep; const char* b3 = b2 + kstep;
            if (last && has_next) S.a_ready(nxt);
            if constexpr (Epi::MID) { if (t == (nt >> 1)) E.mid(acc, cur, wr, wc, fr, fq); }
            if constexpr (SP2) {
            PG8_LDB(B0, 0, 0); PG8_LDB(B1, 0, 1); PG8_SCHED; PG8_LDA(At, 0, 0); PG8_STAGE(PG8_SA(1, 1), a1 + hstep, voffA);
            PG8_WAIT_V(8); PG8_WAIT_L(0); PG8_BAR; PG8_MMA(0, 0, At, B0); PG8_MMA(0, 1, At, B1); PG8_BAR; PG8_SCHED;
            PG8_LDA(At, 0, 1); PG8_STAGE(PG8_SB(0, 0), b2, voffB); PG8_STAGE(PG8_SB(0, 1), b2 + hstep, voffB); PG8_STAGE(PG8_SA(0, 0), a2, voffA);
            PG8_WAIT_V(8); PG8_WAIT_L(0); PG8_BAR; PG8_MMA(1, 0, At, B0); PG8_MMA(1, 1, At, B1); PG8_BAR; PG8_SCHED;
            PG8_LDB(B0, 1, 0); PG8_LDB(B1, 1, 1); PG8_SCHED; PG8_LDA(At, 1, 0); PG8_STAGE(PG8_SA(0, 1), a2 + hstep, voffA);
            PG8_WAIT_V(8); PG8_WAIT_L(0); PG8_BAR; PG8_MMA(0, 0, At, B0); PG8_MMA(0, 1, At, B1); PG8_BAR; PG8_SCHED;
            PG8_LDA(At, 1, 1); PG8_STAGE(PG8_SB(1, 0), b3, voffB); PG8_STAGE(PG8_SB(1, 1), b3 + hstep, voffB); PG8_STAGE(PG8_SA(1, 0), a3, voffA);
            PG8_WAIT_V(8); PG8_WAIT_L(0); PG8_BAR; PG8_MMA(1, 0, At, B0); PG8_MMA(1, 1, At, B1); PG8_BAR; PG8_SCHED;
            } else {
            PG8_LDB(B0, 0, 0); PG8_SCHED; PG8_LDA(At, 0, 0); PG8_STAGE(PG8_SA(1, 1), a1 + hstep, voffA);
            PG8_WAIT_L(8); PG8_BAR; PG8_WAIT_L(0); PG8_MMA(0, 0, At, B0); PG8_BAR; PG8_SCHED;
            PG8_LDB(B1, 0, 1); PG8_STAGE(PG8_SB(0, 0), b2, voffB);
            PG8_BAR; PG8_WAIT_L(0); PG8_MMA(0, 1, At, B1); PG8_BAR;
            PG8_LDA(At, 0, 1); PG8_STAGE(PG8_SA(0, 0), a2, voffA);
            PG8_BAR; PG8_WAIT_L(0); PG8_MMA(1, 0, At, B0); PG8_BAR; PG8_SCHED;
            PG8_STAGE(PG8_SB(0, 1), b2 + hstep, voffB);
            PG8_WAIT_V(6); PG8_BAR; PG8_MMA(1, 1, At, B1); PG8_BAR;
            PG8_LDB(B0, 1, 0); PG8_SCHED; PG8_LDA(At, 1, 0); PG8_STAGE(PG8_SA(0, 1), a2 + hstep, voffA);
            PG8_WAIT_L(8); PG8_BAR; PG8_WAIT_L(0); PG8_MMA(0, 0, At, B0); PG8_BAR; PG8_SCHED;
            PG8_LDB(B1, 1, 1); PG8_STAGE(PG8_SB(1, 0), b3, voffB);
            PG8_BAR; PG8_WAIT_L(0); PG8_MMA(0, 1, At, B1); PG8_BAR;
            PG8_LDA(At, 1, 1); PG8_STAGE(PG8_SA(1, 0), a3, voffA);
            PG8_BAR; PG8_WAIT_L(0); PG8_MMA(1, 0, At, B0); PG8_BAR; PG8_SCHED;
            PG8_STAGE(PG8_SB(1, 1), b3 + hstep, voffB);
            PG8_WAIT_V(6); PG8_BAR; PG8_MMA(1, 1, At, B1); PG8_BAR;
            }
        }
        if constexpr (ALIGN_EPI) { if (wr == 0) PG8_BAR; }
        if constexpr (!Epi::AFTER_DRAIN) { E(acc, cur, wr, wc, fr, fq); S.done(cur); }
        if (!has_next) break;
#pragma unroll
        for (int a = 0; a < 2; ++a)
#pragma unroll
            for (int b = 0; b < 2; ++b)
#pragma unroll
                for (int m = 0; m < 4; ++m)
#pragma unroll
                    for (int n = 0; n < 2; ++n) acc[a][b][m][n] = (f32x4){0.f, 0.f, 0.f, 0.f};
        cur = nxt; cA = nA; cB = nB; ++ui;
        if constexpr (ALIGN_EPI) { if (wr == 1) PG8_BAR; }
    }
    PG8_WAIT_V(0);
    if constexpr (!ALIGN_EPI) { if (wr == 0) PG8_BAR; }
    PG8_BAR;
    if constexpr (Epi::AFTER_DRAIN) { E.fused(acc, cur, wr, wc, fr, fq, lds, wid, lane); S.done(cur); }
#undef PG8_SA
#undef PG8_SB
#undef PG8_STAGE
#undef PG8_LDA
#undef PG8_LDB
#undef PG8_MMA
#undef PG8_WAIT_V
#undef PG8_WAIT_L
#undef PG8_BAR
#undef PG8_SCHED
}
}
#define GAS __attribute__((address_space(1)))
#define LAS __attribute__((address_space(3)))
typedef unsigned short bf16;
typedef unsigned v4u __attribute__((ext_vector_type(4)));
typedef float f32x4 __attribute__((ext_vector_type(4)));
typedef short bf16x8 __attribute__((ext_vector_type(8)));
typedef GAS unsigned gu32;
typedef GAS unsigned long long gu64;
#define RLX_AGENT __ATOMIC_RELAXED, __HIP_MEMORY_SCOPE_AGENT
#define LDS_WAIT() asm volatile("s_waitcnt lgkmcnt(0)" ::: "memory")
#define VM_WAIT() asm volatile("s_waitcnt vmcnt(0)" ::: "memory")
__device__ __forceinline__ unsigned long long rt() { return __builtin_amdgcn_s_memrealtime(); }
__device__ __forceinline__ unsigned f2bf(float f) { unsigned u = __builtin_bit_cast(unsigned, f); return (u + 0x7fffu + ((u >> 16) & 1u)) >> 16; }
__device__ __forceinline__ unsigned pk2(float lo, float hi) { return f2bf(lo) | (f2bf(hi) << 16); }

#define XB_TMO      128
#define XB_XCNT(j)  (256  + 64 * (j))
#define XB_XSUB(j)  (1280 + 64 * (j))
#define XB_XGEN(j)  (2304 + 64 * (j))
#define XB_TOP      3328
#define XB_TOPGEN   3392
#define XCD_BAR_WORDS 3456
#ifdef DEBUG_ORACLE
#define XB_SPIN_CAP (1u << 27)
#else
#define XB_SPIN_CAP (1u << 18)
#endif

__device__ __forceinline__ unsigned xb_ld(unsigned* p)              { return __hip_atomic_load(p, __ATOMIC_RELAXED, __HIP_MEMORY_SCOPE_AGENT); }
__device__ __forceinline__ unsigned xb_add(unsigned* p, unsigned v) { return __hip_atomic_fetch_add(p, v, __ATOMIC_RELAXED, __HIP_MEMORY_SCOPE_AGENT); }
__device__ __forceinline__ unsigned xb_xcc_id() { return (unsigned)__builtin_amdgcn_s_getreg((3 << 11) | 20) & 0xFu; }
#define XB_SPIN(cond, bar) do { unsigned _sp = 0; while (cond) { __builtin_amdgcn_s_sleep(1); \
    if ((++_sp & 255u) == 0u) { if (xb_ld(&(bar)[XB_TMO])) break; if (_sp > XB_SPIN_CAP) { atomicAdd(&(bar)[XB_TMO], 1u); break; } } } } while (0)

struct XcdBarrier {
    unsigned* bar; unsigned x;
    volatile LAS unsigned* st;
};

__device__ __forceinline__ XcdBarrier xcd_barrier_post(unsigned* bar, volatile LAS unsigned* st) {
    XcdBarrier b; b.bar = bar; b.x = xb_xcc_id(); b.st = st;
    if (threadIdx.x == 0) (void)xb_add(&bar[XB_XCNT(b.x)], 1u);
    return b;
}
__device__ __forceinline__ void xcd_barrier_complete(unsigned* bar, unsigned x, unsigned& nloc, unsigned& nx) {
    const unsigned G = gridDim.x * gridDim.y * gridDim.z;
    unsigned sum, cnt, mine, sp = 0u;
    for (;;) {
        sum = 0u; cnt = 0u; mine = 0u;
#pragma unroll
        for (unsigned j = 0; j < 16; ++j) { const unsigned c = xb_ld(&bar[XB_XCNT(j)]); sum += c; cnt += (c > 0u) ? 1u : 0u; mine = (j == x) ? c : mine; }
        if (sum == G) break;
        __builtin_amdgcn_s_sleep(1);
        if ((++sp & 255u) == 0u) { if (xb_ld(&bar[XB_TMO])) break; if (sp > XB_SPIN_CAP) { atomicAdd(&bar[XB_TMO], 1u); break; } }
    }
    nloc = mine > 0u ? mine : 1u; nx = cnt > 0u ? cnt : 1u;
}

__device__ __forceinline__ void xcd_barrier(const XcdBarrier& b) {
    asm volatile("s_waitcnt vmcnt(0)" ::: "memory");
    __syncthreads();
    if (threadIdx.x == 0) {
        unsigned* bar = b.bar;
        __builtin_amdgcn_s_waitcnt(0);
        unsigned nloc = b.st[0], nx = b.st[1];
        if (nloc == 0u) { xcd_barrier_complete(bar, b.x, nloc, nx); b.st[0] = nloc; b.st[1] = nx; }
        const unsigned old = xb_add(&bar[XB_XSUB(b.x)], 1u);
        const unsigned gen = old / nloc;
        if (old + 1u == (gen + 1u) * nloc) {
            __builtin_amdgcn_fence(__ATOMIC_RELEASE, "agent");
            asm volatile("s_waitcnt vmcnt(0)" ::: "memory");
            const unsigned og = xb_add(&bar[XB_TOP], 1u);
            const unsigned tg = og / nx;
            if (og + 1u == (tg + 1u) * nx) xb_add(&bar[XB_TOPGEN], 1u);
            else XB_SPIN(xb_ld(&bar[XB_TOPGEN]) == tg, bar);
            __builtin_amdgcn_fence(__ATOMIC_ACQUIRE, "agent");
            xb_add(&bar[XB_XGEN(b.x)], 1u);
            asm volatile("s_waitcnt vmcnt(0)" ::: "memory");
        } else {
            XB_SPIN(xb_ld(&bar[XB_XGEN(b.x)]) == gen, bar);
            __builtin_amdgcn_fence(__ATOMIC_ACQUIRE, "agent");
            asm volatile("s_waitcnt vmcnt(0)" ::: "memory");
        }
    }
    __syncthreads();
}
constexpr int NWAVES = 8, NTHR = 512;
constexpr int DM = 2048, SEQ = 2048, NBATCH = 8, TDEC = 16, MPROMPT = NBATCH * SEQ  , MSAMPLE = NBATCH * TDEC  , MREAL = MPROMPT + MSAMPLE  , MPAD = 16640  ;
constexpr int DIN = 7424, DATTN = 1024, DSGU = 1024, WINDOW = 128, CHUNK = 64, NHEADS = 16, HD = 64;
constexpr int NEXP = 16384, PEER_H = 8, PEER_K = 16;
#ifndef PEER_FP4
#define PEER_FP4 1
#endif
#ifndef PEER_FP6
#define PEER_FP6 (!PEER_FP4)
#endif
constexpr float PEER_SU = 64.f, PEER_SV = 16.f;
constexpr float EPS = 1e-6f, LOG2E = 1.4426950408889634f;
constexpr size_t OUT_Y = 0, OUT_KP = (size_t)MREAL * DM, OUT_VP = OUT_KP + 131072, OUT_KS = OUT_VP + 131072, OUT_VS = OUT_KS + 16384, OUT_SGU = OUT_VS + 16384, OUT_TOTAL = OUT_SGU + 131072;
constexpr size_t MiB = 1u << 20;
constexpr size_t WS_CTL = 0, CTL_ZERO_BYTES = 64 * 1024;
constexpr size_t WS_WIN = 1 * MiB;
constexpr size_t WS_WAB = 30 * MiB;
constexpr size_t WS_WOUT = 38 * MiB;
constexpr size_t WS_WQ = 46 * MiB;
constexpr size_t WS_KEYS = 54 * MiB;
constexpr size_t WS_WSM = 54 * MiB + 512 * 1024;
constexpr size_t WS_SS1 = 55 * MiB;
constexpr size_t WS_SS2 = 57 * MiB;
constexpr size_t WS_EU = 60 * MiB, WS_EV = 124 * MiB;
constexpr size_t WS_RA = 188 * MiB;
constexpr size_t WS_RB = 253 * MiB;
constexpr size_t WS_Q = WS_RB, WS_KV = WS_Q + (size_t)MPAD * 1024 * 2, WS_U = WS_KV + (size_t)MPAD * 256 * 2, WS_VS = WS_U + (size_t)MPAD * 1024 * 2;
constexpr size_t WS_RC = 359 * MiB;
constexpr size_t WS_RATIO = WS_RC, WS_SB = WS_RC + 65 * MiB, WS_END = WS_RC + 130 * MiB;
static_assert(WS_VS + (size_t)MPAD * 1024 * 2 <= WS_RC && WS_END == 489 * MiB, "d_ws map");
constexpr int CW_BAR = 4096;
constexpr int RING_OFF = 0, RING_BYTES = 131072;
constexpr int LDSCTL_OFF = RING_BYTES, MISC_OFF = LDSCTL_OFF + 320;
constexpr int LDS_BYTES = 147456;
struct Frame {
    LAS unsigned char* lds; volatile LAS unsigned* MISC; gu32* ctl;
    int wave, vcu, G;
    const float *x_prompt, *x_sample, *cache_k, *cache_v, *norm_mix_g, *w_in, *sgu_norm_g, *sgu_w_s, *sgu_b_s, *sinks, *rel_tab, *w_pa, *w_pb, *w_out, *norm_ffn_g, *w_query, *sub_keys, *exp_u, *exp_v, *norm_final_g;
    float* out; unsigned char* ws;
};
__device__ __forceinline__ float wave_sum(float v) {
#pragma unroll
    for (int o = 1; o < 64; o <<= 1) v += __shfl_xor(v, o);
    return v;
}
__device__ __forceinline__ unsigned pkb(float lo, float hi) { return pg8::pk_bf16(lo, hi); }
__device__ __forceinline__ unsigned pkh(float lo, float hi) { return pg8::pk_f16(lo, hi); }
template <bool F16>
__device__ __forceinline__ void p0_transpose_item(const float* W, int N, bf16* WT, int kpitch, int koff, int drow0, int k0, int n0, const float* kscale, LAS float* scr, int lane) {
    float wv[32];
#pragma unroll
    for (int i = 0; i < 32; ++i) { const int kk = 2 * i + (lane >> 5); wv[i] = __builtin_nontemporal_load(W + (size_t)(k0 + kk) * N + n0 + (lane & 31)); }
#pragma unroll
    for (int i = 0; i < 32; ++i) { const int kk = 2 * i + (lane >> 5); scr[kk * 33 + (lane & 31)] = wv[i]; }
    LDS_WAIT(); asm volatile("" ::: "memory");
    const int c = lane & 7;
    float sc[8];
#pragma unroll
    for (int q = 0; q < 8; ++q) sc[q] = kscale ? kscale[k0 + 8 * c + q] : 1.f;
#pragma unroll
    for (int j = 0; j < 4; ++j) { const int n = (lane >> 3) + 8 * j; const LAS float* s = scr + (8 * c) * 33 + n;
        float v[8];
#pragma unroll
        for (int q = 0; q < 8; ++q) v[q] = s[q * 33] * sc[q];
        v4u o;
        if (F16) { o.x = pkh(v[0], v[1]); o.y = pkh(v[2], v[3]); o.z = pkh(v[4], v[5]); o.w = pkh(v[6], v[7]); }
        else     { o.x = pkb(v[0], v[1]); o.y = pkb(v[2], v[3]); o.z = pkb(v[4], v[5]); o.w = pkb(v[6], v[7]); }
        *(GAS v4u*)(WT + (size_t)(drow0 + n) * kpitch + koff + k0 + 8 * c) = o; }
    LDS_WAIT(); asm volatile("" ::: "memory");
}
__device__ __forceinline__ int win_row_of_col(int n) {
    if (n < 3328) return n;
    if (n < 5376) { const int q = n - 3328; return 3328 + (q >> 7) * 256 + (q & 127); }
    const int q = n - 5376; return 3328 + (q >> 7) * 256 + 128 + (q & 127);
}
__device__ __forceinline__ void rms_row_to_bf16(const float* xrow, const float* g, bf16* orow, int lane) {
    const GAS f32x4* xr = (const GAS f32x4*)xrow + lane; const GAS f32x4* gr = (const GAS f32x4*)g + lane;
    f32x4 v[8]; float s = 0.f;
#pragma unroll
    for (int j = 0; j < 8; ++j) { v[j] = xr[64 * j]; s += (v[j].x * v[j].x + v[j].y * v[j].y) + (v[j].z * v[j].z + v[j].w * v[j].w); }
    const float r = 1.0f / sqrtf(wave_sum(s) * (1.f / DM) + EPS);
    GAS unsigned long long* o8 = (GAS unsigned long long*)orow + lane;
#pragma unroll
    for (int j = 0; j < 8; ++j) { const f32x4 gg = gr[64 * j]; o8[64 * j] = (unsigned long long)pkb(v[j].x * r * gg.x, v[j].y * r * gg.y) | ((unsigned long long)pkb(v[j].z * r * gg.z, v[j].w * r * gg.w) << 32); }
}
__device__ __forceinline__ void p0_transposes(Frame& F, int first, int last, int gw, int NGW) {
    const int lane = pg8::lane_id_v();
    LAS float* scr = (LAS float*)(F.lds + RING_OFF + F.wave * 16384);
    bf16* WIN = (bf16*)(F.ws + WS_WIN); bf16* WAB = (bf16*)(F.ws + WS_WAB); bf16* WOUT = (bf16*)(F.ws + WS_WOUT); bf16* WQ = (bf16*)(F.ws + WS_WQ);
    constexpr int I_IN = 32 * 232, I_PA = 16 * 64, I_OUT = 32 * 64;
    for (int it = first + gw; it < last; it += NGW) {
        int r = it;
        if (r < I_IN) { const int kb = r / 232, nb = r % 232; p0_transpose_item<false>(F.w_in, DIN, WIN, 2048, 0, win_row_of_col(32 * nb), 64 * kb, 32 * nb, nullptr, scr, lane); continue; } r -= I_IN;
        if (r < I_PA) { const int kb = r / 64, nb = r % 64; p0_transpose_item<false>(F.w_pa, 2048, WAB, 2048, 0, 32 * nb, 64 * kb, 32 * nb, nullptr, scr, lane); continue; } r -= I_PA;
        if (r < I_PA) { const int kb = r / 64, nb = r % 64; p0_transpose_item<false>(F.w_pb, 2048, WAB, 2048, 1024, 32 * nb, 64 * kb, 32 * nb, nullptr, scr, lane); continue; } r -= I_PA;
        if (r < I_OUT) { const int kb = r / 64, nb = r % 64; p0_transpose_item<false>(F.w_out, 2048, WOUT, 2048, 0, 32 * nb, 64 * kb, 32 * nb, nullptr, scr, lane); continue; } r -= I_OUT;
        { const int kb = r / 64, nb = r % 64; p0_transpose_item<true>(F.w_query, 2048, WQ, 2048, 0, 32 * nb, 64 * kb, 32 * nb, F.norm_ffn_g, scr, lane); }
    }
}
__device__ __forceinline__ void p0_expert_tables(Frame& F, int rank, int nranks) {
    const int lane = pg8::lane_id_v(), tid = F.wave * 64 + lane;
    const size_t gt = (size_t)rank * NTHR + tid, NT = (size_t)nranks * NTHR;
#if PEER_FP4
    { unsigned char* EU4 = F.ws + WS_EU; float* EUS = (float*)(F.ws + WS_EU + 16 * MiB); unsigned char* EV4 = F.ws + WS_EU + 32 * MiB; float* EVS = (float*)(F.ws + WS_EU + 48 * MiB);
        const int gwv = rank * NWAVES + F.wave, nwv = nranks * NWAVES;
        for (int row = gwv; row < NEXP; row += nwv) { const size_t c = (size_t)row * 64 + lane; float fu[32], fv[32]; float mu = 0.f, mv = 0.f;
#pragma unroll
            for (int q = 0; q < 8; ++q) { const size_t eo = (size_t)row * DM + q * 256 + lane * 4;
                const f32x4 a = __builtin_nontemporal_load((const GAS f32x4*)(F.exp_u + eo)) * *(const GAS f32x4*)(F.norm_ffn_g + q * 256 + lane * 4); const f32x4 p = __builtin_nontemporal_load((const GAS f32x4*)(F.exp_v + eo));
#pragma unroll
                for (int e = 0; e < 4; ++e) { fu[4 * q + e] = a[e]; fv[4 * q + e] = p[e]; mu = fmaxf(mu, fabsf(a[e])); mv = fmaxf(mv, fabsf(p[e])); } }
#pragma unroll
            for (int o = 1; o < 64; o <<= 1) { mu = fmaxf(mu, __shfl_xor(mu, o)); mv = fmaxf(mv, __shfl_xor(mv, o)); }
            const float su = fmaxf(mu, 1e-30f) * (1.0f / 6.0f), sv = fmaxf(mv, 1e-30f) * (1.0f / 6.0f), iu = 1.0f / su, iv = 1.0f / sv;
            v4u wu, wv;
#pragma unroll
            for (int q = 0; q < 4; ++q) { unsigned a = 0u, b2 = 0u;
                a = __builtin_amdgcn_cvt_scalef32_pk_fp4_f32(a, fu[8 * q + 0] * iu, fu[8 * q + 1] * iu, 1.0f, 0); a = __builtin_amdgcn_cvt_scalef32_pk_fp4_f32(a, fu[8 * q + 2] * iu, fu[8 * q + 3] * iu, 1.0f, 1);
                a = __builtin_amdgcn_cvt_scalef32_pk_fp4_f32(a, fu[8 * q + 4] * iu, fu[8 * q + 5] * iu, 1.0f, 2); a = __builtin_amdgcn_cvt_scalef32_pk_fp4_f32(a, fu[8 * q + 6] * iu, fu[8 * q + 7] * iu, 1.0f, 3);
                b2 = __builtin_amdgcn_cvt_scalef32_pk_fp4_f32(b2, fv[8 * q + 0] * iv, fv[8 * q + 1] * iv, 1.0f, 0); b2 = __builtin_amdgcn_cvt_scalef32_pk_fp4_f32(b2, fv[8 * q + 2] * iv, fv[8 * q + 3] * iv, 1.0f, 1);
                b2 = __builtin_amdgcn_cvt_scalef32_pk_fp4_f32(b2, fv[8 * q + 4] * iv, fv[8 * q + 5] * iv, 1.0f, 2); b2 = __builtin_amdgcn_cvt_scalef32_pk_fp4_f32(b2, fv[8 * q + 6] * iv, fv[8 * q + 7] * iv, 1.0f, 3);
                wu[q] = a; wv[q] = b2; }
            *(GAS v4u*)(EU4 + c * 16) = wu; *(GAS v4u*)(EV4 + c * 16) = wv; if (lane == 0) { EUS[row] = su; EVS[row] = sv; } } }
#elif PEER_FP6
    { unsigned char* EU6 = F.ws + WS_EU; unsigned char* EV6 = F.ws + WS_EU + 32 * MiB;
        typedef _Float16 h32v __attribute__((ext_vector_type(32))); typedef unsigned u6v __attribute__((ext_vector_type(6)));
        for (size_t c = gt; c < (size_t)NEXP * 64; c += NT) { const int d0 = (int)((c * 32) & (DM - 1)); h32v hu, hv;
#pragma unroll
            for (int q = 0; q < 8; ++q) { const f32x4 a = *(const GAS f32x4*)(F.exp_u + c * 32 + q * 4) * *(const GAS f32x4*)(F.norm_ffn_g + d0 + q * 4) * PEER_SU; const f32x4 p = *(const GAS f32x4*)(F.exp_v + c * 32 + q * 4) * PEER_SV;
                hu[4 * q] = (_Float16)a.x; hu[4 * q + 1] = (_Float16)a.y; hu[4 * q + 2] = (_Float16)a.z; hu[4 * q + 3] = (_Float16)a.w; hv[4 * q] = (_Float16)p.x; hv[4 * q + 1] = (_Float16)p.y; hv[4 * q + 2] = (_Float16)p.z; hv[4 * q + 3] = (_Float16)p.w; }
            const u6v pu = __builtin_amdgcn_cvt_scalef32_pk32_fp6_f16(hu, 1.0f), pv = __builtin_amdgcn_cvt_scalef32_pk32_fp6_f16(hv, 1.0f);
            typedef unsigned u2v __attribute__((ext_vector_type(2)));
            GAS u2v* du = (GAS u2v*)(EU6 + c * 24); GAS u2v* dv = (GAS u2v*)(EV6 + c * 24);
            du[0] = (u2v){pu[0], pu[1]}; du[1] = (u2v){pu[2], pu[3]}; du[2] = (u2v){pu[4], pu[5]}; dv[0] = (u2v){pv[0], pv[1]}; dv[1] = (u2v){pv[2], pv[3]}; dv[2] = (u2v){pv[4], pv[5]}; } }
#endif
}
#ifndef P0_LATE_W
#define P0_LATE_W 1
#endif
#ifndef P0_PIPE
#define P0_PIPE 1
#endif
__device__ __forceinline__ void p0_prologue(Frame& F) {
    const int lane = pg8::lane_id_v(), tid = F.wave * 64 + lane;
    const int gw = F.vcu * NWAVES + F.wave, NGW = F.G * NWAVES;
#if P0_LATE_W
    p0_transposes(F, 0, 32 * 232, gw, NGW);
#else
    p0_transposes(F, 0, 32 * 232 + 2 * 16 * 64 + 2 * 32 * 64, gw, NGW);
#endif
    bf16* XN = (bf16*)(F.ws + WS_RA);
#if P0_PIPE
    {
        f32x4 v[8], nx[8];
        const GAS f32x4* gr = (const GAS f32x4*)F.norm_mix_g + lane;
        int m = gw;
        if (m < MREAL) { const GAS f32x4* xr = (const GAS f32x4*)((m < MPROMPT) ? F.x_prompt + (size_t)m * DM : F.x_sample + (size_t)(m - MPROMPT) * DM) + lane;
#pragma unroll
            for (int j = 0; j < 8; ++j) v[j] = xr[64 * j]; }
        for (; m < MPAD; m += NGW) {
            const int mn = m + NGW;
            if (mn < MREAL) { const GAS f32x4* xr = (const GAS f32x4*)((mn < MPROMPT) ? F.x_prompt + (size_t)mn * DM : F.x_sample + (size_t)(mn - MPROMPT) * DM) + lane;
#pragma unroll
                for (int j = 0; j < 8; ++j) nx[j] = xr[64 * j]; }
            if (m < MREAL) {
                float s = 0.f;
#pragma unroll
                for (int j = 0; j < 8; ++j) s += (v[j].x * v[j].x + v[j].y * v[j].y) + (v[j].z * v[j].z + v[j].w * v[j].w);
                const float r = 1.0f / sqrtf(wave_sum(s) * (1.f / DM) + EPS);
                GAS unsigned long long* o8 = (GAS unsigned long long*)(XN + (size_t)m * DM) + lane;
#pragma unroll
                for (int j = 0; j < 8; ++j) { const f32x4 gg = gr[64 * j]; o8[64 * j] = (unsigned long long)pkb(v[j].x * r * gg.x, v[j].y * r * gg.y) | ((unsigned long long)pkb(v[j].z * r * gg.z, v[j].w * r * gg.w) << 32); }
            } else { GAS v4u* o = (GAS v4u*)(XN + (size_t)m * DM) + lane;
#pragma unroll
                for (int j = 0; j < 4; ++j) o[64 * j] = (v4u){0u, 0u, 0u, 0u}; }
#pragma unroll
            for (int j = 0; j < 8; ++j) v[j] = nx[j];
        }
    }
#else
    for (int m = gw; m < MPAD; m += NGW) {
        if (m < MPROMPT) rms_row_to_bf16(F.x_prompt + (size_t)m * DM, F.norm_mix_g, XN + (size_t)m * DM, lane);
        else if (m < MREAL) rms_row_to_bf16(F.x_sample + (size_t)(m - MPROMPT) * DM, F.norm_mix_g, XN + (size_t)m * DM, lane);
        else { GAS v4u* o = (GAS v4u*)(XN + (size_t)m * DM) + lane;
#pragma unroll
            for (int j = 0; j < 4; ++j) o[64 * j] = (v4u){0u, 0u, 0u, 0u}; }
    }
#endif
    const size_t gt = (size_t)F.vcu * NTHR + tid, NT = (size_t)F.G * NTHR;
    { bf16* KH = (bf16*)(F.ws + WS_KEYS);
        for (size_t c = gt; c < 262144 / 8; c += NT) { const f32x4 a = *(const GAS f32x4*)(F.sub_keys + c * 8), b = *(const GAS f32x4*)(F.sub_keys + c * 8 + 4);
            *(GAS v4u*)(KH + c * 8) = (v4u){pkh(a.x, a.y), pkh(a.z, a.w), pkh(b.x, b.y), pkh(b.z, b.w)}; } }
    { bf16* WSM = (bf16*)(F.ws + WS_WSM);
        for (size_t c = gt; c < 131072 / 8; c += NT) { f32x4 a = *(const GAS f32x4*)(F.sgu_w_s + c * 8), b = *(const GAS f32x4*)(F.sgu_w_s + c * 8 + 4);
            const int t = (int)((c * 8) >> 7) & 127, s0 = (int)(c * 8) & 127;
#pragma unroll
            for (int e = 0; e < 4; ++e) { if (s0 + e > t) a[e] = 0.f; if (s0 + 4 + e > t) b[e] = 0.f; }
            *(GAS v4u*)(WSM + c * 8) = (v4u){pkb(a.x, a.y), pkb(a.z, a.w), pkb(b.x, b.y), pkb(b.z, b.w)}; } }
}
typedef float f32x16 __attribute__((ext_vector_type(16)));
typedef short s16x4 __attribute__((ext_vector_type(4)));
typedef short v4i16_t __attribute__((ext_vector_type(4)));
__device__ __forceinline__ int crow(int r, int hi) { return (r & 3) + 8 * (r >> 2) + 4 * hi; }
__device__ __forceinline__ s16x4 vtr(const LAS unsigned char* p) { return __builtin_bit_cast(s16x4, __builtin_amdgcn_ds_read_tr16_b64_v4i16((LAS v4i16_t*)p)); }
__device__ __forceinline__ bf16 bf1(float x) { return (bf16)(pkb(x, 0.f) & 0xffffu); }
__device__ __forceinline__ float bf2f(bf16 b) { return __builtin_bit_cast(float, (unsigned)b << 16); }
__device__ __forceinline__ float half_max(float m) { return fmaxf(m, __builtin_bit_cast(float, pg8::partner32(__builtin_bit_cast(unsigned, m)))); }
__device__ __forceinline__ float half_sum(float m) { return m + __builtin_bit_cast(float, pg8::partner32(__builtin_bit_cast(unsigned, m))); }
constexpr int P2_KL = 0, P2_VL = 24576, P2_BIAS = 49152, P2_OST = 65536, P2_GL = 0, P2_RL = 32768, P2_SST = 65536;
constexpr int N_ATT_UNITS = 512 + 16, N_SGU_UNITS = 1024 + 64;

struct AttnDesc { int b, c, kvh, qrow0, nqb, jlo, jhi; bool sample; };
__device__ __forceinline__ AttnDesc attn_desc(int uid) { AttnDesc d; d.sample = uid >= 512; d.c = 0;
    if (!d.sample) { d.b = uid >> 6; d.c = (uid >> 1) & 31; d.kvh = uid & 1; d.qrow0 = d.b * SEQ + d.c * CHUNK; d.nqb = 2; d.jlo = 128 - 64 * d.c; if (d.jlo < 0) d.jlo = 0; d.jhi = 192; }
    else { const int s = uid - 512; d.b = s >> 1; d.kvh = s & 1; d.qrow0 = MPROMPT + d.b * TDEC; d.nqb = 1; d.jlo = 0; d.jhi = 144; }
    return d; }
__device__ __forceinline__ void attn_kv_load(Frame& F, const AttnDesc& d, int, v4u (&kq)[3], v4u (&vq)[3]) {
    const int tid = F.wave * 64 + pg8::lane_id_v();
    const bf16* KV = (const bf16*)(F.ws + WS_KV);
#pragma unroll
    for (int i = 0; i < 3; ++i) { const int idx = tid + 512 * i, key = idx >> 3, ch = idx & 7; kq[i] = (v4u){0u, 0u, 0u, 0u}; vq[i] = (v4u){0u, 0u, 0u, 0u};
        if (!d.sample) { const int pos = d.c * CHUNK - WINDOW + key; if (pos >= 0) { const bf16* rp = KV + (size_t)(d.b * SEQ + pos) * 256 + d.kvh * 64 + ch * 8; kq[i] = *(const GAS v4u*)rp; vq[i] = *(const GAS v4u*)(rp + 128); } }
        else if (key < 128) { const size_t o = ((size_t)(d.b * WINDOW + key) * 2 + d.kvh) * 64 + ch * 8;
            const f32x4 a = *(const GAS f32x4*)(F.cache_k + o), a2 = *(const GAS f32x4*)(F.cache_k + o + 4), p = *(const GAS f32x4*)(F.cache_v + o), p2 = *(const GAS f32x4*)(F.cache_v + o + 4);
            kq[i] = (v4u){pkb(a.x, a.y), pkb(a.z, a.w), pkb(a2.x, a2.y), pkb(a2.z, a2.w)}; vq[i] = (v4u){pkb(p.x, p.y), pkb(p.z, p.w), pkb(p2.x, p2.y), pkb(p2.z, p2.w)}; }
        else if (key < 144) { const bf16* rp = KV + (size_t)(MPROMPT + d.b * TDEC + key - 128) * 256 + d.kvh * 64 + ch * 8; kq[i] = *(const GAS v4u*)rp; vq[i] = *(const GAS v4u*)(rp + 128); } }
}
__device__ __forceinline__ void attn_kv_store(Frame& F, int, const v4u (&kq)[3], const v4u (&vq)[3]) {
    const int tid = F.wave * 64 + pg8::lane_id_v();
    LAS unsigned char* KL = F.lds + P2_KL; LAS unsigned char* VL = F.lds + P2_VL;
#pragma unroll
    for (int i = 0; i < 3; ++i) { const int idx = tid + 512 * i, key = idx >> 3, ch = idx & 7; *(LAS v4u*)(KL + ch * 3072 + key * 16) = kq[i]; *(LAS v4u*)(VL + (ch >> 2) * 12288 + key * 64 + (ch & 3) * 16) = vq[i]; }
}
template <bool MASK> __device__ __forceinline__ void attn_compute(Frame& F, const AttnDesc& d, bf16x8 (&qr)[4]) {
    const int lane = pg8::lane_id_v();
    const int w = F.wave, r = lane & 31, h = lane >> 5;
    LAS unsigned char* KL = F.lds + P2_KL; LAS unsigned char* VL = F.lds + P2_VL; const LAS float* BL = (const LAS float*)(F.lds + P2_BIAS); LAS unsigned char* OST = F.lds + P2_OST + w * 4096;
    const bf16* Q = (const bf16*)(F.ws + WS_Q); bf16* OS = (bf16*)(F.ws + WS_RA);
    const int hd = d.kvh * 8 + w; const float sink2 = F.sinks[hd] * LOG2E; const LAS float* bl = BL + hd * 256;
    const int vlane = (4 * h + ((lane & 15) >> 2)) * 64 + (((lane >> 4) & 1) * 16 + (lane & 3) * 4) * 2;
    for (int qb = 0; qb < d.nqb; ++qb) {
        const int qi = qb * 32 + r;
        f32x16 S[6];
#pragma unroll
        for (int kb = 0; kb < 6; ++kb) { f32x16 a = {};
#pragma unroll
            for (int ks = 0; ks < 4; ++ks) { const bf16x8 kf = *(const LAS bf16x8*)(KL + (2 * ks + h) * 3072 + (kb * 32 + r) * 16); a = __builtin_amdgcn_mfma_f32_32x32x16_bf16(kf, qr[ks], a, 0, 0, 0); }
            S[kb] = a; asm volatile("" ::: "memory"); }
        if (qb + 1 < d.nqb) { const int qrow_n = d.qrow0 + (qb + 1) * 32 + r;
#pragma unroll
            for (int ks = 0; ks < 4; ++ks) qr[ks] = *(const GAS bf16x8*)(Q + (size_t)qrow_n * 1024 + hd * 64 + ks * 16 + h * 8); }
        float mx = -1e30f;
        const LAS float* blq = bl + (63 - qi + 4 * h);
        if (MASK) {
#pragma unroll
            for (int kb = 0; kb < 6; ++kb)
#pragma unroll
                for (int i = 0; i < 16; ++i) { const int j = kb * 32 + crow(i, h); float t = S[kb][i] + blq[kb * 32 + (i & 3) + 8 * (i >> 2)]; t = (j >= d.jlo && j < d.jhi) ? t : -1e30f; S[kb][i] = t; mx = fmaxf(mx, t); }
        } else {
#pragma unroll
            for (int kb = 0; kb < 6; ++kb)
#pragma unroll
                for (int i = 0; i < 16; ++i) { const float t = S[kb][i] + blq[kb * 32 + (i & 3) + 8 * (i >> 2)]; S[kb][i] = t; mx = fmaxf(mx, t); }
        }
        mx = fmaxf(half_max(mx), sink2);
        float l = 0.f;
#pragma unroll
        for (int kb = 0; kb < 6; ++kb)
#pragma unroll
            for (int i = 0; i < 16; ++i) { const float e = __builtin_amdgcn_exp2f(S[kb][i] - mx); S[kb][i] = e; l += e; }
        l = half_sum(l) + __builtin_amdgcn_exp2f(sink2 - mx);
        const float inv = 1.0f / l;
        f32x16 O[2]; O[0] = f32x16{}; O[1] = f32x16{};
#pragma unroll
        for (int kb = 0; kb < 6; ++kb)
#pragma unroll
            for (int s2 = 0; s2 < 2; ++s2) { v4u wv; wv.x = pkb(S[kb][8 * s2 + 0] * inv, S[kb][8 * s2 + 1] * inv); wv.y = pkb(S[kb][8 * s2 + 2] * inv, S[kb][8 * s2 + 3] * inv);
                wv.z = pkb(S[kb][8 * s2 + 4] * inv, S[kb][8 * s2 + 5] * inv); wv.w = pkb(S[kb][8 * s2 + 6] * inv, S[kb][8 * s2 + 7] * inv); const bf16x8 pa = __builtin_bit_cast(bf16x8, wv);
#pragma unroll
                for (int db = 0; db < 2; ++db) { const LAS unsigned char* vp = VL + db * 12288 + (kb * 32 + s2 * 16) * 64 + vlane; const s16x4 lo = vtr(vp), hi = vtr(vp + 8 * 64);
                    const bf16x8 vf = (bf16x8){lo[0], lo[1], lo[2], lo[3], hi[0], hi[1], hi[2], hi[3]}; O[db] = __builtin_amdgcn_mfma_f32_32x32x16_bf16(pa, vf, O[db], 0, 0, 0); } }
#pragma unroll
        for (int db = 0; db < 2; ++db)
#pragma unroll
            for (int i = 0; i < 16; ++i) *(LAS bf16*)(OST + (crow(i, h) * 64 + db * 32 + r) * 2) = bf1(O[db][i]);
        LDS_WAIT(); asm volatile("" ::: "memory");
#pragma unroll
        for (int it = 0; it < 4; ++it) { const int row = it * 8 + (lane >> 3), ch = lane & 7; const v4u v = *(const LAS v4u*)(OST + row * 128 + ch * 16);
            if (!d.sample || row < TDEC) *(GAS v4u*)(OS + (size_t)(d.qrow0 + qb * 32 + row) * 2048 + hd * 64 + ch * 8) = v; }
        LDS_WAIT(); asm volatile("" ::: "memory");
    }
}
__device__ __forceinline__ void attn_q_load0(Frame& F, const AttnDesc& d, bf16x8 (&qr)[4]) {
    const int lane = pg8::lane_id_v(), r = lane & 31, h = lane >> 5; const bf16* Q = (const bf16*)(F.ws + WS_Q); const int hd = d.kvh * 8 + F.wave;
    const int qrow = d.qrow0 + (d.sample ? (r & 15) : r);
#pragma unroll
    for (int ks = 0; ks < 4; ++ks) qr[ks] = *(const GAS bf16x8*)(Q + (size_t)qrow * 1024 + hd * 64 + ks * 16 + h * 8);
}
__device__ __forceinline__ void attn_units(Frame& F) {
    for (int u = F.vcu; u < N_ATT_UNITS; u += F.G) {
        bf16x8 qr[4];
        { v4u kq[3], vq[3]; const AttnDesc d0 = attn_desc(u); attn_kv_load(F, d0, 0, kq, vq); attn_q_load0(F, d0, qr); attn_kv_store(F, 0, kq, vq); }
        __syncthreads();
        { const AttnDesc d = attn_desc(u); if (d.jlo == 0 && d.jhi == 192) attn_compute<false>(F, d, qr); else attn_compute<true>(F, d, qr); }
        LDS_WAIT(); __builtin_amdgcn_s_barrier(); asm volatile("" ::: "memory");
    }
}

struct SguOps { v4u gvq[4]; float ssp[4]; bf16x8 af[8]; v4u uq[4]; float bs[4]; f32x4 sg0, sg1; };
__device__ __forceinline__ void sgu_load(Frame& F, const int uid, SguOps& R) {
    const int lane = pg8::lane_id_v(), w = F.wave, tid = w * 64 + lane, r = lane & 31, h = lane >> 5;
    LAS unsigned char* GL = F.lds + P2_GL;
    const bf16* VS = (const bf16*)(F.ws + WS_VS); const bf16* U = (const bf16*)(F.ws + WS_U); const bf16* WSM = (const bf16*)(F.ws + WS_WSM); const float* SS1 = (const float*)(F.ws + WS_SS1); bf16* OS = (bf16*)(F.ws + WS_RA);
    const bool sample = uid >= 1024; int b, g, row0, nv;
    if (!sample) { b = uid >> 7; const int blk = (uid >> 3) & 15; g = uid & 7; row0 = b * SEQ + blk * 128; nv = 128; }
    else { const int s = uid - 1024; b = s >> 3; g = s & 7; row0 = MPROMPT + b * TDEC; nv = TDEC; }
    const int wr = w >> 1, wc = w & 1; const bool active = 32 * wr < nv; const int nks = 2 * (wr + 1);
    const int er = lane >> 3, ec = (lane & 7) * 8;
    (void)GL; (void)VS; (void)U; (void)WSM; (void)SS1; (void)OS; (void)b; (void)r; (void)h; (void)tid; (void)nks; (void)er; (void)ec; (void)active;
#pragma unroll
    for (int i = 0; i < 4; ++i) { const int idx = tid + 512 * i, s = idx >> 4, ch = idx & 15; R.gvq[i] = (v4u){0u, 0u, 0u, 0u}; R.ssp[i] = 0.f;
        if (s < nv) { R.gvq[i] = *(const GAS v4u*)(VS + (size_t)(row0 + s) * 1024 + g * 128 + ch * 8); R.ssp[i] = SS1[(size_t)(row0 + s) * 16 + ch]; } }
    if (active) {
#pragma unroll
        for (int ks = 0; ks < 8; ++ks) { R.af[ks] = (bf16x8){0, 0, 0, 0, 0, 0, 0, 0}; if (ks < nks) R.af[ks] = *(const GAS bf16x8*)(WSM + (size_t)(g * 128 + 32 * wr + r) * 128 + 16 * ks + 8 * h); }
        R.sg0 = *(const GAS f32x4*)(F.sgu_norm_g + g * 128 + 64 * wc + ec); R.sg1 = *(const GAS f32x4*)(F.sgu_norm_g + g * 128 + 64 * wc + ec + 4);
#pragma unroll
        for (int c = 0; c < 4; ++c) { const int t = 32 * wr + 8 * c + er; R.uq[c] = (v4u){0u, 0u, 0u, 0u}; R.bs[c] = F.sgu_b_s[g * 128 + t];
            if (t < nv) R.uq[c] = *(const GAS v4u*)(U + (size_t)(row0 + t) * 1024 + g * 128 + 64 * wc + ec); }
    }
}
__device__ __forceinline__ void sgu_process(Frame& F, const int uid, SguOps& R) {
    const int lane = pg8::lane_id_v(), w = F.wave, tid = w * 64 + lane, r = lane & 31, h = lane >> 5;
    LAS unsigned char* GL = F.lds + P2_GL;
    const bf16* VS = (const bf16*)(F.ws + WS_VS); const bf16* U = (const bf16*)(F.ws + WS_U); const bf16* WSM = (const bf16*)(F.ws + WS_WSM); const float* SS1 = (const float*)(F.ws + WS_SS1); bf16* OS = (bf16*)(F.ws + WS_RA);
    const bool sample = uid >= 1024; int b, g, row0, nv;
    if (!sample) { b = uid >> 7; const int blk = (uid >> 3) & 15; g = uid & 7; row0 = b * SEQ + blk * 128; nv = 128; }
    else { const int s = uid - 1024; b = s >> 3; g = s & 7; row0 = MPROMPT + b * TDEC; nv = TDEC; }
    const int wr = w >> 1, wc = w & 1; const bool active = 32 * wr < nv; const int nks = 2 * (wr + 1);
    const int er = lane >> 3, ec = (lane & 7) * 8;
    (void)GL; (void)VS; (void)U; (void)WSM; (void)SS1; (void)OS; (void)b; (void)r; (void)h; (void)tid; (void)nks; (void)er; (void)ec; (void)active;
#pragma unroll
    for (int i = 0; i < 4; ++i) { const int idx = tid + 512 * i, s = idx >> 4, ch = idx & 15; v4u o = (v4u){0u, 0u, 0u, 0u};
        float ss = R.ssp[i];
        ss += __builtin_bit_cast(float, __builtin_amdgcn_ds_swizzle(__builtin_bit_cast(int, ss), (1 << 10) | 0x1f)); ss += __builtin_bit_cast(float, __builtin_amdgcn_ds_swizzle(__builtin_bit_cast(int, ss), (2 << 10) | 0x1f));
        ss += __builtin_bit_cast(float, __builtin_amdgcn_ds_swizzle(__builtin_bit_cast(int, ss), (4 << 10) | 0x1f)); ss += __builtin_bit_cast(float, __builtin_amdgcn_ds_swizzle(__builtin_bit_cast(int, ss), (8 << 10) | 0x1f));
        if (s < nv) {
            const float rr = 1.0f / sqrtf(ss * (1.f / DSGU) + EPS); const v4u wv = R.gvq[i];
            float f[8] = {pg8::bf_lo(wv.x) * rr, pg8::bf_hi(wv.x) * rr, pg8::bf_lo(wv.y) * rr, pg8::bf_hi(wv.y) * rr, pg8::bf_lo(wv.z) * rr, pg8::bf_hi(wv.z) * rr, pg8::bf_lo(wv.w) * rr, pg8::bf_hi(wv.w) * rr};
            o = (v4u){pkb(f[0], f[1]), pkb(f[2], f[3]), pkb(f[4], f[5]), pkb(f[6], f[7])};
            if (sample) { const f32x4 g0 = *(const GAS f32x4*)(F.sgu_norm_g + g * 128 + ch * 8), g1 = *(const GAS f32x4*)(F.sgu_norm_g + g * 128 + ch * 8 + 4); float* dst = F.out + OUT_SGU + (size_t)(b * TDEC + s) * 1024 + g * 128 + ch * 8;
                *(GAS f32x4*)dst = (f32x4){f[0] * g0.x, f[1] * g0.y, f[2] * g0.z, f[3] * g0.w}; *(GAS f32x4*)(dst + 4) = (f32x4){f[4] * g1.x, f[5] * g1.y, f[6] * g1.z, f[7] * g1.w}; } }
        *(LAS v4u*)(GL + (ch >> 2) * 8192 + s * 64 + (ch & 3) * 16) = o; }
    LDS_WAIT(); __builtin_amdgcn_s_barrier(); asm volatile("" ::: "memory");
    if (active) {
        f32x16 acc[2]; acc[0] = f32x16{}; acc[1] = f32x16{};
        const int glane = (8 * h + ((lane & 15) >> 2)) * 64 + (((lane >> 4) & 1) * 16 + (lane & 3) * 4) * 2;
#pragma unroll
        for (int ks = 0; ks < 8; ++ks) if (ks < nks) {
#pragma unroll
            for (int cb = 0; cb < 2; ++cb) { const LAS unsigned char* gp = GL + (2 * wc + cb) * 8192 + (16 * ks) * 64 + glane; const s16x4 lo = vtr(gp), hi = vtr(gp + 4 * 64);
                const bf16x8 bb = (bf16x8){lo[0], lo[1], lo[2], lo[3], hi[0], hi[1], hi[2], hi[3]}; acc[cb] = __builtin_amdgcn_mfma_f32_32x32x16_bf16(R.af[ks], bb, acc[cb], 0, 0, 0); } }
        LAS float* STG = (LAS float*)(F.lds + P2_SST + w * 8192);
#pragma unroll
        for (int cb = 0; cb < 2; ++cb)
#pragma unroll
            for (int i = 0; i < 16; ++i) STG[crow(i, h) * 64 + 32 * cb + r] = acc[cb][i];
        LDS_WAIT(); asm volatile("" ::: "memory");
#pragma unroll
        for (int c = 0; c < 4; ++c) { const int t = 32 * wr + 8 * c + er;
            const f32x4 a0 = *(const LAS f32x4*)(STG + (8 * c + er) * 64 + ec), a1 = *(const LAS f32x4*)(STG + (8 * c + er) * 64 + ec + 4); const v4u uw = R.uq[c]; const float bb = R.bs[c];
            const v4u o = {pkb(pg8::bf_lo(uw.x) * (a0.x * R.sg0.x + bb), pg8::bf_hi(uw.x) * (a0.y * R.sg0.y + bb)), pkb(pg8::bf_lo(uw.y) * (a0.z * R.sg0.z + bb), pg8::bf_hi(uw.y) * (a0.w * R.sg0.w + bb)),
                           pkb(pg8::bf_lo(uw.z) * (a1.x * R.sg1.x + bb), pg8::bf_hi(uw.z) * (a1.y * R.sg1.y + bb)), pkb(pg8::bf_lo(uw.w) * (a1.z * R.sg1.z + bb), pg8::bf_hi(uw.w) * (a1.w * R.sg1.w + bb))};
            if (t < nv) *(GAS v4u*)(OS + (size_t)(row0 + t) * 2048 + 1024 + g * 128 + 64 * wc + ec) = o; }
    }
    LDS_WAIT(); __builtin_amdgcn_s_barrier(); asm volatile("" ::: "memory");
}
__device__ __forceinline__ int sgu_uid(const Frame& F, const int k) {
    const int u0 = F.G - 1 - F.vcu;
    if (F.G == 256 && F.vcu < 16) return k < 3 ? u0 + k * 256 : -1;
    if (F.G == 256 && F.vcu < 32) return k < 4 ? u0 + k * 256 : (k == 4 ? 1023 - (F.vcu - 16) : -1);
    const int u = u0 + k * F.G; return u < N_SGU_UNITS ? u : -1;
}
__device__ __forceinline__ void sgu_units(Frame& F) {
    SguOps A, B; int k = 0, ua = sgu_uid(F, 0);
    if (ua >= 0) sgu_load(F, ua, A);
    while (ua >= 0) {
        const int ub = sgu_uid(F, k + 1); if (ub >= 0) sgu_load(F, ub, B);
        sgu_process(F, ua, A);
        if (ub < 0) break;
        ua = sgu_uid(F, k + 2); if (ua >= 0) sgu_load(F, ua, A);
        sgu_process(F, ub, B);
        k += 2;
    }
}


__device__ __forceinline__ void p2_mixers(Frame& F) {
    LAS float* BLw = (LAS float*)(F.lds + P2_BIAS);
    { const int e0 = F.wave * 64 + pg8::lane_id_v(); float bv[8];
#pragma unroll
        for (int i = 0; i < 8; ++i) { const int e = e0 + i * NTHR, hh = e >> 8, idx = e & 255, rel = idx - 191, n = rel < 0 ? -rel : rel;
            const int v = n < 8 ? n : (n < 12 ? 8 : n < 16 ? 9 : n < 23 ? 10 : n < 32 ? 11 : n < 46 ? 12 : n < 64 ? 13 : n < 91 ? 14 : 15);
            bv[i] = F.rel_tab[((rel > 0 ? 16 : 0) + v) * 16 + hh]; }
#pragma unroll
        for (int i = 0; i < 8; ++i) { const int e = e0 + i * NTHR; BLw[e] = ((e & 255) < 255) ? bv[i] * LOG2E : 0.f; } }
    __syncthreads();
    attn_units(F);
    sgu_units(F);
#if P0_LATE_W
    __syncthreads();
    if (F.G == 256) { if (F.vcu >= 32) p0_transposes(F, 32 * 232, 32 * 232 + 2 * 16 * 64 + 2 * 32 * 64, (F.vcu - 32) * NWAVES + F.wave, 224 * NWAVES); }
    else p0_transposes(F, 32 * 232, 32 * 232 + 2 * 16 * 64 + 2 * 32 * 64, F.vcu * NWAVES + F.wave, F.G * NWAVES);
#endif
}
constexpr size_t WS_SS2S = WS_SS2 + (size_t)MPROMPT * 32 * 4;
struct SkMerge { const bf16 *RATIO, *SB; bf16* H;
    __device__ __forceinline__ void mid(f32x4& acc, int row, int col) const { const unsigned long long w = *(const GAS unsigned long long*)(RATIO + (size_t)row * 2048 + col); const unsigned lo = (unsigned)w, hi = (unsigned)(w >> 32);
        acc *= (f32x4){pg8::bf_lo(lo), pg8::bf_hi(lo), pg8::bf_lo(hi), pg8::bf_hi(hi)}; }
    __device__ __forceinline__ void fin(const f32x4 acc, int row, int col, int, int) const { const unsigned long long w = *(const GAS unsigned long long*)(SB + (size_t)row * 2048 + col); const unsigned lo = (unsigned)w, hi = (unsigned)(w >> 32);
        const f32x4 v = acc * (f32x4){pg8::bf_lo(lo), pg8::bf_hi(lo), pg8::bf_lo(hi), pg8::bf_hi(hi)};
        *(GAS unsigned long long*)(H + (size_t)row * 2048 + col) = (unsigned long long)pkb(v.x, v.y) | ((unsigned long long)pkb(v.z, v.w) << 32); } };
struct SkOut { const float* xs; bf16* XH; float* SS2S;
    __device__ __forceinline__ void mid(f32x4&, int, int) const {}
    __device__ __forceinline__ void fin(const f32x4 acc, int row, int col, int part, int fq) const { const f32x4 v = acc + *(const GAS f32x4*)(xs + (size_t)(row - MPROMPT) * 2048 + col);
        *(GAS unsigned long long*)(XH + (size_t)row * 2048 + col) = (unsigned long long)pkh(v.x, v.y) | ((unsigned long long)pkh(v.z, v.w) << 32);
        float s = (v.x * v.x + v.y * v.y) + (v.z * v.z + v.w * v.w); s += __shfl_xor(s, 16); s += __shfl_xor(s, 32);
        if (fq == 0) SS2S[(size_t)(row - MPROMPT) * 128 + part] = s; } };
struct SkQ { bf16* QP;
    __device__ __forceinline__ void mid(f32x4&, int, int) const {}
    __device__ __forceinline__ void fin(const f32x4 acc, int row, int col, int, int) const { *(GAS unsigned long long*)(QP + (size_t)row * 2048 + col) = (unsigned long long)pkh(acc.x, acc.y) | ((unsigned long long)pkh(acc.z, acc.w) << 32); } };
template <bool F16, bool MID, class Epi>
__device__ __forceinline__ void skinny_gemm(Frame& F, const bf16* A, const bf16* Bt, const Epi& E) {
    const int lane = pg8::lane_id_v(), w = F.wave, fr = lane & 15, fq = lane >> 4;
    LAS f32x4* part = (LAS f32x4*)(F.lds + RING_OFF);
    for (int job = F.vcu; job < 256; job += F.G) {
        const int rb = job & 3, cb = job >> 2;
        const bf16* ap = A + (size_t)(MPROMPT + 32 * rb + fr) * 2048 + 256 * w + 8 * fq;
        const bf16* bp = Bt + (size_t)(32 * cb + fr) * 2048 + 256 * w + 8 * fq;
        bf16x8 a0[8], a1[8], b0[8], b1[8];
#pragma unroll
        for (int u = 0; u < 8; ++u) { a0[u] = *(const GAS bf16x8*)(ap + 32 * u); a1[u] = *(const GAS bf16x8*)(ap + 16 * 2048 + 32 * u); b0[u] = *(const GAS bf16x8*)(bp + 32 * u); b1[u] = *(const GAS bf16x8*)(bp + 16 * 2048 + 32 * u); }
        f32x4 c00 = {0.f, 0.f, 0.f, 0.f}, c01 = c00, c10 = c00, c11 = c00;
#pragma unroll
        for (int u = 0; u < 8; ++u) { c00 = pg8::mma16<F16>(b0[u], a0[u], c00); c01 = pg8::mma16<F16>(b1[u], a0[u], c01); c10 = pg8::mma16<F16>(b0[u], a1[u], c10); c11 = pg8::mma16<F16>(b1[u], a1[u], c11); }
        __syncthreads();
        part[(w * 4 + 0) * 64 + lane] = c00; part[(w * 4 + 1) * 64 + lane] = c01; part[(w * 4 + 2) * 64 + lane] = c10; part[(w * 4 + 3) * 64 + lane] = c11;
        __syncthreads();
        if (w < 4) {
            f32x4 s1 = part[(0 * 4 + w) * 64 + lane], s2 = part[(4 * 4 + w) * 64 + lane];
#pragma unroll
            for (int ww = 1; ww < 4; ++ww) { s1 += part[(ww * 4 + w) * 64 + lane]; s2 += part[((ww + 4) * 4 + w) * 64 + lane]; }
            const int row = MPROMPT + 32 * rb + 16 * (w >> 1) + fr, col = 32 * cb + 16 * (w & 1) + 4 * fq;
            if (MID) E.mid(s1, row, col);
            E.fin(s1 + s2, row, col, cb * 2 + (w & 1), fq);
        }
    }
}
typedef _Float16 f16x8v __attribute__((ext_vector_type(8)));
__device__ __forceinline__ int enc_f(float f) { const int b = __builtin_bit_cast(int, f); return b ^ ((b >> 31) & 0x7fffffff); }
__device__ __forceinline__ float dec_f(int k) { return __builtin_bit_cast(float, k ^ ((k >> 31) & 0x7fffffff)); }
__device__ __forceinline__ int imax_(int a, int b) { return a > b ? a : b; }
__device__ __forceinline__ int imin_(int a, int b) { return a < b ? a : b; }
#define P6_CE(a, b) do { const int mx_ = imax_(a, b), mn_ = imin_(a, b); a = mx_; b = mn_; } while (0)
__device__ __forceinline__ void sort16_desc(int (&v)[16]) {
#pragma unroll
    for (int k = 2; k <= 16; k <<= 1)
#pragma unroll
        for (int j = k >> 1; j > 0; j >>= 1)
#pragma unroll
            for (int i = 0; i < 16; ++i) { const int l = i ^ j; if (l > i) { if ((i & k) == 0) P6_CE(v[i], v[l]); else P6_CE(v[l], v[i]); } }
}
__device__ __forceinline__ void bitonic_merge16_desc(int (&v)[16]) {
#pragma unroll
    for (int j = 8; j > 0; j >>= 1)
#pragma unroll
        for (int i = 0; i < 16; ++i) { const int l = i ^ j; if (l > i) P6_CE(v[i], v[l]); }
}
__device__ __forceinline__ void merge_top16(int (&T)[16], const int (&N)[16]) {
#pragma unroll
    for (int i = 0; i < 16; ++i) T[i] = imax_(T[i], N[15 - i]);
    bitonic_merge16_desc(T);
}
__device__ __forceinline__ int half_partner(int x) { return (int)pg8::partner32((unsigned)x); }
struct CandTab { int ci[64], cj[64]; };
__host__ __device__ constexpr CandTab make_cand() { CandTab t{}; int n = 0; for (int i = 0; i < 16; ++i) for (int j = 0; j < 16; ++j) if ((i + 1) * (j + 1) <= 16) { t.ci[n] = i; t.cj[n] = j; ++n; } for (; n < 64; ++n) { t.ci[n] = -1; t.cj[n] = -1; } return t; }
constexpr CandTab CAND = make_cand();
constexpr int P6_SC = 0;

constexpr int P6_KEYS = 65536;
__device__ __forceinline__ void p6_job(Frame& F, const int job) {
    const int lane = pg8::lane_id_v(), w = F.wave, r = lane & 31, h = lane >> 5;
    const bf16* QP = (const bf16*)(F.ws + WS_SB); const bf16* KH = (const bf16*)(F.ws + WS_KEYS); const float* SS2 = (const float*)(F.ws + WS_SS2);
    unsigned long long* SEL = (unsigned long long*)(F.ws + WS_RA);
    LAS int* SC = (LAS int*)(F.lds + P6_SC + w * 8192);
    constexpr int NTILE = MREAL / 32, NGRP = (NTILE + 7) / 8, NJOB = NGRP * 8;
    {
        const int hq = job & 7, tile = (job >> 3) * 8 + w;
        { const int tid = w * 64 + lane;
#pragma unroll
            for (int i = 0; i < 8; ++i) { const int idx = tid + 512 * i, p = idx >> 11, n = (idx >> 4) & 127, c = idx & 15;
                *(LAS v4u*)(F.lds + P6_KEYS + p * 32768 + c * 2048 + n * 16) = *(const GAS v4u*)(KH + ((size_t)((hq * 2 + p) * 128 + n)) * 128 + c * 8); } }
        __syncthreads();
        if (tile < NTILE) {
        const int t = tile * 32 + r;
        int AB[2][16];
#pragma unroll
        for (int p = 0; p < 2; ++p) {
            f16x8v qf[8];
#pragma unroll
            for (int ks = 0; ks < 8; ++ks) qf[ks] = *(const GAS f16x8v*)(QP + (size_t)t * 2048 + hq * 256 + p * 128 + ks * 16 + h * 8);
            int T[16];
#pragma unroll
            for (int nb = 0; nb < 4; ++nb) {
                f32x16 acc = {};
                const LAS unsigned char* kp = F.lds + P6_KEYS + p * 32768 + h * 2048 + (nb * 32 + r) * 16;
#pragma unroll
                for (int ks = 0; ks < 8; ++ks) { const f16x8v kf = *(const LAS f16x8v*)(kp + ks * 4096); acc = __builtin_amdgcn_mfma_f32_32x32x16_f16(kf, qf[ks], acc, 0, 0, 0); }
                int N[16];
#pragma unroll
                for (int i = 0; i < 16; ++i) N[i] = (enc_f(acc[i]) & ~127) | (nb * 32 + crow(i, h));
                sort16_desc(N);
                if (nb == 0) {
#pragma unroll
                    for (int i = 0; i < 16; ++i) T[i] = N[i];
                } else merge_top16(T, N);
            }
            int P[16];
#pragma unroll
            for (int i = 0; i < 16; ++i) P[i] = half_partner(T[i]);
            merge_top16(T, P);
#pragma unroll
            for (int i = 0; i < 16; ++i) AB[p][i] = T[i];
        }
#pragma unroll
        for (int i = 0; i < 16; ++i) { SC[i * 64 + lane] = AB[0][i] & 127; SC[(16 + i) * 64 + lane] = AB[1][i] & 127; }
        float fa[16], fb[16];
#pragma unroll
        for (int i = 0; i < 16; ++i) { fa[i] = dec_f(AB[0][i] & ~127); fb[i] = dec_f(AB[1][i] & ~127); }
        int W[16];
#pragma unroll
        for (int g = 0; g < 4; ++g) {
            int N[16];
#pragma unroll
            for (int c = 0; c < 16; ++c) { const int ci = CAND.ci[g * 16 + c], cj = CAND.cj[g * 16 + c]; N[c] = ci >= 0 ? ((enc_f(fa[ci >= 0 ? ci : 0] + fb[cj >= 0 ? cj : 0]) & ~255) | (ci * 16 + cj)) : (int)0x80000000; }
            sort16_desc(N);
            if (g == 0) {
#pragma unroll
                for (int i = 0; i < 16; ++i) W[i] = N[i];
            } else merge_top16(W, N);
        }
        float ssum = 0.f;
        if (tile >= MPROMPT / 32) { const GAS f32x4* sp = (const GAS f32x4*)((const float*)(F.ws + WS_SS2S) + (size_t)(t - MPROMPT) * 128);
#pragma unroll 16
            for (int i = 0; i < 32; ++i) { const f32x4 v = sp[i]; ssum += (v.x + v.y) + (v.z + v.w); } }
        else { const GAS f32x4* sp = (const GAS f32x4*)(SS2 + (size_t)t * 32);
#pragma unroll
            for (int i = 0; i < 8; ++i) { const f32x4 v = sp[i]; ssum += (v.x + v.y) + (v.z + v.w); } }
        const float rt = 1.0f / sqrtf(ssum * (1.f / DM) + EPS);
        LDS_WAIT(); asm volatile("" ::: "memory");
        float gk[16]; int ek[16]; float Z = 0.f; const float c0 = dec_f(W[0] & ~255);
#pragma unroll
        for (int k = 0; k < 16; ++k) { const int code = W[k] & 255, ii = code >> 4, jj = code & 15; const int n0 = SC[ii * 64 + lane], n1 = SC[(16 + jj) * 64 + lane];
            ek[k] = n0 * 128 + n1; gk[k] = __builtin_amdgcn_exp2f((dec_f(W[k] & ~255) - c0) * rt * LOG2E); Z += gk[k]; }
        const float iz = 1.0f / Z;
        unsigned long long* dst = SEL + ((size_t)t * 8 + hq) * 16 + 8 * h;
#pragma unroll
        for (int k = 0; k < 8; k += 2) { const int e0 = h ? ek[k + 8] : ek[k], e1 = h ? ek[k + 9] : ek[k + 1]; const float g0 = (h ? gk[k + 8] : gk[k]) * iz, g1 = (h ? gk[k + 9] : gk[k + 1]) * iz;
            __hip_atomic_store(dst + k, (unsigned long long)(unsigned)e0 | ((unsigned long long)__builtin_bit_cast(unsigned, g0) << 32), RLX_AGENT);
            __hip_atomic_store(dst + k + 1, (unsigned long long)(unsigned)e1 | ((unsigned long long)__builtin_bit_cast(unsigned, g1) << 32), RLX_AGENT); }
        LDS_WAIT(); asm volatile("" ::: "memory");
        }
    }
}
__device__ __forceinline__ void p6_topk(Frame& F) {
    constexpr int NJOB = ((MREAL / 32 + 7) / 8) * 8;
    for (int job = F.vcu; job < NJOB; job += F.G) { p6_job(F, job); __syncthreads(); }
}
typedef _Float16 h2v __attribute__((ext_vector_type(2)));
constexpr int P7_RED = 0, P7_PART = LDSCTL_OFF;
#ifndef P7_UNR
#define P7_UNR (PEER_FP4 ? 16 : 8)
#endif
template <int M> __device__ __forceinline__ float xor_lane(float x) {
    if constexpr (M == 32) return __builtin_bit_cast(float, pg8::partner32(__builtin_bit_cast(unsigned, x)));
    else return __builtin_bit_cast(float, __builtin_amdgcn_ds_swizzle(__builtin_bit_cast(int, x), (M << 10) | 0x1f));
}
__device__ __forceinline__ float wave_sum_sw(float v) { v += xor_lane<1>(v); v += xor_lane<2>(v); v += xor_lane<4>(v); v += xor_lane<8>(v); v += xor_lane<16>(v); v += xor_lane<32>(v); return v; }
#if PEER_FP4
#ifndef P7_MFMA_U
#define P7_MFMA_U 1
#endif
typedef int v8i_t __attribute__((ext_vector_type(8)));
__device__ __forceinline__ void p7_gather(Frame& F) {
    const int lane = pg8::lane_id_v(), w = F.wave;
    const bf16* XH = (const bf16*)(F.ws + WS_RATIO); const unsigned char* EU4 = F.ws + WS_EU; const float* EUS = (const float*)(F.ws + WS_EU + 16 * MiB); const unsigned char* EV4 = F.ws + WS_EU + 32 * MiB; const float* EVS = (const float*)(F.ws + WS_EU + 48 * MiB);
    const unsigned long long* SEL = (const unsigned long long*)(F.ws + WS_RA);
    int it = 0;
#ifdef P7_ACTIVE_PER_XCD
    if ((F.vcu & 31) >= P7_ACTIVE_PER_XCD) return;
    const int rank_ = (F.vcu >> 5) * P7_ACTIVE_PER_XCD + (F.vcu & 31), nrank_ = 8 * P7_ACTIVE_PER_XCD;
#else
    const int rank_ = F.vcu, nrank_ = F.G;
#endif
    for (int t = rank_; t < MREAL; t += nrank_, ++it) {
        LAS float* RED = (LAS float*)(F.lds + P7_RED + (it & 1) * 65536); LAS float* PART = (LAS float*)(F.lds + P7_PART + (it & 1) * 32);
        const unsigned long long sel = SEL[((size_t)t * 8 + w) * 16 + (lane >> 2)];
        const int eidx = (int)(unsigned)sel; const float gate = __builtin_bit_cast(float, (unsigned)(sel >> 32));
        const float su_l = EUS[eidx], sv_l = EVS[eidx];
        unsigned xw[16];
#pragma unroll
        for (int q = 0; q < 8; ++q) { const unsigned long long v = *(const GAS unsigned long long*)(XH + (size_t)t * DM + q * 256 + lane * 4); xw[2 * q] = (unsigned)v; xw[2 * q + 1] = (unsigned)(v >> 32); }
#if P7_MFMA_U
        v8i_t xb;
        { typedef _Float16 h32x __attribute__((ext_vector_type(32))); typedef unsigned u6x __attribute__((ext_vector_type(6))); h32x hx;
#pragma unroll
          for (int i = 0; i < 16; ++i) { const h2v p = __builtin_bit_cast(h2v, xw[i]); hx[2 * i] = p[0]; hx[2 * i + 1] = p[1]; }
          const u6x px = __builtin_amdgcn_cvt_scalef32_pk32_fp6_f16(hx, 1.0f);
          xb = (v8i_t){(int)px[0], (int)px[1], (int)px[2], (int)px[3], (int)px[4], (int)px[5], 0, 0}; }
        float mk[4];
#pragma unroll
        for (int r4 = 0; r4 < 4; ++r4) mk[r4] = ((lane >> 4) == ((lane & 15) >> 2) && (lane & 3) == r4) ? 1.f : 0.f;
#endif
        float ssum = 0.f;
#pragma unroll
        for (int i = 0; i < 16; ++i) { const h2v hv = __builtin_bit_cast(h2v, xw[i]); ssum = __builtin_amdgcn_fdot2(hv, hv, ssum, false); }
        ssum = wave_sum_sw(ssum);
        const float rt = 1.0f / sqrtf(ssum * (1.f / DM) + EPS);
        float dp[16];
#pragma unroll
        for (int k0 = 0; k0 < 16; k0 += P7_UNR) {
            v4u ur[P7_UNR];
#pragma unroll
            for (int kk = 0; kk < P7_UNR; ++kk) { const int e = __builtin_amdgcn_readlane(eidx, 4 * (k0 + kk)); ur[kk] = *(const GAS v4u*)(EU4 + (size_t)e * 1024 + lane * 16); }
#if P7_MFMA_U
#pragma unroll
            for (int kk = 0; kk < P7_UNR; ++kk) { const v8i_t A = {(int)ur[kk].x, (int)ur[kk].y, (int)ur[kk].z, (int)ur[kk].w, 0, 0, 0, 0};
                const f32x4 d = __builtin_amdgcn_mfma_scale_f32_16x16x128_f8f6f4(A, xb, (f32x4){0.f, 0.f, 0.f, 0.f}, 4  , 2  , 0, 127, 0, 127);
                dp[k0 + kk] = (d[0] * mk[0] + d[1] * mk[1]) + (d[2] * mk[2] + d[3] * mk[3]); }
#else
#pragma unroll
            for (int kk = 0; kk < P7_UNR; ++kk) { float a = 0.f;
#pragma unroll
                for (int q = 0; q < 4; ++q) { const unsigned wq = ur[kk][q];
                    a = __builtin_amdgcn_fdot2(__builtin_amdgcn_cvt_scalef32_pk_f16_fp4(wq, 1.0f, 0), __builtin_bit_cast(h2v, xw[4 * q + 0]), a, false); a = __builtin_amdgcn_fdot2(__builtin_amdgcn_cvt_scalef32_pk_f16_fp4(wq, 1.0f, 1), __builtin_bit_cast(h2v, xw[4 * q + 1]), a, false);
                    a = __builtin_amdgcn_fdot2(__builtin_amdgcn_cvt_scalef32_pk_f16_fp4(wq, 1.0f, 2), __builtin_bit_cast(h2v, xw[4 * q + 2]), a, false); a = __builtin_amdgcn_fdot2(__builtin_amdgcn_cvt_scalef32_pk_f16_fp4(wq, 1.0f, 3), __builtin_bit_cast(h2v, xw[4 * q + 3]), a, false); }
                dp[k0 + kk] = a;
                }
#endif
#pragma unroll
            for (int kk = 0; kk < P7_UNR; ++kk) asm volatile("" : "+v"(dp[k0 + kk]) :: "memory");
        }
#define P7_TR(C, M) do { const bool up_ = (lane & (M)) != 0; _Pragma("unroll") for (int i = 0; i < (C) / 2; ++i) { const float keep_ = up_ ? dp[i + (C) / 2] : dp[i], send_ = up_ ? dp[i] : dp[i + (C) / 2]; dp[i] = keep_ + xor_lane<(M)>(send_); } } while (0)
        P7_TR(16, 32); P7_TR(8, 16); P7_TR(4, 8); P7_TR(2, 4);
#undef P7_TR
        float dk = dp[0]; dk += xor_lane<2>(dk); dk += xor_lane<1>(dk);
        const float hval = gate * pg8::gelu_tanh(dk * su_l * rt) * sv_l;
        h2v o2[16];
#pragma unroll
        for (int e = 0; e < 16; ++e) o2[e] = (h2v){(_Float16)0.f, (_Float16)0.f};
#pragma unroll
        for (int k0 = 0; k0 < 16; k0 += P7_UNR) {
            v4u vr[P7_UNR];
#pragma unroll
            for (int kk = 0; kk < P7_UNR; ++kk) { const int e = __builtin_amdgcn_readlane(eidx, 4 * (k0 + kk)); vr[kk] = *(const GAS v4u*)(EV4 + (size_t)e * 1024 + lane * 16); }
#pragma unroll
            for (int kk = 0; kk < P7_UNR; ++kk) { const float hk = __builtin_bit_cast(float, __builtin_amdgcn_readlane(__builtin_bit_cast(int, hval), 4 * (k0 + kk))) * 256.0f; const _Float16 hh = (_Float16)hk; const h2v hk2 = {hh, hh};
#pragma unroll
                for (int q = 0; q < 4; ++q) { const unsigned wq = vr[kk][q];
                    o2[4 * q + 0] = __builtin_elementwise_fma(__builtin_bit_cast(h2v, __builtin_amdgcn_cvt_scalef32_pk_f16_fp4(wq, 1.0f, 0)), hk2, o2[4 * q + 0]); o2[4 * q + 1] = __builtin_elementwise_fma(__builtin_bit_cast(h2v, __builtin_amdgcn_cvt_scalef32_pk_f16_fp4(wq, 1.0f, 1)), hk2, o2[4 * q + 1]);
                    o2[4 * q + 2] = __builtin_elementwise_fma(__builtin_bit_cast(h2v, __builtin_amdgcn_cvt_scalef32_pk_f16_fp4(wq, 1.0f, 2)), hk2, o2[4 * q + 2]); o2[4 * q + 3] = __builtin_elementwise_fma(__builtin_bit_cast(h2v, __builtin_amdgcn_cvt_scalef32_pk_f16_fp4(wq, 1.0f, 3)), hk2, o2[4 * q + 3]); } }
#pragma unroll
            for (int q = 0; q < 2; ++q) asm volatile("" : "+v"(o2[8 * q]), "+v"(o2[8 * q + 1]), "+v"(o2[8 * q + 2]), "+v"(o2[8 * q + 3]), "+v"(o2[8 * q + 4]), "+v"(o2[8 * q + 5]), "+v"(o2[8 * q + 6]), "+v"(o2[8 * q + 7]) :: "memory");
        }
#pragma unroll
        for (int q = 0; q < 8; ++q) *(LAS f32x4*)(RED + w * 2048 + q * 256 + lane * 4) = (f32x4){(float)o2[2 * q][0], (float)o2[2 * q][1], (float)o2[2 * q + 1][0], (float)o2[2 * q + 1][1]} * (1.0f / 256.0f);
        __syncthreads();
        const int col = w * 256 + lane * 4, soff = col;
        f32x4 sum = *(const LAS f32x4*)(RED + soff);
#pragma unroll
        for (int ww = 1; ww < 8; ++ww) sum += *(const LAS f32x4*)(RED + ww * 2048 + soff);
        { const unsigned long long xq = *(const GAS unsigned long long*)(XH + (size_t)t * DM + col); const unsigned x0 = (unsigned)xq, x1 = (unsigned)(xq >> 32); const h2v p0 = __builtin_bit_cast(h2v, x0), p1 = __builtin_bit_cast(h2v, x1);
            sum += (f32x4){(float)p0[0], (float)p0[1], (float)p1[0], (float)p1[1]}; }
        float sq = (sum.x * sum.x + sum.y * sum.y) + (sum.z * sum.z + sum.w * sum.w); sq = wave_sum_sw(sq);
        if (lane == 0) PART[w] = sq;
        __syncthreads();
        float tot = 0.f;
#pragma unroll
        for (int ww = 0; ww < 8; ++ww) tot += PART[ww];
        const float rf = 1.0f / sqrtf(tot * (1.f / DM) + EPS);
        const f32x4 gf = *(const GAS f32x4*)(F.norm_final_g + col);
        *(GAS f32x4*)(F.out + OUT_Y + (size_t)t * DM + col) = sum * rf * gf;
    }
}
#elif PEER_FP6
typedef _Float16 h32v __attribute__((ext_vector_type(32)));
typedef unsigned u6v __attribute__((ext_vector_type(6)));
typedef unsigned u2v __attribute__((ext_vector_type(2)));
__device__ __forceinline__ u6v ld_row6(const unsigned char* p) { const GAS u2v* q = (const GAS u2v*)p; const u2v a = q[0], b = q[1], c = q[2]; return (u6v){a.x, a.y, b.x, b.y, c.x, c.y}; }
__device__ __forceinline__ void p7_gather(Frame& F) {
    const int lane = pg8::lane_id_v(), w = F.wave;
    const bf16* XH = (const bf16*)(F.ws + WS_RATIO); const unsigned char* EU6 = F.ws + WS_EU; const unsigned char* EV6 = F.ws + WS_EU + 32 * MiB;
    const unsigned long long* SEL = (const unsigned long long*)(F.ws + WS_RA);
    int it = 0;
    for (int t = F.vcu; t < MREAL; t += F.G, ++it) {
        LAS float* RED = (LAS float*)(F.lds + P7_RED + (it & 1) * 65536); LAS float* PART = (LAS float*)(F.lds + P7_PART + (it & 1) * 32);
        const unsigned long long sel = SEL[((size_t)t * 8 + w) * 16 + (lane >> 2)];
        const int eidx = (int)(unsigned)sel; const float gate = __builtin_bit_cast(float, (unsigned)(sel >> 32));
        unsigned xw[16];
#pragma unroll
        for (int q = 0; q < 4; ++q) { const v4u v = *(const GAS v4u*)(XH + (size_t)t * DM + lane * 32 + q * 8); xw[4 * q] = v.x; xw[4 * q + 1] = v.y; xw[4 * q + 2] = v.z; xw[4 * q + 3] = v.w; }
        float ssum = 0.f;
#pragma unroll
        for (int i = 0; i < 16; ++i) { const h2v hv = __builtin_bit_cast(h2v, xw[i]); ssum = __builtin_amdgcn_fdot2(hv, hv, ssum, false); }
        ssum = wave_sum_sw(ssum);
        const float rt = 1.0f / sqrtf(ssum * (1.f / DM) + EPS);
        float dp[16];
#pragma unroll
        for (int k0 = 0; k0 < 16; k0 += P7_UNR) {
            u6v ur[P7_UNR];
#pragma unroll
            for (int kk = 0; kk < P7_UNR; ++kk) { const int e = __builtin_amdgcn_readlane(eidx, 4 * (k0 + kk)); ur[kk] = ld_row6(EU6 + (size_t)e * 1536 + lane * 24); }
#pragma unroll
            for (int kk = 0; kk < P7_UNR; ++kk) { const h32v d = __builtin_amdgcn_cvt_scalef32_pk32_f16_fp6(ur[kk], 1.0f); float a = 0.f;
#pragma unroll
                for (int i = 0; i < 16; ++i) { const h2v dd = {d[2 * i], d[2 * i + 1]}; a = __builtin_amdgcn_fdot2(dd, __builtin_bit_cast(h2v, xw[i]), a, false); }
                dp[k0 + kk] = a; }
#pragma unroll
            for (int kk = 0; kk < P7_UNR; ++kk) asm volatile("" : "+v"(dp[k0 + kk]) :: "memory");
        }
#define P7_TR(C, M) do { const bool up_ = (lane & (M)) != 0; _Pragma("unroll") for (int i = 0; i < (C) / 2; ++i) { const float keep_ = up_ ? dp[i + (C) / 2] : dp[i], send_ = up_ ? dp[i] : dp[i + (C) / 2]; dp[i] = keep_ + xor_lane<(M)>(send_); } } while (0)
        P7_TR(16, 32); P7_TR(8, 16); P7_TR(4, 8); P7_TR(2, 4);
#undef P7_TR
        float dk = dp[0]; dk += xor_lane<2>(dk); dk += xor_lane<1>(dk);
        const float hval = gate * pg8::gelu_tanh(dk * rt * (1.0f / PEER_SU)) * (1.0f / PEER_SV);
        float o[32];
#pragma unroll
        for (int e = 0; e < 32; ++e) o[e] = 0.f;
#pragma unroll
        for (int k0 = 0; k0 < 16; k0 += P7_UNR) {
            u6v vr[P7_UNR];
#pragma unroll
            for (int kk = 0; kk < P7_UNR; ++kk) { const int e = __builtin_amdgcn_readlane(eidx, 4 * (k0 + kk)); vr[kk] = ld_row6(EV6 + (size_t)e * 1536 + lane * 24); }
#pragma unroll
            for (int kk = 0; kk < P7_UNR; ++kk) { const float hk = __builtin_bit_cast(float, __builtin_amdgcn_readlane(__builtin_bit_cast(int, hval), 4 * (k0 + kk))); const h32v d = __builtin_amdgcn_cvt_scalef32_pk32_f16_fp6(vr[kk], 1.0f);
#pragma unroll
                for (int e = 0; e < 32; ++e) o[e] = __builtin_fmaf((float)d[e], hk, o[e]); }
#pragma unroll
            for (int q = 0; q < 4; ++q) asm volatile("" : "+v"(o[8 * q]), "+v"(o[8 * q + 1]), "+v"(o[8 * q + 2]), "+v"(o[8 * q + 3]), "+v"(o[8 * q + 4]), "+v"(o[8 * q + 5]), "+v"(o[8 * q + 6]), "+v"(o[8 * q + 7]) :: "memory");
        }
        { const int L = lane;
#pragma unroll
            for (int q = 0; q < 8; ++q) *(LAS f32x4*)(RED + w * 2048 + L * 32 + ((q + L) & 7) * 4) = (f32x4){o[4 * q], o[4 * q + 1], o[4 * q + 2], o[4 * q + 3]}; }
        __syncthreads();
        const int col = w * 256 + lane * 4; const int Lb = col >> 5, qb = (col >> 2) & 7, soff = Lb * 32 + ((qb + Lb) & 7) * 4;
        f32x4 sum = *(const LAS f32x4*)(RED + soff);
#pragma unroll
        for (int ww = 1; ww < 8; ++ww) sum += *(const LAS f32x4*)(RED + ww * 2048 + soff);
        { const unsigned long long xq = *(const GAS unsigned long long*)(XH + (size_t)t * DM + col); const unsigned x0 = (unsigned)xq, x1 = (unsigned)(xq >> 32); const h2v p0 = __builtin_bit_cast(h2v, x0), p1 = __builtin_bit_cast(h2v, x1);
            sum += (f32x4){(float)p0[0], (float)p0[1], (float)p1[0], (float)p1[1]}; }
        float sq = (sum.x * sum.x + sum.y * sum.y) + (sum.z * sum.z + sum.w * sum.w); sq = wave_sum_sw(sq);
        if (lane == 0) PART[w] = sq;
        __syncthreads();
        float tot = 0.f;
#pragma unroll
        for (int ww = 0; ww < 8; ++ww) tot += PART[ww];
        const float rf = 1.0f / sqrtf(tot * (1.f / DM) + EPS);
        const f32x4 gf = *(const GAS f32x4*)(F.norm_final_g + col);
        *(GAS f32x4*)(F.out + OUT_Y + (size_t)t * DM + col) = sum * rf * gf;
    }
}
#else
#error "PEER expert tables: PEER_FP4 or PEER_FP6"
#endif
#ifndef PQ_MERGE
#define PQ_MERGE PEER_FP4
#endif
#if PQ_MERGE
constexpr int CW_QUEUE = 8192, CW_GCNT = 8256;
constexpr int Q_NITEM = 520 + MREAL;
static_assert(MREAL == 16512 && (CW_GCNT + 65) * 4 <= (int)CTL_ZERO_BYTES, "queue layout");
__device__ __forceinline__ int q_decode(const int idx) { return idx < 520 ? ~idx : idx - 520; }
__device__ __forceinline__ unsigned q_ready(unsigned* gcnt, const int g, int& upto, const int lane) {
    if (g >= upto) { const unsigned c = xb_ld(&gcnt[lane]), c64 = xb_ld(&gcnt[64]); const unsigned long long m = __ballot(c >= 8u);
        int n = (m == ~0ull) ? 64 : __builtin_ctzll(~m); if (n == 64 && c64 >= 8u) n = 65; upto = n; }
    return g < upto ? 8u : 0u;
}
__device__ __forceinline__ void p67_queue(Frame& F) {
    const int w = F.wave;
    unsigned* qctr = (unsigned*)(F.ctl + CW_QUEUE); unsigned* gcnt = (unsigned*)(F.ctl + CW_GCNT); unsigned* bar = (unsigned*)(F.ctl + CW_BAR);
    volatile LAS int* LQ = (volatile LAS int*)(F.lds + LDSCTL_OFF + 128);
    const bf16* XH = (const bf16*)(F.ws + WS_RATIO); const unsigned char* EU4 = F.ws + WS_EU; const float* EUS = (const float*)(F.ws + WS_EU + 16 * MiB); const unsigned char* EV4 = F.ws + WS_EU + 32 * MiB; const float* EVS = (const float*)(F.ws + WS_EU + 48 * MiB);
    unsigned long long* SEL = (unsigned long long*)(F.ws + WS_RA);
    int idx = F.vcu, slot = 0, ntok = 0, rdy_upto = 0; int ready = q_decode(idx) < 0 ? 1 : 0;
    while (idx < Q_NITEM) {
        const int lane = pg8::lane_id_v();
        unsigned nxr = 0u; if (w == 0 && lane == 0) nxr = xb_add(qctr, 1u);
        int nx = Q_NITEM; unsigned nrdy = 8u;
        const int item = q_decode(idx);
        if (item < 0) {
            const int job = ~item;
            p6_job(F, job);
            VM_WAIT();
            if (w == 0) { nx = (int)F.G + __builtin_amdgcn_readfirstlane((int)nxr); if (nx < Q_NITEM) { const int ni = q_decode(nx); if (ni >= 0) nrdy = q_ready(gcnt, ni >> 8, rdy_upto, lane); }
                if (lane == 0) { LQ[(slot ^ 1) * 2] = nx; LQ[(slot ^ 1) * 2 + 1] = nrdy >= 8u ? 1 : 0; } }
            __syncthreads();
            if (w == 0 && lane == 0) (void)xb_add(&gcnt[job >> 3], 1u);
        } else {
            const int t = item;
            if (!ready) { XB_SPIN(xb_ld(&gcnt[t >> 8]) < 8u, bar); }
            LAS float* RED = (LAS float*)(F.lds + P7_RED + (ntok & 1) * 65536); LAS float* PART = (LAS float*)(F.lds + P7_PART + (ntok & 1) * 32);
            const unsigned long long sel = __hip_atomic_load(SEL + ((size_t)t * 8 + w) * 16 + (lane >> 2), RLX_AGENT);
            const int eidx = (int)(unsigned)sel; const float gate = __builtin_bit_cast(float, (unsigned)(sel >> 32));
            const float su_l = EUS[eidx], sv_l = EVS[eidx];
            unsigned xw[16];
#pragma unroll
            for (int q = 0; q < 8; ++q) { const unsigned long long v = *(const GAS unsigned long long*)(XH + (size_t)t * DM + q * 256 + lane * 4); xw[2 * q] = (unsigned)v; xw[2 * q + 1] = (unsigned)(v >> 32); }
#if P7_MFMA_U
            v8i_t xb;
            { typedef _Float16 h32x __attribute__((ext_vector_type(32))); typedef unsigned u6x __attribute__((ext_vector_type(6))); h32x hx;
#pragma unroll
              for (int i = 0; i < 16; ++i) { const h2v p = __builtin_bit_cast(h2v, xw[i]); hx[2 * i] = p[0]; hx[2 * i + 1] = p[1]; }
              const u6x px = __builtin_amdgcn_cvt_scalef32_pk32_fp6_f16(hx, 1.0f);
              xb = (v8i_t){(int)px[0], (int)px[1], (int)px[2], (int)px[3], (int)px[4], (int)px[5], 0, 0}; }
            float mk[4];
#pragma unroll
            for (int r4 = 0; r4 < 4; ++r4) mk[r4] = ((lane >> 4) == ((lane & 15) >> 2) && (lane & 3) == r4) ? 1.f : 0.f;
#endif
            float ssum = 0.f;
#pragma unroll
            for (int i = 0; i < 16; ++i) { const h2v hv = __builtin_bit_cast(h2v, xw[i]); ssum = __builtin_amdgcn_fdot2(hv, hv, ssum, false); }
            ssum = wave_sum_sw(ssum);
            const float rt = 1.0f / sqrtf(ssum * (1.f / DM) + EPS);
            float dp[16];
#pragma unroll
            for (int k0 = 0; k0 < 16; k0 += P7_UNR) {
                v4u ur[P7_UNR];
#pragma unroll
                for (int kk = 0; kk < P7_UNR; ++kk) { const int e = __builtin_amdgcn_readlane(eidx, 4 * (k0 + kk)); ur[kk] = *(const GAS v4u*)(EU4 + (size_t)e * 1024 + lane * 16); }
#if P7_MFMA_U
#pragma unroll
                for (int kk = 0; kk < P7_UNR; ++kk) { const v8i_t A = {(int)ur[kk].x, (int)ur[kk].y, (int)ur[kk].z, (int)ur[kk].w, 0, 0, 0, 0};
                    const f32x4 d = __builtin_amdgcn_mfma_scale_f32_16x16x128_f8f6f4(A, xb, (f32x4){0.f, 0.f, 0.f, 0.f}, 4  , 2  , 0, 127, 0, 127);
                    dp[k0 + kk] = (d[0] * mk[0] + d[1] * mk[1]) + (d[2] * mk[2] + d[3] * mk[3]); }
#else
#pragma unroll
                for (int kk = 0; kk < P7_UNR; ++kk) { float a = 0.f;
#pragma unroll
                    for (int q = 0; q < 4; ++q) { const unsigned wq = ur[kk][q];
                        a = __builtin_amdgcn_fdot2(__builtin_amdgcn_cvt_scalef32_pk_f16_fp4(wq, 1.0f, 0), __builtin_bit_cast(h2v, xw[4 * q + 0]), a, false); a = __builtin_amdgcn_fdot2(__builtin_amdgcn_cvt_scalef32_pk_f16_fp4(wq, 1.0f, 1), __builtin_bit_cast(h2v, xw[4 * q + 1]), a, false);
                        a = __builtin_amdgcn_fdot2(__builtin_amdgcn_cvt_scalef32_pk_f16_fp4(wq, 1.0f, 2), __builtin_bit_cast(h2v, xw[4 * q + 2]), a, false); a = __builtin_amdgcn_fdot2(__builtin_amdgcn_cvt_scalef32_pk_f16_fp4(wq, 1.0f, 3), __builtin_bit_cast(h2v, xw[4 * q + 3]), a, false); }
                    dp[k0 + kk] = a;
                    }
#endif
#pragma unroll
                for (int kk = 0; kk < P7_UNR; ++kk) asm volatile("" : "+v"(dp[k0 + kk]) :: "memory");
            }
            if (w == 0) { nx = (int)F.G + __builtin_amdgcn_readfirstlane((int)nxr); if (nx < Q_NITEM) { const int ni = q_decode(nx); if (ni >= 0) nrdy = q_ready(gcnt, ni >> 8, rdy_upto, lane); } }
#define P7_TR(C, M) do { const bool up_ = (lane & (M)) != 0; _Pragma("unroll") for (int i = 0; i < (C) / 2; ++i) { const float keep_ = up_ ? dp[i + (C) / 2] : dp[i], send_ = up_ ? dp[i] : dp[i + (C) / 2]; dp[i] = keep_ + xor_lane<(M)>(send_); } } while (0)
            P7_TR(16, 32); P7_TR(8, 16); P7_TR(4, 8); P7_TR(2, 4);
#undef P7_TR
            float dk = dp[0]; dk += xor_lane<2>(dk); dk += xor_lane<1>(dk);
            const float hval = gate * pg8::gelu_tanh(dk * su_l * rt) * sv_l;
            unsigned long long xq = 0ull; f32x4 gf = {0.f, 0.f, 0.f, 0.f};
            h2v o2[16];
#pragma unroll
            for (int e = 0; e < 16; ++e) o2[e] = (h2v){(_Float16)0.f, (_Float16)0.f};
#pragma unroll
            for (int k0 = 0; k0 < 16; k0 += P7_UNR) {
                v4u vr[P7_UNR];
#pragma unroll
                for (int kk = 0; kk < P7_UNR; ++kk) { const int e = __builtin_amdgcn_readlane(eidx, 4 * (k0 + kk)); vr[kk] = *(const GAS v4u*)(EV4 + (size_t)e * 1024 + lane * 16); }
                if (k0 == 0) { xq = *(const GAS unsigned long long*)(XH + (size_t)t * DM + w * 256 + lane * 4); gf = *(const GAS f32x4*)(F.norm_final_g + w * 256 + lane * 4); }
#pragma unroll
                for (int kk = 0; kk < P7_UNR; ++kk) { const float hk = __builtin_bit_cast(float, __builtin_amdgcn_readlane(__builtin_bit_cast(int, hval), 4 * (k0 + kk))) * 256.0f; const _Float16 hh = (_Float16)hk; const h2v hk2 = {hh, hh};
#pragma unroll
                    for (int q = 0; q < 4; ++q) { const unsigned wq = vr[kk][q];
                        o2[4 * q + 0] = __builtin_elementwise_fma(__builtin_bit_cast(h2v, __builtin_amdgcn_cvt_scalef32_pk_f16_fp4(wq, 1.0f, 0)), hk2, o2[4 * q + 0]); o2[4 * q + 1] = __builtin_elementwise_fma(__builtin_bit_cast(h2v, __builtin_amdgcn_cvt_scalef32_pk_f16_fp4(wq, 1.0f, 1)), hk2, o2[4 * q + 1]);
                        o2[4 * q + 2] = __builtin_elementwise_fma(__builtin_bit_cast(h2v, __builtin_amdgcn_cvt_scalef32_pk_f16_fp4(wq, 1.0f, 2)), hk2, o2[4 * q + 2]); o2[4 * q + 3] = __builtin_elementwise_fma(__builtin_bit_cast(h2v, __builtin_amdgcn_cvt_scalef32_pk_f16_fp4(wq, 1.0f, 3)), hk2, o2[4 * q + 3]); } }
#pragma unroll
                for (int q = 0; q < 2; ++q) asm volatile("" : "+v"(o2[8 * q]), "+v"(o2[8 * q + 1]), "+v"(o2[8 * q + 2]), "+v"(o2[8 * q + 3]), "+v"(o2[8 * q + 4]), "+v"(o2[8 * q + 5]), "+v"(o2[8 * q + 6]), "+v"(o2[8 * q + 7]) :: "memory");
            }
#pragma unroll
            for (int q = 0; q < 8; ++q) *(LAS f32x4*)(RED + w * 2048 + q * 256 + lane * 4) = (f32x4){(float)o2[2 * q][0], (float)o2[2 * q][1], (float)o2[2 * q + 1][0], (float)o2[2 * q + 1][1]} * (1.0f / 256.0f);
            __syncthreads();
            const int col = w * 256 + lane * 4, soff = col;
            f32x4 sum = *(const LAS f32x4*)(RED + soff);
#pragma unroll
            for (int ww = 1; ww < 8; ++ww) sum += *(const LAS f32x4*)(RED + ww * 2048 + soff);
            { const unsigned x0 = (unsigned)xq, x1 = (unsigned)(xq >> 32); const h2v p0 = __builtin_bit_cast(h2v, x0), p1 = __builtin_bit_cast(h2v, x1);
                sum += (f32x4){(float)p0[0], (float)p0[1], (float)p1[0], (float)p1[1]}; }
            float sq = (sum.x * sum.x + sum.y * sum.y) + (sum.z * sum.z + sum.w * sum.w); sq = wave_sum_sw(sq);
            if (lane == 0) PART[w] = sq;
            if (w == 0 && lane == 0) { LQ[(slot ^ 1) * 2] = nx; LQ[(slot ^ 1) * 2 + 1] = nrdy >= 8u ? 1 : 0; }
            __syncthreads();
            float tot = 0.f;
#pragma unroll
            for (int ww = 0; ww < 8; ++ww) tot += PART[ww];
            const float rf = 1.0f / sqrtf(tot * (1.f / DM) + EPS);
            __builtin_nontemporal_store(sum * rf * gf, (GAS f32x4*)(F.out + OUT_Y + (size_t)t * DM + col));
        }
        slot ^= 1; ++ntok;
        idx = __builtin_amdgcn_readfirstlane(LQ[slot * 2]); ready = __builtin_amdgcn_readfirstlane(LQ[slot * 2 + 1]);
    }
}
#endif
struct Args { const float* in[20]; float* out; unsigned char* ws; };
__global__ void __launch_bounds__(NWAVES * 64, 2) hybrid_fwd(Args args) {
    extern __shared__ __attribute__((aligned(16))) unsigned char lds[];
    Frame F;
    F.lds = (LAS unsigned char*)lds;
    F.MISC = (volatile LAS unsigned*)(F.lds + MISC_OFF);
    F.wave = __builtin_amdgcn_readfirstlane(threadIdx.x >> 6);
    F.G = gridDim.x; { const int bx = blockIdx.x; F.vcu = (F.G % 8 == 0) ? (bx % 8) * (F.G / 8) + bx / 8 : bx; }
    F.ws = args.ws; F.out = args.out; F.ctl = (gu32*)(args.ws + WS_CTL);
    F.x_prompt = args.in[0]; F.x_sample = args.in[1]; F.cache_k = args.in[2]; F.cache_v = args.in[3]; F.norm_mix_g = args.in[4]; F.w_in = args.in[5]; F.sgu_norm_g = args.in[6];
    F.sgu_w_s = args.in[7]; F.sgu_b_s = args.in[8]; F.sinks = args.in[9]; F.rel_tab = args.in[10]; F.w_pa = args.in[11]; F.w_pb = args.in[12]; F.w_out = args.in[13]; F.norm_ffn_g = args.in[14];
    F.w_query = args.in[15]; F.sub_keys = args.in[16]; F.exp_u = args.in[17]; F.exp_v = args.in[18]; F.norm_final_g = args.in[19];
    for (int u = threadIdx.x; u < (LDS_BYTES - LDSCTL_OFF) / 4; u += NWAVES * 64) ((LAS unsigned*)(F.lds + LDSCTL_OFF))[u] = 0u;
    __syncthreads();
    XcdBarrier bar = xcd_barrier_post((unsigned*)(F.ctl + CW_BAR), F.MISC + 8);
    unsigned char* ws = args.ws;
    p0_prologue(F);
    xcd_barrier(bar);
    {
        pg8::Gemm g{(const bf16*)(ws + WS_RA), (const bf16*)(ws + WS_WIN), MPAD, DIN, DM}; pg8::StaticOrder S; S.init(MPAD, DIN, F.G, (int)blockIdx.x);
        pg8::EpiIn E{(bf16*)(ws + WS_Q), (bf16*)(ws + WS_KV), (bf16*)(ws + WS_U), (bf16*)(ws + WS_VS), (bf16*)(ws + WS_RATIO), (bf16*)(ws + WS_SB), (float*)(ws + WS_SS1),
                     F.out + OUT_KP, F.out + OUT_VP, F.out + OUT_KS, F.out + OUT_VS};
        pg8::gemm_phase<pg8::EpiIn, pg8::StaticOrder, true, true, false>(F.lds + RING_OFF, g, S, E, F.wave);
        constexpr int NU = (MPAD / 256) * (DIN / 256); const int full = NU % (int)F.G;
        if (NU > (int)F.G && full > 0) { if ((int)blockIdx.x >= full) p0_expert_tables(F, (int)blockIdx.x - full, (int)F.G - full); }
        else p0_expert_tables(F, F.vcu, F.G);
    }
    xcd_barrier(bar);
    p2_mixers(F);
    xcd_barrier(bar);
    {
        pg8::Gemm g{(const bf16*)(ws + WS_RA), (const bf16*)(ws + WS_WAB), MPROMPT, DM, DM}; pg8::StaticOrder S; S.init(MPROMPT, DM, F.G, (int)blockIdx.x);
        pg8::EpiMerge E{(const bf16*)(ws + WS_RATIO), (const bf16*)(ws + WS_SB), (bf16*)(ws + WS_RB)};
        pg8::gemm_phase<pg8::EpiMerge, pg8::StaticOrder, true, true, false>(F.lds + RING_OFF, g, S, E, F.wave);
        const SkMerge SE{(const bf16*)(ws + WS_RATIO), (const bf16*)(ws + WS_SB), (bf16*)(ws + WS_RB)}; skinny_gemm<false, true>(F, (const bf16*)(ws + WS_RA), (const bf16*)(ws + WS_WAB), SE);
    }
    xcd_barrier(bar);
    {
        pg8::Gemm g{(const bf16*)(ws + WS_RB), (const bf16*)(ws + WS_WOUT), MPROMPT, DM, DM}; pg8::StaticOrder S; S.init(MPROMPT, DM, F.G, (int)blockIdx.x);
        pg8::EpiOut E{F.x_prompt, F.x_sample, (bf16*)(ws + WS_RATIO), (float*)(ws + WS_SS2)};
        pg8::gemm_phase<pg8::EpiOut, pg8::StaticOrder, true, true, false>(F.lds + RING_OFF, g, S, E, F.wave);
        const SkOut SE{F.x_sample, (bf16*)(ws + WS_RATIO), (float*)(ws + WS_SS2S)}; skinny_gemm<false, false>(F, (const bf16*)(ws + WS_RB), (const bf16*)(ws + WS_WOUT), SE);
    }
    xcd_barrier(bar);
    {
        pg8::Gemm g{(const bf16*)(ws + WS_RATIO), (const bf16*)(ws + WS_WQ), MPROMPT, DM, DM}; pg8::StaticOrder S; S.init(MPROMPT, DM, F.G, (int)blockIdx.x);
        pg8::EpiQ E{(bf16*)(ws + WS_SB)};
        pg8::gemm_phase<pg8::EpiQ, pg8::StaticOrder, true, true, true>(F.lds + RING_OFF, g, S, E, F.wave);
        const SkQ SE{(bf16*)(ws + WS_SB)}; skinny_gemm<true, false>(F, (const bf16*)(ws + WS_RATIO), (const bf16*)(ws + WS_WQ), SE);
    }
    xcd_barrier(bar);
#if PQ_MERGE
    p67_queue(F);
#else
    p6_topk(F);
    xcd_barrier(bar);
    p7_gather(F);
#endif
}

extern "C" void kernel_launch(void* const* d_in, const int* in_sizes, int n_in, void* d_out, int out_size, void* d_ws, size_t ws_size, hipStream_t stream) {
    static int grid = 0;
    if (grid == 0) {
        if (n_in != 20 || in_sizes[0] != MPROMPT * DM || out_size != (int)OUT_TOTAL || ws_size < WS_END) {
            fprintf(stderr, "kernel_launch: shape mismatch: n_in %d, in0 %d, out %d (want %zu), ws %zu (want %zu); nothing launched\n", n_in, n_in > 0 ? in_sizes[0] : -1, out_size, (size_t)OUT_TOTAL, ws_size, (size_t)WS_END); grid = -1; return; }
        int dev = 0, cus = 0, per_cu = 0;
        if (hipGetDevice(&dev) != hipSuccess || hipDeviceGetAttribute(&cus, hipDeviceAttributeMultiprocessorCount, dev) != hipSuccess) { fprintf(stderr, "kernel_launch: device query failed\n"); grid = -1; return; }
        if (hipFuncSetAttribute((const void*)hybrid_fwd, hipFuncAttributeMaxDynamicSharedMemorySize, LDS_BYTES) != hipSuccess) { fprintf(stderr, "kernel_launch: hipFuncSetAttribute failed\n"); grid = -1; return; }
        if (hipOccupancyMaxActiveBlocksPerMultiprocessor(&per_cu, (const void*)hybrid_fwd, NWAVES * 64, LDS_BYTES) != hipSuccess || per_cu < 1)
            fprintf(stderr, "kernel_launch: note: occupancy query reports %d workgroups per CU\n", per_cu);
        (void)hipGetLastError();
        grid = cus;
    }
    if (grid < 0) return;
    if (hipMemsetAsync((char*)d_ws + WS_CTL, 0, CTL_ZERO_BYTES, stream) != hipSuccess) { fprintf(stderr, "kernel_launch: memset failed\n"); return; }
    Args a{};
    for (int i = 0; i < 20; ++i) a.in[i] = (const float*)d_in[i];
    a.out = (float*)d_out; a.ws = (unsigned char*)d_ws;

    hipLaunchKernelGGL(hybrid_fwd, dim3(grid), dim3(NWAVES * 64), LDS_BYTES, stream, a);
    const hipError_t le = hipPeekAtLastError();
    if (le != hipSuccess) fprintf(stderr, "kernel_launch: launch failed: %s\n", hipGetErrorName(le));
}
```

```cpp
#include <hip/hip_runtime.h>
#include <cstdio>
#include <cstdint>

namespace pg8 {
#define PG8_LAS __attribute__((address_space(3)))
typedef unsigned short bf16_t;
typedef short bf16x8 __attribute__((ext_vector_type(8)));
typedef float f32x4 __attribute__((ext_vector_type(4)));
typedef unsigned u32x4 __attribute__((ext_vector_type(4)));
constexpr int BM = 256, BK = 64, HALF = 128, HTB = HALF * BK * 2  , STAGE_BYTES = 8 * HTB, NXCD = 8, WGM = 8;

__host__ __device__ __forceinline__ int lds_byte(int r, int c) { const int st = (r >> 4) * 2 + (c >> 5), rr = r & 15, cc = c & 31, ob = rr * 64 + cc * 2; return st * 1024 + (ob ^ (((ob >> 9) & 1) << 5)); }
__host__ __device__ __forceinline__ void stage_rc(int b, int& R, int& C) { const int st = b / 1024, sb = b % 1024, swz = sb ^ (((sb >> 9) & 1) << 5); R = (st >> 1) * 16 + swz / 64; C = (st & 1) * 32 + (swz % 64) / 2; }
__host__ __device__ __forceinline__ int perm32(int rho) { const int n = rho >> 4, i = rho & 15; return 8 * (i >> 2) + 4 * n + (i & 3); }

__device__ __forceinline__ int lane_id_v() { int l; asm volatile("v_mbcnt_lo_u32_b32 %0, -1, 0\n\tv_mbcnt_hi_u32_b32 %0, -1, %0" : "=v"(l)); return l; }
__device__ __forceinline__ unsigned partner32(unsigned x) { unsigned a = x, b = x; asm volatile("" : "+v"(a)); asm volatile("" : "+v"(b)); auto rr = __builtin_amdgcn_permlane32_swap(a, b, false, false); return rr[0] ^ rr[1] ^ x; }
struct Unit { int pm, pn; };
struct Gemm { const bf16_t* A; const bf16_t* Bt; int M, N, K; };

struct StaticOrder {
    int nM, nN, nwg, G, c;
    __host__ __device__ void init(int M, int N, int G_, int c_) { nM = M / BM; nN = N / BM; nwg = nM * nN; G = G_; c = c_; }
    __host__ __device__ bool next(int i, Unit& u) const {
        const long L = (long)i * G + c; if (L >= nwg) return false;
        int wgid = (int)L; { const int q = nwg / NXCD, r = nwg % NXCD, xcd = wgid % NXCD, off = wgid / NXCD; wgid = (xcd < r ? xcd * (q + 1) : r * (q + 1) + (xcd - r) * q) + off; }
        const int nig = WGM * nN, gid = wgid / nig, fm = gid * WGM, gsz = (nM - fm) < WGM ? (nM - fm) : WGM;
        u.pm = fm + ((wgid % nig) % gsz); u.pn = (wgid % nig) / gsz; return true;
    }
    __device__ __forceinline__ void a_ready(const Unit&) const {}
    __device__ __forceinline__ void done(const Unit&) const {}
};

typedef float f32x2 __attribute__((ext_vector_type(2)));
typedef __bf16 bf16x2_t __attribute__((ext_vector_type(2)));
typedef _Float16 f16x2_t __attribute__((ext_vector_type(2)));
typedef _Float16 f16x8_t __attribute__((ext_vector_type(8)));
__device__ __forceinline__ unsigned pk_bf16(float lo, float hi) { f32x2 v = {lo, hi}; return __builtin_bit_cast(unsigned, __builtin_convertvector(v, bf16x2_t)); }
__device__ __forceinline__ unsigned pk_f16(float lo, float hi) { f32x2 v = {lo, hi}; return __builtin_bit_cast(unsigned, __builtin_convertvector(v, f16x2_t)); }
__device__ __forceinline__ float bf_lo(unsigned w) { return __builtin_bit_cast(float, w << 16); }
__device__ __forceinline__ float bf_hi(unsigned w) { return __builtin_bit_cast(float, w & 0xffff0000u); }
template <bool F16> __device__ __forceinline__ f32x4 mma16(bf16x8 a, bf16x8 b, f32x4 c) {
    if constexpr (F16) return __builtin_amdgcn_mfma_f32_16x16x32_f16(__builtin_bit_cast(f16x8_t, a), __builtin_bit_cast(f16x8_t, b), c, 0, 0, 0);
    else return __builtin_amdgcn_mfma_f32_16x16x32_bf16(a, b, c, 0, 0, 0);
}
__device__ __forceinline__ float gelu_tanh(float x) { const float y = x * (-2.3022081981f - 0.1029432396f * (x * x)); return x * __builtin_amdgcn_rcpf(1.f + __builtin_amdgcn_exp2f(y)); }
__device__ __forceinline__ float sigmoidf_(float x) { return __builtin_amdgcn_rcpf(1.f + __builtin_amdgcn_exp2f(-1.4426950409f * x)); }
__device__ __forceinline__ u32x4 pack8_bf16(const f32x4 a, const f32x4 b) { u32x4 w; w.x = pk_bf16(a[0], a[1]); w.y = pk_bf16(a[2], a[3]); w.z = pk_bf16(b[0], b[1]); w.w = pk_bf16(b[2], b[3]); return w; }
__device__ __forceinline__ u32x4 pack8_f16(const f32x4 a, const f32x4 b) { u32x4 w; w.x = pk_f16(a[0], a[1]); w.y = pk_f16(a[2], a[3]); w.z = pk_f16(b[0], b[1]); w.w = pk_f16(b[2], b[3]); return w; }
__device__ __forceinline__ float sq4(const f32x4 a) { return (a[0] * a[0] + a[1] * a[1]) + (a[2] * a[2] + a[3] * a[3]); }

constexpr float QSCALE = 0.125f * 1.4426950408889634f;
struct EpiIn {
    static constexpr bool PERM = true, AFTER_DRAIN = false, MID = false;
    bf16_t *Q, *KV, *U, *VS, *RATIO, *SB; float* SS1; float *outKp, *outVp, *outKs, *outVs;
    __device__ __forceinline__ void operator()(const f32x4 (&acc)[2][2][4][2], const Unit& u, int wr, int wc, int, int) const {
        const int lane_ = lane_id_v(), fr = lane_ & 15, fq = lane_ >> 4;
        const int pn = u.pn, rowb = u.pm * BM + wr * 64 + fr, cl = wc * 32 + 8 * fq;
        if (pn < 4) {
#pragma unroll
            for (int ai = 0; ai < 2; ++ai)
#pragma unroll
                for (int m = 0; m < 4; ++m) { bf16_t* rp = Q + (size_t)(rowb + ai * HALF + m * 16) * 1024 + pn * 256 + cl;
#pragma unroll
                    for (int bj = 0; bj < 2; ++bj) *(u32x4*)(rp + bj * HALF) = pack8_bf16(acc[ai][bj][m][0] * QSCALE, acc[ai][bj][m][1] * QSCALE); }
        } else if (pn == 4) {
#pragma unroll
            for (int ai = 0; ai < 2; ++ai)
#pragma unroll
                for (int m = 0; m < 4; ++m) { bf16_t* rp = KV + (size_t)(rowb + ai * HALF + m * 16) * 256 + cl;
#pragma unroll
                    for (int bj = 0; bj < 2; ++bj) *(u32x4*)(rp + bj * HALF) = pack8_bf16(acc[ai][bj][m][0], acc[ai][bj][m][1]); }
            if (u.pm < 64 && (u.pm & 7) == 7) {
#pragma unroll
                for (int m = 0; m < 4; ++m) { const size_t o = (size_t)((u.pm >> 3) * 128 + wr * 64 + m * 16 + fr) * 128 + cl;
                    __builtin_nontemporal_store(acc[1][0][m][0], (f32x4*)(outKp + o)); __builtin_nontemporal_store(acc[1][0][m][1], (f32x4*)(outKp + o + 4));
                    __builtin_nontemporal_store(acc[1][1][m][0], (f32x4*)(outVp + o)); __builtin_nontemporal_store(acc[1][1][m][1], (f32x4*)(outVp + o + 4)); }
            }
            if (u.pm == 64) {
#pragma unroll
                for (int m = 0; m < 4; ++m) { const size_t o = (size_t)(wr * 64 + m * 16 + fr) * 128 + cl;
                    __builtin_nontemporal_store(acc[0][0][m][0], (f32x4*)(outKs + o)); __builtin_nontemporal_store(acc[0][0][m][1], (f32x4*)(outKs + o + 4));
                    __builtin_nontemporal_store(acc[0][1][m][0], (f32x4*)(outVs + o)); __builtin_nontemporal_store(acc[0][1][m][1], (f32x4*)(outVs + o + 4)); }
            }
        } else if (pn < 13) {
            const bool isv = pn >= 9; bf16_t* base = isv ? VS : U; const int ct = (isv ? pn - 9 : pn - 5) * 256 + cl;
#pragma unroll
            for (int ai = 0; ai < 2; ++ai)
#pragma unroll
                for (int m = 0; m < 4; ++m) { const int row = rowb + ai * HALF + m * 16; bf16_t* rp = base + (size_t)row * 1024 + ct; float s = 0.f;
#pragma unroll
                    for (int bj = 0; bj < 2; ++bj) { f32x4 a = acc[ai][bj][m][0], b = acc[ai][bj][m][1];
#pragma unroll
                        for (int e = 0; e < 4; ++e) { a[e] = gelu_tanh(a[e]); b[e] = gelu_tanh(b[e]); }
                        s += sq4(a) + sq4(b); *(u32x4*)(rp + bj * HALF) = pack8_bf16(a, b); }
                    if (isv) { s += __shfl_xor(s, 16); s += __shfl_xor(s, 32); if (fq == 0) SS1[(size_t)row * 16 + (pn - 9) * 4 + wc] = s; } }
        } else {
            const int ct = (pn - 13) * 128 + cl;
#pragma unroll
            for (int ai = 0; ai < 2; ++ai)
#pragma unroll
                for (int m = 0; m < 4; ++m) { const size_t o = (size_t)(rowb + ai * HALF + m * 16) * 2048 + ct; f32x4 ra, rb, sa, sb2;
#pragma unroll
                    for (int e = 0; e < 4; ++e) {
                        const float eb0 = 1.f + __builtin_amdgcn_exp2f(-1.4426950409f * acc[ai][1][m][0][e]), eb1 = 1.f + __builtin_amdgcn_exp2f(-1.4426950409f * acc[ai][1][m][1][e]);
                        const float ea0 = 1.f + __builtin_amdgcn_exp2f(-1.4426950409f * acc[ai][0][m][0][e]), ea1 = 1.f + __builtin_amdgcn_exp2f(-1.4426950409f * acc[ai][0][m][1][e]);
                        sa[e] = __builtin_amdgcn_rcpf(eb0); sb2[e] = __builtin_amdgcn_rcpf(eb1); ra[e] = eb0 * __builtin_amdgcn_rcpf(ea0); rb[e] = eb1 * __builtin_amdgcn_rcpf(ea1); }
                    *(u32x4*)(RATIO + o) = pack8_bf16(ra, rb); *(u32x4*)(SB + o) = pack8_bf16(sa, sb2); }
        }
    }
};
struct EpiMerge {
    static constexpr bool PERM = true, AFTER_DRAIN = false, MID = true;
    const bf16_t *RATIO, *SB; bf16_t* H;
    __device__ __forceinline__ void mid(f32x4 (&acc)[2][2][4][2], const Unit& u, int wr, int wc, int, int) const {
        const int lane_ = lane_id_v(), fr = lane_ & 15, fq = lane_ >> 4;
        const int rowb = u.pm * BM + wr * 64 + fr, col = u.pn * 256 + wc * 32 + 8 * fq;
        u32x4 w[2][4][2];
#pragma unroll
        for (int ai = 0; ai < 2; ++ai)
#pragma unroll
            for (int m = 0; m < 4; ++m)
#pragma unroll
                for (int bj = 0; bj < 2; ++bj) w[ai][m][bj] = __builtin_nontemporal_load((const u32x4*)(RATIO + (size_t)(rowb + ai * HALF + m * 16) * 2048 + col + bj * HALF));
        asm volatile("" ::: "memory");
#pragma unroll
        for (int ai = 0; ai < 2; ++ai)
#pragma unroll
            for (int m = 0; m < 4; ++m)
#pragma unroll
                for (int bj = 0; bj < 2; ++bj) { const u32x4 v = w[ai][m][bj];
                    acc[ai][bj][m][0] *= (f32x4){bf_lo(v.x), bf_hi(v.x), bf_lo(v.y), bf_hi(v.y)}; acc[ai][bj][m][1] *= (f32x4){bf_lo(v.z), bf_hi(v.z), bf_lo(v.w), bf_hi(v.w)}; }
        asm volatile("" ::: "memory");
    }
    __device__ __forceinline__ void operator()(const f32x4 (&acc)[2][2][4][2], const Unit& u, int wr, int wc, int, int) const {
        const int lane_ = lane_id_v(), fr = lane_ & 15, fq = lane_ >> 4;
        const int rowb = u.pm * BM + wr * 64 + fr, col = u.pn * 256 + wc * 32 + 8 * fq;
        u32x4 w[2][4][2];
#pragma unroll
        for (int ai = 0; ai < 2; ++ai)
#pragma unroll
            for (int m = 0; m < 4; ++m)
#pragma unroll
                for (int bj = 0; bj < 2; ++bj) w[ai][m][bj] = __builtin_nontemporal_load((const u32x4*)(SB + (size_t)(rowb + ai * HALF + m * 16) * 2048 + col + bj * HALF));
        asm volatile("" ::: "memory");
#pragma unroll
        for (int ai = 0; ai < 2; ++ai) {
#pragma unroll
            for (int m = 0; m < 4; ++m)
#pragma unroll
                for (int bj = 0; bj < 2; ++bj) { const size_t o = (size_t)(rowb + ai * HALF + m * 16) * 2048 + col + bj * HALF; const u32x4 v = w[ai][m][bj];
                    *(u32x4*)(H + o) = pack8_bf16(acc[ai][bj][m][0] * (f32x4){bf_lo(v.x), bf_hi(v.x), bf_lo(v.y), bf_hi(v.y)}, acc[ai][bj][m][1] * (f32x4){bf_lo(v.z), bf_hi(v.z), bf_lo(v.w), bf_hi(v.w)}); }
            asm volatile("" ::: "memory");
        }
    }
};
#ifndef EPI_OUT_ROWS
#define EPI_OUT_ROWS 4
#endif
struct EpiOut {
    static constexpr bool PERM = true, AFTER_DRAIN = false, MID = false;
    const float *xp, *xs; bf16_t* XH; float* SS2;
    __device__ __forceinline__ void operator()(const f32x4 (&acc)[2][2][4][2], const Unit& u, int wr, int wc, int, int) const {
        const int lane_ = lane_id_v(), fr = lane_ & 15, fq = lane_ >> 4;
        const int rowb = u.pm * BM + wr * 64 + fr, col = u.pn * 256 + wc * 32 + 8 * fq;
#pragma unroll
        for (int ai = 0; ai < 2; ++ai)
#pragma unroll
            for (int mp = 0; mp < 4; mp += EPI_OUT_ROWS) {
                f32x4 xv[EPI_OUT_ROWS][2][2];
#pragma unroll
                for (int mm = 0; mm < EPI_OUT_ROWS; ++mm) { const int row = rowb + ai * HALF + (mp + mm) * 16; const float* xr = row < 16384 ? xp + (size_t)row * 2048 : (row < 16512 ? xs + (size_t)(row - 16384) * 2048 : nullptr);
#pragma unroll
                    for (int bj = 0; bj < 2; ++bj) { if (xr) { xv[mm][bj][0] = __builtin_nontemporal_load((const f32x4*)(xr + col + bj * HALF)); xv[mm][bj][1] = __builtin_nontemporal_load((const f32x4*)(xr + col + bj * HALF + 4)); } else { xv[mm][bj][0] = (f32x4){0.f, 0.f, 0.f, 0.f}; xv[mm][bj][1] = (f32x4){0.f, 0.f, 0.f, 0.f}; } } }
                asm volatile("" ::: "memory");
#pragma unroll
                for (int mm = 0; mm < EPI_OUT_ROWS; ++mm) { const int m = mp + mm, row = rowb + ai * HALF + m * 16; float s = 0.f;
#pragma unroll
                    for (int bj = 0; bj < 2; ++bj) { const f32x4 a = acc[ai][bj][m][0] + xv[mm][bj][0], b = acc[ai][bj][m][1] + xv[mm][bj][1];
                        s += sq4(a) + sq4(b); *(u32x4*)(XH + (size_t)row * 2048 + col + bj * HALF) = pack8_f16(a, b); }
                    s += __shfl_xor(s, 16); s += __shfl_xor(s, 32); if (fq == 0) SS2[(size_t)row * 32 + u.pn * 4 + wc] = s; }
                asm volatile("" ::: "memory");
            }
    }
};
struct EpiQ {
    static constexpr bool PERM = true, AFTER_DRAIN = false, MID = false;
    bf16_t* QP;
    __device__ __forceinline__ void operator()(const f32x4 (&acc)[2][2][4][2], const Unit& u, int wr, int wc, int, int) const {
        const int lane_ = lane_id_v(), fr = lane_ & 15, fq = lane_ >> 4;
        const int rowb = u.pm * BM + wr * 64 + fr, col = u.pn * 256 + wc * 32 + 8 * fq;
#pragma unroll
        for (int ai = 0; ai < 2; ++ai)
#pragma unroll
            for (int m = 0; m < 4; ++m)
#pragma unroll
                for (int bj = 0; bj < 2; ++bj) *(u32x4*)(QP + (size_t)(rowb + ai * HALF + m * 16) * 2048 + col + bj * HALF) = pack8_f16(acc[ai][bj][m][0], acc[ai][bj][m][1]);
    }
};
template <class Epi, class Sched, bool ALIGN_EPI = false, bool SP2 = false, bool F16 = false>
__device__ __forceinline__ void gemm_phase(PG8_LAS unsigned char* lds, const Gemm g, const Sched& S, const Epi& E, const int wid_in) {
    const int lane = lane_id_v(), wid = wid_in, tid = wid * 64 + lane, wr = wid >> 2, wc = wid & 3, fr = lane & 15, fq = lane >> 4;
    const int K = g.K, nt = K / BK;
    unsigned voffA[2], voffB[2];
#pragma unroll
    for (int i = 0; i < 2; ++i) { int R, C; stage_rc(tid * 16 + i * 8192, R, C); const int Rb = Epi::PERM ? ((R & ~31) + perm32(R & 31)) : R;
        voffA[i] = (unsigned)(R * K + C) * 2u; voffB[i] = (unsigned)(Rb * K + C) * 2u; }
    const size_t kstep = (size_t)(BK * 2);
    const size_t hstep = (size_t)HALF * K * 2;
    const size_t tstep = 2 * hstep;
    const unsigned ldsw = (unsigned)wid * 1024u;
    const int aoff = lds_byte(wr * 64 + fr, fq * 8), boff = lds_byte(wc * 32 + fr, fq * 8);
#define PG8_SA(b, h) (((b) * 2 + (h)) * HTB)
#define PG8_SB(b, h) ((4 + (b) * 2 + (h)) * HTB)
#define PG8_STAGE(bufoff, gbase, voff) do { _Pragma("unroll") for (int _i = 0; _i < 2; ++_i) \
        __builtin_amdgcn_global_load_lds((const unsigned*)((const char*)(gbase) + (voff)[_i]), (PG8_LAS unsigned*)(lds + (bufoff) + ldsw + _i * 8192), 16, 0, 0); } while (0)
#define PG8_LDA(dst, b, h) do { _Pragma("unroll") for (int m = 0; m < 4; ++m) _Pragma("unroll") for (int k = 0; k < 2; ++k) dst[m][k] = *(const PG8_LAS bf16x8*)(lds + PG8_SA(b, h) + aoff + m * 2048 + k * 1024); } while (0)
#define PG8_LDB(dst, b, h) do { _Pragma("unroll") for (int n = 0; n < 2; ++n) _Pragma("unroll") for (int k = 0; k < 2; ++k) dst[n][k] = *(const PG8_LAS bf16x8*)(lds + PG8_SB(b, h) + boff + n * 2048 + k * 1024); } while (0)
#define PG8_MMA(ai, bj, At, Bt) do { __builtin_amdgcn_s_setprio(1); _Pragma("unroll") for (int m = 0; m < 4; ++m) _Pragma("unroll") for (int n = 0; n < 2; ++n) _Pragma("unroll") for (int k = 0; k < 2; ++k) \
        acc[ai][bj][m][n] = mma16<F16>(Bt[n][k], At[m][k], acc[ai][bj][m][n]); __builtin_amdgcn_s_setprio(0); } while (0)
#define PG8_WAIT_V(n) asm volatile("s_waitcnt vmcnt(" #n ")" ::: "memory")
#define PG8_WAIT_L(n) asm volatile("s_waitcnt lgkmcnt(" #n ")" ::: "memory")
#define PG8_BAR __builtin_amdgcn_s_barrier()
#define PG8_SCHED __builtin_amdgcn_sched_barrier(0)
    Unit cur, nxt; int ui = 0;
    if (!S.next(0, cur)) return;
    f32x4 acc[2][2][4][2];
#pragma unroll
    for (int a = 0; a < 2; ++a)
#pragma unroll
        for (int b = 0; b < 2; ++b)
#pragma unroll
            for (int m = 0; m < 4; ++m)
#pragma unroll
                for (int n = 0; n < 2; ++n) acc[a][b][m][n] = (f32x4){0.f, 0.f, 0.f, 0.f};
    bf16x8 At[4][2], B0[2][2], B1[2][2];
    const char* cA = (const char*)g.A + (size_t)cur.pm * tstep; const char* cB = (const char*)g.Bt + (size_t)cur.pn * tstep;
    S.a_ready(cur);
    if constexpr (SP2) {
        PG8_STAGE(PG8_SB(0, 0), cB, voffB); PG8_STAGE(PG8_SB(0, 1), cB + hstep, voffB); PG8_STAGE(PG8_SA(0, 0), cA, voffA); PG8_STAGE(PG8_SA(0, 1), cA + hstep, voffA);
        if (wr == 1) PG8_BAR;
        PG8_WAIT_V(2); PG8_BAR;
        PG8_STAGE(PG8_SB(1, 0), cB + kstep, voffB); PG8_STAGE(PG8_SA(1, 0), cA + kstep, voffA); PG8_STAGE(PG8_SB(1, 1), cB + hstep + kstep, voffB);
        PG8_WAIT_V(6); PG8_BAR;
    } else {
        PG8_STAGE(PG8_SB(0, 0), cB, voffB); PG8_STAGE(PG8_SA(0, 0), cA, voffA); PG8_STAGE(PG8_SB(0, 1), cB + hstep, voffB); PG8_STAGE(PG8_SA(0, 1), cA + hstep, voffA);
        if (wr == 1) PG8_BAR;
        PG8_WAIT_V(4); PG8_BAR;
        PG8_STAGE(PG8_SB(1, 0), cB + kstep, voffB); PG8_STAGE(PG8_SA(1, 0), cA + kstep, voffA); PG8_STAGE(PG8_SB(1, 1), cB + hstep + kstep, voffB);
        PG8_WAIT_V(6); PG8_BAR;
    }
    for (;;) {
        const bool has_next = S.next(ui + 1, nxt);
        const char* nA = has_next ? (const char*)g.A + (size_t)nxt.pm * tstep : cA; const char* nB = has_next ? (const char*)g.Bt + (size_t)nxt.pn * tstep : cB;
        for (int t = 0; t < nt; t += 2) {
            const bool last = (t == nt - 2);
            const char* a1 = cA + (size_t)(t + 1) * kstep;
            const char* a2 = last ? nA : cA + (size_t)(t + 2) * kstep; const char* b2 = last ? nB : cB + (size_t)(t + 2) * kstep;
            const char* a3 = a2 + kstep; const char* b3 = b2 + kstep;
            if (last && has_next) S.a_ready(nxt);
            if constexpr (Epi::MID) { if (t == (nt >> 1)) E.mid(acc, cur, wr, wc, fr, fq); }
            if constexpr (SP2) {
            PG8_LDB(B0, 0, 0); PG8_LDB(B1, 0, 1); PG8_SCHED; PG8_LDA(At, 0, 0); PG8_STAGE(PG8_SA(1, 1), a1 + hstep, voffA);
            PG8_WAIT_V(8); PG8_WAIT_L(0); PG8_BAR; PG8_MMA(0, 0, At, B0); PG8_MMA(0, 1, At, B1); PG8_BAR; PG8_SCHED;
            PG8_LDA(At, 0, 1); PG8_STAGE(PG8_SB(0, 0), b2, voffB); PG8_STAGE(PG8_SB(0, 1), b2 + hstep, voffB); PG8_STAGE(PG8_SA(0, 0), a2, voffA);
            PG8_WAIT_V(8); PG8_WAIT_L(0); PG8_BAR; PG8_MMA(1, 0, At, B0); PG8_MMA(1, 1, At, B1); PG8_BAR; PG8_SCHED;
            PG8_LDB(B0, 1, 0); PG8_LDB(B1, 1, 1); PG8_SCHED; PG8_LDA(At, 1, 0); PG8_STAGE(PG8_SA(0, 1), a2 + hstep, voffA);
            PG8_WAIT_V(8); PG8_WAIT_L(0); PG8_BAR; PG8_MMA(0, 0, At, B0); PG8_MMA(0, 1, At, B1); PG8_BAR; PG8_SCHED;
            PG8_LDA(At, 1, 1); PG8_STAGE(PG8_SB(1, 0), b3, voffB); PG8_STAGE(PG8_SB(1, 1), b3 + hstep, voffB); PG8_STAGE(PG8_SA(1, 0), a3, voffA);
            PG8_WAIT_V(8); PG8_WAIT_L(0); PG8_BAR; PG8_MMA(1, 0, At, B0); PG8_MMA(1, 1, At, B1); PG8_BAR; PG8_SCHED;
            } else {
            PG8_LDB(B0, 0, 0); PG8_SCHED; PG8_LDA(At, 0, 0); PG8_STAGE(PG8_SA(1, 1), a1 + hstep, voffA);
            PG8_WAIT_L(8); PG8_BAR; PG8_WAIT_L(0); PG8_MMA(0, 0, At, B0); PG8_BAR; PG8_SCHED;
            PG8_LDB(B1, 0, 1); PG8_STAGE(PG8_SB(0, 0), b2, voffB);
            PG8_BAR; PG8_WAIT_L(0); PG8_MMA(0, 1, At, B1); PG8_BAR;
            PG8_LDA(At, 0, 1); PG8_STAGE(PG8_SA(0, 0), a2, voffA);
            PG8_BAR; PG8_WAIT_L(0); PG8_MMA(1, 0, At, B0); PG8_BAR; PG8_SCHED;
            PG8_STAGE(PG8_SB(0, 1), b2 + hstep, voffB);
            PG8_WAIT_V(6); PG8_BAR; PG8_MMA(1, 1, At, B1); PG8_BAR;
            PG8_LDB(B0, 1, 0); PG8_SCHED; PG8_LDA(At, 1, 0); PG8_STAGE(PG8_SA(0, 1), a2 + hstep, voffA);
            PG8_WAIT_L(8); PG8_BAR; PG8_WAIT_L(0); PG8_MMA(0, 0, At, B0); PG8_BAR; PG8_SCHED;
            PG8_LDB(B1, 1, 1); PG8_STAGE(PG8_SB(1, 0), b3, voffB);
            PG8_BAR; PG8_WAIT_L(0); PG8_MMA(0, 1, At, B1); PG8_BAR;
            PG8_LDA(At, 1, 1); PG8_STAGE(PG8_SA(1, 0), a3, voffA);
            PG8_BAR; PG8_WAIT_L(0); PG8_MMA(1, 0, At, B0); PG8_BAR; PG8_SCHED;
            PG8_STAGE(PG8_SB(1, 1), b3 + hstep, voffB);
            PG8_WAIT_V(6); PG8_BAR; PG8_MMA(1, 1, At, B1); PG8_BAR;
            }
        }
        if constexpr (ALIGN_EPI) { if (wr == 0) PG8_BAR; }
        if constexpr (!Epi::AFTER_DRAIN) { E(acc, cur, wr, wc, fr, fq); S.done(cur); }
        if (!has_next) break;
#pragma unroll
        for (int a = 0; a < 2; ++a)
#pragma unroll
            for (int b = 0; b < 2; ++b)
#pragma unroll
                for (int m = 0; m < 4; ++m)
#pragma unroll
                    for (int n = 0; n < 2; ++n) acc[a][b][m][n] = (f32x4){0.f, 0.f, 0.f, 0.f};
        cur = nxt; cA = nA; cB = nB; ++ui;
        if constexpr (ALIGN_EPI) { if (wr == 1) PG8_BAR; }
    }
    PG8_WAIT_V(0);
    if constexpr (!ALIGN_EPI) { if (wr == 0) PG8_BAR; }
    PG8_BAR;
    if constexpr (Epi::AFTER_DRAIN) { E.fused(acc, cur, wr, wc, fr, fq, lds, wid, lane); S.done(cur); }
#undef PG8_SA
#undef PG8_SB
#undef PG8_STAGE
#undef PG8_LDA
#undef PG8_LDB
#undef PG8_MMA
#undef PG8_WAIT_V
#undef PG8_WAIT_L
#undef PG8_BAR
#undef PG8_SCHED
}
}
#define GAS __attribute__((address_space(1)))
#define LAS __attribute__((address_space(3)))
typedef unsigned short bf16;
typedef unsigned v4u __attribute__((ext_vector_type(4)));
typedef float f32x4 __attribute__((ext_vector_type(4)));
typedef short bf16x8 __attribute__((ext_vector_type(8)));
typedef GAS unsigned gu32;
typedef GAS unsigned long long gu64;
#define RLX_AGENT __ATOMIC_RELAXED, __HIP_MEMORY_SCOPE_AGENT
#define LDS_WAIT() asm volatile("s_waitcnt lgkmcnt(0)" ::: "memory")
#define VM_WAIT() asm volatile("s_waitcnt vmcnt(0)" ::: "memory")
__device__ __forceinline__ unsigned long long rt() { return __builtin_amdgcn_s_memrealtime(); }
__device__ __forceinline__ unsigned f2bf(float f) { unsigned u = __builtin_bit_cast(unsigned, f); return (u + 0x7fffu + ((u >> 16) & 1u)) >> 16; }
__device__ __forceinline__ unsigned pk2(float lo, float hi) { return f2bf(lo) | (f2bf(hi) << 16); }

#define XB_TMO      128
#define XB_XCNT(j)  (256  + 64 * (j))
#define XB_XSUB(j)  (1280 + 64 * (j))
#define XB_XGEN(j)  (2304 + 64 * (j))
#define XB_TOP      3328
#define XB_TOPGEN   3392
#define XCD_BAR_WORDS 3456
#ifdef DEBUG_ORACLE
#define XB_SPIN_CAP (1u << 27)
#else
#define XB_SPIN_CAP (1u << 18)
#endif

__device__ __forceinline__ unsigned xb_ld(unsigned* p)              { return __hip_atomic_load(p, __ATOMIC_RELAXED, __HIP_MEMORY_SCOPE_AGENT); }
__device__ __forceinline__ unsigned xb_add(unsigned* p, unsigned v) { return __hip_atomic_fetch_add(p, v, __ATOMIC_RELAXED, __HIP_MEMORY_SCOPE_AGENT); }
__device__ __forceinline__ unsigned xb_xcc_id() { return (unsigned)__builtin_amdgcn_s_getreg((3 << 11) | 20) & 0xFu; }
#define XB_SPIN(cond, bar) do { unsigned _sp = 0; while (cond) { __builtin_amdgcn_s_sleep(1); \
    if ((++_sp & 255u) == 0u) { if (xb_ld(&(bar)[XB_TMO])) break; if (_sp > XB_SPIN_CAP) { atomicAdd(&(bar)[XB_TMO], 1u); break; } } } } while (0)

struct XcdBarrier {
    unsigned* bar; unsigned x;
    volatile LAS unsigned* st;
};

__device__ __forceinline__ XcdBarrier xcd_barrier_post(unsigned* bar, volatile LAS unsigned* st) {
    XcdBarrier b; b.bar = bar; b.x = xb_xcc_id(); b.st = st;
    if (threadIdx.x == 0) (void)xb_add(&bar[XB_XCNT(b.x)], 1u);
    return b;
}
__device__ __forceinline__ void xcd_barrier_complete(unsigned* bar, unsigned x, unsigned& nloc, unsigned& nx) {
    const unsigned G = gridDim.x * gridDim.y * gridDim.z;
    unsigned sum, cnt, mine, sp = 0u;
    for (;;) {
        sum = 0u; cnt = 0u; mine = 0u;
#pragma unroll
        for (unsigned j = 0; j < 16; ++j) { const unsigned c = xb_ld(&bar[XB_XCNT(j)]); sum += c; cnt += (c > 0u) ? 1u : 0u; mine = (j == x) ? c : mine; }
        if (sum == G) break;
        __builtin_amdgcn_s_sleep(1);
        if ((++sp & 255u) == 0u) { if (xb_ld(&bar[XB_TMO])) break; if (sp > XB_SPIN_CAP) { atomicAdd(&bar[XB_TMO], 1u); break; } }
    }
    nloc = mine > 0u ? mine : 1u; nx = cnt > 0u ? cnt : 1u;
}

__device__ __forceinline__ void xcd_barrier(const XcdBarrier& b) {
    asm volatile("s_waitcnt vmcnt(0)" ::: "memory");
    __syncthreads();
    if (threadIdx.x == 0) {
        unsigned* bar = b.bar;
        __builtin_amdgcn_s_waitcnt(0);
        unsigned nloc = b.st[0], nx = b.st[1];
        if (nloc == 0u) { xcd_barrier_complete(bar, b.x, nloc, nx); b.st[0] = nloc; b.st[1] = nx; }
        const unsigned old = xb_add(&bar[XB_XSUB(b.x)], 1u);
        const unsigned gen = old / nloc;
        if (old + 1u == (gen + 1u) * nloc) {
            __builtin_amdgcn_fence(__ATOMIC_RELEASE, "agent");
            asm volatile("s_waitcnt vmcnt(0)" ::: "memory");
            const unsigned og = xb_add(&bar[XB_TOP], 1u);
            const unsigned tg = og / nx;
            if (og + 1u == (tg + 1u) * nx) xb_add(&bar[XB_TOPGEN], 1u);
            else XB_SPIN(xb_ld(&bar[XB_TOPGEN]) == tg, bar);
            __builtin_amdgcn_fence(__ATOMIC_ACQUIRE, "agent");
            xb_add(&bar[XB_XGEN(b.x)], 1u);
            asm volatile("s_waitcnt vmcnt(0)" ::: "memory");
        } else {
            XB_SPIN(xb_ld(&bar[XB_XGEN(b.x)]) == gen, bar);
            __builtin_amdgcn_fence(__ATOMIC_ACQUIRE, "agent");
            asm volatile("s_waitcnt vmcnt(0)" ::: "memory");
        }
    }
    __syncthreads();
}
constexpr int NWAVES = 8, NTHR = 512;
constexpr int DM = 2048, SEQ = 2048, NBATCH = 8, TDEC = 16, MPROMPT = NBATCH * SEQ  , MSAMPLE = NBATCH * TDEC  , MREAL = MPROMPT + MSAMPLE  , MPAD = 16640  ;
constexpr int DIN = 7424, DATTN = 1024, DSGU = 1024, WINDOW = 128, CHUNK = 64, NHEADS = 16, HD = 64;
constexpr int NEXP = 16384, PEER_H = 8, PEER_K = 16;
#ifndef PEER_FP4
#define PEER_FP4 1
#endif
#ifndef PEER_FP6
#define PEER_FP6 (!PEER_FP4)
#endif
constexpr float PEER_SU = 64.f, PEER_SV = 16.f;
constexpr float EPS = 1e-6f, LOG2E = 1.4426950408889634f;
constexpr size_t OUT_Y = 0, OUT_KP = (size_t)MREAL * DM, OUT_VP = OUT_KP + 131072, OUT_KS = OUT_VP + 131072, OUT_VS = OUT_KS + 16384, OUT_SGU = OUT_VS + 16384, OUT_TOTAL = OUT_SGU + 131072;
constexpr size_t MiB = 1u << 20;
constexpr size_t WS_CTL = 0, CTL_ZERO_BYTES = 64 * 1024;
constexpr size_t WS_WIN = 1 * MiB;
constexpr size_t WS_WAB = 30 * MiB;
constexpr size_t WS_WOUT = 38 * MiB;
constexpr size_t WS_WQ = 46 * MiB;
constexpr size_t WS_KEYS = 54 * MiB;
constexpr size_t WS_WSM = 54 * MiB + 512 * 1024;
constexpr size_t WS_SS1 = 55 * MiB;
constexpr size_t WS_SS2 = 57 * MiB;
constexpr size_t WS_EU = 60 * MiB, WS_EV = 124 * MiB;
constexpr size_t WS_RA = 188 * MiB;
constexpr size_t WS_RB = 253 * MiB;
constexpr size_t WS_Q = WS_RB, WS_KV = WS_Q + (size_t)MPAD * 1024 * 2, WS_U = WS_KV + (size_t)MPAD * 256 * 2, WS_VS = WS_U + (size_t)MPAD * 1024 * 2;
constexpr size_t WS_RC = 359 * MiB;
constexpr size_t WS_RATIO = WS_RC, WS_SB = WS_RC + 65 * MiB, WS_END = WS_RC + 130 * MiB;
static_assert(WS_VS + (size_t)MPAD * 1024 * 2 <= WS_RC && WS_END == 489 * MiB, "d_ws map");
constexpr int CW_BAR = 4096;
constexpr int RING_OFF = 0, RING_BYTES = 131072;
constexpr int LDSCTL_OFF = RING_BYTES, MISC_OFF = LDSCTL_OFF + 320;
constexpr int LDS_BYTES = 147456;
struct Frame {
    LAS unsigned char* lds; volatile LAS unsigned* MISC; gu32* ctl;
    int wave, vcu, G;
    const float *x_prompt, *x_sample, *cache_k, *cache_v, *norm_mix_g, *w_in, *sgu_norm_g, *sgu_w_s, *sgu_b_s, *sinks, *rel_tab, *w_pa, *w_pb, *w_out, *norm_ffn_g, *w_query, *sub_keys, *exp_u, *exp_v, *norm_final_g;
    float* out; unsigned char* ws;
};
__device__ __forceinline__ float wave_sum(float v) {
#pragma unroll
    for (int o = 1; o < 64; o <<= 1) v += __shfl_xor(v, o);
    return v;
}
__device__ __forceinline__ unsigned pkb(float lo, float hi) { return pg8::pk_bf16(lo, hi); }
__device__ __forceinline__ unsigned pkh(float lo, float hi) { return pg8::pk_f16(lo, hi); }
template <bool F16>
__device__ __forceinline__ void p0_transpose_item(const float* W, int N, bf16* WT, int kpitch, int koff, int drow0, int k0, int n0, const float* kscale, LAS float* scr, int lane) {
    float wv[32];
#pragma unroll
    for (int i = 0; i < 32; ++i) { const int kk = 2 * i + (lane >> 5); wv[i] = __builtin_nontemporal_load(W + (size_t)(k0 + kk) * N + n0 + (lane & 31)); }
#pragma unroll
    for (int i = 0; i < 32; ++i) { const int kk = 2 * i + (lane >> 5); scr[kk * 33 + (lane & 31)] = wv[i]; }
    LDS_WAIT(); asm volatile("" ::: "memory");
    const int c = lane & 7;
    float sc[8];
#pragma unroll
    for (int q = 0; q < 8; ++q) sc[q] = kscale ? kscale[k0 + 8 * c + q] : 1.f;
#pragma unroll
    for (int j = 0; j < 4; ++j) { const int n = (lane >> 3) + 8 * j; const LAS float* s = scr + (8 * c) * 33 + n;
        float v[8];
#pragma unroll
        for (int q = 0; q < 8; ++q) v[q] = s[q * 33] * sc[q];
        v4u o;
        if (F16) { o.x = pkh(v[0], v[1]); o.y = pkh(v[2], v[3]); o.z = pkh(v[4], v[5]); o.w = pkh(v[6], v[7]); }
        else     { o.x = pkb(v[0], v[1]); o.y = pkb(v[2], v[3]); o.z = pkb(v[4], v[5]); o.w = pkb(v[6], v[7]); }
        *(GAS v4u*)(WT + (size_t)(drow0 + n) * kpitch + koff + k0 + 8 * c) = o; }
    LDS_WAIT(); asm volatile("" ::: "memory");
}
__device__ __forceinline__ int win_row_of_col(int n) {
    if (n < 3328) return n;
    if (n < 5376) { const int q = n - 3328; return 3328 + (q >> 7) * 256 + (q & 127); }
    const int q = n - 5376; return 3328 + (q >> 7) * 256 + 128 + (q & 127);
}
__device__ __forceinline__ void rms_row_to_bf16(const float* xrow, const float* g, bf16* orow, int lane) {
    const GAS f32x4* xr = (const GAS f32x4*)xrow + lane; const GAS f32x4* gr = (const GAS f32x4*)g + lane;
    f32x4 v[8]; float s = 0.f;
#pragma unroll
    for (int j = 0; j < 8; ++j) { v[j] = xr[64 * j]; s += (v[j].x * v[j].x + v[j].y * v[j].y) + (v[j].z * v[j].z + v[j].w * v[j].w); }
    const float r = 1.0f / sqrtf(wave_sum(s) * (1.f / DM) + EPS);
    GAS unsigned long long* o8 = (GAS unsigned long long*)orow + lane;
#pragma unroll
    for (int j = 0; j < 8; ++j) { const f32x4 gg = gr[64 * j]; o8[64 * j] = (unsigned long long)pkb(v[j].x * r * gg.x, v[j].y * r * gg.y) | ((unsigned long long)pkb(v[j].z * r * gg.z, v[j].w * r * gg.w) << 32); }
}
__device__ __forceinline__ void p0_transposes(Frame& F, int first, int last, int gw, int NGW) {
    const int lane = pg8::lane_id_v();
    LAS float* scr = (LAS float*)(F.lds + RING_OFF + F.wave * 16384);
    bf16* WIN = (bf16*)(F.ws + WS_WIN); bf16* WAB = (bf16*)(F.ws + WS_WAB); bf16* WOUT = (bf16*)(F.ws + WS_WOUT); bf16* WQ = (bf16*)(F.ws + WS_WQ);
    constexpr int I_IN = 32 * 232, I_PA = 16 * 64, I_OUT = 32 * 64;
    for (int it = first + gw; it < last; it += NGW) {
        int r = it;
        if (r < I_IN) { const int kb = r / 232, nb = r % 232; p0_transpose_item<false>(F.w_in, DIN, WIN, 2048, 0, win_row_of_col(32 * nb), 64 * kb, 32 * nb, nullptr, scr, lane); continue; } r -= I_IN;
        if (r < I_PA) { const int kb = r / 64, nb = r % 64; p0_transpose_item<false>(F.w_pa, 2048, WAB, 2048, 0, 32 * nb, 64 * kb, 32 * nb, nullptr, scr, lane); continue; } r -= I_PA;
        if (r < I_PA) { const int kb = r / 64, nb = r % 64; p0_transpose_item<false>(F.w_pb, 2048, WAB, 2048, 1024, 32 * nb, 64 * kb, 32 * nb, nullptr, scr, lane); continue; } r -= I_PA;
        if (r < I_OUT) { const int kb = r / 64, nb = r % 64; p0_transpose_item<false>(F.w_out, 2048, WOUT, 2048, 0, 32 * nb, 64 * kb, 32 * nb, nullptr, scr, lane); continue; } r -= I_OUT;
        { const int kb = r / 64, nb = r % 64; p0_transpose_item<true>(F.w_query, 2048, WQ, 2048, 0, 32 * nb, 64 * kb, 32 * nb, F.norm_ffn_g, scr, lane); }
    }
}
__device__ __forceinline__ void p0_expert_tables(Frame& F, int rank, int nranks) {
    const int lane = pg8::lane_id_v(), tid = F.wave * 64 + lane;
    const size_t gt = (size_t)rank * NTHR + tid, NT = (size_t)nranks * NTHR;
#if PEER_FP4
    { unsigned char* EU4 = F.ws + WS_EU; float* EUS = (float*)(F.ws + WS_EU + 16 * MiB); unsigned char* EV4 = F.ws + WS_EU + 32 * MiB; float* EVS = (float*)(F.ws + WS_EU + 48 * MiB);
        const int gwv = rank * NWAVES + F.wave, nwv = nranks * NWAVES;
        for (int row = gwv; row < NEXP; row += nwv) { const size_t c = (size_t)row * 64 + lane; float fu[32], fv[32]; float mu = 0.f, mv = 0.f;
#pragma unroll
            for (int q = 0; q < 8; ++q) { const size_t eo = (size_t)row * DM + q * 256 + lane * 4;
                const f32x4 a = __builtin_nontemporal_load((const GAS f32x4*)(F.exp_u + eo)) * *(const GAS f32x4*)(F.norm_ffn_g + q * 256 + lane * 4); const f32x4 p = __builtin_nontemporal_load((const GAS f32x4*)(F.exp_v + eo));
#pragma unroll
                for (int e = 0; e < 4; ++e) { fu[4 * q + e] = a[e]; fv[4 * q + e] = p[e]; mu = fmaxf(mu, fabsf(a[e])); mv = fmaxf(mv, fabsf(p[e])); } }
#pragma unroll
            for (int o = 1; o < 64; o <<= 1) { mu = fmaxf(mu, __shfl_xor(mu, o)); mv = fmaxf(mv, __shfl_xor(mv, o)); }
            const float su = fmaxf(mu, 1e-30f) * (1.0f / 6.0f), sv = fmaxf(mv, 1e-30f) * (1.0f / 6.0f), iu = 1.0f / su, iv = 1.0f / sv;
            v4u wu, wv;
#pragma unroll
            for (int q = 0; q < 4; ++q) { unsigned a = 0u, b2 = 0u;
                a = __builtin_amdgcn_cvt_scalef32_pk_fp4_f32(a, fu[8 * q + 0] * iu, fu[8 * q + 1] * iu, 1.0f, 0); a = __builtin_amdgcn_cvt_scalef32_pk_fp4_f32(a, fu[8 * q + 2] * iu, fu[8 * q + 3] * iu, 1.0f, 1);
                a = __builtin_amdgcn_cvt_scalef32_pk_fp4_f32(a, fu[8 * q + 4] * iu, fu[8 * q + 5] * iu, 1.0f, 2); a = __builtin_amdgcn_cvt_scalef32_pk_fp4_f32(a, fu[8 * q + 6] * iu, fu[8 * q + 7] * iu, 1.0f, 3);
                b2 = __builtin_amdgcn_cvt_scalef32_pk_fp4_f32(b2, fv[8 * q + 0] * iv, fv[8 * q + 1] * iv, 1.0f, 0); b2 = __builtin_amdgcn_cvt_scalef32_pk_fp4_f32(b2, fv[8 * q + 2] * iv, fv[8 * q + 3] * iv, 1.0f, 1);
                b2 = __builtin_amdgcn_cvt_scalef32_pk_fp4_f32(b2, fv[8 * q + 4] * iv, fv[8 * q + 5] * iv, 1.0f, 2); b2 = __builtin_amdgcn_cvt_scalef32_pk_fp4_f32(b2, fv[8 * q + 6] * iv, fv[8 * q + 7] * iv, 1.0f, 3);
                wu[q] = a; wv[q] = b2; }
            *(GAS v4u*)(EU4 + c * 16) = wu; *(GAS v4u*)(EV4 + c * 16) = wv; if (lane == 0) { EUS[row] = su; EVS[row] = sv; } } }
#elif PEER_FP6
    { unsigned char* EU6 = F.ws + WS_EU; unsigned char* EV6 = F.ws + WS_EU + 32 * MiB;
        typedef _Float16 h32v __attribute__((ext_vector_type(32))); typedef unsigned u6v __attribute__((ext_vector_type(6)));
        for (size_t c = gt; c < (size_t)NEXP * 64; c += NT) { const int d0 = (int)((c * 32) & (DM - 1)); h32v hu, hv;
#pragma unroll
            for (int q = 0; q < 8; ++q) { const f32x4 a = *(const GAS f32x4*)(F.exp_u + c * 32 + q * 4) * *(const GAS f32x4*)(F.norm_ffn_g + d0 + q * 4) * PEER_SU; const f32x4 p = *(const GAS f32x4*)(F.exp_v + c * 32 + q * 4) * PEER_SV;
                hu[4 * q] = (_Float16)a.x; hu[4 * q + 1] = (_Float16)a.y; hu[4 * q + 2] = (_Float16)a.z; hu[4 * q + 3] = (_Float16)a.w; hv[4 * q] = (_Float16)p.x; hv[4 * q + 1] = (_Float16)p.y; hv[4 * q + 2] = (_Float16)p.z; hv[4 * q + 3] = (_Float16)p.w; }
            const u6v pu = __builtin_amdgcn_cvt_scalef32_pk32_fp6_f16(hu, 1.0f), pv = __builtin_amdgcn_cvt_scalef32_pk32_fp6_f16(hv, 1.0f);
            typedef unsigned u2v __attribute__((ext_vector_type(2)));
            GAS u2v* du = (GAS u2v*)(EU6 + c * 24); GAS u2v* dv = (GAS u2v*)(EV6 + c * 24);
            du[0] = (u2v){pu[0], pu[1]}; du[1] = (u2v){pu[2], pu[3]}; du[2] = (u2v){pu[4], pu[5]}; dv[0] = (u2v){pv[0], pv[1]}; dv[1] = (u2v){pv[2], pv[3]}; dv[2] = (u2v){pv[4], pv[5]}; } }
#endif
}
#ifndef P0_LATE_W
#define P0_LATE_W 1
#endif
#ifndef P0_PIPE
#define P0_PIPE 1
#endif
__device__ __forceinline__ void p0_prologue(Frame& F) {
    const int lane = pg8::lane_id_v(), tid = F.wave * 64 + lane;
    const int gw = F.vcu * NWAVES + F.wave, NGW = F.G * NWAVES;
#if P0_LATE_W
    p0_transposes(F, 0, 32 * 232, gw, NGW);
#else
    p0_transposes(F, 0, 32 * 232 + 2 * 16 * 64 + 2 * 32 * 64, gw, NGW);
#endif
    bf16* XN = (bf16*)(F.ws + WS_RA);
#if P0_PIPE
    {
        f32x4 v[8], nx[8];
        const GAS f32x4* gr = (const GAS f32x4*)F.norm_mix_g + lane;
        int m = gw;
        if (m < MREAL) { const GAS f32x4* xr = (const GAS f32x4*)((m < MPROMPT) ? F.x_prompt + (size_t)m * DM : F.x_sample + (size_t)(m - MPROMPT) * DM) + lane;
#pragma unroll
            for (int j = 0; j < 8; ++j) v[j] = __builtin_nontemporal_load(xr + 64 * j); }
        for (; m < MPAD; m += NGW) {
            const int mn = m + NGW;
            if (mn < MREAL) { const GAS f32x4* xr = (const GAS f32x4*)((mn < MPROMPT) ? F.x_prompt + (size_t)mn * DM : F.x_sample + (size_t)(mn - MPROMPT) * DM) + lane;
#pragma unroll
                for (int j = 0; j < 8; ++j) nx[j] = __builtin_nontemporal_load(xr + 64 * j); }
            if (m < MREAL) {
                float s = 0.f;
#pragma unroll
                for (int j = 0; j < 8; ++j) s += (v[j].x * v[j].x + v[j].y * v[j].y) + (v[j].z * v[j].z + v[j].w * v[j].w);
                const float r = 1.0f / sqrtf(wave_sum(s) * (1.f / DM) + EPS);
                GAS unsigned long long* o8 = (GAS unsigned long long*)(XN + (size_t)m * DM) + lane;
#pragma unroll
                for (int j = 0; j < 8; ++j) { const f32x4 gg = gr[64 * j]; o8[64 * j] = (unsigned long long)pkb(v[j].x * r * gg.x, v[j].y * r * gg.y) | ((unsigned long long)pkb(v[j].z * r * gg.z, v[j].w * r * gg.w) << 32); }
            } else { GAS v4u* o = (GAS v4u*)(XN + (size_t)m * DM) + lane;
#pragma unroll
                for (int j = 0; j < 4; ++j) o[64 * j] = (v4u){0u, 0u, 0u, 0u}; }
#pragma unroll
            for (int j = 0; j < 8; ++j) v[j] = nx[j];
        }
    }
#else
    for (int m = gw; m < MPAD; m += NGW) {
        if (m < MPROMPT) rms_row_to_bf16(F.x_prompt + (size_t)m * DM, F.norm_mix_g, XN + (size_t)m * DM, lane);
        else if (m < MREAL) rms_row_to_bf16(F.x_sample + (size_t)(m - MPROMPT) * DM, F.norm_mix_g, XN + (size_t)m * DM, lane);
        else { GAS v4u* o = (GAS v4u*)(XN + (size_t)m * DM) + lane;
#pragma unroll
            for (int j = 0; j < 4; ++j) o[64 * j] = (v4u){0u, 0u, 0u, 0u}; }
    }
#endif
    const size_t gt = (size_t)F.vcu * NTHR + tid, NT = (size_t)F.G * NTHR;
    { bf16* KH = (bf16*)(F.ws + WS_KEYS);
        for (size_t c = gt; c < 262144 / 8; c += NT) { const f32x4 a = *(const GAS f32x4*)(F.sub_keys + c * 8), b = *(const GAS f32x4*)(F.sub_keys + c * 8 + 4);
            *(GAS v4u*)(KH + c * 8) = (v4u){pkh(a.x, a.y), pkh(a.z, a.w), pkh(b.x, b.y), pkh(b.z, b.w)}; } }
    { bf16* WSM = (bf16*)(F.ws + WS_WSM);
        for (size_t c = gt; c < 131072 / 8; c += NT) { f32x4 a = *(const GAS f32x4*)(F.sgu_w_s + c * 8), b = *(const GAS f32x4*)(F.sgu_w_s + c * 8 + 4);
            const int t = (int)((c * 8) >> 7) & 127, s0 = (int)(c * 8) & 127;
#pragma unroll
            for (int e = 0; e < 4; ++e) { if (s0 + e > t) a[e] = 0.f; if (s0 + 4 + e > t) b[e] = 0.f; }
            *(GAS v4u*)(WSM + c * 8) = (v4u){pkb(a.x, a.y), pkb(a.z, a.w), pkb(b.x, b.y), pkb(b.z, b.w)}; } }
}
typedef float f32x16 __attribute__((ext_vector_type(16)));
typedef short s16x4 __attribute__((ext_vector_type(4)));
typedef short v4i16_t __attribute__((ext_vector_type(4)));
__device__ __forceinline__ int crow(int r, int hi) { return (r & 3) + 8 * (r >> 2) + 4 * hi; }
__device__ __forceinline__ s16x4 vtr(const LAS unsigned char* p) { return __builtin_bit_cast(s16x4, __builtin_amdgcn_ds_read_tr16_b64_v4i16((LAS v4i16_t*)p)); }
__device__ __forceinline__ bf16 bf1(float x) { return (bf16)(pkb(x, 0.f) & 0xffffu); }
__device__ __forceinline__ float bf2f(bf16 b) { return __builtin_bit_cast(float, (unsigned)b << 16); }
__device__ __forceinline__ float half_max(float m) { return fmaxf(m, __builtin_bit_cast(float, pg8::partner32(__builtin_bit_cast(unsigned, m)))); }
__device__ __forceinline__ float half_sum(float m) { return m + __builtin_bit_cast(float, pg8::partner32(__builtin_bit_cast(unsigned, m))); }
constexpr int P2_KL = 0, P2_VL = 24576, P2_BIAS = 49152, P2_OST = 65536, P2_GL = 0, P2_RL = 32768, P2_SST = 65536;
constexpr int N_ATT_UNITS = 512 + 16, N_SGU_UNITS = 1024 + 64;

struct AttnDesc { int b, c, kvh, qrow0, nqb, jlo, jhi; bool sample; };
__device__ __forceinline__ AttnDesc attn_desc(int uid) { AttnDesc d; d.sample = uid >= 512; d.c = 0;
    if (!d.sample) { d.b = uid >> 6; d.c = (uid >> 1) & 31; d.kvh = uid & 1; d.qrow0 = d.b * SEQ + d.c * CHUNK; d.nqb = 2; d.jlo = 128 - 64 * d.c; if (d.jlo < 0) d.jlo = 0; d.jhi = 192; }
    else { const int s = uid - 512; d.b = s >> 1; d.kvh = s & 1; d.qrow0 = MPROMPT + d.b * TDEC; d.nqb = 1; d.jlo = 0; d.jhi = 144; }
    return d; }
__device__ __forceinline__ void attn_kv_load(Frame& F, const AttnDesc& d, int, v4u (&kq)[3], v4u (&vq)[3]) {
    const int tid = F.wave * 64 + pg8::lane_id_v();
    const bf16* KV = (const bf16*)(F.ws + WS_KV);
#pragma unroll
    for (int i = 0; i < 3; ++i) { const int idx = tid + 512 * i, key = idx >> 3, ch = idx & 7; kq[i] = (v4u){0u, 0u, 0u, 0u}; vq[i] = (v4u){0u, 0u, 0u, 0u};
        if (!d.sample) { const int pos = d.c * CHUNK - WINDOW + key; if (pos >= 0) { const bf16* rp = KV + (size_t)(d.b * SEQ + pos) * 256 + d.kvh * 64 + ch * 8; kq[i] = *(const GAS v4u*)rp; vq[i] = *(const GAS v4u*)(rp + 128); } }
        else if (key < 128) { const size_t o = ((size_t)(d.b * WINDOW + key) * 2 + d.kvh) * 64 + ch * 8;
            const f32x4 a = *(const GAS f32x4*)(F.cache_k + o), a2 = *(const GAS f32x4*)(F.cache_k + o + 4), p = *(const GAS f32x4*)(F.cache_v + o), p2 = *(const GAS f32x4*)(F.cache_v + o + 4);
            kq[i] = (v4u){pkb(a.x, a.y), pkb(a.z, a.w), pkb(a2.x, a2.y), pkb(a2.z, a2.w)}; vq[i] = (v4u){pkb(p.x, p.y), pkb(p.z, p.w), pkb(p2.x, p2.y), pkb(p2.z, p2.w)}; }
        else if (key < 144) { const bf16* rp = KV + (size_t)(MPROMPT + d.b * TDEC + key - 128) * 256 + d.kvh * 64 + ch * 8; kq[i] = *(const GAS v4u*)rp; vq[i] = *(const GAS v4u*)(rp + 128); } }
}
__device__ __forceinline__ void attn_kv_store(Frame& F, int, const v4u (&kq)[3], const v4u (&vq)[3]) {
    const int tid = F.wave * 64 + pg8::lane_id_v();
    LAS unsigned char* KL = F.lds + P2_KL; LAS unsigned char* VL = F.lds + P2_VL;
#pragma unroll
    for (int i = 0; i < 3; ++i) { const int idx = tid + 512 * i, key = idx >> 3, ch = idx & 7; *(LAS v4u*)(KL + ch * 3072 + key * 16) = kq[i]; *(LAS v4u*)(VL + (ch >> 2) * 12288 + key * 64 + (ch & 3) * 16) = vq[i]; }
}
template <bool MASK> __device__ __forceinline__ void attn_compute(Frame& F, const AttnDesc& d, bf16x8 (&qr)[4]) {
    const int lane = pg8::lane_id_v();
    const int w = F.wave, r = lane & 31, h = lane >> 5;
    LAS unsigned char* KL = F.lds + P2_KL; LAS unsigned char* VL = F.lds + P2_VL; const LAS float* BL = (const LAS float*)(F.lds + P2_BIAS); LAS unsigned char* OST = F.lds + P2_OST + w * 4096;
    const bf16* Q = (const bf16*)(F.ws + WS_Q); bf16* OS = (bf16*)(F.ws + WS_RA);
    const int hd = d.kvh * 8 + w; const float sink2 = F.sinks[hd] * LOG2E; const LAS float* bl = BL + hd * 256;
    const int vlane = (4 * h + ((lane & 15) >> 2)) * 64 + (((lane >> 4) & 1) * 16 + (lane & 3) * 4) * 2;
    for (int qb = 0; qb < d.nqb; ++qb) {
        const int qi = qb * 32 + r;
        f32x16 S[6];
#pragma unroll
        for (int kb = 0; kb < 6; ++kb) { f32x16 a = {};
#pragma unroll
            for (int ks = 0; ks < 4; ++ks) { const bf16x8 kf = *(const LAS bf16x8*)(KL + (2 * ks + h) * 3072 + (kb * 32 + r) * 16); a = __builtin_amdgcn_mfma_f32_32x32x16_bf16(kf, qr[ks], a, 0, 0, 0); }
            S[kb] = a; asm volatile("" ::: "memory"); }
        if (qb + 1 < d.nqb) { const int qrow_n = d.qrow0 + (qb + 1) * 32 + r;
#pragma unroll
            for (int ks = 0; ks < 4; ++ks) qr[ks] = *(const GAS bf16x8*)(Q + (size_t)qrow_n * 1024 + hd * 64 + ks * 16 + h * 8); }
        float mx = -1e30f;
        const LAS float* blq = bl + (63 - qi + 4 * h);
        if (MASK) {
#pragma unroll
            for (int kb = 0; kb < 6; ++kb)
#pragma unroll
                for (int i = 0; i < 16; ++i) { const int j = kb * 32 + crow(i, h); float t = S[kb][i] + blq[kb * 32 + (i & 3) + 8 * (i >> 2)]; t = (j >= d.jlo && j < d.jhi) ? t : -1e30f; S[kb][i] = t; mx = fmaxf(mx, t); }
        } else {
#pragma unroll
            for (int kb = 0; kb < 6; ++kb)
#pragma unroll
                for (int i = 0; i < 16; ++i) { const float t = S[kb][i] + blq[kb * 32 + (i & 3) + 8 * (i >> 2)]; S[kb][i] = t; mx = fmaxf(mx, t); }
        }
        mx = fmaxf(half_max(mx), sink2);
        float l = 0.f;
#pragma unroll
        for (int kb = 0; kb < 6; ++kb)
#pragma unroll
            for (int i = 0; i < 16; ++i) { const float e = __builtin_amdgcn_exp2f(S[kb][i] - mx); S[kb][i] = e; l += e; }
        l = half_sum(l) + __builtin_amdgcn_exp2f(sink2 - mx);
        const float inv = 1.0f / l;
        f32x16 O[2]; O[0] = f32x16{}; O[1] = f32x16{};
#pragma unroll
        for (int kb = 0; kb < 6; ++kb)
#pragma unroll
            for (int s2 = 0; s2 < 2; ++s2) { v4u wv; wv.x = pkb(S[kb][8 * s2 + 0] * inv, S[kb][8 * s2 + 1] * inv); wv.y = pkb(S[kb][8 * s2 + 2] * inv, S[kb][8 * s2 + 3] * inv);
                wv.z = pkb(S[kb][8 * s2 + 4] * inv, S[kb][8 * s2 + 5] * inv); wv.w = pkb(S[kb][8 * s2 + 6] * inv, S[kb][8 * s2 + 7] * inv); const bf16x8 pa = __builtin_bit_cast(bf16x8, wv);
#pragma unroll
                for (int db = 0; db < 2; ++db) { const LAS unsigned char* vp = VL + db * 12288 + (kb * 32 + s2 * 16) * 64 + vlane; const s16x4 lo = vtr(vp), hi = vtr(vp + 8 * 64);
                    const bf16x8 vf = (bf16x8){lo[0], lo[1], lo[2], lo[3], hi[0], hi[1], hi[2], hi[3]}; O[db] = __builtin_amdgcn_mfma_f32_32x32x16_bf16(pa, vf, O[db], 0, 0, 0); } }
#pragma unroll
        for (int db = 0; db < 2; ++db)
#pragma unroll
            for (int i = 0; i < 16; ++i) *(LAS bf16*)(OST + (crow(i, h) * 64 + db * 32 + r) * 2) = bf1(O[db][i]);
        LDS_WAIT(); asm volatile("" ::: "memory");
#pragma unroll
        for (int it = 0; it < 4; ++it) { const int row = it * 8 + (lane >> 3), ch = lane & 7; const v4u v = *(const LAS v4u*)(OST + row * 128 + ch * 16);
            if (!d.sample || row < TDEC) *(GAS v4u*)(OS + (size_t)(d.qrow0 + qb * 32 + row) * 2048 + hd * 64 + ch * 8) = v; }
        LDS_WAIT(); asm volatile("" ::: "memory");
    }
}
__device__ __forceinline__ void attn_q_load0(Frame& F, const AttnDesc& d, bf16x8 (&qr)[4]) {
    const int lane = pg8::lane_id_v(), r = lane & 31, h = lane >> 5; const bf16* Q = (const bf16*)(F.ws + WS_Q); const int hd = d.kvh * 8 + F.wave;
    const int qrow = d.qrow0 + (d.sample ? (r & 15) : r);
#pragma unroll
    for (int ks = 0; ks < 4; ++ks) qr[ks] = *(const GAS bf16x8*)(Q + (size_t)qrow * 1024 + hd * 64 + ks * 16 + h * 8);
}
__device__ __forceinline__ void attn_units(Frame& F) {
    for (int u = F.vcu; u < N_ATT_UNITS; u += F.G) {
        bf16x8 qr[4];
        { v4u kq[3], vq[3]; const AttnDesc d0 = attn_desc(u); attn_kv_load(F, d0, 0, kq, vq); attn_q_load0(F, d0, qr); attn_kv_store(F, 0, kq, vq); }
        __syncthreads();
        { const AttnDesc d = attn_desc(u); if (d.jlo == 0 && d.jhi == 192) attn_compute<false>(F, d, qr); else attn_compute<true>(F, d, qr); }
        LDS_WAIT(); __builtin_amdgcn_s_barrier(); asm volatile("" ::: "memory");
    }
}

struct SguOps { v4u gvq[4]; float ssp[4]; bf16x8 af[8]; v4u uq[4]; float bs[4]; f32x4 sg0, sg1; };
__device__ __forceinline__ void sgu_load(Frame& F, const int uid, SguOps& R) {
    const int lane = pg8::lane_id_v(), w = F.wave, tid = w * 64 + lane, r = lane & 31, h = lane >> 5;
    LAS unsigned char* GL = F.lds + P2_GL;
    const bf16* VS = (const bf16*)(F.ws + WS_VS); const bf16* U = (const bf16*)(F.ws + WS_U); const bf16* WSM = (const bf16*)(F.ws + WS_WSM); const float* SS1 = (const float*)(F.ws + WS_SS1); bf16* OS = (bf16*)(F.ws + WS_RA);
    const bool sample = uid >= 1024; int b, g, row0, nv;
    if (!sample) { b = uid >> 7; const int blk = (uid >> 3) & 15; g = uid & 7; row0 = b * SEQ + blk * 128; nv = 128; }
    else { const int s = uid - 1024; b = s >> 3; g = s & 7; row0 = MPROMPT + b * TDEC; nv = TDEC; }
    const int wr = w >> 1, wc = w & 1; const bool active = 32 * wr < nv; const int nks = 2 * (wr + 1);
    const int er = lane >> 3, ec = (lane & 7) * 8;
    (void)GL; (void)VS; (void)U; (void)WSM; (void)SS1; (void)OS; (void)b; (void)r; (void)h; (void)tid; (void)nks; (void)er; (void)ec; (void)active;
#pragma unroll
    for (int i = 0; i < 4; ++i) { const int idx = tid + 512 * i, s = idx >> 4, ch = idx & 15; R.gvq[i] = (v4u){0u, 0u, 0u, 0u}; R.ssp[i] = 0.f;
        if (s < nv) { R.gvq[i] = *(const GAS v4u*)(VS + (size_t)(row0 + s) * 1024 + g * 128 + ch * 8); R.ssp[i] = SS1[(size_t)(row0 + s) * 16 + ch]; } }
    if (active) {
#pragma unroll
        for (int ks = 0; ks < 8; ++ks) { R.af[ks] = (bf16x8){0, 0, 0, 0, 0, 0, 0, 0}; if (ks < nks) R.af[ks] = *(const GAS bf16x8*)(WSM + (size_t)(g * 128 + 32 * wr + r) * 128 + 16 * ks + 8 * h); }
        R.sg0 = *(const GAS f32x4*)(F.sgu_norm_g + g * 128 + 64 * wc + ec); R.sg1 = *(const GAS f32x4*)(F.sgu_norm_g + g * 128 + 64 * wc + ec + 4);
#pragma unroll
        for (int c = 0; c < 4; ++c) { const int t = 32 * wr + 8 * c + er; R.uq[c] = (v4u){0u, 0u, 0u, 0u}; R.bs[c] = F.sgu_b_s[g * 128 + t];
            if (t < nv) R.uq[c] = *(const GAS v4u*)(U + (size_t)(row0 + t) * 1024 + g * 128 + 64 * wc + ec); }
    }
}
__device__ __forceinline__ void sgu_process(Frame& F, const int uid, SguOps& R) {
    const int lane = pg8::lane_id_v(), w = F.wave, tid = w * 64 + lane, r = lane & 31, h = lane >> 5;
    LAS unsigned char* GL = F.lds + P2_GL;
    const bf16* VS = (const bf16*)(F.ws + WS_VS); const bf16* U = (const bf16*)(F.ws + WS_U); const bf16* WSM = (const bf16*)(F.ws + WS_WSM); const float* SS1 = (const float*)(F.ws + WS_SS1); bf16* OS = (bf16*)(F.ws + WS_RA);
    const bool sample = uid >= 1024; int b, g, row0, nv;
    if (!sample) { b = uid >> 7; const int blk = (uid >> 3) & 15; g = uid & 7; row0 = b * SEQ + blk * 128; nv = 128; }
    else { const int s = uid - 1024; b = s >> 3; g = s & 7; row0 = MPROMPT + b * TDEC; nv = TDEC; }
    const int wr = w >> 1, wc = w & 1; const bool active = 32 * wr < nv; const int nks = 2 * (wr + 1);
    const int er = lane >> 3, ec = (lane & 7) * 8;
    (void)GL; (void)VS; (void)U; (void)WSM; (void)SS1; (void)OS; (void)b; (void)r; (void)h; (void)tid; (void)nks; (void)er; (void)ec; (void)active;
#pragma unroll
    for (int i = 0; i < 4; ++i) { const int idx = tid + 512 * i, s = idx >> 4, ch = idx & 15; v4u o = (v4u){0u, 0u, 0u, 0u};
        float ss = R.ssp[i];
        ss += __builtin_bit_cast(float, __builtin_amdgcn_ds_swizzle(__builtin_bit_cast(int, ss), (1 << 10) | 0x1f)); ss += __builtin_bit_cast(float, __builtin_amdgcn_ds_swizzle(__builtin_bit_cast(int, ss), (2 << 10) | 0x1f));
        ss += __builtin_bit_cast(float, __builtin_amdgcn_ds_swizzle(__builtin_bit_cast(int, ss), (4 << 10) | 0x1f)); ss += __builtin_bit_cast(float, __builtin_amdgcn_ds_swizzle(__builtin_bit_cast(int, ss), (8 << 10) | 0x1f));
        if (s < nv) {
            const float rr = 1.0f / sqrtf(ss * (1.f / DSGU) + EPS); const v4u wv = R.gvq[i];
            float f[8] = {pg8::bf_lo(wv.x) * rr, pg8::bf_hi(wv.x) * rr, pg8::bf_lo(wv.y) * rr, pg8::bf_hi(wv.y) * rr, pg8::bf_lo(wv.z) * rr, pg8::bf_hi(wv.z) * rr, pg8::bf_lo(wv.w) * rr, pg8::bf_hi(wv.w) * rr};
            o = (v4u){pkb(f[0], f[1]), pkb(f[2], f[3]), pkb(f[4], f[5]), pkb(f[6], f[7])};
            if (sample) { const f32x4 g0 = *(const GAS f32x4*)(F.sgu_norm_g + g * 128 + ch * 8), g1 = *(const GAS f32x4*)(F.sgu_norm_g + g * 128 + ch * 8 + 4); float* dst = F.out + OUT_SGU + (size_t)(b * TDEC + s) * 1024 + g * 128 + ch * 8;
                *(GAS f32x4*)dst = (f32x4){f[0] * g0.x, f[1] * g0.y, f[2] * g0.z, f[3] * g0.w}; *(GAS f32x4*)(dst + 4) = (f32x4){f[4] * g1.x, f[5] * g1.y, f[6] * g1.z, f[7] * g1.w}; } }
        *(LAS v4u*)(GL + (ch >> 2) * 8192 + s * 64 + (ch & 3) * 16) = o; }
    LDS_WAIT(); __builtin_amdgcn_s_barrier(); asm volatile("" ::: "memory");
    if (active) {
        f32x16 acc[2]; acc[0] = f32x16{}; acc[1] = f32x16{};
        const int glane = (8 * h + ((lane & 15) >> 2)) * 64 + (((lane >> 4) & 1) * 16 + (lane & 3) * 4) * 2;
#pragma unroll
        for (int ks = 0; ks < 8; ++ks) if (ks < nks) {
#pragma unroll
            for (int cb = 0; cb < 2; ++cb) { const LAS unsigned char* gp = GL + (2 * wc + cb) * 8192 + (16 * ks) * 64 + glane; const s16x4 lo = vtr(gp), hi = vtr(gp + 4 * 64);
                const bf16x8 bb = (bf16x8){lo[0], lo[1], lo[2], lo[3], hi[0], hi[1], hi[2], hi[3]}; acc[cb] = __builtin_amdgcn_mfma_f32_32x32x16_bf16(R.af[ks], bb, acc[cb], 0, 0, 0); } }
        LAS float* STG = (LAS float*)(F.lds + P2_SST + w * 8192);
#pragma unroll
        for (int cb = 0; cb < 2; ++cb)
#pragma unroll
            for (int i = 0; i < 16; ++i) STG[crow(i, h) * 64 + 32 * cb + r] = acc[cb][i];
        LDS_WAIT(); asm volatile("" ::: "memory");
#pragma unroll
        for (int c = 0; c < 4; ++c) { const int t = 32 * wr + 8 * c + er;
            const f32x4 a0 = *(const LAS f32x4*)(STG + (8 * c + er) * 64 + ec), a1 = *(const LAS f32x4*)(STG + (8 * c + er) * 64 + ec + 4); const v4u uw = R.uq[c]; const float bb = R.bs[c];
            const v4u o = {pkb(pg8::bf_lo(uw.x) * (a0.x * R.sg0.x + bb), pg8::bf_hi(uw.x) * (a0.y * R.sg0.y + bb)), pkb(pg8::bf_lo(uw.y) * (a0.z * R.sg0.z + bb), pg8::bf_hi(uw.y) * (a0.w * R.sg0.w + bb)),
                           pkb(pg8::bf_lo(uw.z) * (a1.x * R.sg1.x + bb), pg8::bf_hi(uw.z) * (a1.y * R.sg1.y + bb)), pkb(pg8::bf_lo(uw.w) * (a1.z * R.sg1.z + bb), pg8::bf_hi(uw.w) * (a1.w * R.sg1.w + bb))};
            if (t < nv) *(GAS v4u*)(OS + (size_t)(row0 + t) * 2048 + 1024 + g * 128 + 64 * wc + ec) = o; }
    }
    LDS_WAIT(); __builtin_amdgcn_s_barrier(); asm volatile("" ::: "memory");
}
__device__ __forceinline__ int sgu_uid(const Frame& F, const int k) {
    const int u0 = F.G - 1 - F.vcu;
    if (F.G == 256 && F.vcu < 16) return k < 3 ? u0 + k * 256 : -1;
    if (F.G == 256 && F.vcu < 32) return k < 4 ? u0 + k * 256 : (k == 4 ? 1023 - (F.vcu - 16) : -1);
    const int u = u0 + k * F.G; return u < N_SGU_UNITS ? u : -1;
}
__device__ __forceinline__ void sgu_units(Frame& F) {
    SguOps A, B; int k = 0, ua = sgu_uid(F, 0);
    if (ua >= 0) sgu_load(F, ua, A);
    while (ua >= 0) {
        const int ub = sgu_uid(F, k + 1); if (ub >= 0) sgu_load(F, ub, B);
        sgu_process(F, ua, A);
        if (ub < 0) break;
        ua = sgu_uid(F, k + 2); if (ua >= 0) sgu_load(F, ua, A);
        sgu_process(F, ub, B);
        k += 2;
    }
}


__device__ __forceinline__ void p2_mixers(Frame& F) {
    LAS float* BLw = (LAS float*)(F.lds + P2_BIAS);
    { const int e0 = F.wave * 64 + pg8::lane_id_v(); float bv[8];
#pragma unroll
        for (int i = 0; i < 8; ++i) { const int e = e0 + i * NTHR, hh = e >> 8, idx = e & 255, rel = idx - 191, n = rel < 0 ? -rel : rel;
            const int v = n < 8 ? n : (n < 12 ? 8 : n < 16 ? 9 : n < 23 ? 10 : n < 32 ? 11 : n < 46 ? 12 : n < 64 ? 13 : n < 91 ? 14 : 15);
            bv[i] = F.rel_tab[((rel > 0 ? 16 : 0) + v) * 16 + hh]; }
#pragma unroll
        for (int i = 0; i < 8; ++i) { const int e = e0 + i * NTHR; BLw[e] = ((e & 255) < 255) ? bv[i] * LOG2E : 0.f; } }
    __syncthreads();
    attn_units(F);
    sgu_units(F);
#if P0_LATE_W
    __syncthreads();
    if (F.G == 256) { if (F.vcu >= 32) p0_transposes(F, 32 * 232, 32 * 232 + 2 * 16 * 64 + 2 * 32 * 64, (F.vcu - 32) * NWAVES + F.wave, 224 * NWAVES); }
    else p0_transposes(F, 32 * 232, 32 * 232 + 2 * 16 * 64 + 2 * 32 * 64, F.vcu * NWAVES + F.wave, F.G * NWAVES);
#endif
}
constexpr size_t WS_SS2S = WS_SS2 + (size_t)MPROMPT * 32 * 4;
struct SkMerge { const bf16 *RATIO, *SB; bf16* H;
    __device__ __forceinline__ void mid(f32x4& acc, int row, int col) const { const unsigned long long w = *(const GAS unsigned long long*)(RATIO + (size_t)row * 2048 + col); const unsigned lo = (unsigned)w, hi = (unsigned)(w >> 32);
        acc *= (f32x4){pg8::bf_lo(lo), pg8::bf_hi(lo), pg8::bf_lo(hi), pg8::bf_hi(hi)}; }
    __device__ __forceinline__ void fin(const f32x4 acc, int row, int col, int, int) const { const unsigned long long w = *(const GAS unsigned long long*)(SB + (size_t)row * 2048 + col); const unsigned lo = (unsigned)w, hi = (unsigned)(w >> 32);
        const f32x4 v = acc * (f32x4){pg8::bf_lo(lo), pg8::bf_hi(lo), pg8::bf_lo(hi), pg8::bf_hi(hi)};
        *(GAS unsigned long long*)(H + (size_t)row * 2048 + col) = (unsigned long long)pkb(v.x, v.y) | ((unsigned long long)pkb(v.z, v.w) << 32); } };
struct SkOut { const float* xs; bf16* XH; float* SS2S;
    __device__ __forceinline__ void mid(f32x4&, int, int) const {}
    __device__ __forceinline__ void fin(const f32x4 acc, int row, int col, int part, int fq) const { const f32x4 v = acc + *(const GAS f32x4*)(xs + (size_t)(row - MPROMPT) * 2048 + col);
        *(GAS unsigned long long*)(XH + (size_t)row * 2048 + col) = (unsigned long long)pkh(v.x, v.y) | ((unsigned long long)pkh(v.z, v.w) << 32);
        float s = (v.x * v.x + v.y * v.y) + (v.z * v.z + v.w * v.w); s += __shfl_xor(s, 16); s += __shfl_xor(s, 32);
        if (fq == 0) SS2S[(size_t)(row - MPROMPT) * 128 + part] = s; } };
struct SkQ { bf16* QP;
    __device__ __forceinline__ void mid(f32x4&, int, int) const {}
    __device__ __forceinline__ void fin(const f32x4 acc, int row, int col, int, int) const { *(GAS unsigned long long*)(QP + (size_t)row * 2048 + col) = (unsigned long long)pkh(acc.x, acc.y) | ((unsigned long long)pkh(acc.z, acc.w) << 32); } };
template <bool F16, bool MID, class Epi>
__device__ __forceinline__ void skinny_gemm(Frame& F, const bf16* A, const bf16* Bt, const Epi& E) {
    const int lane = pg8::lane_id_v(), w = F.wave, fr = lane & 15, fq = lane >> 4;
    LAS f32x4* part = (LAS f32x4*)(F.lds + RING_OFF);
    for (int job = F.vcu; job < 256; job += F.G) {
        const int rb = job & 3, cb = job >> 2;
        const bf16* ap = A + (size_t)(MPROMPT + 32 * rb + fr) * 2048 + 256 * w + 8 * fq;
        const bf16* bp = Bt + (size_t)(32 * cb + fr) * 2048 + 256 * w + 8 * fq;
        bf16x8 a0[8], a1[8], b0[8], b1[8];
#pragma unroll
        for (int u = 0; u < 8; ++u) { a0[u] = *(const GAS bf16x8*)(ap + 32 * u); a1[u] = *(const GAS bf16x8*)(ap + 16 * 2048 + 32 * u); b0[u] = *(const GAS bf16x8*)(bp + 32 * u); b1[u] = *(const GAS bf16x8*)(bp + 16 * 2048 + 32 * u); }
        f32x4 c00 = {0.f, 0.f, 0.f, 0.f}, c01 = c00, c10 = c00, c11 = c00;
#pragma unroll
        for (int u = 0; u < 8; ++u) { c00 = pg8::mma16<F16>(b0[u], a0[u], c00); c01 = pg8::mma16<F16>(b1[u], a0[u], c01); c10 = pg8::mma16<F16>(b0[u], a1[u], c10); c11 = pg8::mma16<F16>(b1[u], a1[u], c11); }
        __syncthreads();
        part[(w * 4 + 0) * 64 + lane] = c00; part[(w * 4 + 1) * 64 + lane] = c01; part[(w * 4 + 2) * 64 + lane] = c10; part[(w * 4 + 3) * 64 + lane] = c11;
        __syncthreads();
        if (w < 4) {
            f32x4 s1 = part[(0 * 4 + w) * 64 + lane], s2 = part[(4 * 4 + w) * 64 + lane];
#pragma unroll
            for (int ww = 1; ww < 4; ++ww) { s1 += part[(ww * 4 + w) * 64 + lane]; s2 += part[((ww + 4) * 4 + w) * 64 + lane]; }
            const int row = MPROMPT + 32 * rb + 16 * (w >> 1) + fr, col = 32 * cb + 16 * (w & 1) + 4 * fq;
            if (MID) E.mid(s1, row, col);
            E.fin(s1 + s2, row, col, cb * 2 + (w & 1), fq);
        }
    }
}
typedef _Float16 f16x8v __attribute__((ext_vector_type(8)));
__device__ __forceinline__ int enc_f(float f) { const int b = __builtin_bit_cast(int, f); return b ^ ((b >> 31) & 0x7fffffff); }
__device__ __forceinline__ float dec_f(int k) { return __builtin_bit_cast(float, k ^ ((k >> 31) & 0x7fffffff)); }
__device__ __forceinline__ int imax_(int a, int b) { return a > b ? a : b; }
__device__ __forceinline__ int imin_(int a, int b) { return a < b ? a : b; }
#define P6_CE(a, b) do { const int mx_ = imax_(a, b), mn_ = imin_(a, b); a = mx_; b = mn_; } while (0)
__device__ __forceinline__ void sort16_desc(int (&v)[16]) {
#pragma unroll
    for (int k = 2; k <= 16; k <<= 1)
#pragma unroll
        for (int j = k >> 1; j > 0; j >>= 1)
#pragma unroll
            for (int i = 0; i < 16; ++i) { const int l = i ^ j; if (l > i) { if ((i & k) == 0) P6_CE(v[i], v[l]); else P6_CE(v[l], v[i]); } }
}
__device__ __forceinline__ void bitonic_merge16_desc(int (&v)[16]) {
#pragma unroll
    for (int j = 8; j > 0; j >>= 1)
#pragma unroll
        for (int i = 0; i < 16; ++i) { const int l = i ^ j; if (l > i) P6_CE(v[i], v[l]); }
}
__device__ __forceinline__ void merge_top16(int (&T)[16], const int (&N)[16]) {
#pragma unroll
    for (int i = 0; i < 16; ++i) T[i] = imax_(T[i], N[15 - i]);
    bitonic_merge16_desc(T);
}
__device__ __forceinline__ int half_partner(int x) { return (int)pg8::partner32((unsigned)x); }
struct CandTab { int ci[64], cj[64]; };
__host__ __device__ constexpr CandTab make_cand() { CandTab t{}; int n = 0; for (int i = 0; i < 16; ++i) for (int j = 0; j < 16; ++j) if ((i + 1) * (j + 1) <= 16) { t.ci[n] = i; t.cj[n] = j; ++n; } for (; n < 64; ++n) { t.ci[n] = -1; t.cj[n] = -1; } return t; }
constexpr CandTab CAND = make_cand();
constexpr int P6_SC = 0;

constexpr int P6_KEYS = 65536;
__device__ __forceinline__ void p6_job(Frame& F, const int job) {
    const int lane = pg8::lane_id_v(), w = F.wave, r = lane & 31, h = lane >> 5;
    const bf16* QP = (const bf16*)(F.ws + WS_SB); const bf16* KH = (const bf16*)(F.ws + WS_KEYS); const float* SS2 = (const float*)(F.ws + WS_SS2);
    unsigned long long* SEL = (unsigned long long*)(F.ws + WS_RA);
    LAS int* SC = (LAS int*)(F.lds + P6_SC + w * 8192);
    constexpr int NTILE = MREAL / 32, NGRP = (NTILE + 7) / 8, NJOB = NGRP * 8;
    {
        const int hq = job & 7, tile = (job >> 3) * 8 + w;
        { const int tid = w * 64 + lane;
#pragma unroll
            for (int i = 0; i < 8; ++i) { const int idx = tid + 512 * i, p = idx >> 11, n = (idx >> 4) & 127, c = idx & 15;
                *(LAS v4u*)(F.lds + P6_KEYS + p * 32768 + c * 2048 + n * 16) = *(const GAS v4u*)(KH + ((size_t)((hq * 2 + p) * 128 + n)) * 128 + c * 8); } }
        __syncthreads();
        if (tile < NTILE) {
        const int t = tile * 32 + r;
        int AB[2][16];
#pragma unroll
        for (int p = 0; p < 2; ++p) {
            f16x8v qf[8];
#pragma unroll
            for (int ks = 0; ks < 8; ++ks) qf[ks] = *(const GAS f16x8v*)(QP + (size_t)t * 2048 + hq * 256 + p * 128 + ks * 16 + h * 8);
            int T[16];
#pragma unroll
            for (int nb = 0; nb < 4; ++nb) {
                f32x16 acc = {};
                const LAS unsigned char* kp = F.lds + P6_KEYS + p * 32768 + h * 2048 + (nb * 32 + r) * 16;
#pragma unroll
                for (int ks = 0; ks < 8; ++ks) { const f16x8v kf = *(const LAS f16x8v*)(kp + ks * 4096); acc = __builtin_amdgcn_mfma_f32_32x32x16_f16(kf, qf[ks], acc, 0, 0, 0); }
                int N[16];
#pragma unroll
                for (int i = 0; i < 16; ++i) N[i] = (enc_f(acc[i]) & ~127) | (nb * 32 + crow(i, h));
                sort16_desc(N);
                if (nb == 0) {
#pragma unroll
                    for (int i = 0; i < 16; ++i) T[i] = N[i];
                } else merge_top16(T, N);
            }
            int P[16];
#pragma unroll
            for (int i = 0; i < 16; ++i) P[i] = half_partner(T[i]);
            merge_top16(T, P);
#pragma unroll
            for (int i = 0; i < 16; ++i) AB[p][i] = T[i];
        }
#pragma unroll
        for (int i = 0; i < 16; ++i) { SC[i * 64 + lane] = AB[0][i] & 127; SC[(16 + i) * 64 + lane] = AB[1][i] & 127; }
        float fa[16], fb[16];
#pragma unroll
        for (int i = 0; i < 16; ++i) { fa[i] = dec_f(AB[0][i] & ~127); fb[i] = dec_f(AB[1][i] & ~127); }
        int W[16];
#pragma unroll
        for (int g = 0; g < 4; ++g) {
            int N[16];
#pragma unroll
            for (int c = 0; c < 16; ++c) { const int ci = CAND.ci[g * 16 + c], cj = CAND.cj[g * 16 + c]; N[c] = ci >= 0 ? ((enc_f(fa[ci >= 0 ? ci : 0] + fb[cj >= 0 ? cj : 0]) & ~255) | (ci * 16 + cj)) : (int)0x80000000; }
            sort16_desc(N);
            if (g == 0) {
#pragma unroll
                for (int i = 0; i < 16; ++i) W[i] = N[i];
            } else merge_top16(W, N);
        }
        float ssum = 0.f;
        if (tile >= MPROMPT / 32) { const GAS f32x4* sp = (const GAS f32x4*)((const float*)(F.ws + WS_SS2S) + (size_t)(t - MPROMPT) * 128);
#pragma unroll 16
            for (int i = 0; i < 32; ++i) { const f32x4 v = sp[i]; ssum += (v.x + v.y) + (v.z + v.w); } }
        else { const GAS f32x4* sp = (const GAS f32x4*)(SS2 + (size_t)t * 32);
#pragma unroll
            for (int i = 0; i < 8; ++i) { const f32x4 v = sp[i]; ssum += (v.x + v.y) + (v.z + v.w); } }
        const float rt = 1.0f / sqrtf(ssum * (1.f / DM) + EPS);
        LDS_WAIT(); asm volatile("" ::: "memory");
        float gk[16]; int ek[16]; float Z = 0.f; const float c0 = dec_f(W[0] & ~255);
#pragma unroll
        for (int k = 0; k < 16; ++k) { const int code = W[k] & 255, ii = code >> 4, jj = code & 15; const int n0 = SC[ii * 64 + lane], n1 = SC[(16 + jj) * 64 + lane];
            ek[k] = n0 * 128 + n1; gk[k] = __builtin_amdgcn_exp2f((dec_f(W[k] & ~255) - c0) * rt * LOG2E); Z += gk[k]; }
        const float iz = 1.0f / Z;
        unsigned long long* dst = SEL + ((size_t)t * 8 + hq) * 16 + 8 * h;
#pragma unroll
        for (int k = 0; k < 8; k += 2) { const int e0 = h ? ek[k + 8] : ek[k], e1 = h ? ek[k + 9] : ek[k + 1]; const float g0 = (h ? gk[k + 8] : gk[k]) * iz, g1 = (h ? gk[k + 9] : gk[k + 1]) * iz;
            __hip_atomic_store(dst + k, (unsigned long long)(unsigned)e0 | ((unsigned long long)__builtin_bit_cast(unsigned, g0) << 32), RLX_AGENT);
            __hip_atomic_store(dst + k + 1, (unsigned long long)(unsigned)e1 | ((unsigned long long)__builtin_bit_cast(unsigned, g1) << 32), RLX_AGENT); }
        LDS_WAIT(); asm volatile("" ::: "memory");
        }
    }
}
__device__ __forceinline__ void p6_topk(Frame& F) {
    constexpr int NJOB = ((MREAL / 32 + 7) / 8) * 8;
    for (int job = F.vcu; job < NJOB; job += F.G) { p6_job(F, job); __syncthreads(); }
}
typedef _Float16 h2v __attribute__((ext_vector_type(2)));
constexpr int P7_RED = 0, P7_PART = LDSCTL_OFF;
#ifndef P7_UNR
#define P7_UNR (PEER_FP4 ? 16 : 8)
#endif
template <int M> __device__ __forceinline__ float xor_lane(float x) {
    if constexpr (M == 32) return __builtin_bit_cast(float, pg8::partner32(__builtin_bit_cast(unsigned, x)));
    else return __builtin_bit_cast(float, __builtin_amdgcn_ds_swizzle(__builtin_bit_cast(int, x), (M << 10) | 0x1f));
}
__device__ __forceinline__ float wave_sum_sw(float v) { v += xor_lane<1>(v); v += xor_lane<2>(v); v += xor_lane<4>(v); v += xor_lane<8>(v); v += xor_lane<16>(v); v += xor_lane<32>(v); return v; }
#if PEER_FP4
#ifndef P7_MFMA_U
#define P7_MFMA_U 1
#endif
typedef int v8i_t __attribute__((ext_vector_type(8)));
__device__ __forceinline__ void p7_gather(Frame& F) {
    const int lane = pg8::lane_id_v(), w = F.wave;
    const bf16* XH = (const bf16*)(F.ws + WS_RATIO); const unsigned char* EU4 = F.ws + WS_EU; const float* EUS = (const float*)(F.ws + WS_EU + 16 * MiB); const unsigned char* EV4 = F.ws + WS_EU + 32 * MiB; const float* EVS = (const float*)(F.ws + WS_EU + 48 * MiB);
    const unsigned long long* SEL = (const unsigned long long*)(F.ws + WS_RA);
    int it = 0;
#ifdef P7_ACTIVE_PER_XCD
    if ((F.vcu & 31) >= P7_ACTIVE_PER_XCD) return;
    const int rank_ = (F.vcu >> 5) * P7_ACTIVE_PER_XCD + (F.vcu & 31), nrank_ = 8 * P7_ACTIVE_PER_XCD;
#else
    const int rank_ = F.vcu, nrank_ = F.G;
#endif
    for (int t = rank_; t < MREAL; t += nrank_, ++it) {
        LAS float* RED = (LAS float*)(F.lds + P7_RED + (it & 1) * 65536); LAS float* PART = (LAS float*)(F.lds + P7_PART + (it & 1) * 32);
        const unsigned long long sel = SEL[((size_t)t * 8 + w) * 16 + (lane >> 2)];
        const int eidx = (int)(unsigned)sel; const float gate = __builtin_bit_cast(float, (unsigned)(sel >> 32));
        const float su_l = EUS[eidx], sv_l = EVS[eidx];
        unsigned xw[16];
#pragma unroll
        for (int q = 0; q < 8; ++q) { const unsigned long long v = *(const GAS unsigned long long*)(XH + (size_t)t * DM + q * 256 + lane * 4); xw[2 * q] = (unsigned)v; xw[2 * q + 1] = (unsigned)(v >> 32); }
#if P7_MFMA_U
        v8i_t xb;
        { typedef _Float16 h32x __attribute__((ext_vector_type(32))); typedef unsigned u6x __attribute__((ext_vector_type(6))); h32x hx;
#pragma unroll
          for (int i = 0; i < 16; ++i) { const h2v p = __builtin_bit_cast(h2v, xw[i]); hx[2 * i] = p[0]; hx[2 * i + 1] = p[1]; }
          const u6x px = __builtin_amdgcn_cvt_scalef32_pk32_fp6_f16(hx, 1.0f);
          xb = (v8i_t){(int)px[0], (int)px[1], (int)px[2], (int)px[3], (int)px[4], (int)px[5], 0, 0}; }
        float mk[4];
#pragma unroll
        for (int r4 = 0; r4 < 4; ++r4) mk[r4] = ((lane >> 4) == ((lane & 15) >> 2) && (lane & 3) == r4) ? 1.f : 0.f;
#endif
        float ssum = 0.f;
#pragma unroll
        for (int i = 0; i < 16; ++i) { const h2v hv = __builtin_bit_cast(h2v, xw[i]); ssum = __builtin_amdgcn_fdot2(hv, hv, ssum, false); }
        ssum = wave_sum_sw(ssum);
        const float rt = 1.0f / sqrtf(ssum * (1.f / DM) + EPS);
        float dp[16];
#pragma unroll
        for (int k0 = 0; k0 < 16; k0 += P7_UNR) {
            v4u ur[P7_UNR];
#pragma unroll
            for (int kk = 0; kk < P7_UNR; ++kk) { const int e = __builtin_amdgcn_readlane(eidx, 4 * (k0 + kk)); ur[kk] = *(const GAS v4u*)(EU4 + (size_t)e * 1024 + lane * 16); }
#if P7_MFMA_U
#pragma unroll
            for (int kk = 0; kk < P7_UNR; ++kk) { const v8i_t A = {(int)ur[kk].x, (int)ur[kk].y, (int)ur[kk].z, (int)ur[kk].w, 0, 0, 0, 0};
                const f32x4 d = __builtin_amdgcn_mfma_scale_f32_16x16x128_f8f6f4(A, xb, (f32x4){0.f, 0.f, 0.f, 0.f}, 4  , 2  , 0, 127, 0, 127);
                dp[k0 + kk] = (d[0] * mk[0] + d[1] * mk[1]) + (d[2] * mk[2] + d[3] * mk[3]); }
#else
#pragma unroll
            for (int kk = 0; kk < P7_UNR; ++kk) { float a = 0.f;
#pragma unroll
                for (int q = 0; q < 4; ++q) { const unsigned wq = ur[kk][q];
                    a = __builtin_amdgcn_fdot2(__builtin_amdgcn_cvt_scalef32_pk_f16_fp4(wq, 1.0f, 0), __builtin_bit_cast(h2v, xw[4 * q + 0]), a, false); a = __builtin_amdgcn_fdot2(__builtin_amdgcn_cvt_scalef32_pk_f16_fp4(wq, 1.0f, 1), __builtin_bit_cast(h2v, xw[4 * q + 1]), a, false);
                    a = __builtin_amdgcn_fdot2(__builtin_amdgcn_cvt_scalef32_pk_f16_fp4(wq, 1.0f, 2), __builtin_bit_cast(h2v, xw[4 * q + 2]), a, false); a = __builtin_amdgcn_fdot2(__builtin_amdgcn_cvt_scalef32_pk_f16_fp4(wq, 1.0f, 3), __builtin_bit_cast(h2v, xw[4 * q + 3]), a, false); }
                dp[k0 + kk] = a;
                }
#endif
#pragma unroll
            for (int kk = 0; kk < P7_UNR; ++kk) asm volatile("" : "+v"(dp[k0 + kk]) :: "memory");
        }
#define P7_TR(C, M) do { const bool up_ = (lane & (M)) != 0; _Pragma("unroll") for (int i = 0; i < (C) / 2; ++i) { const float keep_ = up_ ? dp[i + (C) / 2] : dp[i], send_ = up_ ? dp[i] : dp[i + (C) / 2]; dp[i] = keep_ + xor_lane<(M)>(send_); } } while (0)
        P7_TR(16, 32); P7_TR(8, 16); P7_TR(4, 8); P7_TR(2, 4);
#undef P7_TR
        float dk = dp[0]; dk += xor_lane<2>(dk); dk += xor_lane<1>(dk);
        const float hval = gate * pg8::gelu_tanh(dk * su_l * rt) * sv_l;
        h2v o2[16];
#pragma unroll
        for (int e = 0; e < 16; ++e) o2[e] = (h2v){(_Float16)0.f, (_Float16)0.f};
#pragma unroll
        for (int k0 = 0; k0 < 16; k0 += P7_UNR) {
            v4u vr[P7_UNR];
#pragma unroll
            for (int kk = 0; kk < P7_UNR; ++kk) { const int e = __builtin_amdgcn_readlane(eidx, 4 * (k0 + kk)); vr[kk] = *(const GAS v4u*)(EV4 + (size_t)e * 1024 + lane * 16); }
#pragma unroll
            for (int kk = 0; kk < P7_UNR; ++kk) { const float hk = __builtin_bit_cast(float, __builtin_amdgcn_readlane(__builtin_bit_cast(int, hval), 4 * (k0 + kk))) * 256.0f; const _Float16 hh = (_Float16)hk; const h2v hk2 = {hh, hh};
#pragma unroll
                for (int q = 0; q < 4; ++q) { const unsigned wq = vr[kk][q];
                    o2[4 * q + 0] = __builtin_elementwise_fma(__builtin_bit_cast(h2v, __builtin_amdgcn_cvt_scalef32_pk_f16_fp4(wq, 1.0f, 0)), hk2, o2[4 * q + 0]); o2[4 * q + 1] = __builtin_elementwise_fma(__builtin_bit_cast(h2v, __builtin_amdgcn_cvt_scalef32_pk_f16_fp4(wq, 1.0f, 1)), hk2, o2[4 * q + 1]);
                    o2[4 * q + 2] = __builtin_elementwise_fma(__builtin_bit_cast(h2v, __builtin_amdgcn_cvt_scalef32_pk_f16_fp4(wq, 1.0f, 2)), hk2, o2[4 * q + 2]); o2[4 * q + 3] = __builtin_elementwise_fma(__builtin_bit_cast(h2v, __builtin_amdgcn_cvt_scalef32_pk_f16_fp4(wq, 1.0f, 3)), hk2, o2[4 * q + 3]); } }
#pragma unroll
            for (int q = 0; q < 2; ++q) asm volatile("" : "+v"(o2[8 * q]), "+v"(o2[8 * q + 1]), "+v"(o2[8 * q + 2]), "+v"(o2[8 * q + 3]), "+v"(o2[8 * q + 4]), "+v"(o2[8 * q + 5]), "+v"(o2[8 * q + 6]), "+v"(o2[8 * q + 7]) :: "memory");
        }
#pragma unroll
        for (int q = 0; q < 8; ++q) *(LAS f32x4*)(RED + w * 2048 + q * 256 + lane * 4) = (f32x4){(float)o2[2 * q][0], (float)o2[2 * q][1], (float)o2[2 * q + 1][0], (float)o2[2 * q + 1][1]} * (1.0f / 256.0f);
        __syncthreads();
        const int col = w * 256 + lane * 4, soff = col;
        f32x4 sum = *(const LAS f32x4*)(RED + soff);
#pragma unroll
        for (int ww = 1; ww < 8; ++ww) sum += *(const LAS f32x4*)(RED + ww * 2048 + soff);
        { const unsigned long long xq = *(const GAS unsigned long long*)(XH + (size_t)t * DM + col); const unsigned x0 = (unsigned)xq, x1 = (unsigned)(xq >> 32); const h2v p0 = __builtin_bit_cast(h2v, x0), p1 = __builtin_bit_cast(h2v, x1);
            sum += (f32x4){(float)p0[0], (float)p0[1], (float)p1[0], (float)p1[1]}; }
        float sq = (sum.x * sum.x + sum.y * sum.y) + (sum.z * sum.z + sum.w * sum.w); sq = wave_sum_sw(sq);
        if (lane == 0) PART[w] = sq;
        __syncthreads();
        float tot = 0.f;
#pragma unroll
        for (int ww = 0; ww < 8; ++ww) tot += PART[ww];
        const float rf = 1.0f / sqrtf(tot * (1.f / DM) + EPS);
        const f32x4 gf = *(const GAS f32x4*)(F.norm_final_g + col);
        *(GAS f32x4*)(F.out + OUT_Y + (size_t)t * DM + col) = sum * rf * gf;
    }
}
#elif PEER_FP6
typedef _Float16 h32v __attribute__((ext_vector_type(32)));
typedef unsigned u6v __attribute__((ext_vector_type(6)));
typedef unsigned u2v __attribute__((ext_vector_type(2)));
__device__ __forceinline__ u6v ld_row6(const unsigned char* p) { const GAS u2v* q = (const GAS u2v*)p; const u2v a = q[0], b = q[1], c = q[2]; return (u6v){a.x, a.y, b.x, b.y, c.x, c.y}; }
__device__ __forceinline__ void p7_gather(Frame& F) {
    const int lane = pg8::lane_id_v(), w = F.wave;
    const bf16* XH = (const bf16*)(F.ws + WS_RATIO); const unsigned char* EU6 = F.ws + WS_EU; const unsigned char* EV6 = F.ws + WS_EU + 32 * MiB;
    const unsigned long long* SEL = (const unsigned long long*)(F.ws + WS_RA);
    int it = 0;
    for (int t = F.vcu; t < MREAL; t += F.G, ++it) {
        LAS float* RED = (LAS float*)(F.lds + P7_RED + (it & 1) * 65536); LAS float* PART = (LAS float*)(F.lds + P7_PART + (it & 1) * 32);
        const unsigned long long sel = SEL[((size_t)t * 8 + w) * 16 + (lane >> 2)];
        const int eidx = (int)(unsigned)sel; const float gate = __builtin_bit_cast(float, (unsigned)(sel >> 32));
        unsigned xw[16];
#pragma unroll
        for (int q = 0; q < 4; ++q) { const v4u v = *(const GAS v4u*)(XH + (size_t)t * DM + lane * 32 + q * 8); xw[4 * q] = v.x; xw[4 * q + 1] = v.y; xw[4 * q + 2] = v.z; xw[4 * q + 3] = v.w; }
        float ssum = 0.f;
#pragma unroll
        for (int i = 0; i < 16; ++i) { const h2v hv = __builtin_bit_cast(h2v, xw[i]); ssum = __builtin_amdgcn_fdot2(hv, hv, ssum, false); }
        ssum = wave_sum_sw(ssum);
        const float rt = 1.0f / sqrtf(ssum * (1.f / DM) + EPS);
        float dp[16];
#pragma unroll
        for (int k0 = 0; k0 < 16; k0 += P7_UNR) {
            u6v ur[P7_UNR];
#pragma unroll
            for (int kk = 0; kk < P7_UNR; ++kk) { const int e = __builtin_amdgcn_readlane(eidx, 4 * (k0 + kk)); ur[kk] = ld_row6(EU6 + (size_t)e * 1536 + lane * 24); }
#pragma unroll
            for (int kk = 0; kk < P7_UNR; ++kk) { const h32v d = __builtin_amdgcn_cvt_scalef32_pk32_f16_fp6(ur[kk], 1.0f); float a = 0.f;
#pragma unroll
                for (int i = 0; i < 16; ++i) { const h2v dd = {d[2 * i], d[2 * i + 1]}; a = __builtin_amdgcn_fdot2(dd, __builtin_bit_cast(h2v, xw[i]), a, false); }
                dp[k0 + kk] = a; }
#pragma unroll
            for (int kk = 0; kk < P7_UNR; ++kk) asm volatile("" : "+v"(dp[k0 + kk]) :: "memory");
        }
#define P7_TR(C, M) do { const bool up_ = (lane & (M)) != 0; _Pragma("unroll") for (int i = 0; i < (C) / 2; ++i) { const float keep_ = up_ ? dp[i + (C) / 2] : dp[i], send_ = up_ ? dp[i] : dp[i + (C) / 2]; dp[i] = keep_ + xor_lane<(M)>(send_); } } while (0)
        P7_TR(16, 32); P7_TR(8, 16); P7_TR(4, 8); P7_TR(2, 4);
#undef P7_TR
        float dk = dp[0]; dk += xor_lane<2>(dk); dk += xor_lane<1>(dk);
        const float hval = gate * pg8::gelu_tanh(dk * rt * (1.0f / PEER_SU)) * (1.0f / PEER_SV);
        float o[32];
#pragma unroll
        for (int e = 0; e < 32; ++e) o[e] = 0.f;
#pragma unroll
        for (int k0 = 0; k0 < 16; k0 += P7_UNR) {
            u6v vr[P7_UNR];
#pragma unroll
            for (int kk = 0; kk < P7_UNR; ++kk) { const int e = __builtin_amdgcn_readlane(eidx, 4 * (k0 + kk)); vr[kk] = ld_row6(EV6 + (size_t)e * 1536 + lane * 24); }
#pragma unroll
            for (int kk = 0; kk < P7_UNR; ++kk) { const float hk = __builtin_bit_cast(float, __builtin_amdgcn_readlane(__builtin_bit_cast(int, hval), 4 * (k0 + kk))); const h32v d = __builtin_amdgcn_cvt_scalef32_pk32_f16_fp6(vr[kk], 1.0f);
#pragma unroll
                for (int e = 0; e < 32; ++e) o[e] = __builtin_fmaf((float)d[e], hk, o[e]); }
#pragma unroll
            for (int q = 0; q < 4; ++q) asm volatile("" : "+v"(o[8 * q]), "+v"(o[8 * q + 1]), "+v"(o[8 * q + 2]), "+v"(o[8 * q + 3]), "+v"(o[8 * q + 4]), "+v"(o[8 * q + 5]), "+v"(o[8 * q + 6]), "+v"(o[8 * q + 7]) :: "memory");
        }
        { const int L = lane;
#pragma unroll
            for (int q = 0; q < 8; ++q) *(LAS f32x4*)(RED + w * 2048 + L * 32 + ((q + L) & 7) * 4) = (f32x4){o[4 * q], o[4 * q + 1], o[4 * q + 2], o[4 * q + 3]}; }
        __syncthreads();
        const int col = w * 256 + lane * 4; const int Lb = col >> 5, qb = (col >> 2) & 7, soff = Lb * 32 + ((qb + Lb) & 7) * 4;
        f32x4 sum = *(const LAS f32x4*)(RED + soff);
#pragma unroll
        for (int ww = 1; ww < 8; ++ww) sum += *(const LAS f32x4*)(RED + ww * 2048 + soff);
        { const unsigned long long xq = *(const GAS unsigned long long*)(XH + (size_t)t * DM + col); const unsigned x0 = (unsigned)xq, x1 = (unsigned)(xq >> 32); const h2v p0 = __builtin_bit_cast(h2v, x0), p1 = __builtin_bit_cast(h2v, x1);
            sum += (f32x4){(float)p0[0], (float)p0[1], (float)p1[0], (float)p1[1]}; }
        float sq = (sum.x * sum.x + sum.y * sum.y) + (sum.z * sum.z + sum.w * sum.w); sq = wave_sum_sw(sq);
        if (lane == 0) PART[w] = sq;
        __syncthreads();
        float tot = 0.f;
#pragma unroll
        for (int ww = 0; ww < 8; ++ww) tot += PART[ww];
        const float rf = 1.0f / sqrtf(tot * (1.f / DM) + EPS);
        const f32x4 gf = *(const GAS f32x4*)(F.norm_final_g + col);
        *(GAS f32x4*)(F.out + OUT_Y + (size_t)t * DM + col) = sum * rf * gf;
    }
}
#else
#error "PEER expert tables: PEER_FP4 or PEER_FP6"
#endif
#ifndef PQ_MERGE
#define PQ_MERGE PEER_FP4
#endif
#if PQ_MERGE
constexpr int CW_QUEUE = 8192, CW_GCNT = 8256;
constexpr int Q_NITEM = 520 + MREAL;
static_assert(MREAL == 16512 && (CW_GCNT + 65) * 4 <= (int)CTL_ZERO_BYTES, "queue layout");
__device__ __forceinline__ int q_decode(const int idx) { return idx < 520 ? ~idx : idx - 520; }
__device__ __forceinline__ unsigned q_ready(unsigned* gcnt, const int g, int& upto, const int lane) {
    if (g >= upto) { const unsigned c = xb_ld(&gcnt[lane]), c64 = xb_ld(&gcnt[64]); const unsigned long long m = __ballot(c >= 8u);
        int n = (m == ~0ull) ? 64 : __builtin_ctzll(~m); if (n == 64 && c64 >= 8u) n = 65; upto = n; }
    return g < upto ? 8u : 0u;
}
__device__ __forceinline__ void p67_queue(Frame& F) {
    const int w = F.wave;
    unsigned* qctr = (unsigned*)(F.ctl + CW_QUEUE); unsigned* gcnt = (unsigned*)(F.ctl + CW_GCNT); unsigned* bar = (unsigned*)(F.ctl + CW_BAR);
    volatile LAS int* LQ = (volatile LAS int*)(F.lds + LDSCTL_OFF + 128);
    const bf16* XH = (const bf16*)(F.ws + WS_RATIO); const unsigned char* EU4 = F.ws + WS_EU; const float* EUS = (const float*)(F.ws + WS_EU + 16 * MiB); const unsigned char* EV4 = F.ws + WS_EU + 32 * MiB; const float* EVS = (const float*)(F.ws + WS_EU + 48 * MiB);
    unsigned long long* SEL = (unsigned long long*)(F.ws + WS_RA);
    int idx = F.vcu, slot = 0, ntok = 0, rdy_upto = 0; int ready = q_decode(idx) < 0 ? 1 : 0;
    while (idx < Q_NITEM) {
        const int lane = pg8::lane_id_v();
        unsigned nxr = 0u; if (w == 0 && lane == 0) nxr = xb_add(qctr, 1u);
        int nx = Q_NITEM; unsigned nrdy = 8u;
        const int item = q_decode(idx);
        if (item < 0) {
            const int job = ~item;
            p6_job(F, job);
            VM_WAIT();
            if (w == 0) { nx = (int)F.G + __builtin_amdgcn_readfirstlane((int)nxr); if (nx < Q_NITEM) { const int ni = q_decode(nx); if (ni >= 0) nrdy = q_ready(gcnt, ni >> 8, rdy_upto, lane); }
                if (lane == 0) { LQ[(slot ^ 1) * 2] = nx; LQ[(slot ^ 1) * 2 + 1] = nrdy >= 8u ? 1 : 0; } }
            __syncthreads();
            if (w == 0 && lane == 0) (void)xb_add(&gcnt[job >> 3], 1u);
        } else {
            const int t = item;
            if (!ready) { XB_SPIN(xb_ld(&gcnt[t >> 8]) < 8u, bar); }
            LAS float* RED = (LAS float*)(F.lds + P7_RED + (ntok & 1) * 65536); LAS float* PART = (LAS float*)(F.lds + P7_PART + (ntok & 1) * 32);
            const unsigned long long sel = __hip_atomic_load(SEL + ((size_t)t * 8 + w) * 16 + (lane >> 2), RLX_AGENT);
            const int eidx = (int)(unsigned)sel; const float gate = __builtin_bit_cast(float, (unsigned)(sel >> 32));
            const float su_l = EUS[eidx], sv_l = EVS[eidx];
            unsigned xw[16];
#pragma unroll
            for (int q = 0; q < 8; ++q) { const unsigned long long v = *(const GAS unsigned long long*)(XH + (size_t)t * DM + q * 256 + lane * 4); xw[2 * q] = (unsigned)v; xw[2 * q + 1] = (unsigned)(v >> 32); }
#if P7_MFMA_U
            v8i_t xb;
            { typedef _Float16 h32x __attribute__((ext_vector_type(32))); typedef unsigned u6x __attribute__((ext_vector_type(6))); h32x hx;
#pragma unroll
              for (int i = 0; i < 16; ++i) { const h2v p = __builtin_bit_cast(h2v, xw[i]); hx[2 * i] = p[0]; hx[2 * i + 1] = p[1]; }
              const u6x px = __builtin_amdgcn_cvt_scalef32_pk32_fp6_f16(hx, 1.0f);
              xb = (v8i_t){(int)px[0], (int)px[1], (int)px[2], (int)px[3], (int)px[4], (int)px[5], 0, 0}; }
            float mk[4];
#pragma unroll
            for (int r4 = 0; r4 < 4; ++r4) mk[r4] = ((lane >> 4) == ((lane & 15) >> 2) && (lane & 3) == r4) ? 1.f : 0.f;
#endif
            float ssum = 0.f;
#pragma unroll
            for (int i = 0; i < 16; ++i) { const h2v hv = __builtin_bit_cast(h2v, xw[i]); ssum = __builtin_amdgcn_fdot2(hv, hv, ssum, false); }
            ssum = wave_sum_sw(ssum);
            const float rt = 1.0f / sqrtf(ssum * (1.f / DM) + EPS);
            float dp[16];
#pragma unroll
            for (int k0 = 0; k0 < 16; k0 += P7_UNR) {
                v4u ur[P7_UNR];
#pragma unroll
                for (int kk = 0; kk < P7_UNR; ++kk) { const int e = __builtin_amdgcn_readlane(eidx, 4 * (k0 + kk)); ur[kk] = *(const GAS v4u*)(EU4 + (size_t)e * 1024 + lane * 16); }
#if P7_MFMA_U
#pragma unroll
                for (int kk = 0; kk < P7_UNR; ++kk) { const v8i_t A = {(int)ur[kk].x, (int)ur[kk].y, (int)ur[kk].z, (int)ur[kk].w, 0, 0, 0, 0};
                    const f32x4 d = __builtin_amdgcn_mfma_scale_f32_16x16x128_f8f6f4(A, xb, (f32x4){0.f, 0.f, 0.f, 0.f}, 4  , 2  , 0, 127, 0, 127);
                    dp[k0 + kk] = (d[0] * mk[0] + d[1] * mk[1]) + (d[2] * mk[2] + d[3] * mk[3]); }
#else
#pragma unroll
                for (int kk = 0; kk < P7_UNR; ++kk) { float a = 0.f;
#pragma unroll
                    for (int q = 0; q < 4; ++q) { const unsigned wq = ur[kk][q];
                        a = __builtin_amdgcn_fdot2(__builtin_amdgcn_cvt_scalef32_pk_f16_fp4(wq, 1.0f, 0), __builtin_bit_cast(h2v, xw[4 * q + 0]), a, false); a = __builtin_amdgcn_fdot2(__builtin_amdgcn_cvt_scalef32_pk_f16_fp4(wq, 1.0f, 1), __builtin_bit_cast(h2v, xw[4 * q + 1]), a, false);
                        a = __builtin_amdgcn_fdot2(__builtin_amdgcn_cvt_scalef32_pk_f16_fp4(wq, 1.0f, 2), __builtin_bit_cast(h2v, xw[4 * q + 2]), a, false); a = __builtin_amdgcn_fdot2(__builtin_amdgcn_cvt_scalef32_pk_f16_fp4(wq, 1.0f, 3), __builtin_bit_cast(h2v, xw[4 * q + 3]), a, false); }
                    dp[k0 + kk] = a;
                    }
#endif
#pragma unroll
                for (int kk = 0; kk < P7_UNR; ++kk) asm volatile("" : "+v"(dp[k0 + kk]) :: "memory");
            }
            if (w == 0) { nx = (int)F.G + __builtin_amdgcn_readfirstlane((int)nxr); if (nx < Q_NITEM) { const int ni = q_decode(nx); if (ni >= 0) nrdy = q_ready(gcnt, ni >> 8, rdy_upto, lane); } }
#define P7_TR(C, M) do { const bool up_ = (lane & (M)) != 0; _Pragma("unroll") for (int i = 0; i < (C) / 2; ++i) { const float keep_ = up_ ? dp[i + (C) / 2] : dp[i], send_ = up_ ? dp[i] : dp[i + (C) / 2]; dp[i] = keep_ + xor_lane<(M)>(send_); } } while (0)
            P7_TR(16, 32); P7_TR(8, 16); P7_TR(4, 8); P7_TR(2, 4);
#undef P7_TR
            float dk = dp[0]; dk += xor_lane<2>(dk); dk += xor_lane<1>(dk);
            const float hval = gate * pg8::gelu_tanh(dk * su_l * rt) * sv_l;
            unsigned long long xq = 0ull; f32x4 gf = {0.f, 0.f, 0.f, 0.f};
            h2v o2[16];
#pragma unroll
            for (int e = 0; e < 16; ++e) o2[e] = (h2v){(_Float16)0.f, (_Float16)0.f};
#pragma unroll
            for (int k0 = 0; k0 < 16; k0 += P7_UNR) {
                v4u vr[P7_UNR];
#pragma unroll
                for (int kk = 0; kk < P7_UNR; ++kk) { const int e = __builtin_amdgcn_readlane(eidx, 4 * (k0 + kk)); vr[kk] = *(const GAS v4u*)(EV4 + (size_t)e * 1024 + lane * 16); }
                if (k0 == 0) { xq = *(const GAS unsigned long long*)(XH + (size_t)t * DM + w * 256 + lane * 4); gf = *(const GAS f32x4*)(F.norm_final_g + w * 256 + lane * 4); }
#pragma unroll
                for (int kk = 0; kk < P7_UNR; ++kk) { const float hk = __builtin_bit_cast(float, __builtin_amdgcn_readlane(__builtin_bit_cast(int, hval), 4 * (k0 + kk))) * 256.0f; const _Float16 hh = (_Float16)hk; const h2v hk2 = {hh, hh};
#pragma unroll
                    for (int q = 0; q < 4; ++q) { const unsigned wq = vr[kk][q];
                        o2[4 * q + 0] = __builtin_elementwise_fma(__builtin_bit_cast(h2v, __builtin_amdgcn_cvt_scalef32_pk_f16_fp4(wq, 1.0f, 0)), hk2, o2[4 * q + 0]); o2[4 * q + 1] = __builtin_elementwise_fma(__builtin_bit_cast(h2v, __builtin_amdgcn_cvt_scalef32_pk_f16_fp4(wq, 1.0f, 1)), hk2, o2[4 * q + 1]);
                        o2[4 * q + 2] = __builtin_elementwise_fma(__builtin_bit_cast(h2v, __builtin_amdgcn_cvt_scalef32_pk_f16_fp4(wq, 1.0f, 2)), hk2, o2[4 * q + 2]); o2[4 * q + 3] = __builtin_elementwise_fma(__builtin_bit_cast(h2v, __builtin_amdgcn_cvt_scalef32_pk_f16_fp4(wq, 1.0f, 3)), hk2, o2[4 * q + 3]); } }
#pragma unroll
                for (int q = 0; q < 2; ++q) asm volatile("" : "+v"(o2[8 * q]), "+v"(o2[8 * q + 1]), "+v"(o2[8 * q + 2]), "+v"(o2[8 * q + 3]), "+v"(o2[8 * q + 4]), "+v"(o2[8 * q + 5]), "+v"(o2[8 * q + 6]), "+v"(o2[8 * q + 7]) :: "memory");
            }
#pragma unroll
            for (int q = 0; q < 8; ++q) *(LAS f32x4*)(RED + w * 2048 + q * 256 + lane * 4) = (f32x4){(float)o2[2 * q][0], (float)o2[2 * q][1], (float)o2[2 * q + 1][0], (float)o2[2 * q + 1][1]} * (1.0f / 256.0f);
            __syncthreads();
            const int col = w * 256 + lane * 4, soff = col;
            f32x4 sum = *(const LAS f32x4*)(RED + soff);
#pragma unroll
            for (int ww = 1; ww < 8; ++ww) sum += *(const LAS f32x4*)(RED + ww * 2048 + soff);
            { const unsigned x0 = (unsigned)xq, x1 = (unsigned)(xq >> 32); const h2v p0 = __builtin_bit_cast(h2v, x0), p1 = __builtin_bit_cast(h2v, x1);
                sum += (f32x4){(float)p0[0], (float)p0[1], (float)p1[0], (float)p1[1]}; }
            float sq = (sum.x * sum.x + sum.y * sum.y) + (sum.z * sum.z + sum.w * sum.w); sq = wave_sum_sw(sq);
            if (lane == 0) PART[w] = sq;
            if (w == 0 && lane == 0) { LQ[(slot ^ 1) * 2] = nx; LQ[(slot ^ 1) * 2 + 1] = nrdy >= 8u ? 1 : 0; }
            __syncthreads();
            float tot = 0.f;
#pragma unroll
            for (int ww = 0; ww < 8; ++ww) tot += PART[ww];
            const float rf = 1.0f / sqrtf(tot * (1.f / DM) + EPS);
            __builtin_nontemporal_store(sum * rf * gf, (GAS f32x4*)(F.out + OUT_Y + (size_t)t * DM + col));
        }
        slot ^= 1; ++ntok;
        idx = __builtin_amdgcn_readfirstlane(LQ[slot * 2]); ready = __builtin_amdgcn_readfirstlane(LQ[slot * 2 + 1]);
    }
}
#endif
struct Args { const float* in[20]; float* out; unsigned char* ws; };
__global__ void __launch_bounds__(NWAVES * 64, 2) hybrid_fwd(Args args) {
    extern __shared__ __attribute__((aligned(16))) unsigned char lds[];
    Frame F;
    F.lds = (LAS unsigned char*)lds;
    F.MISC = (volatile LAS unsigned*)(F.lds + MISC_OFF);
    F.wave = __builtin_amdgcn_readfirstlane(threadIdx.x >> 6);
    F.G = gridDim.x; { const int bx = blockIdx.x; F.vcu = (F.G % 8 == 0) ? (bx % 8) * (F.G / 8) + bx / 8 : bx; }
    F.ws = args.ws; F.out = args.out; F.ctl = (gu32*)(args.ws + WS_CTL);
    F.x_prompt = args.in[0]; F.x_sample = args.in[1]; F.cache_k = args.in[2]; F.cache_v = args.in[3]; F.norm_mix_g = args.in[4]; F.w_in = args.in[5]; F.sgu_norm_g = args.in[6];
    F.sgu_w_s = args.in[7]; F.sgu_b_s = args.in[8]; F.sinks = args.in[9]; F.rel_tab = args.in[10]; F.w_pa = args.in[11]; F.w_pb = args.in[12]; F.w_out = args.in[13]; F.norm_ffn_g = args.in[14];
    F.w_query = args.in[15]; F.sub_keys = args.in[16]; F.exp_u = args.in[17]; F.exp_v = args.in[18]; F.norm_final_g = args.in[19];
    for (int u = threadIdx.x; u < (LDS_BYTES - LDSCTL_OFF) / 4; u += NWAVES * 64) ((LAS unsigned*)(F.lds + LDSCTL_OFF))[u] = 0u;
    __syncthreads();
    XcdBarrier bar = xcd_barrier_post((unsigned*)(F.ctl + CW_BAR), F.MISC + 8);
    unsigned char* ws = args.ws;
    p0_prologue(F);
    xcd_barrier(bar);
    {
        pg8::Gemm g{(const bf16*)(ws + WS_RA), (const bf16*)(ws + WS_WIN), MPAD, DIN, DM}; pg8::StaticOrder S; S.init(MPAD, DIN, F.G, (int)blockIdx.x);
        pg8::EpiIn E{(bf16*)(ws + WS_Q), (bf16*)(ws + WS_KV), (bf16*)(ws + WS_U), (bf16*)(ws + WS_VS), (bf16*)(ws + WS_RATIO), (bf16*)(ws + WS_SB), (float*)(ws + WS_SS1),
                     F.out + OUT_KP, F.out + OUT_VP, F.out + OUT_KS, F.out + OUT_VS};
        pg8::gemm_phase<pg8::EpiIn, pg8::StaticOrder, true, true, false>(F.lds + RING_OFF, g, S, E, F.wave);
        constexpr int NU = (MPAD / 256) * (DIN / 256); const int full = NU % (int)F.G;
        if (NU > (int)F.G && full > 0) { if ((int)blockIdx.x >= full) p0_expert_tables(F, (int)blockIdx.x - full, (int)F.G - full); }
        else p0_expert_tables(F, F.vcu, F.G);
    }
    xcd_barrier(bar);
    p2_mixers(F);
    xcd_barrier(bar);
    {
        pg8::Gemm g{(const bf16*)(ws + WS_RA), (const bf16*)(ws + WS_WAB), MPROMPT, DM, DM}; pg8::StaticOrder S; S.init(MPROMPT, DM, F.G, (int)blockIdx.x);
        pg8::EpiMerge E{(const bf16*)(ws + WS_RATIO), (const bf16*)(ws + WS_SB), (bf16*)(ws + WS_RB)};
        pg8::gemm_phase<pg8::EpiMerge, pg8::StaticOrder, true, true, false>(F.lds + RING_OFF, g, S, E, F.wave);
        const SkMerge SE{(const bf16*)(ws + WS_RATIO), (const bf16*)(ws + WS_SB), (bf16*)(ws + WS_RB)}; skinny_gemm<false, true>(F, (const bf16*)(ws + WS_RA), (const bf16*)(ws + WS_WAB), SE);
    }
    xcd_barrier(bar);
    {
        pg8::Gemm g{(const bf16*)(ws + WS_RB), (const bf16*)(ws + WS_WOUT), MPROMPT, DM, DM}; pg8::StaticOrder S; S.init(MPROMPT, DM, F.G, (int)blockIdx.x);
        pg8::EpiOut E{F.x_prompt, F.x_sample, (bf16*)(ws + WS_RATIO), (float*)(ws + WS_SS2)};
        pg8::gemm_phase<pg8::EpiOut, pg8::StaticOrder, true, true, false>(F.lds + RING_OFF, g, S, E, F.wave);
        const SkOut SE{F.x_sample, (bf16*)(ws + WS_RATIO), (float*)(ws + WS_SS2S)}; skinny_gemm<false, false>(F, (const bf16*)(ws + WS_RB), (const bf16*)(ws + WS_WOUT), SE);
    }
    xcd_barrier(bar);
    {
        pg8::Gemm g{(const bf16*)(ws + WS_RATIO), (const bf16*)(ws + WS_WQ), MPROMPT, DM, DM}; pg8::StaticOrder S; S.init(MPROMPT, DM, F.G, (int)blockIdx.x);
        pg8::EpiQ E{(bf16*)(ws + WS_SB)};
        pg8::gemm_phase<pg8::EpiQ, pg8::StaticOrder, true, true, true>(F.lds + RING_OFF, g, S, E, F.wave);
        const SkQ SE{(bf16*)(ws + WS_SB)}; skinny_gemm<true, false>(F, (const bf16*)(ws + WS_RATIO), (const bf16*)(ws + WS_WQ), SE);
    }
    xcd_barrier(bar);
#if PQ_MERGE
    p67_queue(F);
#else
    p6_topk(F);
    xcd_barrier(bar);
    p7_gather(F);
#endif
}

extern "C" void kernel_launch(void* const* d_in, const int* in_sizes, int n_in, void* d_out, int out_size, void* d_ws, size_t ws_size, hipStream_t stream) {
    static int grid = 0;
    if (grid == 0) {
        if (n_in != 20 || in_sizes[0] != MPROMPT * DM || out_size != (int)OUT_TOTAL || ws_size < WS_END) {
            fprintf(stderr, "kernel_launch: shape mismatch: n_in %d, in0 %d, out %d (want %zu), ws %zu (want %zu); nothing launched\n", n_in, n_in > 0 ? in_sizes[0] : -1, out_size, (size_t)OUT_TOTAL, ws_size, (size_t)WS_END); grid = -1; return; }
        int dev = 0, cus = 0, per_cu = 0;
        if (hipGetDevice(&dev) != hipSuccess || hipDeviceGetAttribute(&cus, hipDeviceAttributeMultiprocessorCount, dev) != hipSuccess) { fprintf(stderr, "kernel_launch: device query failed\n"); grid = -1; return; }
        if (hipFuncSetAttribute((const void*)hybrid_fwd, hipFuncAttributeMaxDynamicSharedMemorySize, LDS_BYTES) != hipSuccess) { fprintf(stderr, "kernel_launch: hipFuncSetAttribute failed\n"); grid = -1; return; }
        if (hipOccupancyMaxActiveBlocksPerMultiprocessor(&per_cu, (const void*)hybrid_fwd, NWAVES * 64, LDS_BYTES) != hipSuccess || per_cu < 1)
            fprintf(stderr, "kernel_launch: note: occupancy query reports %d workgroups per CU\n", per_cu);
        (void)hipGetLastError();
        grid = cus;
    }
    if (grid < 0) return;
    if (hipMemsetAsync((char*)d_ws + WS_CTL, 0, CTL_ZERO_BYTES, stream) != hipSuccess) { fprintf(stderr, "kernel_launch: memset failed\n"); return; }
    Args a{};
    for (int i = 0; i < 20; ++i) a.in[i] = (const float*)d_in[i];
    a.out = (float*)d_out; a.ws = (unsigned char*)d_ws;

    hipLaunchKernelGGL(hybrid_fwd, dim3(grid), dim3(NWAVES * 64), LDS_BYTES, stream, a);
    const hipError_t le = hipPeekAtLastError();
    if (le != hipSuccess) fprintf(stderr, "kernel_launch: launch failed: %s\n", hipGetErrorName(le));
}
```

```cpp
#include <hip/hip_runtime.h>
#include <cstdio>
#include <cstdint>

namespace pg8 {
#define PG8_LAS __attribute__((address_space(3)))
typedef unsigned short bf16_t;
typedef short bf16x8 __attribute__((ext_vector_type(8)));
typedef float f32x4 __attribute__((ext_vector_type(4)));
typedef unsigned u32x4 __attribute__((ext_vector_type(4)));
constexpr int BM = 256, BK = 64, HALF = 128, HTB = HALF * BK * 2  , STAGE_BYTES = 8 * HTB, NXCD = 8, WGM = 8;

__host__ __device__ __forceinline__ int lds_byte(int r, int c) { const int st = (r >> 4) * 2 + (c >> 5), rr = r & 15, cc = c & 31, ob = rr * 64 + cc * 2; return st * 1024 + (ob ^ (((ob >> 9) & 1) << 5)); }
__host__ __device__ __forceinline__ void stage_rc(int b, int& R, int& C) { const int st = b / 1024, sb = b % 1024, swz = sb ^ (((sb >> 9) & 1) << 5); R = (st >> 1) * 16 + swz / 64; C = (st & 1) * 32 + (swz % 64) / 2; }
__host__ __device__ __forceinline__ int perm32(int rho) { const int n = rho >> 4, i = rho & 15; return 8 * (i >> 2) + 4 * n + (i & 3); }

__device__ __forceinline__ int lane_id_v() { int l; asm volatile("v_mbcnt_lo_u32_b32 %0, -1, 0\n\tv_mbcnt_hi_u32_b32 %0, -1, %0" : "=v"(l)); return l; }
__device__ __forceinline__ unsigned partner32(unsigned x) { unsigned a = x, b = x; asm volatile("" : "+v"(a)); asm volatile("" : "+v"(b)); auto rr = __builtin_amdgcn_permlane32_swap(a, b, false, false); return rr[0] ^ rr[1] ^ x; }
struct Unit { int pm, pn; };
struct Gemm { const bf16_t* A; const bf16_t* Bt; int M, N, K; };

struct StaticOrder {
    int nM, nN, nwg, G, c;
    __host__ __device__ void init(int M, int N, int G_, int c_) { nM = M / BM; nN = N / BM; nwg = nM * nN; G = G_; c = c_; }
    __host__ __device__ bool next(int i, Unit& u) const {
        const long L = (long)i * G + c; if (L >= nwg) return false;
        int wgid = (int)L; { const int q = nwg / NXCD, r = nwg % NXCD, xcd = wgid % NXCD, off = wgid / NXCD; wgid = (xcd < r ? xcd * (q + 1) : r * (q + 1) + (xcd - r) * q) + off; }
        const int nig = WGM * nN, gid = wgid / nig, fm = gid * WGM, gsz = (nM - fm) < WGM ? (nM - fm) : WGM;
        u.pm = fm + ((wgid % nig) % gsz); u.pn = (wgid % nig) / gsz; return true;
    }
    __device__ __forceinline__ void a_ready(const Unit&) const {}
    __device__ __forceinline__ void done(const Unit&) const {}
};

typedef float f32x2 __attribute__((ext_vector_type(2)));
typedef __bf16 bf16x2_t __attribute__((ext_vector_type(2)));
typedef _Float16 f16x2_t __attribute__((ext_vector_type(2)));
typedef _Float16 f16x8_t __attribute__((ext_vector_type(8)));
__device__ __forceinline__ unsigned pk_bf16(float lo, float hi) { f32x2 v = {lo, hi}; return __builtin_bit_cast(unsigned, __builtin_convertvector(v, bf16x2_t)); }
__device__ __forceinline__ unsigned pk_f16(float lo, float hi) { f32x2 v = {lo, hi}; return __builtin_bit_cast(unsigned, __builtin_convertvector(v, f16x2_t)); }
__device__ __forceinline__ float bf_lo(unsigned w) { return __builtin_bit_cast(float, w << 16); }
__device__ __forceinline__ float bf_hi(unsigned w) { return __builtin_bit_cast(float, w & 0xffff0000u); }
template <bool F16> __device__ __forceinline__ f32x4 mma16(bf16x8 a, bf16x8 b, f32x4 c) {
    if constexpr (F16) return __builtin_amdgcn_mfma_f32_16x16x32_f16(__builtin_bit_cast(f16x8_t, a), __builtin_bit_cast(f16x8_t, b), c, 0, 0, 0);
    else return __builtin_amdgcn_mfma_f32_16x16x32_bf16(a, b, c, 0, 0, 0);
}
__device__ __forceinline__ float gelu_tanh(float x) { const float y = x * (-2.3022081981f - 0.1029432396f * (x * x)); return x * __builtin_amdgcn_rcpf(1.f + __builtin_amdgcn_exp2f(y)); }
__device__ __forceinline__ float sigmoidf_(float x) { return __builtin_amdgcn_rcpf(1.f + __builtin_amdgcn_exp2f(-1.4426950409f * x)); }
__device__ __forceinline__ u32x4 pack8_bf16(const f32x4 a, const f32x4 b) { u32x4 w; w.x = pk_bf16(a[0], a[1]); w.y = pk_bf16(a[2], a[3]); w.z = pk_bf16(b[0], b[1]); w.w = pk_bf16(b[2], b[3]); return w; }
__device__ __forceinline__ u32x4 pack8_f16(const f32x4 a, const f32x4 b) { u32x4 w; w.x = pk_f16(a[0], a[1]); w.y = pk_f16(a[2], a[3]); w.z = pk_f16(b[0], b[1]); w.w = pk_f16(b[2], b[3]); return w; }
__device__ __forceinline__ float sq4(const f32x4 a) { return (a[0] * a[0] + a[1] * a[1]) + (a[2] * a[2] + a[3] * a[3]); }

constexpr float QSCALE = 0.125f * 1.4426950408889634f;
struct EpiIn {
    static constexpr bool PERM = true, AFTER_DRAIN = false, MID = false;
    bf16_t *Q, *KV, *U, *VS, *RATIO, *SB; float* SS1; float *outKp, *outVp, *outKs, *outVs;
    __device__ __forceinline__ void operator()(const f32x4 (&acc)[2][2][4][2], const Unit& u, int wr, int wc, int, int) const {
        const int lane_ = lane_id_v(), fr = lane_ & 15, fq = lane_ >> 4;
        const int pn = u.pn, rowb = u.pm * BM + wr * 64 + fr, cl = wc * 32 + 8 * fq;
        if (pn < 4) {
#pragma unroll
            for (int ai = 0; ai < 2; ++ai)
#pragma unroll
                for (int m = 0; m < 4; ++m) { bf16_t* rp = Q + (size_t)(rowb + ai * HALF + m * 16) * 1024 + pn * 256 + cl;
#pragma unroll
                    for (int bj = 0; bj < 2; ++bj) *(u32x4*)(rp + bj * HALF) = pack8_bf16(acc[ai][bj][m][0] * QSCALE, acc[ai][bj][m][1] * QSCALE); }
        } else if (pn == 4) {
#pragma unroll
            for (int ai = 0; ai < 2; ++ai)
#pragma unroll
                for (int m = 0; m < 4; ++m) { bf16_t* rp = KV + (size_t)(rowb + ai * HALF + m * 16) * 256 + cl;
#pragma unroll
                    for (int bj = 0; bj < 2; ++bj) *(u32x4*)(rp + bj * HALF) = pack8_bf16(acc[ai][bj][m][0], acc[ai][bj][m][1]); }
            if (u.pm < 64 && (u.pm & 7) == 7) {
#pragma unroll
                for (int m = 0; m < 4; ++m) { const size_t o = (size_t)((u.pm >> 3) * 128 + wr * 64 + m * 16 + fr) * 128 + cl;
                    __builtin_nontemporal_store(acc[1][0][m][0], (f32x4*)(outKp + o)); __builtin_nontemporal_store(acc[1][0][m][1], (f32x4*)(outKp + o + 4));
                    __builtin_nontemporal_store(acc[1][1][m][0], (f32x4*)(outVp + o)); __builtin_nontemporal_store(acc[1][1][m][1], (f32x4*)(outVp + o + 4)); }
            }
            if (u.pm == 64) {
#pragma unroll
                for (int m = 0; m < 4; ++m) { const size_t o = (size_t)(wr * 64 + m * 16 + fr) * 128 + cl;
                    __builtin_nontemporal_store(acc[0][0][m][0], (f32x4*)(outKs + o)); __builtin_nontemporal_store(acc[0][0][m][1], (f32x4*)(outKs + o + 4));
                    __builtin_nontemporal_store(acc[0][1][m][0], (f32x4*)(outVs + o)); __builtin_nontemporal_store(acc[0][1][m][1], (f32x4*)(outVs + o + 4)); }
            }
        } else if (pn < 13) {
            const bool isv = pn >= 9; bf16_t* base = isv ? VS : U; const int ct = (isv ? pn - 9 : pn - 5) * 256 + cl;
#pragma unroll
            for (int ai = 0; ai < 2; ++ai)
#pragma unroll
                for (int m = 0; m < 4; ++m) { const int row = rowb + ai * HALF + m * 16; bf16_t* rp = base + (size_t)row * 1024 + ct; float s = 0.f;
#pragma unroll
                    for (int bj = 0; bj < 2; ++bj) { f32x4 a = acc[ai][bj][m][0], b = acc[ai][bj][m][1];
#pragma unroll
                        for (int e = 0; e < 4; ++e) { a[e] = gelu_tanh(a[e]); b[e] = gelu_tanh(b[e]); }
                        s += sq4(a) + sq4(b); *(u32x4*)(rp + bj * HALF) = pack8_bf16(a, b); }
                    if (isv) { s += __shfl_xor(s, 16); s += __shfl_xor(s, 32); if (fq == 0) SS1[(size_t)row * 16 + (pn - 9) * 4 + wc] = s; } }
        } else {
            const int ct = (pn - 13) * 128 + cl;
#pragma unroll
            for (int ai = 0; ai < 2; ++ai)
#pragma unroll
                for (int m = 0; m < 4; ++m) { const size_t o = (size_t)(rowb + ai * HALF + m * 16) * 2048 + ct; f32x4 ra, rb, sa, sb2;
#pragma unroll
                    for (int e = 0; e < 4; ++e) {
                        const float eb0 = 1.f + __builtin_amdgcn_exp2f(-1.4426950409f * acc[ai][1][m][0][e]), eb1 = 1.f + __builtin_amdgcn_exp2f(-1.4426950409f * acc[ai][1][m][1][e]);
                        const float ea0 = 1.f + __builtin_amdgcn_exp2f(-1.4426950409f * acc[ai][0][m][0][e]), ea1 = 1.f + __builtin_amdgcn_exp2f(-1.4426950409f * acc[ai][0][m][1][e]);
                        sa[e] = __builtin_amdgcn_rcpf(eb0); sb2[e] = __builtin_amdgcn_rcpf(eb1); ra[e] = eb0 * __builtin_amdgcn_rcpf(ea0); rb[e] = eb1 * __builtin_amdgcn_rcpf(ea1); }
                    *(u32x4*)(RATIO + o) = pack8_bf16(ra, rb); *(u32x4*)(SB + o) = pack8_bf16(sa, sb2); }
        }
    }
};
struct EpiMerge {
    static constexpr bool PERM = true, AFTER_DRAIN = false, MID = true;
    const bf16_t *RATIO, *SB; bf16_t* H;
    __device__ __forceinline__ void mid(f32x4 (&acc)[2][2][4][2], const Unit& u, int wr, int wc, int, int) const {
        const int lane_ = lane_id_v(), fr = lane_ & 15, fq = lane_ >> 4;
        const int rowb = u.pm * BM + wr * 64 + fr, col = u.pn * 256 + wc * 32 + 8 * fq;
        u32x4 w[2][4][2];
#pragma unroll
        for (int ai = 0; ai < 2; ++ai)
#pragma unroll
            for (int m = 0; m < 4; ++m)
#pragma unroll
                for (int bj = 0; bj < 2; ++bj) w[ai][m][bj] = __builtin_nontemporal_load((const u32x4*)(RATIO + (size_t)(rowb + ai * HALF + m * 16) * 2048 + col + bj * HALF));
        asm volatile("" ::: "memory");
#pragma unroll
        for (int ai = 0; ai < 2; ++ai)
#pragma unroll
            for (int m = 0; m < 4; ++m)
#pragma unroll
                for (int bj = 0; bj < 2; ++bj) { const u32x4 v = w[ai][m][bj];
                    acc[ai][bj][m][0] *= (f32x4){bf_lo(v.x), bf_hi(v.x), bf_lo(v.y), bf_hi(v.y)}; acc[ai][bj][m][1] *= (f32x4){bf_lo(v.z), bf_hi(v.z), bf_lo(v.w), bf_hi(v.w)}; }
        asm volatile("" ::: "memory");
    }
    __device__ __forceinline__ void operator()(const f32x4 (&acc)[2][2][4][2], const Unit& u, int wr, int wc, int, int) const {
        const int lane_ = lane_id_v(), fr = lane_ & 15, fq = lane_ >> 4;
        const int rowb = u.pm * BM + wr * 64 + fr, col = u.pn * 256 + wc * 32 + 8 * fq;
        u32x4 w[2][4][2];
#pragma unroll
        for (int ai = 0; ai < 2; ++ai)
#pragma unroll
            for (int m = 0; m < 4; ++m)
#pragma unroll
                for (int bj = 0; bj < 2; ++bj) w[ai][m][bj] = __builtin_nontemporal_load((const u32x4*)(SB + (size_t)(rowb + ai * HALF + m * 16) * 2048 + col + bj * HALF));
        asm volatile("" ::: "memory");
#pragma unroll
        for (int ai = 0; ai < 2; ++ai) {
#pragma unroll
            for (int m = 0; m < 4; ++m)
#pragma unroll
                for (int bj = 0; bj < 2; ++bj) { const size_t o = (size_t)(rowb + ai * HALF + m * 16) * 2048 + col + bj * HALF; const u32x4 v = w[ai][m][bj];
                    *(u32x4*)(H + o) = pack8_bf16(acc[ai][bj][m][0] * (f32x4){bf_lo(v.x), bf_hi(v.x), bf_lo(v.y), bf_hi(v.y)}, acc[ai][bj][m][1] * (f32x4){bf_lo(v.z), bf_hi(v.z), bf_lo(v.w), bf_hi(v.w)}); }
            asm volatile("" ::: "memory");
        }
    }
};
#ifndef EPI_OUT_ROWS
#define EPI_OUT_ROWS 4
#endif
struct EpiOut {
    static constexpr bool PERM = true, AFTER_DRAIN = false, MID = false;
    const float *xp, *xs; bf16_t* XH; float* SS2;
    __device__ __forceinline__ void operator()(const f32x4 (&acc)[2][2][4][2], const Unit& u, int wr, int wc, int, int) const {
        const int lane_ = lane_id_v(), fr = lane_ & 15, fq = lane_ >> 4;
        const int rowb = u.pm * BM + wr * 64 + fr, col = u.pn * 256 + wc * 32 + 8 * fq;
#pragma unroll
        for (int ai = 0; ai < 2; ++ai)
#pragma unroll
            for (int mp = 0; mp < 4; mp += EPI_OUT_ROWS) {
                f32x4 xv[EPI_OUT_ROWS][2][2];
#pragma unroll
                for (int mm = 0; mm < EPI_OUT_ROWS; ++mm) { const int row = rowb + ai * HALF + (mp + mm) * 16; const float* xr = row < 16384 ? xp + (size_t)row * 2048 : (row < 16512 ? xs + (size_t)(row - 16384) * 2048 : nullptr);
#pragma unroll
                    for (int bj = 0; bj < 2; ++bj) { if (xr) { xv[mm][bj][0] = __builtin_nontemporal_load((const f32x4*)(xr + col + bj * HALF)); xv[mm][bj][1] = __builtin_nontemporal_load((const f32x4*)(xr + col + bj * HALF + 4)); } else { xv[mm][bj][0] = (f32x4){0.f, 0.f, 0.f, 0.f}; xv[mm][bj][1] = (f32x4){0.f, 0.f, 0.f, 0.f}; } } }
                asm volatile("" ::: "memory");
#pragma unroll
                for (int mm = 0; mm < EPI_OUT_ROWS; ++mm) { const int m = mp + mm, row = rowb + ai * HALF + m * 16; float s = 0.f;
#pragma unroll
                    for (int bj = 0; bj < 2; ++bj) { const f32x4 a = acc[ai][bj][m][0] + xv[mm][bj][0], b = acc[ai][bj][m][1] + xv[mm][bj][1];
                        s += sq4(a) + sq4(b); *(u32x4*)(XH + (size_t)row * 2048 + col + bj * HALF) = pack8_f16(a, b); }
                    s += __shfl_xor(s, 16); s += __shfl_xor(s, 32); if (fq == 0) SS2[(size_t)row * 32 + u.pn * 4 + wc] = s; }
                asm volatile("" ::: "memory");
            }
    }
};
struct EpiQ {
    static constexpr bool PERM = true, AFTER_DRAIN = false, MID = false;
    bf16_t* QP;
    __device__ __forceinline__ void operator()(const f32x4 (&acc)[2][2][4][2], const Unit& u, int wr, int wc, int, int) const {
        const int lane_ = lane_id_v(), fr = lane_ & 15, fq = lane_ >> 4;
        const int rowb = u.pm * BM + wr * 64 + fr, col = u.pn * 256 + wc * 32 + 8 * fq;
#pragma unroll
        for (int ai = 0; ai < 2; ++ai)
#pragma unroll
            for (int m = 0; m < 4; ++m)
#pragma unroll
                for (int bj = 0; bj < 2; ++bj) *(u32x4*)(QP + (size_t)(rowb + ai * HALF + m * 16) * 2048 + col + bj * HALF) = pack8_f16(acc[ai][bj][m][0], acc[ai][bj][m][1]);
    }
};
template <class Epi, class Sched, bool ALIGN_EPI = false, bool SP2 = false, bool F16 = false>
__device__ __forceinline__ void gemm_phase(PG8_LAS unsigned char* lds, const Gemm g, const Sched& S, const Epi& E, const int wid_in) {
    const int lane = lane_id_v(), wid = wid_in, tid = wid * 64 + lane, wr = wid >> 2, wc = wid & 3, fr = lane & 15, fq = lane >> 4;
    const int K = g.K, nt = K / BK;
    unsigned voffA[2], voffB[2];
#pragma unroll
    for (int i = 0; i < 2; ++i) { int R, C; stage_rc(tid * 16 + i * 8192, R, C); const int Rb = Epi::PERM ? ((R & ~31) + perm32(R & 31)) : R;
        voffA[i] = (unsigned)(R * K + C) * 2u; voffB[i] = (unsigned)(Rb * K + C) * 2u; }
    const size_t kstep = (size_t)(BK * 2);
    const size_t hstep = (size_t)HALF * K * 2;
    const size_t tstep = 2 * hstep;
    const unsigned ldsw = (unsigned)wid * 1024u;
    const int aoff = lds_byte(wr * 64 + fr, fq * 8), boff = lds_byte(wc * 32 + fr, fq * 8);
#define PG8_SA(b, h) (((b) * 2 + (h)) * HTB)
#define PG8_SB(b, h) ((4 + (b) * 2 + (h)) * HTB)
#define PG8_STAGE(bufoff, gbase, voff) do { _Pragma("unroll") for (int _i = 0; _i < 2; ++_i) \
        __builtin_amdgcn_global_load_lds((const unsigned*)((const char*)(gbase) + (voff)[_i]), (PG8_LAS unsigned*)(lds + (bufoff) + ldsw + _i * 8192), 16, 0, 0); } while (0)
#define PG8_LDA(dst, b, h) do { _Pragma("unroll") for (int m = 0; m < 4; ++m) _Pragma("unroll") for (int k = 0; k < 2; ++k) dst[m][k] = *(const PG8_LAS bf16x8*)(lds + PG8_SA(b, h) + aoff + m * 2048 + k * 1024); } while (0)
#define PG8_LDB(dst, b, h) do { _Pragma("unroll") for (int n = 0; n < 2; ++n) _Pragma("unroll") for (int k = 0; k < 2; ++k) dst[n][k] = *(const PG8_LAS bf16x8*)(lds + PG8_SB(b, h) + boff + n * 2048 + k * 1024); } while (0)
#define PG8_MMA(ai, bj, At, Bt) do { __builtin_amdgcn_s_setprio(1); _Pragma("unroll") for (int m = 0; m < 4; ++m) _Pragma("unroll") for (int n = 0; n < 2; ++n) _Pragma("unroll") for (int k = 0; k < 2; ++k) \
        acc[ai][bj][m][n] = mma16<F16>(Bt[n][k], At[m][k], acc[ai][bj][m][n]); __builtin_amdgcn_s_setprio(0); } while (0)
#define PG8_WAIT_V(n) asm volatile("s_waitcnt vmcnt(" #n ")" ::: "memory")
#define PG8_WAIT_L(n) asm volatile("s_waitcnt lgkmcnt(" #n ")" ::: "memory")
#define PG8_BAR __builtin_amdgcn_s_barrier()
#define PG8_SCHED __builtin_amdgcn_sched_barrier(0)
    Unit cur, nxt; int ui = 0;
    if (!S.next(0, cur)) return;
    f32x4 acc[2][2][4][2];
#pragma unroll
    for (int a = 0; a < 2; ++a)
#pragma unroll
        for (int b = 0; b < 2; ++b)
#pragma unroll
            for (int m = 0; m < 4; ++m)
#pragma unroll
                for (int n = 0; n < 2; ++n) acc[a][b][m][n] = (f32x4){0.f, 0.f, 0.f, 0.f};
    bf16x8 At[4][2], B0[2][2], B1[2][2];
    const char* cA = (const char*)g.A + (size_t)cur.pm * tstep; const char* cB = (const char*)g.Bt + (size_t)cur.pn * tstep;
    S.a_ready(cur);
    if constexpr (SP2) {
        PG8_STAGE(PG8_SB(0, 0), cB, voffB); PG8_STAGE(PG8_SB(0, 1), cB + hstep, voffB); PG8_STAGE(PG8_SA(0, 0), cA, voffA); PG8_STAGE(PG8_SA(0, 1), cA + hstep, voffA);
        if (wr == 1) PG8_BAR;
        PG8_WAIT_V(2); PG8_BAR;
        PG8_STAGE(PG8_SB(1, 0), cB + kstep, voffB); PG8_STAGE(PG8_SA(1, 0), cA + kstep, voffA); PG8_STAGE(PG8_SB(1, 1), cB + hstep + kstep, voffB);
        PG8_WAIT_V(6); PG8_BAR;
    } else {
        PG8_STAGE(PG8_SB(0, 0), cB, voffB); PG8_STAGE(PG8_SA(0, 0), cA, voffA); PG8_STAGE(PG8_SB(0, 1), cB + hstep, voffB); PG8_STAGE(PG8_SA(0, 1), cA + hstep, voffA);
        if (wr == 1) PG8_BAR;
        PG8_WAIT_V(4); PG8_BAR;
        PG8_STAGE(PG8_SB(1, 0), cB + kstep, voffB); PG8_STAGE(PG8_SA(1, 0), cA + kstep, voffA); PG8_STAGE(PG8_SB(1, 1), cB + hstep + kstep, voffB);
        PG8_WAIT_V(6); PG8_BAR;
    }
    for (;;) {
        const bool has_next = S.next(ui + 1, nxt);
        const char* nA = has_next ? (const char*)g.A + (size_t)nxt.pm * tstep : cA; const char* nB = has_next ? (const char*)g.Bt + (size_t)nxt.pn * tstep : cB;
        for (int t = 0; t < nt; t += 2) {
            const bool last = (t == nt - 2);
            const char* a1 = cA + (size_t)(t + 1) * kstep;
            const char* a2 = last ? nA : cA + (size_t)(t + 2) * kstep; const char* b2 = last ? nB : cB + (size_t)(t + 2) * kstep;
            const char* a3 = a2 + kstep; const char* b3 = b2 + kstep;
            if (last && has_next) S.a_ready(nxt);
            if constexpr (Epi::MID) { if (t == (nt >> 1)) E.mid(acc, cur, wr, wc, fr, fq); }
            if constexpr (SP2) {
            PG8_LDB(B0, 0, 0); PG8_LDB(B1, 0, 1); PG8_SCHED; PG8_LDA(At, 0, 0); PG8_STAGE(PG8_SA(1, 1), a1 + hstep, voffA);
            PG8_WAIT_V(8); PG8_WAIT_L(0); PG8_BAR; PG8_MMA(0, 0, At, B0); PG8_MMA(0, 1, At, B1); PG8_BAR; PG8_SCHED;
            PG8_LDA(At, 0, 1); PG8_STAGE(PG8_SB(0, 0), b2, voffB); PG8_STAGE(PG8_SB(0, 1), b2 + hstep, voffB); PG8_STAGE(PG8_SA(0, 0), a2, voffA);
            PG8_WAIT_V(8); PG8_WAIT_L(0); PG8_BAR; PG8_MMA(1, 0, At, B0); PG8_MMA(1, 1, At, B1); PG8_BAR; PG8_SCHED;
            PG8_LDB(B0, 1, 0); PG8_LDB(B1, 1, 1); PG8_SCHED; PG8_LDA(At, 1, 0); PG8_STAGE(PG8_SA(0, 1), a2 + hstep, voffA);
            PG8_WAIT_V(8); PG8_WAIT_L(0); PG8_BAR; PG8_MMA(0, 0, At, B0); PG8_MMA(0, 1, At, B1); PG8_BAR; PG8_SCHED;
            PG8_LDA(At, 1, 1); PG8_STAGE(PG8_SB(1, 0), b3, voffB); PG8_STAGE(PG8_SB(1, 1), b3 + hstep, voffB); PG8_STAGE(PG8_SA(1, 0), a3, voffA);
            PG8_WAIT_V(8); PG8_WAIT_L(0); PG8_BAR; PG8_MMA(1, 0, At, B0); PG8_MMA(1, 1, At, B1); PG8_BAR; PG8_SCHED;
            } else {
            PG8_LDB(B0, 0, 0); PG8_SCHED; PG8_LDA(At, 0, 0); PG8_STAGE(PG8_SA(1, 1), a1 + hstep, voffA);
            PG8_WAIT_L(8); PG8_BAR; PG8_WAIT_L(0); PG8_MMA(0, 0, At, B0); PG8_BAR; PG8_SCHED;
            PG8_LDB(B1, 0, 1); PG8_STAGE(PG8_SB(0, 0), b2, voffB);
            PG8_BAR; PG8_WAIT_L(0); PG8_MMA(0, 1, At, B1); PG8_BAR;
            PG8_LDA(At, 0, 1); PG8_STAGE(PG8_SA(0, 0), a2, voffA);
            PG8_BAR; PG8_WAIT_L(0); PG8_MMA(1, 0, At, B0); PG8_BAR; PG8_SCHED;
            PG8_STAGE(PG8_SB(0, 1), b2 + hstep, voffB);
            PG8_WAIT_V(6); PG8_BAR; PG8_MMA(1, 1, At, B1); PG8_BAR;
            PG8_LDB(B0, 1, 0); PG8_SCHED; PG8_LDA(At, 1, 0); PG8_STAGE(PG8_SA(0, 1), a2 + hstep, voffA);
            PG8_WAIT_L(8); PG8_BAR; PG8_WAIT_L(0); PG8_MMA(0, 0, At, B0); PG8_BAR; PG8_SCHED;
            PG8_LDB(B1, 1, 1); PG8_STAGE(PG8_SB(1, 0), b3, voffB);
            PG8_BAR; PG8_WAIT_L(0); PG8_MMA(0, 1, At, B1); PG8_BAR;
            PG8_LDA(At, 1, 1); PG8_STAGE(PG8_SA(1, 0), a3, voffA);
            PG8_BAR; PG8_WAIT_L(0); PG8_MMA(1, 0, At, B0); PG8_BAR; PG8_SCHED;
            PG8_STAGE(PG8_SB(1, 1), b3 + hstep, voffB);
            PG8_WAIT_V(6); PG8_BAR; PG8_MMA(1, 1, At, B1); PG8_BAR;
            }
        }
        if constexpr (ALIGN_EPI) { if (wr == 0) PG8_BAR; }
        if constexpr (!Epi::AFTER_DRAIN) { E(acc, cur, wr, wc, fr, fq); S.done(cur); }
        if (!has_next) break;
#pragma unroll
        for (int a = 0; a < 2; ++a)
#pragma unroll
            for (int b = 0; b < 2; ++b)
#pragma unroll
                for (int m = 0; m < 4; ++m)
#pragma unroll
                    for (int n = 0; n < 2; ++n) acc[a][b][m][n] = (f32x4){0.f, 0.f, 0.f, 0.f};
        cur = nxt; cA = nA; cB = nB; ++ui;
        if constexpr (ALIGN_EPI) { if (wr == 1) PG8_BAR; }
    }
    PG8_WAIT_V(0);
    if constexpr (!ALIGN_EPI) { if (wr == 0) PG8_BAR; }
    PG8_BAR;
    if constexpr (Epi::AFTER_DRAIN) { E.fused(acc, cur, wr, wc, fr, fq, lds, wid, lane); S.done(cur); }
#undef PG8_SA
#undef PG8_SB
#undef PG8_STAGE
#undef PG8_LDA
#undef PG8_LDB
#undef PG8_MMA
#undef PG8_WAIT_V
#undef PG8_WAIT_L
#undef PG8_BAR
#undef PG8_SCHED
}
}
#define GAS __attribute__((address_space(1)))
#define LAS __attribute__((address_space(3)))
typedef unsigned short bf16;
typedef unsigned v4u __attribute__((ext_vector_type(4)));
typedef float f32x4 __attribute__((ext_vector_type(4)));
typedef short bf16x8 __attribute__((ext_vector_type(8)));
typedef GAS unsigned gu32;
typedef GAS unsigned long long gu64;
#define RLX_AGENT __ATOMIC_RELAXED, __HIP_MEMORY_SCOPE_AGENT
#define LDS_WAIT() asm volatile("s_waitcnt lgkmcnt(0)" ::: "memory")
#define VM_WAIT() asm volatile("s_waitcnt vmcnt(0)" ::: "memory")
__device__ __forceinline__ unsigned long long rt() { return __builtin_amdgcn_s_memrealtime(); }
__device__ __forceinline__ unsigned f2bf(float f) { unsigned u = __builtin_bit_cast(unsigned, f); return (u + 0x7fffu + ((u >> 16) & 1u)) >> 16; }
__device__ __forceinline__ unsigned pk2(float lo, float hi) { return f2bf(lo) | (f2bf(hi) << 16); }

#define XB_TMO      128
#define XB_XCNT(j)  (256  + 64 * (j))
#define XB_XSUB(j)  (1280 + 64 * (j))
#define XB_XGEN(j)  (2304 + 64 * (j))
#define XB_TOP      3328
#define XB_TOPGEN   3392
#define XCD_BAR_WORDS 3456
#ifdef DEBUG_ORACLE
#define XB_SPIN_CAP (1u << 27)
#else
#define XB_SPIN_CAP (1u << 18)
#endif

__device__ __forceinline__ unsigned xb_ld(unsigned* p)              { return __hip_atomic_load(p, __ATOMIC_RELAXED, __HIP_MEMORY_SCOPE_AGENT); }
__device__ __forceinline__ unsigned xb_add(unsigned* p, unsigned v) { return __hip_atomic_fetch_add(p, v, __ATOMIC_RELAXED, __HIP_MEMORY_SCOPE_AGENT); }
__device__ __forceinline__ unsigned xb_xcc_id() { return (unsigned)__builtin_amdgcn_s_getreg((3 << 11) | 20) & 0xFu; }
#define XB_SPIN(cond, bar) do { unsigned _sp = 0; while (cond) { __builtin_amdgcn_s_sleep(1); \
    if ((++_sp & 255u) == 0u) { if (xb_ld(&(bar)[XB_TMO])) break; if (_sp > XB_SPIN_CAP) { atomicAdd(&(bar)[XB_TMO], 1u); break; } } } } while (0)

struct XcdBarrier {
    unsigned* bar; unsigned x;
    volatile LAS unsigned* st;
};

__device__ __forceinline__ XcdBarrier xcd_barrier_post(unsigned* bar, volatile LAS unsigned* st) {
    XcdBarrier b; b.bar = bar; b.x = xb_xcc_id(); b.st = st;
    if (threadIdx.x == 0) (void)xb_add(&bar[XB_XCNT(b.x)], 1u);
    return b;
}
__device__ __forceinline__ void xcd_barrier_complete(unsigned* bar, unsigned x, unsigned& nloc, unsigned& nx) {
    const unsigned G = gridDim.x * gridDim.y * gridDim.z;
    unsigned sum, cnt, mine, sp = 0u;
    for (;;) {
        sum = 0u; cnt = 0u; mine = 0u;
#pragma unroll
        for (unsigned j = 0; j < 16; ++j) { const unsigned c = xb_ld(&bar[XB_XCNT(j)]); sum += c; cnt += (c > 0u) ? 1u : 0u; mine = (j == x) ? c : mine; }
        if (sum == G) break;
        __builtin_amdgcn_s_sleep(1);
        if ((++sp & 255u) == 0u) { if (xb_ld(&bar[XB_TMO])) break; if (sp > XB_SPIN_CAP) { atomicAdd(&bar[XB_TMO], 1u); break; } }
    }
    nloc = mine > 0u ? mine : 1u; nx = cnt > 0u ? cnt : 1u;
}

__device__ __forceinline__ void xcd_barrier(const XcdBarrier& b) {
    asm volatile("s_waitcnt vmcnt(0)" ::: "memory");
    __syncthreads();
    if (threadIdx.x == 0) {
        unsigned* bar = b.bar;
        __builtin_amdgcn_s_waitcnt(0);
        unsigned nloc = b.st[0], nx = b.st[1];
        if (nloc == 0u) { xcd_barrier_complete(bar, b.x, nloc, nx); b.st[0] = nloc; b.st[1] = nx; }
        const unsigned old = xb_add(&bar[XB_XSUB(b.x)], 1u);
        const unsigned gen = old / nloc;
        if (old + 1u == (gen + 1u) * nloc) {
            __builtin_amdgcn_fence(__ATOMIC_RELEASE, "agent");
            asm volatile("s_waitcnt vmcnt(0)" ::: "memory");
            const unsigned og = xb_add(&bar[XB_TOP], 1u);
            const unsigned tg = og / nx;
            if (og + 1u == (tg + 1u) * nx) xb_add(&bar[XB_TOPGEN], 1u);
            else XB_SPIN(xb_ld(&bar[XB_TOPGEN]) == tg, bar);
            __builtin_amdgcn_fence(__ATOMIC_ACQUIRE, "agent");
            xb_add(&bar[XB_XGEN(b.x)], 1u);
            asm volatile("s_waitcnt vmcnt(0)" ::: "memory");
        } else {
            XB_SPIN(xb_ld(&bar[XB_XGEN(b.x)]) == gen, bar);
            __builtin_amdgcn_fence(__ATOMIC_ACQUIRE, "agent");
            asm volatile("s_waitcnt vmcnt(0)" ::: "memory");
        }
    }
    __syncthreads();
}
constexpr int NWAVES = 8, NTHR = 512;
constexpr int DM = 2048, SEQ = 2048, NBATCH = 8, TDEC = 16, MPROMPT = NBATCH * SEQ  , MSAMPLE = NBATCH * TDEC  , MREAL = MPROMPT + MSAMPLE  , MPAD = 16640  ;
constexpr int DIN = 7424, DATTN = 1024, DSGU = 1024, WINDOW = 128, CHUNK = 64, NHEADS = 16, HD = 64;
constexpr int NEXP = 16384, PEER_H = 8, PEER_K = 16;
#ifndef PEER_FP4
#define PEER_FP4 1
#endif
#ifndef PEER_FP6
#define PEER_FP6 (!PEER_FP4)
#endif
constexpr float PEER_SU = 64.f, PEER_SV = 16.f;
constexpr float EPS = 1e-6f, LOG2E = 1.4426950408889634f;
constexpr size_t OUT_Y = 0, OUT_KP = (size_t)MREAL * DM, OUT_VP = OUT_KP + 131072, OUT_KS = OUT_VP + 131072, OUT_VS = OUT_KS + 16384, OUT_SGU = OUT_VS + 16384, OUT_TOTAL = OUT_SGU + 131072;
constexpr size_t MiB = 1u << 20;
constexpr size_t WS_CTL = 0, CTL_ZERO_BYTES = 64 * 1024;
constexpr size_t WS_WIN = 1 * MiB;
constexpr size_t WS_WAB = 30 * MiB;
constexpr size_t WS_WOUT = 38 * MiB;
constexpr size_t WS_WQ = 46 * MiB;
constexpr size_t WS_KEYS = 54 * MiB;
constexpr size_t WS_WSM = 54 * MiB + 512 * 1024;
constexpr size_t WS_SS1 = 55 * MiB;
constexpr size_t WS_SS2 = 57 * MiB;
constexpr size_t WS_EU = 60 * MiB, WS_EV = 124 * MiB;
constexpr size_t WS_RA = 188 * MiB;
constexpr size_t WS_RB = 253 * MiB;
constexpr size_t WS_Q = WS_RB, WS_KV = WS_Q + (size_t)MPAD * 1024 * 2, WS_U = WS_KV + (size_t)MPAD * 256 * 2, WS_VS = WS_U + (size_t)MPAD * 1024 * 2;
constexpr size_t WS_RC = 359 * MiB;
constexpr size_t WS_RATIO = WS_RC, WS_SB = WS_RC + 65 * MiB, WS_END = WS_RC + 130 * MiB;
static_assert(WS_VS + (size_t)MPAD * 1024 * 2 <= WS_RC && WS_END == 489 * MiB, "d_ws map");
constexpr int CW_BAR = 4096;
constexpr int RING_OFF = 0, RING_BYTES = 131072;
constexpr int LDSCTL_OFF = RING_BYTES, MISC_OFF = LDSCTL_OFF + 320;
constexpr int LDS_BYTES = 147456;
struct Frame {
    LAS unsigned char* lds; volatile LAS unsigned* MISC; gu32* ctl;
    int wave, vcu, G;
    const float *x_prompt, *x_sample, *cache_k, *cache_v, *norm_mix_g, *w_in, *sgu_norm_g, *sgu_w_s, *sgu_b_s, *sinks, *rel_tab, *w_pa, *w_pb, *w_out, *norm_ffn_g, *w_query, *sub_keys, *exp_u, *exp_v, *norm_final_g;
    float* out; unsigned char* ws;
};
__device__ __forceinline__ float wave_sum(float v) {
#pragma unroll
    for (int o = 1; o < 64; o <<= 1) v += __shfl_xor(v, o);
    return v;
}
__device__ __forceinline__ unsigned pkb(float lo, float hi) { return pg8::pk_bf16(lo, hi); }
__device__ __forceinline__ unsigned pkh(float lo, float hi) { return pg8::pk_f16(lo, hi); }
template <bool F16>
__device__ __forceinline__ void p0_transpose_item(const float* W, int N, bf16* WT, int kpitch, int koff, int drow0, int k0, int n0, const float* kscale, LAS float* scr, int lane) {
    float wv[32];
#pragma unroll
    for (int i = 0; i < 32; ++i) { const int kk = 2 * i + (lane >> 5); wv[i] = __builtin_nontemporal_load(W + (size_t)(k0 + kk) * N + n0 + (lane & 31)); }
#pragma unroll
    for (int i = 0; i < 32; ++i) { const int kk = 2 * i + (lane >> 5); scr[kk * 33 + (lane & 31)] = wv[i]; }
    LDS_WAIT(); asm volatile("" ::: "memory");
    const int c = lane & 7;
    float sc[8];
#pragma unroll
    for (int q = 0; q < 8; ++q) sc[q] = kscale ? kscale[k0 + 8 * c + q] : 1.f;
#pragma unroll
    for (int j = 0; j < 4; ++j) { const int n = (lane >> 3) + 8 * j; const LAS float* s = scr + (8 * c) * 33 + n;
        float v[8];
#pragma unroll
        for (int q = 0; q < 8; ++q) v[q] = s[q * 33] * sc[q];
        v4u o;
        if (F16) { o.x = pkh(v[0], v[1]); o.y = pkh(v[2], v[3]); o.z = pkh(v[4], v[5]); o.w = pkh(v[6], v[7]); }
        else     { o.x = pkb(v[0], v[1]); o.y = pkb(v[2], v[3]); o.z = pkb(v[4], v[5]); o.w = pkb(v[6], v[7]); }
        *(GAS v4u*)(WT + (size_t)(drow0 + n) * kpitch + koff + k0 + 8 * c) = o; }
    LDS_WAIT(); asm volatile("" ::: "memory");
}
__device__ __forceinline__ int win_row_of_col(int n) {
    if (n < 3328) return n;
    if (n < 5376) { const int q = n - 3328; return 3328 + (q >> 7) * 256 + (q & 127); }
    const int q = n - 5376; return 3328 + (q >> 7) * 256 + 128 + (q & 127);
}
__device__ __forceinline__ void rms_row_to_bf16(const float* xrow, const float* g, bf16* orow, int lane) {
    const GAS f32x4* xr = (const GAS f32x4*)xrow + lane; const GAS f32x4* gr = (const GAS f32x4*)g + lane;
    f32x4 v[8]; float s = 0.f;
#pragma unroll
    for (int j = 0; j < 8; ++j) { v[j] = xr[64 * j]; s += (v[j].x * v[j].x + v[j].y * v[j].y) + (v[j].z * v[j].z + v[j].w * v[j].w); }
    const float r = 1.0f / sqrtf(wave_sum(s) * (1.f / DM) + EPS);
    GAS unsigned long long* o8 = (GAS unsigned long long*)orow + lane;
#pragma unroll
    for (int j = 0; j < 8; ++j) { const f32x4 gg = gr[64 * j]; o8[64 * j] = (unsigned long long)pkb(v[j].x * r * gg.x, v[j].y * r * gg.y) | ((unsigned long long)pkb(v[j].z * r * gg.z, v[j].w * r * gg.w) << 32); }
}
__device__ __forceinline__ void p0_transposes(Frame& F, int first, int last, int gw, int NGW) {
    const int lane = pg8::lane_id_v();
    LAS float* scr = (LAS float*)(F.lds + RING_OFF + F.wave * 16384);
    bf16* WIN = (bf16*)(F.ws + WS_WIN); bf16* WAB = (bf16*)(F.ws + WS_WAB); bf16* WOUT = (bf16*)(F.ws + WS_WOUT); bf16* WQ = (bf16*)(F.ws + WS_WQ);
    constexpr int I_IN = 32 * 232, I_PA = 16 * 64, I_OUT = 32 * 64;
    for (int it = first + gw; it < last; it += NGW) {
        int r = it;
        if (r < I_IN) { const int kb = r / 232, nb = r % 232; p0_transpose_item<false>(F.w_in, DIN, WIN, 2048, 0, win_row_of_col(32 * nb), 64 * kb, 32 * nb, nullptr, scr, lane); continue; } r -= I_IN;
        if (r < I_PA) { const int kb = r / 64, nb = r % 64; p0_transpose_item<false>(F.w_pa, 2048, WAB, 2048, 0, 32 * nb, 64 * kb, 32 * nb, nullptr, scr, lane); continue; } r -= I_PA;
        if (r < I_PA) { const int kb = r / 64, nb = r % 64; p0_transpose_item<false>(F.w_pb, 2048, WAB, 2048, 1024, 32 * nb, 64 * kb, 32 * nb, nullptr, scr, lane); continue; } r -= I_PA;
        if (r < I_OUT) { const int kb = r / 64, nb = r % 64; p0_transpose_item<false>(F.w_out, 2048, WOUT, 2048, 0, 32 * nb, 64 * kb, 32 * nb, nullptr, scr, lane); continue; } r -= I_OUT;
        { const int kb = r / 64, nb = r % 64; p0_transpose_item<true>(F.w_query, 2048, WQ, 2048, 0, 32 * nb, 64 * kb, 32 * nb, F.norm_ffn_g, scr, lane); }
    }
}
__device__ __forceinline__ void p0_expert_tables(Frame& F, int rank, int nranks) {
    const int lane = pg8::lane_id_v(), tid = F.wave * 64 + lane;
    const size_t gt = (size_t)rank * NTHR + tid, NT = (size_t)nranks * NTHR;
#if PEER_FP4
    { unsigned char* EU4 = F.ws + WS_EU; float* EUS = (float*)(F.ws + WS_EU + 16 * MiB); unsigned char* EV4 = F.ws + WS_EU + 32 * MiB; float* EVS = (float*)(F.ws + WS_EU + 48 * MiB);
        const int gwv = rank * NWAVES + F.wave, nwv = nranks * NWAVES;
        for (int row = gwv; row < NEXP; row += nwv) { const size_t c = (size_t)row * 64 + lane; float fu[32], fv[32]; float mu = 0.f, mv = 0.f;
#pragma unroll
            for (int q = 0; q < 8; ++q) { const size_t eo = (size_t)row * DM + q * 256 + lane * 4;
                const f32x4 a = __builtin_nontemporal_load((const GAS f32x4*)(F.exp_u + eo)) * *(const GAS f32x4*)(F.norm_ffn_g + q * 256 + lane * 4); const f32x4 p = __builtin_nontemporal_load((const GAS f32x4*)(F.exp_v + eo));
#pragma unroll
                for (int e = 0; e < 4; ++e) { fu[4 * q + e] = a[e]; fv[4 * q + e] = p[e]; mu = fmaxf(mu, fabsf(a[e])); mv = fmaxf(mv, fabsf(p[e])); } }
#pragma unroll
            for (int o = 1; o < 64; o <<= 1) { mu = fmaxf(mu, __shfl_xor(mu, o)); mv = fmaxf(mv, __shfl_xor(mv, o)); }
            const float su = fmaxf(mu, 1e-30f) * (1.0f / 6.0f), sv = fmaxf(mv, 1e-30f) * (1.0f / 6.0f), iu = 1.0f / su, iv = 1.0f / sv;
            v4u wu, wv;
#pragma unroll
            for (int q = 0; q < 4; ++q) { unsigned a = 0u, b2 = 0u;
                a = __builtin_amdgcn_cvt_scalef32_pk_fp4_f32(a, fu[8 * q + 0] * iu, fu[8 * q + 1] * iu, 1.0f, 0); a = __builtin_amdgcn_cvt_scalef32_pk_fp4_f32(a, fu[8 * q + 2] * iu, fu[8 * q + 3] * iu, 1.0f, 1);
                a = __builtin_amdgcn_cvt_scalef32_pk_fp4_f32(a, fu[8 * q + 4] * iu, fu[8 * q + 5] * iu, 1.0f, 2); a = __builtin_amdgcn_cvt_scalef32_pk_fp4_f32(a, fu[8 * q + 6] * iu, fu[8 * q + 7] * iu, 1.0f, 3);
                b2 = __builtin_amdgcn_cvt_scalef32_pk_fp4_f32(b2, fv[8 * q + 0] * iv, fv[8 * q + 1] * iv, 1.0f, 0); b2 = __builtin_amdgcn_cvt_scalef32_pk_fp4_f32(b2, fv[8 * q + 2] * iv, fv[8 * q + 3] * iv, 1.0f, 1);
                b2 = __builtin_amdgcn_cvt_scalef32_pk_fp4_f32(b2, fv[8 * q + 4] * iv, fv[8 * q + 5] * iv, 1.0f, 2); b2 = __builtin_amdgcn_cvt_scalef32_pk_fp4_f32(b2, fv[8 * q + 6] * iv, fv[8 * q + 7] * iv, 1.0f, 3);
                wu[q] = a; wv[q] = b2; }
            *(GAS v4u*)(EU4 + c * 16) = wu; *(GAS v4u*)(EV4 + c * 16) = wv; if (lane == 0) { EUS[row] = su; EVS[row] = sv; } } }
#elif PEER_FP6
    { unsigned char* EU6 = F.ws + WS_EU; unsigned char* EV6 = F.ws + WS_EU + 32 * MiB;
        typedef _Float16 h32v __attribute__((ext_vector_type(32))); typedef unsigned u6v __attribute__((ext_vector_type(6)));
        for (size_t c = gt; c < (size_t)NEXP * 64; c += NT) { const int d0 = (int)((c * 32) & (DM - 1)); h32v hu, hv;
#pragma unroll
            for (int q = 0; q < 8; ++q) { const f32x4 a = *(const GAS f32x4*)(F.exp_u + c * 32 + q * 4) * *(const GAS f32x4*)(F.norm_ffn_g + d0 + q * 4) * PEER_SU; const f32x4 p = *(const GAS f32x4*)(F.exp_v + c * 32 + q * 4) * PEER_SV;
                hu[4 * q] = (_Float16)a.x; hu[4 * q + 1] = (_Float16)a.y; hu[4 * q + 2] = (_Float16)a.z; hu[4 * q + 3] = (_Float16)a.w; hv[4 * q] = (_Float16)p.x; hv[4 * q + 1] = (_Float16)p.y; hv[4 * q + 2] = (_Float16)p.z; hv[4 * q + 3] = (_Float16)p.w; }
            const u6v pu = __builtin_amdgcn_cvt_scalef32_pk32_fp6_f16(hu, 1.0f), pv = __builtin_amdgcn_cvt_scalef32_pk32_fp6_f16(hv, 1.0f);
            typedef unsigned u2v __attribute__((ext_vector_type(2)));
            GAS u2v* du = (GAS u2v*)(EU6 + c * 24); GAS u2v* dv = (GAS u2v*)(EV6 + c * 24);
            du[0] = (u2v){pu[0], pu[1]}; du[1] = (u2v){pu[2], pu[3]}; du[2] = (u2v){pu[4], pu[5]}; dv[0] = (u2v){pv[0], pv[1]}; dv[1] = (u2v){pv[2], pv[3]}; dv[2] = (u2v){pv[4], pv[5]}; } }
#endif
}
#ifndef P0_LATE_W
#define P0_LATE_W 1
#endif
#ifndef P0_PIPE
#define P0_PIPE 1
#endif
__device__ __forceinline__ void p0_prologue(Frame& F) {
    const int lane = pg8::lane_id_v(), tid = F.wave * 64 + lane;
    const int gw = F.vcu * NWAVES + F.wave, NGW = F.G * NWAVES;
#if P0_LATE_W
    p0_transposes(F, 0, 32 * 232, gw, NGW);
#else
    p0_transposes(F, 0, 32 * 232 + 2 * 16 * 64 + 2 * 32 * 64, gw, NGW);
#endif
    bf16* XN = (bf16*)(F.ws + WS_RA);
#if P0_PIPE
    {
        f32x4 v[8], nx[8];
        const GAS f32x4* gr = (const GAS f32x4*)F.norm_mix_g + lane;
        int m = gw;
        if (m < MREAL) { const GAS f32x4* xr = (const GAS f32x4*)((m < MPROMPT) ? F.x_prompt + (size_t)m * DM : F.x_sample + (size_t)(m - MPROMPT) * DM) + lane;
#pragma unroll
            for (int j = 0; j < 8; ++j) v[j] = __builtin_nontemporal_load(xr + 64 * j); }
        for (; m < MPAD; m += NGW) {
            const int mn = m + NGW;
            if (mn < MREAL) { const GAS f32x4* xr = (const GAS f32x4*)((mn < MPROMPT) ? F.x_prompt + (size_t)mn * DM : F.x_sample + (size_t)(mn - MPROMPT) * DM) + lane;
#pragma unroll
                for (int j = 0; j < 8; ++j) nx[j] = __builtin_nontemporal_load(xr + 64 * j); }
            if (m < MREAL) {
                float s = 0.f;
#pragma unroll
                for (int j = 0; j < 8; ++j) s += (v[j].x * v[j].x + v[j].y * v[j].y) + (v[j].z * v[j].z + v[j].w * v[j].w);
                const float r = 1.0f / sqrtf(wave_sum(s) * (1.f / DM) + EPS);
                GAS unsigned long long* o8 = (GAS unsigned long long*)(XN + (size_t)m * DM) + lane;
#pragma unroll
                for (int j = 0; j < 8; ++j) { const f32x4 gg = gr[64 * j]; o8[64 * j] = (unsigned long long)pkb(v[j].x * r * gg.x, v[j].y * r * gg.y) | ((unsigned long long)pkb(v[j].z * r * gg.z, v[j].w * r * gg.w) << 32); }
            } else { GAS v4u* o = (GAS v4u*)(XN + (size_t)m * DM) + lane;
#pragma unroll
                for (int j = 0; j < 4; ++j) o[64 * j] = (v4u){0u, 0u, 0u, 0u}; }
#pragma unroll
            for (int j = 0; j < 8; ++j) v[j] = nx[j];
        }
    }
#else
    for (int m = gw; m < MPAD; m += NGW) {
        if (m < MPROMPT) rms_row_to_bf16(F.x_prompt + (size_t)m * DM, F.norm_mix_g, XN + (size_t)m * DM, lane);
        else if (m < MREAL) rms_row_to_bf16(F.x_sample + (size_t)(m - MPROMPT) * DM, F.norm_mix_g, XN + (size_t)m * DM, lane);
        else { GAS v4u* o = (GAS v4u*)(XN + (size_t)m * DM) + lane;
#pragma unroll
            for (int j = 0; j < 4; ++j) o[64 * j] = (v4u){0u, 0u, 0u, 0u}; }
    }
#endif
    const size_t gt = (size_t)F.vcu * NTHR + tid, NT = (size_t)F.G * NTHR;
    { bf16* KH = (bf16*)(F.ws + WS_KEYS);
        for (size_t c = gt; c < 262144 / 8; c += NT) { const f32x4 a = *(const GAS f32x4*)(F.sub_keys + c * 8), b = *(const GAS f32x4*)(F.sub_keys + c * 8 + 4);
            *(GAS v4u*)(KH + c * 8) = (v4u){pkh(a.x, a.y), pkh(a.z, a.w), pkh(b.x, b.y), pkh(b.z, b.w)}; } }
    { bf16* WSM = (bf16*)(F.ws + WS_WSM);
        for (size_t c = gt; c < 131072 / 8; c += NT) { f32x4 a = *(const GAS f32x4*)(F.sgu_w_s + c * 8), b = *(const GAS f32x4*)(F.sgu_w_s + c * 8 + 4);
            const int t = (int)((c * 8) >> 7) & 127, s0 = (int)(c * 8) & 127;
#pragma unroll
            for (int e = 0; e < 4; ++e) { if (s0 + e > t) a[e] = 0.f; if (s0 + 4 + e > t) b[e] = 0.f; }
            *(GAS v4u*)(WSM + c * 8) = (v4u){pkb(a.x, a.y), pkb(a.z, a.w), pkb(b.x, b.y), pkb(b.z, b.w)}; } }
}
typedef float f32x16 __attribute__((ext_vector_type(16)));
typedef short s16x4 __attribute__((ext_vector_type(4)));
typedef short v4i16_t __attribute__((ext_vector_type(4)));
__device__ __forceinline__ int crow(int r, int hi) { return (r & 3) + 8 * (r >> 2) + 4 * hi; }
__device__ __forceinline__ s16x4 vtr(const LAS unsigned char* p) { return __builtin_bit_cast(s16x4, __builtin_amdgcn_ds_read_tr16_b64_v4i16((LAS v4i16_t*)p)); }
__device__ __forceinline__ bf16 bf1(float x) { return (bf16)(pkb(x, 0.f) & 0xffffu); }
__device__ __forceinline__ float bf2f(bf16 b) { return __builtin_bit_cast(float, (unsigned)b << 16); }
__device__ __forceinline__ float half_max(float m) { return fmaxf(m, __builtin_bit_cast(float, pg8::partner32(__builtin_bit_cast(unsigned, m)))); }
__device__ __forceinline__ float half_sum(float m) { return m + __builtin_bit_cast(float, pg8::partner32(__builtin_bit_cast(unsigned, m))); }
constexpr int P2_KL = 0, P2_VL = 24576, P2_BIAS = 49152, P2_OST = 65536, P2_GL = 0, P2_RL = 32768, P2_SST = 65536;
constexpr int N_ATT_UNITS = 512 + 16, N_SGU_UNITS = 1024 + 64;

struct AttnDesc { int b, c, kvh, qrow0, nqb, jlo, jhi; bool sample; };
__device__ __forceinline__ AttnDesc attn_desc(int uid) { AttnDesc d; d.sample = uid >= 512; d.c = 0;
    if (!d.sample) { d.b = uid >> 6; d.c = (uid >> 1) & 31; d.kvh = uid & 1; d.qrow0 = d.b * SEQ + d.c * CHUNK; d.nqb = 2; d.jlo = 128 - 64 * d.c; if (d.jlo < 0) d.jlo = 0; d.jhi = 192; }
    else { const int s = uid - 512; d.b = s >> 1; d.kvh = s & 1; d.qrow0 = MPROMPT + d.b * TDEC; d.nqb = 1; d.jlo = 0; d.jhi = 144; }
    return d; }
__device__ __forceinline__ void attn_kv_load(Frame& F, const AttnDesc& d, int, v4u (&kq)[3], v4u (&vq)[3]) {
    const int tid = F.wave * 64 + pg8::lane_id_v();
    const bf16* KV = (const bf16*)(F.ws + WS_KV);
#pragma unroll
    for (int i = 0; i < 3; ++i) { const int idx = tid + 512 * i, key = idx >> 3, ch = idx & 7; kq[i] = (v4u){0u, 0u, 0u, 0u}; vq[i] = (v4u){0u, 0u, 0u, 0u};
        if (!d.sample) { const int pos = d.c * CHUNK - WINDOW + key; if (pos >= 0) { const bf16* rp = KV + (size_t)(d.b * SEQ + pos) * 256 + d.kvh * 64 + ch * 8; kq[i] = *(const GAS v4u*)rp; vq[i] = *(const GAS v4u*)(rp + 128); } }
        else if (key < 128) { const size_t o = ((size_t)(d.b * WINDOW + key) * 2 + d.kvh) * 64 + ch * 8;
            const f32x4 a = *(const GAS f32x4*)(F.cache_k + o), a2 = *(const GAS f32x4*)(F.cache_k + o + 4), p = *(const GAS f32x4*)(F.cache_v + o), p2 = *(const GAS f32x4*)(F.cache_v + o + 4);
            kq[i] = (v4u){pkb(a.x, a.y), pkb(a.z, a.w), pkb(a2.x, a2.y), pkb(a2.z, a2.w)}; vq[i] = (v4u){pkb(p.x, p.y), pkb(p.z, p.w), pkb(p2.x, p2.y), pkb(p2.z, p2.w)}; }
        else if (key < 144) { const bf16* rp = KV + (size_t)(MPROMPT + d.b * TDEC + key - 128) * 256 + d.kvh * 64 + ch * 8; kq[i] = *(const GAS v4u*)rp; vq[i] = *(const GAS v4u*)(rp + 128); } }
}
__device__ __forceinline__ void attn_kv_store(Frame& F, int, const v4u (&kq)[3], const v4u (&vq)[3]) {
    const int tid = F.wave * 64 + pg8::lane_id_v();
    LAS unsigned char* KL = F.lds + P2_KL; LAS unsigned char* VL = F.lds + P2_VL;
#pragma unroll
    for (int i = 0; i < 3; ++i) { const int idx = tid + 512 * i, key = idx >> 3, ch = idx & 7; *(LAS v4u*)(KL + ch * 3072 + key * 16) = kq[i]; *(LAS v4u*)(VL + (ch >> 2) * 12288 + key * 64 + (ch & 3) * 16) = vq[i]; }
}
template <bool MASK> __device__ __forceinline__ void attn_compute(Frame& F, const AttnDesc& d, bf16x8 (&qr)[4]) {
    const int lane = pg8::lane_id_v();
    const int w = F.wave, r = lane & 31, h = lane >> 5;
    LAS unsigned char* KL = F.lds + P2_KL; LAS unsigned char* VL = F.lds + P2_VL; const LAS float* BL = (const LAS float*)(F.lds + P2_BIAS); LAS unsigned char* OST = F.lds + P2_OST + w * 4096;
    const bf16* Q = (const bf16*)(F.ws + WS_Q); bf16* OS = (bf16*)(F.ws + WS_RA);
    const int hd = d.kvh * 8 + w; const float sink2 = F.sinks[hd] * LOG2E; const LAS float* bl = BL + hd * 256;
    const int vlane = (4 * h + ((lane & 15) >> 2)) * 64 + (((lane >> 4) & 1) * 16 + (lane & 3) * 4) * 2;
    for (int qb = 0; qb < d.nqb; ++qb) {
        const int qi = qb * 32 + r;
        f32x16 S[6];
#pragma unroll
        for (int kb = 0; kb < 6; ++kb) { f32x16 a = {};
#pragma unroll
            for (int ks = 0; ks < 4; ++ks) { const bf16x8 kf = *(const LAS bf16x8*)(KL + (2 * ks + h) * 3072 + (kb * 32 + r) * 16); a = __builtin_amdgcn_mfma_f32_32x32x16_bf16(kf, qr[ks], a, 0, 0, 0); }
            S[kb] = a; asm volatile("" ::: "memory"); }
        if (qb + 1 < d.nqb) { const int qrow_n = d.qrow0 + (qb + 1) * 32 + r;
#pragma unroll
            for (int ks = 0; ks < 4; ++ks) qr[ks] = __builtin_nontemporal_load((const GAS bf16x8*)(Q + (size_t)qrow_n * 1024 + hd * 64 + ks * 16 + h * 8)); }
        float mx = -1e30f;
        const LAS float* blq = bl + (63 - qi + 4 * h);
        if (MASK) {
#pragma unroll
            for (int kb = 0; kb < 6; ++kb)
#pragma unroll
                for (int i = 0; i < 16; ++i) { const int j = kb * 32 + crow(i, h); float t = S[kb][i] + blq[kb * 32 + (i & 3) + 8 * (i >> 2)]; t = (j >= d.jlo && j < d.jhi) ? t : -1e30f; S[kb][i] = t; mx = fmaxf(mx, t); }
        } else {
#pragma unroll
            for (int kb = 0; kb < 6; ++kb)
#pragma unroll
                for (int i = 0; i < 16; ++i) { const float t = S[kb][i] + blq[kb * 32 + (i & 3) + 8 * (i >> 2)]; S[kb][i] = t; mx = fmaxf(mx, t); }
        }
        mx = fmaxf(half_max(mx), sink2);
        float l = 0.f;
#pragma unroll
        for (int kb = 0; kb < 6; ++kb)
#pragma unroll
            for (int i = 0; i < 16; ++i) { const float e = __builtin_amdgcn_exp2f(S[kb][i] - mx); S[kb][i] = e; l += e; }
        l = half_sum(l) + __builtin_amdgcn_exp2f(sink2 - mx);
        const float inv = 1.0f / l;
        f32x16 O[2]; O[0] = f32x16{}; O[1] = f32x16{};
#pragma unroll
        for (int kb = 0; kb < 6; ++kb)
#pragma unroll
            for (int s2 = 0; s2 < 2; ++s2) { v4u wv; wv.x = pkb(S[kb][8 * s2 + 0] * inv, S[kb][8 * s2 + 1] * inv); wv.y = pkb(S[kb][8 * s2 + 2] * inv, S[kb][8 * s2 + 3] * inv);
                wv.z = pkb(S[kb][8 * s2 + 4] * inv, S[kb][8 * s2 + 5] * inv); wv.w = pkb(S[kb][8 * s2 + 6] * inv, S[kb][8 * s2 + 7] * inv); const bf16x8 pa = __builtin_bit_cast(bf16x8, wv);
#pragma unroll
                for (int db = 0; db < 2; ++db) { const LAS unsigned char* vp = VL + db * 12288 + (kb * 32 + s2 * 16) * 64 + vlane; const s16x4 lo = vtr(vp), hi = vtr(vp + 8 * 64);
                    const bf16x8 vf = (bf16x8){lo[0], lo[1], lo[2], lo[3], hi[0], hi[1], hi[2], hi[3]}; O[db] = __builtin_amdgcn_mfma_f32_32x32x16_bf16(pa, vf, O[db], 0, 0, 0); } }
#pragma unroll
        for (int db = 0; db < 2; ++db)
#pragma unroll
            for (int i = 0; i < 16; ++i) *(LAS bf16*)(OST + (crow(i, h) * 64 + db * 32 + r) * 2) = bf1(O[db][i]);
        LDS_WAIT(); asm volatile("" ::: "memory");
#pragma unroll
        for (int it = 0; it < 4; ++it) { const int row = it * 8 + (lane >> 3), ch = lane & 7; const v4u v = *(const LAS v4u*)(OST + row * 128 + ch * 16);
            if (!d.sample || row < TDEC) *(GAS v4u*)(OS + (size_t)(d.qrow0 + qb * 32 + row) * 2048 + hd * 64 + ch * 8) = v; }
        LDS_WAIT(); asm volatile("" ::: "memory");
    }
}
__device__ __forceinline__ void attn_q_load0(Frame& F, const AttnDesc& d, bf16x8 (&qr)[4]) {
    const int lane = pg8::lane_id_v(), r = lane & 31, h = lane >> 5; const bf16* Q = (const bf16*)(F.ws + WS_Q); const int hd = d.kvh * 8 + F.wave;
    const int qrow = d.qrow0 + (d.sample ? (r & 15) : r);
#pragma unroll
    for (int ks = 0; ks < 4; ++ks) qr[ks] = __builtin_nontemporal_load((const GAS bf16x8*)(Q + (size_t)qrow * 1024 + hd * 64 + ks * 16 + h * 8));
}
__device__ __forceinline__ void attn_units(Frame& F) {
    for (int u = F.vcu; u < N_ATT_UNITS; u += F.G) {
        bf16x8 qr[4];
        { v4u kq[3], vq[3]; const AttnDesc d0 = attn_desc(u); attn_kv_load(F, d0, 0, kq, vq); attn_q_load0(F, d0, qr); attn_kv_store(F, 0, kq, vq); }
        __syncthreads();
        { const AttnDesc d = attn_desc(u); if (d.jlo == 0 && d.jhi == 192) attn_compute<false>(F, d, qr); else attn_compute<true>(F, d, qr); }
        LDS_WAIT(); __builtin_amdgcn_s_barrier(); asm volatile("" ::: "memory");
    }
}

struct SguOps { v4u gvq[4]; float ssp[4]; bf16x8 af[8]; v4u uq[4]; float bs[4]; f32x4 sg0, sg1; };
__device__ __forceinline__ void sgu_load(Frame& F, const int uid, SguOps& R) {
    const int lane = pg8::lane_id_v(), w = F.wave, tid = w * 64 + lane, r = lane & 31, h = lane >> 5;
    LAS unsigned char* GL = F.lds + P2_GL;
    const bf16* VS = (const bf16*)(F.ws + WS_VS); const bf16* U = (const bf16*)(F.ws + WS_U); const bf16* WSM = (const bf16*)(F.ws + WS_WSM); const float* SS1 = (const float*)(F.ws + WS_SS1); bf16* OS = (bf16*)(F.ws + WS_RA);
    const bool sample = uid >= 1024; int b, g, row0, nv;
    if (!sample) { b = uid >> 7; const int blk = (uid >> 3) & 15; g = uid & 7; row0 = b * SEQ + blk * 128; nv = 128; }
    else { const int s = uid - 1024; b = s >> 3; g = s & 7; row0 = MPROMPT + b * TDEC; nv = TDEC; }
    const int wr = w >> 1, wc = w & 1; const bool active = 32 * wr < nv; const int nks = 2 * (wr + 1);
    const int er = lane >> 3, ec = (lane & 7) * 8;
    (void)GL; (void)VS; (void)U; (void)WSM; (void)SS1; (void)OS; (void)b; (void)r; (void)h; (void)tid; (void)nks; (void)er; (void)ec; (void)active;
#pragma unroll
    for (int i = 0; i < 4; ++i) { const int idx = tid + 512 * i, s = idx >> 4, ch = idx & 15; R.gvq[i] = (v4u){0u, 0u, 0u, 0u}; R.ssp[i] = 0.f;
        if (s < nv) { R.gvq[i] = __builtin_nontemporal_load((const GAS v4u*)(VS + (size_t)(row0 + s) * 1024 + g * 128 + ch * 8)); R.ssp[i] = SS1[(size_t)(row0 + s) * 16 + ch]; } }
    if (active) {
#pragma unroll
        for (int ks = 0; ks < 8; ++ks) { R.af[ks] = (bf16x8){0, 0, 0, 0, 0, 0, 0, 0}; if (ks < nks) R.af[ks] = *(const GAS bf16x8*)(WSM + (size_t)(g * 128 + 32 * wr + r) * 128 + 16 * ks + 8 * h); }
        R.sg0 = *(const GAS f32x4*)(F.sgu_norm_g + g * 128 + 64 * wc + ec); R.sg1 = *(const GAS f32x4*)(F.sgu_norm_g + g * 128 + 64 * wc + ec + 4);
#pragma unroll
        for (int c = 0; c < 4; ++c) { const int t = 32 * wr + 8 * c + er; R.uq[c] = (v4u){0u, 0u, 0u, 0u}; R.bs[c] = F.sgu_b_s[g * 128 + t];
            if (t < nv) R.uq[c] = __builtin_nontemporal_load((const GAS v4u*)(U + (size_t)(row0 + t) * 1024 + g * 128 + 64 * wc + ec)); }
    }
}
__device__ __forceinline__ void sgu_process(Frame& F, const int uid, SguOps& R) {
    const int lane = pg8::lane_id_v(), w = F.wave, tid = w * 64 + lane, r = lane & 31, h = lane >> 5;
    LAS unsigned char* GL = F.lds + P2_GL;
    const bf16* VS = (const bf16*)(F.ws + WS_VS); const bf16* U = (const bf16*)(F.ws + WS_U); const bf16* WSM = (const bf16*)(F.ws + WS_WSM); const float* SS1 = (const float*)(F.ws + WS_SS1); bf16* OS = (bf16*)(F.ws + WS_RA);
    const bool sample = uid >= 1024; int b, g, row0, nv;
    if (!sample) { b = uid >> 7; const int blk = (uid >> 3) & 15; g = uid & 7; row0 = b * SEQ + blk * 128; nv = 128; }
    else { const int s = uid - 1024; b = s >> 3; g = s & 7; row0 = MPROMPT + b * TDEC; nv = TDEC; }
    const int wr = w >> 1, wc = w & 1; const bool active = 32 * wr < nv; const int nks = 2 * (wr + 1);
    const int er = lane >> 3, ec = (lane & 7) * 8;
    (void)GL; (void)VS; (void)U; (void)WSM; (void)SS1; (void)OS; (void)b; (void)r; (void)h; (void)tid; (void)nks; (void)er; (void)ec; (void)active;
#pragma unroll
    for (int i = 0; i < 4; ++i) { const int idx = tid + 512 * i, s = idx >> 4, ch = idx & 15; v4u o = (v4u){0u, 0u, 0u, 0u};
        float ss = R.ssp[i];
        ss += __builtin_bit_cast(float, __builtin_amdgcn_ds_swizzle(__builtin_bit_cast(int, ss), (1 << 10) | 0x1f)); ss += __builtin_bit_cast(float, __builtin_amdgcn_ds_swizzle(__builtin_bit_cast(int, ss), (2 << 10) | 0x1f));
        ss += __builtin_bit_cast(float, __builtin_amdgcn_ds_swizzle(__builtin_bit_cast(int, ss), (4 << 10) | 0x1f)); ss += __builtin_bit_cast(float, __builtin_amdgcn_ds_swizzle(__builtin_bit_cast(int, ss), (8 << 10) | 0x1f));
        if (s < nv) {
            const float rr = 1.0f / sqrtf(ss * (1.f / DSGU) + EPS); const v4u wv = R.gvq[i];
            float f[8] = {pg8::bf_lo(wv.x) * rr, pg8::bf_hi(wv.x) * rr, pg8::bf_lo(wv.y) * rr, pg8::bf_hi(wv.y) * rr, pg8::bf_lo(wv.z) * rr, pg8::bf_hi(wv.z) * rr, pg8::bf_lo(wv.w) * rr, pg8::bf_hi(wv.w) * rr};
            o = (v4u){pkb(f[0], f[1]), pkb(f[2], f[3]), pkb(f[4], f[5]), pkb(f[6], f[7])};
            if (sample) { const f32x4 g0 = *(const GAS f32x4*)(F.sgu_norm_g + g * 128 + ch * 8), g1 = *(const GAS f32x4*)(F.sgu_norm_g + g * 128 + ch * 8 + 4); float* dst = F.out + OUT_SGU + (size_t)(b * TDEC + s) * 1024 + g * 128 + ch * 8;
                *(GAS f32x4*)dst = (f32x4){f[0] * g0.x, f[1] * g0.y, f[2] * g0.z, f[3] * g0.w}; *(GAS f32x4*)(dst + 4) = (f32x4){f[4] * g1.x, f[5] * g1.y, f[6] * g1.z, f[7] * g1.w}; } }
        *(LAS v4u*)(GL + (ch >> 2) * 8192 + s * 64 + (ch & 3) * 16) = o; }
    LDS_WAIT(); __builtin_amdgcn_s_barrier(); asm volatile("" ::: "memory");
    if (active) {
        f32x16 acc[2]; acc[0] = f32x16{}; acc[1] = f32x16{};
        const int glane = (8 * h + ((lane & 15) >> 2)) * 64 + (((lane >> 4) & 1) * 16 + (lane & 3) * 4) * 2;
#pragma unroll
        for (int ks = 0; ks < 8; ++ks) if (ks < nks) {
#pragma unroll
            for (int cb = 0; cb < 2; ++cb) { const LAS unsigned char* gp = GL + (2 * wc + cb) * 8192 + (16 * ks) * 64 + glane; const s16x4 lo = vtr(gp), hi = vtr(gp + 4 * 64);
                const bf16x8 bb = (bf16x8){lo[0], lo[1], lo[2], lo[3], hi[0], hi[1], hi[2], hi[3]}; acc[cb] = __builtin_amdgcn_mfma_f32_32x32x16_bf16(R.af[ks], bb, acc[cb], 0, 0, 0); } }
        LAS float* STG = (LAS float*)(F.lds + P2_SST + w * 8192);
#pragma unroll
        for (int cb = 0; cb < 2; ++cb)
#pragma unroll
            for (int i = 0; i < 16; ++i) STG[crow(i, h) * 64 + 32 * cb + r] = acc[cb][i];
        LDS_WAIT(); asm volatile("" ::: "memory");
#pragma unroll
        for (int c = 0; c < 4; ++c) { const int t = 32 * wr + 8 * c + er;
            const f32x4 a0 = *(const LAS f32x4*)(STG + (8 * c + er) * 64 + ec), a1 = *(const LAS f32x4*)(STG + (8 * c + er) * 64 + ec + 4); const v4u uw = R.uq[c]; const float bb = R.bs[c];
            const v4u o = {pkb(pg8::bf_lo(uw.x) * (a0.x * R.sg0.x + bb), pg8::bf_hi(uw.x) * (a0.y * R.sg0.y + bb)), pkb(pg8::bf_lo(uw.y) * (a0.z * R.sg0.z + bb), pg8::bf_hi(uw.y) * (a0.w * R.sg0.w + bb)),
                           pkb(pg8::bf_lo(uw.z) * (a1.x * R.sg1.x + bb), pg8::bf_hi(uw.z) * (a1.y * R.sg1.y + bb)), pkb(pg8::bf_lo(uw.w) * (a1.z * R.sg1.z + bb), pg8::bf_hi(uw.w) * (a1.w * R.sg1.w + bb))};
            if (t < nv) *(GAS v4u*)(OS + (size_t)(row0 + t) * 2048 + 1024 + g * 128 + 64 * wc + ec) = o; }
    }
    LDS_WAIT(); __builtin_amdgcn_s_barrier(); asm volatile("" ::: "memory");
}
__device__ __forceinline__ int sgu_uid(const Frame& F, const int k) {
    const int u0 = F.G - 1 - F.vcu;
    if (F.G == 256 && F.vcu < 16) return k < 3 ? u0 + k * 256 : -1;
    if (F.G == 256 && F.vcu < 32) return k < 4 ? u0 + k * 256 : (k == 4 ? 1023 - (F.vcu - 16) : -1);
    const int u = u0 + k * F.G; return u < N_SGU_UNITS ? u : -1;
}
__device__ __forceinline__ void sgu_units(Frame& F) {
    SguOps A, B; int k = 0, ua = sgu_uid(F, 0);
    if (ua >= 0) sgu_load(F, ua, A);
    while (ua >= 0) {
        const int ub = sgu_uid(F, k + 1); if (ub >= 0) sgu_load(F, ub, B);
        sgu_process(F, ua, A);
        if (ub < 0) break;
        ua = sgu_uid(F, k + 2); if (ua >= 0) sgu_load(F, ua, A);
        sgu_process(F, ub, B);
        k += 2;
    }
}


__device__ __forceinline__ void p2_mixers(Frame& F) {
    LAS float* BLw = (LAS float*)(F.lds + P2_BIAS);
    { const int e0 = F.wave * 64 + pg8::lane_id_v(); float bv[8];
#pragma unroll
        for (int i = 0; i < 8; ++i) { const int e = e0 + i * NTHR, hh = e >> 8, idx = e & 255, rel = idx - 191, n = rel < 0 ? -rel : rel;
            const int v = n < 8 ? n : (n < 12 ? 8 : n < 16 ? 9 : n < 23 ? 10 : n < 32 ? 11 : n < 46 ? 12 : n < 64 ? 13 : n < 91 ? 14 : 15);
            bv[i] = F.rel_tab[((rel > 0 ? 16 : 0) + v) * 16 + hh]; }
#pragma unroll
        for (int i = 0; i < 8; ++i) { const int e = e0 + i * NTHR; BLw[e] = ((e & 255) < 255) ? bv[i] * LOG2E : 0.f; } }
    __syncthreads();
    attn_units(F);
    sgu_units(F);
#if P0_LATE_W
    __syncthreads();
    if (F.G == 256) { if (F.vcu >= 32) p0_transposes(F, 32 * 232, 32 * 232 + 2 * 16 * 64 + 2 * 32 * 64, (F.vcu - 32) * NWAVES + F.wave, 224 * NWAVES); }
    else p0_transposes(F, 32 * 232, 32 * 232 + 2 * 16 * 64 + 2 * 32 * 64, F.vcu * NWAVES + F.wave, F.G * NWAVES);
#endif
}
constexpr size_t WS_SS2S = WS_SS2 + (size_t)MPROMPT * 32 * 4;
struct SkMerge { const bf16 *RATIO, *SB; bf16* H;
    __device__ __forceinline__ void mid(f32x4& acc, int row, int col) const { const unsigned long long w = *(const GAS unsigned long long*)(RATIO + (size_t)row * 2048 + col); const unsigned lo = (unsigned)w, hi = (unsigned)(w >> 32);
        acc *= (f32x4){pg8::bf_lo(lo), pg8::bf_hi(lo), pg8::bf_lo(hi), pg8::bf_hi(hi)}; }
    __device__ __forceinline__ void fin(const f32x4 acc, int row, int col, int, int) const { const unsigned long long w = *(const GAS unsigned long long*)(SB + (size_t)row * 2048 + col); const unsigned lo = (unsigned)w, hi = (unsigned)(w >> 32);
        const f32x4 v = acc * (f32x4){pg8::bf_lo(lo), pg8::bf_hi(lo), pg8::bf_lo(hi), pg8::bf_hi(hi)};
        *(GAS unsigned long long*)(H + (size_t)row * 2048 + col) = (unsigned long long)pkb(v.x, v.y) | ((unsigned long long)pkb(v.z, v.w) << 32); } };
struct SkOut { const float* xs; bf16* XH; float* SS2S;
    __device__ __forceinline__ void mid(f32x4&, int, int) const {}
    __device__ __forceinline__ void fin(const f32x4 acc, int row, int col, int part, int fq) const { const f32x4 v = acc + *(const GAS f32x4*)(xs + (size_t)(row - MPROMPT) * 2048 + col);
        *(GAS unsigned long long*)(XH + (size_t)row * 2048 + col) = (unsigned long long)pkh(v.x, v.y) | ((unsigned long long)pkh(v.z, v.w) << 32);
        float s = (v.x * v.x + v.y * v.y) + (v.z * v.z + v.w * v.w); s += __shfl_xor(s, 16); s += __shfl_xor(s, 32);
        if (fq == 0) SS2S[(size_t)(row - MPROMPT) * 128 + part] = s; } };
struct SkQ { bf16* QP;
    __device__ __forceinline__ void mid(f32x4&, int, int) const {}
    __device__ __forceinline__ void fin(const f32x4 acc, int row, int col, int, int) const { *(GAS unsigned long long*)(QP + (size_t)row * 2048 + col) = (unsigned long long)pkh(acc.x, acc.y) | ((unsigned long long)pkh(acc.z, acc.w) << 32); } };
template <bool F16, bool MID, class Epi>
__device__ __forceinline__ void skinny_gemm(Frame& F, const bf16* A, const bf16* Bt, const Epi& E) {
    const int lane = pg8::lane_id_v(), w = F.wave, fr = lane & 15, fq = lane >> 4;
    LAS f32x4* part = (LAS f32x4*)(F.lds + RING_OFF);
    for (int job = F.vcu; job < 256; job += F.G) {
        const int rb = job & 3, cb = job >> 2;
        const bf16* ap = A + (size_t)(MPROMPT + 32 * rb + fr) * 2048 + 256 * w + 8 * fq;
        const bf16* bp = Bt + (size_t)(32 * cb + fr) * 2048 + 256 * w + 8 * fq;
        bf16x8 a0[8], a1[8], b0[8], b1[8];
#pragma unroll
        for (int u = 0; u < 8; ++u) { a0[u] = *(const GAS bf16x8*)(ap + 32 * u); a1[u] = *(const GAS bf16x8*)(ap + 16 * 2048 + 32 * u); b0[u] = *(const GAS bf16x8*)(bp + 32 * u); b1[u] = *(const GAS bf16x8*)(bp + 16 * 2048 + 32 * u); }
        f32x4 c00 = {0.f, 0.f, 0.f, 0.f}, c01 = c00, c10 = c00, c11 = c00;
#pragma unroll
        for (int u = 0; u < 8; ++u) { c00 = pg8::mma16<F16>(b0[u], a0[u], c00); c01 = pg8::mma16<F16>(b1[u], a0[u], c01); c10 = pg8::mma16<F16>(b0[u], a1[u], c10); c11 = pg8::mma16<F16>(b1[u], a1[u], c11); }
        __syncthreads();
        part[(w * 4 + 0) * 64 + lane] = c00; part[(w * 4 + 1) * 64 + lane] = c01; part[(w * 4 + 2) * 64 + lane] = c10; part[(w * 4 + 3) * 64 + lane] = c11;
        __syncthreads();
        if (w < 4) {
            f32x4 s1 = part[(0 * 4 + w) * 64 + lane], s2 = part[(4 * 4 + w) * 64 + lane];
#pragma unroll
            for (int ww = 1; ww < 4; ++ww) { s1 += part[(ww * 4 + w) * 64 + lane]; s2 += part[((ww + 4) * 4 + w) * 64 + lane]; }
            const int row = MPROMPT + 32 * rb + 16 * (w >> 1) + fr, col = 32 * cb + 16 * (w & 1) + 4 * fq;
            if (MID) E.mid(s1, row, col);
            E.fin(s1 + s2, row, col, cb * 2 + (w & 1), fq);
        }
    }
}
typedef _Float16 f16x8v __attribute__((ext_vector_type(8)));
__device__ __forceinline__ int enc_f(float f) { const int b = __builtin_bit_cast(int, f); return b ^ ((b >> 31) & 0x7fffffff); }
__device__ __forceinline__ float dec_f(int k) { return __builtin_bit_cast(float, k ^ ((k >> 31) & 0x7fffffff)); }
__device__ __forceinline__ int imax_(int a, int b) { return a > b ? a : b; }
__device__ __forceinline__ int imin_(int a, int b) { return a < b ? a : b; }
#define P6_CE(a, b) do { const int mx_ = imax_(a, b), mn_ = imin_(a, b); a = mx_; b = mn_; } while (0)
__device__ __forceinline__ void sort16_desc(int (&v)[16]) {
#pragma unroll
    for (int k = 2; k <= 16; k <<= 1)
#pragma unroll
        for (int j = k >> 1; j > 0; j >>= 1)
#pragma unroll
            for (int i = 0; i < 16; ++i) { const int l = i ^ j; if (l > i) { if ((i & k) == 0) P6_CE(v[i], v[l]); else P6_CE(v[l], v[i]); } }
}
__device__ __forceinline__ void bitonic_merge16_desc(int (&v)[16]) {
#pragma unroll
    for (int j = 8; j > 0; j >>= 1)
#pragma unroll
        for (int i = 0; i < 16; ++i) { const int l = i ^ j; if (l > i) P6_CE(v[i], v[l]); }
}
__device__ __forceinline__ void merge_top16(int (&T)[16], const int (&N)[16]) {
#pragma unroll
    for (int i = 0; i < 16; ++i) T[i] = imax_(T[i], N[15 - i]);
    bitonic_merge16_desc(T);
}
__device__ __forceinline__ int half_partner(int x) { return (int)pg8::partner32((unsigned)x); }
struct CandTab { int ci[64], cj[64]; };
__host__ __device__ constexpr CandTab make_cand() { CandTab t{}; int n = 0; for (int i = 0; i < 16; ++i) for (int j = 0; j < 16; ++j) if ((i + 1) * (j + 1) <= 16) { t.ci[n] = i; t.cj[n] = j; ++n; } for (; n < 64; ++n) { t.ci[n] = -1; t.cj[n] = -1; } return t; }
constexpr CandTab CAND = make_cand();
constexpr int P6_SC = 0;

constexpr int P6_KEYS = 65536;
__device__ __forceinline__ void p6_job(Frame& F, const int job) {
    const int lane = pg8::lane_id_v(), w = F.wave, r = lane & 31, h = lane >> 5;
    const bf16* QP = (const bf16*)(F.ws + WS_SB); const bf16* KH = (const bf16*)(F.ws + WS_KEYS); const float* SS2 = (const float*)(F.ws + WS_SS2);
    unsigned long long* SEL = (unsigned long long*)(F.ws + WS_RA);
    LAS int* SC = (LAS int*)(F.lds + P6_SC + w * 8192);
    constexpr int NTILE = MREAL / 32, NGRP = (NTILE + 7) / 8, NJOB = NGRP * 8;
    {
        const int hq = job & 7, tile = (job >> 3) * 8 + w;
        { const int tid = w * 64 + lane;
#pragma unroll
            for (int i = 0; i < 8; ++i) { const int idx = tid + 512 * i, p = idx >> 11, n = (idx >> 4) & 127, c = idx & 15;
                *(LAS v4u*)(F.lds + P6_KEYS + p * 32768 + c * 2048 + n * 16) = *(const GAS v4u*)(KH + ((size_t)((hq * 2 + p) * 128 + n)) * 128 + c * 8); } }
        __syncthreads();
        if (tile < NTILE) {
        const int t = tile * 32 + r;
        int AB[2][16];
#pragma unroll
        for (int p = 0; p < 2; ++p) {
            f16x8v qf[8];
#pragma unroll
            for (int ks = 0; ks < 8; ++ks) qf[ks] = *(const GAS f16x8v*)(QP + (size_t)t * 2048 + hq * 256 + p * 128 + ks * 16 + h * 8);
            int T[16];
#pragma unroll
            for (int nb = 0; nb < 4; ++nb) {
                f32x16 acc = {};
                const LAS unsigned char* kp = F.lds + P6_KEYS + p * 32768 + h * 2048 + (nb * 32 + r) * 16;
#pragma unroll
                for (int ks = 0; ks < 8; ++ks) { const f16x8v kf = *(const LAS f16x8v*)(kp + ks * 4096); acc = __builtin_amdgcn_mfma_f32_32x32x16_f16(kf, qf[ks], acc, 0, 0, 0); }
                int N[16];
#pragma unroll
                for (int i = 0; i < 16; ++i) N[i] = (enc_f(acc[i]) & ~127) | (nb * 32 + crow(i, h));
                sort16_desc(N);
                if (nb == 0) {
#pragma unroll
                    for (int i = 0; i < 16; ++i) T[i] = N[i];
                } else merge_top16(T, N);
            }
            int P[16];
#pragma unroll
            for (int i = 0; i < 16; ++i) P[i] = half_partner(T[i]);
            merge_top16(T, P);
#pragma unroll
            for (int i = 0; i < 16; ++i) AB[p][i] = T[i];
        }
#pragma unroll
        for (int i = 0; i < 16; ++i) { SC[i * 64 + lane] = AB[0][i] & 127; SC[(16 + i) * 64 + lane] = AB[1][i] & 127; }
        float fa[16], fb[16];
#pragma unroll
        for (int i = 0; i < 16; ++i) { fa[i] = dec_f(AB[0][i] & ~127); fb[i] = dec_f(AB[1][i] & ~127); }
        int W[16];
#pragma unroll
        for (int g = 0; g < 4; ++g) {
            int N[16];
#pragma unroll
            for (int c = 0; c < 16; ++c) { const int ci = CAND.ci[g * 16 + c], cj = CAND.cj[g * 16 + c]; N[c] = ci >= 0 ? ((enc_f(fa[ci >= 0 ? ci : 0] + fb[cj >= 0 ? cj : 0]) & ~255) | (ci * 16 + cj)) : (int)0x80000000; }
            sort16_desc(N);
            if (g == 0) {
#pragma unroll
                for (int i = 0; i < 16; ++i) W[i] = N[i];
            } else merge_top16(W, N);
        }
        float ssum = 0.f;
        if (tile >= MPROMPT / 32) { const GAS f32x4* sp = (const GAS f32x4*)((const float*)(F.ws + WS_SS2S) + (size_t)(t - MPROMPT) * 128);
#pragma unroll 16
            for (int i = 0; i < 32; ++i) { const f32x4 v = sp[i]; ssum += (v.x + v.y) + (v.z + v.w); } }
        else { const GAS f32x4* sp = (const GAS f32x4*)(SS2 + (size_t)t * 32);
#pragma unroll
            for (int i = 0; i < 8; ++i) { const f32x4 v = sp[i]; ssum += (v.x + v.y) + (v.z + v.w); } }
        const float rt = 1.0f / sqrtf(ssum * (1.f / DM) + EPS);
        LDS_WAIT(); asm volatile("" ::: "memory");
        float gk[16]; int ek[16]; float Z = 0.f; const float c0 = dec_f(W[0] & ~255);
#pragma unroll
        for (int k = 0; k < 16; ++k) { const int code = W[k] & 255, ii = code >> 4, jj = code & 15; const int n0 = SC[ii * 64 + lane], n1 = SC[(16 + jj) * 64 + lane];
            ek[k] = n0 * 128 + n1; gk[k] = __builtin_amdgcn_exp2f((dec_f(W[k] & ~255) - c0) * rt * LOG2E); Z += gk[k]; }
        const float iz = 1.0f / Z;
        unsigned long long* dst = SEL + ((size_t)t * 8 + hq) * 16 + 8 * h;
#pragma unroll
        for (int k = 0; k < 8; k += 2) { const int e0 = h ? ek[k + 8] : ek[k], e1 = h ? ek[k + 9] : ek[k + 1]; const float g0 = (h ? gk[k + 8] : gk[k]) * iz, g1 = (h ? gk[k + 9] : gk[k + 1]) * iz;
            __hip_atomic_store(dst + k, (unsigned long long)(unsigned)e0 | ((unsigned long long)__builtin_bit_cast(unsigned, g0) << 32), RLX_AGENT);
            __hip_atomic_store(dst + k + 1, (unsigned long long)(unsigned)e1 | ((unsigned long long)__builtin_bit_cast(unsigned, g1) << 32), RLX_AGENT); }
        LDS_WAIT(); asm volatile("" ::: "memory");
        }
    }
}
__device__ __forceinline__ void p6_topk(Frame& F) {
    constexpr int NJOB = ((MREAL / 32 + 7) / 8) * 8;
    for (int job = F.vcu; job < NJOB; job += F.G) { p6_job(F, job); __syncthreads(); }
}
typedef _Float16 h2v __attribute__((ext_vector_type(2)));
constexpr int P7_RED = 0, P7_PART = LDSCTL_OFF;
#ifndef P7_UNR
#define P7_UNR (PEER_FP4 ? 16 : 8)
#endif
template <int M> __device__ __forceinline__ float xor_lane(float x) {
    if constexpr (M == 32) return __builtin_bit_cast(float, pg8::partner32(__builtin_bit_cast(unsigned, x)));
    else return __builtin_bit_cast(float, __builtin_amdgcn_ds_swizzle(__builtin_bit_cast(int, x), (M << 10) | 0x1f));
}
__device__ __forceinline__ float wave_sum_sw(float v) { v += xor_lane<1>(v); v += xor_lane<2>(v); v += xor_lane<4>(v); v += xor_lane<8>(v); v += xor_lane<16>(v); v += xor_lane<32>(v); return v; }
#if PEER_FP4
#ifndef P7_MFMA_U
#define P7_MFMA_U 1
#endif
typedef int v8i_t __attribute__((ext_vector_type(8)));
__device__ __forceinline__ void p7_gather(Frame& F) {
    const int lane = pg8::lane_id_v(), w = F.wave;
    const bf16* XH = (const bf16*)(F.ws + WS_RATIO); const unsigned char* EU4 = F.ws + WS_EU; const float* EUS = (const float*)(F.ws + WS_EU + 16 * MiB); const unsigned char* EV4 = F.ws + WS_EU + 32 * MiB; const float* EVS = (const float*)(F.ws + WS_EU + 48 * MiB);
    const unsigned long long* SEL = (const unsigned long long*)(F.ws + WS_RA);
    int it = 0;
#ifdef P7_ACTIVE_PER_XCD
    if ((F.vcu & 31) >= P7_ACTIVE_PER_XCD) return;
    const int rank_ = (F.vcu >> 5) * P7_ACTIVE_PER_XCD + (F.vcu & 31), nrank_ = 8 * P7_ACTIVE_PER_XCD;
#else
    const int rank_ = F.vcu, nrank_ = F.G;
#endif
    for (int t = rank_; t < MREAL; t += nrank_, ++it) {
        LAS float* RED = (LAS float*)(F.lds + P7_RED + (it & 1) * 65536); LAS float* PART = (LAS float*)(F.lds + P7_PART + (it & 1) * 32);
        const unsigned long long sel = SEL[((size_t)t * 8 + w) * 16 + (lane >> 2)];
        const int eidx = (int)(unsigned)sel; const float gate = __builtin_bit_cast(float, (unsigned)(sel >> 32));
        const float su_l = EUS[eidx], sv_l = EVS[eidx];
        unsigned xw[16];
#pragma unroll
        for (int q = 0; q < 8; ++q) { const unsigned long long v = *(const GAS unsigned long long*)(XH + (size_t)t * DM + q * 256 + lane * 4); xw[2 * q] = (unsigned)v; xw[2 * q + 1] = (unsigned)(v >> 32); }
#if P7_MFMA_U
        v8i_t xb;
        { typedef _Float16 h32x __attribute__((ext_vector_type(32))); typedef unsigned u6x __attribute__((ext_vector_type(6))); h32x hx;
#pragma unroll
          for (int i = 0; i < 16; ++i) { const h2v p = __builtin_bit_cast(h2v, xw[i]); hx[2 * i] = p[0]; hx[2 * i + 1] = p[1]; }
          const u6x px = __builtin_amdgcn_cvt_scalef32_pk32_fp6_f16(hx, 1.0f);
          xb = (v8i_t){(int)px[0], (int)px[1], (int)px[2], (int)px[3], (int)px[4], (int)px[5], 0, 0}; }
        float mk[4];
#pragma unroll
        for (int r4 = 0; r4 < 4; ++r4) mk[r4] = ((lane >> 4) == ((lane & 15) >> 2) && (lane & 3) == r4) ? 1.f : 0.f;
#endif
        float ssum = 0.f;
#pragma unroll
        for (int i = 0; i < 16; ++i) { const h2v hv = __builtin_bit_cast(h2v, xw[i]); ssum = __builtin_amdgcn_fdot2(hv, hv, ssum, false); }
        ssum = wave_sum_sw(ssum);
        const float rt = 1.0f / sqrtf(ssum * (1.f / DM) + EPS);
        float dp[16];
#pragma unroll
        for (int k0 = 0; k0 < 16; k0 += P7_UNR) {
            v4u ur[P7_UNR];
#pragma unroll
            for (int kk = 0; kk < P7_UNR; ++kk) { const int e = __builtin_amdgcn_readlane(eidx, 4 * (k0 + kk)); ur[kk] = *(const GAS v4u*)(EU4 + (size_t)e * 1024 + lane * 16); }
#if P7_MFMA_U
#pragma unroll
            for (int kk = 0; kk < P7_UNR; ++kk) { const v8i_t A = {(int)ur[kk].x, (int)ur[kk].y, (int)ur[kk].z, (int)ur[kk].w, 0, 0, 0, 0};
                const f32x4 d = __builtin_amdgcn_mfma_scale_f32_16x16x128_f8f6f4(A, xb, (f32x4){0.f, 0.f, 0.f, 0.f}, 4  , 2  , 0, 127, 0, 127);
                dp[k0 + kk] = (d[0] * mk[0] + d[1] * mk[1]) + (d[2] * mk[2] + d[3] * mk[3]); }
#else
#pragma unroll
            for (int kk = 0; kk < P7_UNR; ++kk) { float a = 0.f;
#pragma unroll
                for (int q = 0; q < 4; ++q) { const unsigned wq = ur[kk][q];
                    a = __builtin_amdgcn_fdot2(__builtin_amdgcn_cvt_scalef32_pk_f16_fp4(wq, 1.0f, 0), __builtin_bit_cast(h2v, xw[4 * q + 0]), a, false); a = __builtin_amdgcn_fdot2(__builtin_amdgcn_cvt_scalef32_pk_f16_fp4(wq, 1.0f, 1), __builtin_bit_cast(h2v, xw[4 * q + 1]), a, false);
                    a = __builtin_amdgcn_fdot2(__builtin_amdgcn_cvt_scalef32_pk_f16_fp4(wq, 1.0f, 2), __builtin_bit_cast(h2v, xw[4 * q + 2]), a, false); a = __builtin_amdgcn_fdot2(__builtin_amdgcn_cvt_scalef32_pk_f16_fp4(wq, 1.0f, 3), __builtin_bit_cast(h2v, xw[4 * q + 3]), a, false); }
                dp[k0 + kk] = a;
                }
#endif
#pragma unroll
            for (int kk = 0; kk < P7_UNR; ++kk) asm volatile("" : "+v"(dp[k0 + kk]) :: "memory");
        }
#define P7_TR(C, M) do { const bool up_ = (lane & (M)) != 0; _Pragma("unroll") for (int i = 0; i < (C) / 2; ++i) { const float keep_ = up_ ? dp[i + (C) / 2] : dp[i], send_ = up_ ? dp[i] : dp[i + (C) / 2]; dp[i] = keep_ + xor_lane<(M)>(send_); } } while (0)
        P7_TR(16, 32); P7_TR(8, 16); P7_TR(4, 8); P7_TR(2, 4);
#undef P7_TR
        float dk = dp[0]; dk += xor_lane<2>(dk); dk += xor_lane<1>(dk);
        const float hval = gate * pg8::gelu_tanh(dk * su_l * rt) * sv_l;
        h2v o2[16];
#pragma unroll
        for (int e = 0; e < 16; ++e) o2[e] = (h2v){(_Float16)0.f, (_Float16)0.f};
#pragma unroll
        for (int k0 = 0; k0 < 16; k0 += P7_UNR) {
            v4u vr[P7_UNR];
#pragma unroll
            for (int kk = 0; kk < P7_UNR; ++kk) { const int e = __builtin_amdgcn_readlane(eidx, 4 * (k0 + kk)); vr[kk] = *(const GAS v4u*)(EV4 + (size_t)e * 1024 + lane * 16); }
#pragma unroll
            for (int kk = 0; kk < P7_UNR; ++kk) { const float hk = __builtin_bit_cast(float, __builtin_amdgcn_readlane(__builtin_bit_cast(int, hval), 4 * (k0 + kk))) * 256.0f; const _Float16 hh = (_Float16)hk; const h2v hk2 = {hh, hh};
#pragma unroll
                for (int q = 0; q < 4; ++q) { const unsigned wq = vr[kk][q];
                    o2[4 * q + 0] = __builtin_elementwise_fma(__builtin_bit_cast(h2v, __builtin_amdgcn_cvt_scalef32_pk_f16_fp4(wq, 1.0f, 0)), hk2, o2[4 * q + 0]); o2[4 * q + 1] = __builtin_elementwise_fma(__builtin_bit_cast(h2v, __builtin_amdgcn_cvt_scalef32_pk_f16_fp4(wq, 1.0f, 1)), hk2, o2[4 * q + 1]);
                    o2[4 * q + 2] = __builtin_elementwise_fma(__builtin_bit_cast(h2v, __builtin_amdgcn_cvt_scalef32_pk_f16_fp4(wq, 1.0f, 2)), hk2, o2[4 * q + 2]); o2[4 * q + 3] = __builtin_elementwise_fma(__builtin_bit_cast(h2v, __builtin_amdgcn_cvt_scalef32_pk_f16_fp4(wq, 1.0f, 3)), hk2, o2[4 * q + 3]); } }
#pragma unroll
            for (int q = 0; q < 2; ++q) asm volatile("" : "+v"(o2[8 * q]), "+v"(o2[8 * q + 1]), "+v"(o2[8 * q + 2]), "+v"(o2[8 * q + 3]), "+v"(o2[8 * q + 4]), "+v"(o2[8 * q + 5]), "+v"(o2[8 * q + 6]), "+v"(o2[8 * q + 7]) :: "memory");
        }
#pragma unroll
        for (int q = 0; q < 8; ++q) *(LAS f32x4*)(RED + w * 2048 + q * 256 + lane * 4) = (f32x4){(float)o2[2 * q][0], (float)o2[2 * q][1], (float)o2[2 * q + 1][0], (float)o2[2 * q + 1][1]} * (1.0f / 256.0f);
        __syncthreads();
        const int col = w * 256 + lane * 4, soff = col;
        f32x4 sum = *(const LAS f32x4*)(RED + soff);
#pragma unroll
        for (int ww = 1; ww < 8; ++ww) sum += *(const LAS f32x4*)(RED + ww * 2048 + soff);
        { const unsigned long long xq = *(const GAS unsigned long long*)(XH + (size_t)t * DM + col); const unsigned x0 = (unsigned)xq, x1 = (unsigned)(xq >> 32); const h2v p0 = __builtin_bit_cast(h2v, x0), p1 = __builtin_bit_cast(h2v, x1);
            sum += (f32x4){(float)p0[0], (float)p0[1], (float)p1[0], (float)p1[1]}; }
        float sq = (sum.x * sum.x + sum.y * sum.y) + (sum.z * sum.z + sum.w * sum.w); sq = wave_sum_sw(sq);
        if (lane == 0) PART[w] = sq;
        __syncthreads();
        float tot = 0.f;
#pragma unroll
        for (int ww = 0; ww < 8; ++ww) tot += PART[ww];
        const float rf = 1.0f / sqrtf(tot * (1.f / DM) + EPS);
        const f32x4 gf = *(const GAS f32x4*)(F.norm_final_g + col);
        *(GAS f32x4*)(F.out + OUT_Y + (size_t)t * DM + col) = sum * rf * gf;
    }
}
#elif PEER_FP6
typedef _Float16 h32v __attribute__((ext_vector_type(32)));
typedef unsigned u6v __attribute__((ext_vector_type(6)));
typedef unsigned u2v __attribute__((ext_vector_type(2)));
__device__ __forceinline__ u6v ld_row6(const unsigned char* p) { const GAS u2v* q = (const GAS u2v*)p; const u2v a = q[0], b = q[1], c = q[2]; return (u6v){a.x, a.y, b.x, b.y, c.x, c.y}; }
__device__ __forceinline__ void p7_gather(Frame& F) {
    const int lane = pg8::lane_id_v(), w = F.wave;
    const bf16* XH = (const bf16*)(F.ws + WS_RATIO); const unsigned char* EU6 = F.ws + WS_EU; const unsigned char* EV6 = F.ws + WS_EU + 32 * MiB;
    const unsigned long long* SEL = (const unsigned long long*)(F.ws + WS_RA);
    int it = 0;
    for (int t = F.vcu; t < MREAL; t += F.G, ++it) {
        LAS float* RED = (LAS float*)(F.lds + P7_RED + (it & 1) * 65536); LAS float* PART = (LAS float*)(F.lds + P7_PART + (it & 1) * 32);
        const unsigned long long sel = SEL[((size_t)t * 8 + w) * 16 + (lane >> 2)];
        const int eidx = (int)(unsigned)sel; const float gate = __builtin_bit_cast(float, (unsigned)(sel >> 32));
        unsigned xw[16];
#pragma unroll
        for (int q = 0; q < 4; ++q) { const v4u v = *(const GAS v4u*)(XH + (size_t)t * DM + lane * 32 + q * 8); xw[4 * q] = v.x; xw[4 * q + 1] = v.y; xw[4 * q + 2] = v.z; xw[4 * q + 3] = v.w; }
        float ssum = 0.f;
#pragma unroll
        for (int i = 0; i < 16; ++i) { const h2v hv = __builtin_bit_cast(h2v, xw[i]); ssum = __builtin_amdgcn_fdot2(hv, hv, ssum, false); }
        ssum = wave_sum_sw(ssum);
        const float rt = 1.0f / sqrtf(ssum * (1.f / DM) + EPS);
        float dp[16];
#pragma unroll
        for (int k0 = 0; k0 < 16; k0 += P7_UNR) {
            u6v ur[P7_UNR];
#pragma unroll
            for (int kk = 0; kk < P7_UNR; ++kk) { const int e = __builtin_amdgcn_readlane(eidx, 4 * (k0 + kk)); ur[kk] = ld_row6(EU6 + (size_t)e * 1536 + lane * 24); }
#pragma unroll
            for (int kk = 0; kk < P7_UNR; ++kk) { const h32v d = __builtin_amdgcn_cvt_scalef32_pk32_f16_fp6(ur[kk], 1.0f); float a = 0.f;
#pragma unroll
                for (int i = 0; i < 16; ++i) { const h2v dd = {d[2 * i], d[2 * i + 1]}; a = __builtin_amdgcn_fdot2(dd, __builtin_bit_cast(h2v, xw[i]), a, false); }
                dp[k0 + kk] = a; }
#pragma unroll
            for (int kk = 0; kk < P7_UNR; ++kk) asm volatile("" : "+v"(dp[k0 + kk]) :: "memory");
        }
#define P7_TR(C, M) do { const bool up_ = (lane & (M)) != 0; _Pragma("unroll") for (int i = 0; i < (C) / 2; ++i) { const float keep_ = up_ ? dp[i + (C) / 2] : dp[i], send_ = up_ ? dp[i] : dp[i + (C) / 2]; dp[i] = keep_ + xor_lane<(M)>(send_); } } while (0)
        P7_TR(16, 32); P7_TR(8, 16); P7_TR(4, 8); P7_TR(2, 4);
#undef P7_TR
        float dk = dp[0]; dk += xor_lane<2>(dk); dk += xor_lane<1>(dk);
        const float hval = gate * pg8::gelu_tanh(dk * rt * (1.0f / PEER_SU)) * (1.0f / PEER_SV);
        float o[32];
#pragma unroll
        for (int e = 0; e < 32; ++e) o[e] = 0.f;
#pragma unroll
        for (int k0 = 0; k0 < 16; k0 += P7_UNR) {
            u6v vr[P7_UNR];
#pragma unroll
            for (int kk = 0; kk < P7_UNR; ++kk) { const int e = __builtin_amdgcn_readlane(eidx, 4 * (k0 + kk)); vr[kk] = ld_row6(EV6 + (size_t)e * 1536 + lane * 24); }
#pragma unroll
            for (int kk = 0; kk < P7_UNR; ++kk) { const float hk = __builtin_bit_cast(float, __builtin_amdgcn_readlane(__builtin_bit_cast(int, hval), 4 * (k0 + kk))); const h32v d = __builtin_amdgcn_cvt_scalef32_pk32_f16_fp6(vr[kk], 1.0f);
#pragma unroll
                for (int e = 0; e < 32; ++e) o[e] = __builtin_fmaf((float)d[e], hk, o[e]); }
#pragma unroll
            for (int q = 0; q < 4; ++q) asm volatile("" : "+v"(o[8 * q]), "+v"(o[8 * q + 1]), "+v"(o[8 * q + 2]), "+v"(o[8 * q + 3]), "+v"(o[8 * q + 4]), "+v"(o[8 * q + 5]), "+v"(o[8 * q + 6]), "+v"(o[8 * q + 7]) :: "memory");
        }
        { const int L = lane;
#pragma unroll
            for (int q = 0; q < 8; ++q) *(LAS f32x4*)(RED + w * 2048 + L * 32 + ((q + L) & 7) * 4) = (f32x4){o[4 * q], o[4 * q + 1], o[4 * q + 2], o[4 * q + 3]}; }
        __syncthreads();
        const int col = w * 256 + lane * 4; const int Lb = col >> 5, qb = (col >> 2) & 7, soff = Lb * 32 + ((qb + Lb) & 7) * 4;
        f32x4 sum = *(const LAS f32x4*)(RED + soff);
#pragma unroll
        for (int ww = 1; ww < 8; ++ww) sum += *(const LAS f32x4*)(RED + ww * 2048 + soff);
        { const unsigned long long xq = *(const GAS unsigned long long*)(XH + (size_t)t * DM + col); const unsigned x0 = (unsigned)xq, x1 = (unsigned)(xq >> 32); const h2v p0 = __builtin_bit_cast(h2v, x0), p1 = __builtin_bit_cast(h2v, x1);
            sum += (f32x4){(float)p0[0], (float)p0[1], (float)p1[0], (float)p1[1]}; }
        float sq = (sum.x * sum.x + sum.y * sum.y) + (sum.z * sum.z + sum.w * sum.w); sq = wave_sum_sw(sq);
        if (lane == 0) PART[w] = sq;
        __syncthreads();
        float tot = 0.f;
#pragma unroll
        for (int ww = 0; ww < 8; ++ww) tot += PART[ww];
        const float rf = 1.0f / sqrtf(tot * (1.f / DM) + EPS);
        const f32x4 gf = *(const GAS f32x4*)(F.norm_final_g + col);
        *(GAS f32x4*)(F.out + OUT_Y + (size_t)t * DM + col) = sum * rf * gf;
    }
}
#else
#error "PEER expert tables: PEER_FP4 or PEER_FP6"
#endif
#ifndef PQ_MERGE
#define PQ_MERGE PEER_FP4
#endif
#if PQ_MERGE
constexpr int CW_QUEUE = 8192, CW_GCNT = 8256;
constexpr int Q_NITEM = 520 + MREAL;
static_assert(MREAL == 16512 && (CW_GCNT + 65) * 4 <= (int)CTL_ZERO_BYTES, "queue layout");
__device__ __forceinline__ int q_decode(const int idx) { return idx < 520 ? ~idx : idx - 520; }
__device__ __forceinline__ unsigned q_ready(unsigned* gcnt, const int g, int& upto, const int lane) {
    if (g >= upto) { const unsigned c = xb_ld(&gcnt[lane]), c64 = xb_ld(&gcnt[64]); const unsigned long long m = __ballot(c >= 8u);
        int n = (m == ~0ull) ? 64 : __builtin_ctzll(~m); if (n == 64 && c64 >= 8u) n = 65; upto = n; }
    return g < upto ? 8u : 0u;
}
__device__ __forceinline__ void p67_queue(Frame& F) {
    const int w = F.wave;
    unsigned* qctr = (unsigned*)(F.ctl + CW_QUEUE); unsigned* gcnt = (unsigned*)(F.ctl + CW_GCNT); unsigned* bar = (unsigned*)(F.ctl + CW_BAR);
    volatile LAS int* LQ = (volatile LAS int*)(F.lds + LDSCTL_OFF + 128);
    const bf16* XH = (const bf16*)(F.ws + WS_RATIO); const unsigned char* EU4 = F.ws + WS_EU; const float* EUS = (const float*)(F.ws + WS_EU + 16 * MiB); const unsigned char* EV4 = F.ws + WS_EU + 32 * MiB; const float* EVS = (const float*)(F.ws + WS_EU + 48 * MiB);
    unsigned long long* SEL = (unsigned long long*)(F.ws + WS_RA);
    int idx = F.vcu, slot = 0, ntok = 0, rdy_upto = 0; int ready = q_decode(idx) < 0 ? 1 : 0;
    while (idx < Q_NITEM) {
        const int lane = pg8::lane_id_v();
        unsigned nxr = 0u; if (w == 0 && lane == 0) nxr = xb_add(qctr, 1u);
        int nx = Q_NITEM; unsigned nrdy = 8u;
        const int item = q_decode(idx);
        if (item < 0) {
            const int job = ~item;
            p6_job(F, job);
            VM_WAIT();
            if (w == 0) { nx = (int)F.G + __builtin_amdgcn_readfirstlane((int)nxr); if (nx < Q_NITEM) { const int ni = q_decode(nx); if (ni >= 0) nrdy = q_ready(gcnt, ni >> 8, rdy_upto, lane); }
                if (lane == 0) { LQ[(slot ^ 1) * 2] = nx; LQ[(slot ^ 1) * 2 + 1] = nrdy >= 8u ? 1 : 0; } }
            __syncthreads();
            if (w == 0 && lane == 0) (void)xb_add(&gcnt[job >> 3], 1u);
        } else {
            const int t = item;
            if (!ready) { XB_SPIN(xb_ld(&gcnt[t >> 8]) < 8u, bar); }
            LAS float* RED = (LAS float*)(F.lds + P7_RED + (ntok & 1) * 65536); LAS float* PART = (LAS float*)(F.lds + P7_PART + (ntok & 1) * 32);
            const unsigned long long sel = __hip_atomic_load(SEL + ((size_t)t * 8 + w) * 16 + (lane >> 2), RLX_AGENT);
            const int eidx = (int)(unsigned)sel; const float gate = __builtin_bit_cast(float, (unsigned)(sel >> 32));
            const float su_l = EUS[eidx], sv_l = EVS[eidx];
            unsigned xw[16];
#pragma unroll
            for (int q = 0; q < 8; ++q) { const unsigned long long v = *(const GAS unsigned long long*)(XH + (size_t)t * DM + q * 256 + lane * 4); xw[2 * q] = (unsigned)v; xw[2 * q + 1] = (unsigned)(v >> 32); }
#if P7_MFMA_U
            v8i_t xb;
            { typedef _Float16 h32x __attribute__((ext_vector_type(32))); typedef unsigned u6x __attribute__((ext_vector_type(6))); h32x hx;
#pragma unroll
              for (int i = 0; i < 16; ++i) { const h2v p = __builtin_bit_cast(h2v, xw[i]); hx[2 * i] = p[0]; hx[2 * i + 1] = p[1]; }
              const u6x px = __builtin_amdgcn_cvt_scalef32_pk32_fp6_f16(hx, 1.0f);
              xb = (v8i_t){(int)px[0], (int)px[1], (int)px[2], (int)px[3], (int)px[4], (int)px[5], 0, 0}; }
            float mk[4];
#pragma unroll
            for (int r4 = 0; r4 < 4; ++r4) mk[r4] = ((lane >> 4) == ((lane & 15) >> 2) && (lane & 3) == r4) ? 1.f : 0.f;
#endif
            float ssum = 0.f;
#pragma unroll
            for (int i = 0; i < 16; ++i) { const h2v hv = __builtin_bit_cast(h2v, xw[i]); ssum = __builtin_amdgcn_fdot2(hv, hv, ssum, false); }
            ssum = wave_sum_sw(ssum);
            const float rt = 1.0f / sqrtf(ssum * (1.f / DM) + EPS);
            float dp[16];
#pragma unroll
            for (int k0 = 0; k0 < 16; k0 += P7_UNR) {
                v4u ur[P7_UNR];
#pragma unroll
                for (int kk = 0; kk < P7_UNR; ++kk) { const int e = __builtin_amdgcn_readlane(eidx, 4 * (k0 + kk)); ur[kk] = *(const GAS v4u*)(EU4 + (size_t)e * 1024 + lane * 16); }
#if P7_MFMA_U
#pragma unroll
                for (int kk = 0; kk < P7_UNR; ++kk) { const v8i_t A = {(int)ur[kk].x, (int)ur[kk].y, (int)ur[kk].z, (int)ur[kk].w, 0, 0, 0, 0};
                    const f32x4 d = __builtin_amdgcn_mfma_scale_f32_16x16x128_f8f6f4(A, xb, (f32x4){0.f, 0.f, 0.f, 0.f}, 4  , 2  , 0, 127, 0, 127);
                    dp[k0 + kk] = (d[0] * mk[0] + d[1] * mk[1]) + (d[2] * mk[2] + d[3] * mk[3]); }
#else
#pragma unroll
                for (int kk = 0; kk < P7_UNR; ++kk) { float a = 0.f;
#pragma unroll
                    for (int q = 0; q < 4; ++q) { const unsigned wq = ur[kk][q];
                        a = __builtin_amdgcn_fdot2(__builtin_amdgcn_cvt_scalef32_pk_f16_fp4(wq, 1.0f, 0), __builtin_bit_cast(h2v, xw[4 * q + 0]), a, false); a = __builtin_amdgcn_fdot2(__builtin_amdgcn_cvt_scalef32_pk_f16_fp4(wq, 1.0f, 1), __builtin_bit_cast(h2v, xw[4 * q + 1]), a, false);
                        a = __builtin_amdgcn_fdot2(__builtin_amdgcn_cvt_scalef32_pk_f16_fp4(wq, 1.0f, 2), __builtin_bit_cast(h2v, xw[4 * q + 2]), a, false); a = __builtin_amdgcn_fdot2(__builtin_amdgcn_cvt_scalef32_pk_f16_fp4(wq, 1.0f, 3), __builtin_bit_cast(h2v, xw[4 * q + 3]), a, false); }
                    dp[k0 + kk] = a;
                    }
#endif
#pragma unroll
                for (int kk = 0; kk < P7_UNR; ++kk) asm volatile("" : "+v"(dp[k0 + kk]) :: "memory");
            }
            if (w == 0) { nx = (int)F.G + __builtin_amdgcn_readfirstlane((int)nxr); if (nx < Q_NITEM) { const int ni = q_decode(nx); if (ni >= 0) nrdy = q_ready(gcnt, ni >> 8, rdy_upto, lane); } }
#define P7_TR(C, M) do { const bool up_ = (lane & (M)) != 0; _Pragma("unroll") for (int i = 0; i < (C) / 2; ++i) { const float keep_ = up_ ? dp[i + (C) / 2] : dp[i], send_ = up_ ? dp[i] : dp[i + (C) / 2]; dp[i] = keep_ + xor_lane<(M)>(send_); } } while (0)
            P7_TR(16, 32); P7_TR(8, 16); P7_TR(4, 8); P7_TR(2, 4);
#undef P7_TR
            float dk = dp[0]; dk += xor_lane<2>(dk); dk += xor_lane<1>(dk);
            const float hval = gate * pg8::gelu_tanh(dk * su_l * rt) * sv_l;
            unsigned long long xq = 0ull; f32x4 gf = {0.f, 0.f, 0.f, 0.f};
            h2v o2[16];
#pragma unroll
            for (int e = 0; e < 16; ++e) o2[e] = (h2v){(_Float16)0.f, (_Float16)0.f};
#pragma unroll
            for (int k0 = 0; k0 < 16; k0 += P7_UNR) {
                v4u vr[P7_UNR];
#pragma unroll
                for (int kk = 0; kk < P7_UNR; ++kk) { const int e = __builtin_amdgcn_readlane(eidx, 4 * (k0 + kk)); vr[kk] = *(const GAS v4u*)(EV4 + (size_t)e * 1024 + lane * 16); }
                if (k0 == 0) { xq = *(const GAS unsigned long long*)(XH + (size_t)t * DM + w * 256 + lane * 4); gf = *(const GAS f32x4*)(F.norm_final_g + w * 256 + lane * 4); }
#pragma unroll
                for (int kk = 0; kk < P7_UNR; ++kk) { const float hk = __builtin_bit_cast(float, __builtin_amdgcn_readlane(__builtin_bit_cast(int, hval), 4 * (k0 + kk))) * 256.0f; const _Float16 hh = (_Float16)hk; const h2v hk2 = {hh, hh};
#pragma unroll
                    for (int q = 0; q < 4; ++q) { const unsigned wq = vr[kk][q];
                        o2[4 * q + 0] = __builtin_elementwise_fma(__builtin_bit_cast(h2v, __builtin_amdgcn_cvt_scalef32_pk_f16_fp4(wq, 1.0f, 0)), hk2, o2[4 * q + 0]); o2[4 * q + 1] = __builtin_elementwise_fma(__builtin_bit_cast(h2v, __builtin_amdgcn_cvt_scalef32_pk_f16_fp4(wq, 1.0f, 1)), hk2, o2[4 * q + 1]);
                        o2[4 * q + 2] = __builtin_elementwise_fma(__builtin_bit_cast(h2v, __builtin_amdgcn_cvt_scalef32_pk_f16_fp4(wq, 1.0f, 2)), hk2, o2[4 * q + 2]); o2[4 * q + 3] = __builtin_elementwise_fma(__builtin_bit_cast(h2v, __builtin_amdgcn_cvt_scalef32_pk_f16_fp4(wq, 1.0f, 3)), hk2, o2[4 * q + 3]); } }
#pragma unroll
                for (int q = 0; q < 2; ++q) asm volatile("" : "+v"(o2[8 * q]), "+v"(o2[8 * q + 1]), "+v"(o2[8 * q + 2]), "+v"(o2[8 * q + 3]), "+v"(o2[8 * q + 4]), "+v"(o2[8 * q + 5]), "+v"(o2[8 * q + 6]), "+v"(o2[8 * q + 7]) :: "memory");
            }
#pragma unroll
            for (int q = 0; q < 8; ++q) *(LAS f32x4*)(RED + w * 2048 + q * 256 + lane * 4) = (f32x4){(float)o2[2 * q][0], (float)o2[2 * q][1], (float)o2[2 * q + 1][0], (float)o2[2 * q + 1][1]} * (1.0f / 256.0f);
            __syncthreads();
            const int col = w * 256 + lane * 4, soff = col;
            f32x4 sum = *(const LAS f32x4*)(RED + soff);
#pragma unroll
            for (int ww = 1; ww < 8; ++ww) sum += *(const LAS f32x4*)(RED + ww * 2048 + soff);
            { const unsigned x0 = (unsigned)xq, x1 = (unsigned)(xq >> 32); const h2v p0 = __builtin_bit_cast(h2v, x0), p1 = __builtin_bit_cast(h2v, x1);
                sum += (f32x4){(float)p0[0], (float)p0[1], (float)p1[0], (float)p1[1]}; }
            float sq = (sum.x * sum.x + sum.y * sum.y) + (sum.z * sum.z + sum.w * sum.w); sq = wave_sum_sw(sq);
            if (lane == 0) PART[w] = sq;
            if (w == 0 && lane == 0) { LQ[(slot ^ 1) * 2] = nx; LQ[(slot ^ 1) * 2 + 1] = nrdy >= 8u ? 1 : 0; }
            __syncthreads();
            float tot = 0.f;
#pragma unroll
            for (int ww = 0; ww < 8; ++ww) tot += PART[ww];
            const float rf = 1.0f / sqrtf(tot * (1.f / DM) + EPS);
            __builtin_nontemporal_store(sum * rf * gf, (GAS f32x4*)(F.out + OUT_Y + (size_t)t * DM + col));
        }
        slot ^= 1; ++ntok;
        idx = __builtin_amdgcn_readfirstlane(LQ[slot * 2]); ready = __builtin_amdgcn_readfirstlane(LQ[slot * 2 + 1]);
    }
}
#endif
struct Args { const float* in[20]; float* out; unsigned char* ws; };
__global__ void __launch_bounds__(NWAVES * 64, 2) hybrid_fwd(Args args) {
    extern __shared__ __attribute__((aligned(16))) unsigned char lds[];
    Frame F;
    F.lds = (LAS unsigned char*)lds;
    F.MISC = (volatile LAS unsigned*)(F.lds + MISC_OFF);
    F.wave = __builtin_amdgcn_readfirstlane(threadIdx.x >> 6);
    F.G = gridDim.x; { const int bx = blockIdx.x; F.vcu = (F.G % 8 == 0) ? (bx % 8) * (F.G / 8) + bx / 8 : bx; }
    F.ws = args.ws; F.out = args.out; F.ctl = (gu32*)(args.ws + WS_CTL);
    F.x_prompt = args.in[0]; F.x_sample = args.in[1]; F.cache_k = args.in[2]; F.cache_v = args.in[3]; F.norm_mix_g = args.in[4]; F.w_in = args.in[5]; F.sgu_norm_g = args.in[6];
    F.sgu_w_s = args.in[7]; F.sgu_b_s = args.in[8]; F.sinks = args.in[9]; F.rel_tab = args.in[10]; F.w_pa = args.in[11]; F.w_pb = args.in[12]; F.w_out = args.in[13]; F.norm_ffn_g = args.in[14];
    F.w_query = args.in[15]; F.sub_keys = args.in[16]; F.exp_u = args.in[17]; F.exp_v = args.in[18]; F.norm_final_g = args.in[19];
    for (int u = threadIdx.x; u < (LDS_BYTES - LDSCTL_OFF) / 4; u += NWAVES * 64) ((LAS unsigned*)(F.lds + LDSCTL_OFF))[u] = 0u;
    __syncthreads();
    XcdBarrier bar = xcd_barrier_post((unsigned*)(F.ctl + CW_BAR), F.MISC + 8);
    unsigned char* ws = args.ws;
    p0_prologue(F);
    xcd_barrier(bar);
    {
        pg8::Gemm g{(const bf16*)(ws + WS_RA), (const bf16*)(ws + WS_WIN), MPAD, DIN, DM}; pg8::StaticOrder S; S.init(MPAD, DIN, F.G, (int)blockIdx.x);
        pg8::EpiIn E{(bf16*)(ws + WS_Q), (bf16*)(ws + WS_KV), (bf16*)(ws + WS_U), (bf16*)(ws + WS_VS), (bf16*)(ws + WS_RATIO), (bf16*)(ws + WS_SB), (float*)(ws + WS_SS1),
                     F.out + OUT_KP, F.out + OUT_VP, F.out + OUT_KS, F.out + OUT_VS};
        pg8::gemm_phase<pg8::EpiIn, pg8::StaticOrder, true, true, false>(F.lds + RING_OFF, g, S, E, F.wave);
        constexpr int NU = (MPAD / 256) * (DIN / 256); const int full = NU % (int)F.G;
        if (NU > (int)F.G && full > 0) { if ((int)blockIdx.x >= full) p0_expert_tables(F, (int)blockIdx.x - full, (int)F.G - full); }
        else p0_expert_tables(F, F.vcu, F.G);
    }
    xcd_barrier(bar);
    p2_mixers(F);
    xcd_barrier(bar);
    {
        pg8::Gemm g{(const bf16*)(ws + WS_RA), (const bf16*)(ws + WS_WAB), MPROMPT, DM, DM}; pg8::StaticOrder S; S.init(MPROMPT, DM, F.G, (int)blockIdx.x);
        pg8::EpiMerge E{(const bf16*)(ws + WS_RATIO), (const bf16*)(ws + WS_SB), (bf16*)(ws + WS_RB)};
        pg8::gemm_phase<pg8::EpiMerge, pg8::StaticOrder, true, true, false>(F.lds + RING_OFF, g, S, E, F.wave);
        const SkMerge SE{(const bf16*)(ws + WS_RATIO), (const bf16*)(ws + WS_SB), (bf16*)(ws + WS_RB)}; skinny_gemm<false, true>(F, (const bf16*)(ws + WS_RA), (const bf16*)(ws + WS_WAB), SE);
    }
    xcd_barrier(bar);
    {
        pg8::Gemm g{(const bf16*)(ws + WS_RB), (const bf16*)(ws + WS_WOUT), MPROMPT, DM, DM}; pg8::StaticOrder S; S.init(MPROMPT, DM, F.G, (int)blockIdx.x);
        pg8::EpiOut E{F.x_prompt, F.x_sample, (bf16*)(ws + WS_RATIO), (float*)(ws + WS_SS2)};
        pg8::gemm_phase<pg8::EpiOut, pg8::StaticOrder, true, true, false>(F.lds + RING_OFF, g, S, E, F.wave);
        const SkOut SE{F.x_sample, (bf16*)(ws + WS_RATIO), (float*)(ws + WS_SS2S)}; skinny_gemm<false, false>(F, (const bf16*)(ws + WS_RB), (const bf16*)(ws + WS_WOUT), SE);
    }
    xcd_barrier(bar);
    {
        pg8::Gemm g{(const bf16*)(ws + WS_RATIO), (const bf16*)(ws + WS_WQ), MPROMPT, DM, DM}; pg8::StaticOrder S; S.init(MPROMPT, DM, F.G, (int)blockIdx.x);
        pg8::EpiQ E{(bf16*)(ws + WS_SB)};
        pg8::gemm_phase<pg8::EpiQ, pg8::StaticOrder, true, true, true>(F.lds + RING_OFF, g, S, E, F.wave);
        const SkQ SE{(bf16*)(ws + WS_SB)}; skinny_gemm<true, false>(F, (const bf16*)(ws + WS_RATIO), (const bf16*)(ws + WS_WQ), SE);
    }
    xcd_barrier(bar);
#if PQ_MERGE
    p67_queue(F);
#else
    p6_topk(F);
    xcd_barrier(bar);
    p7_gather(F);
#endif
}

extern "C" void kernel_launch(void* const* d_in, const int* in_sizes, int n_in, void* d_out, int out_size, void* d_ws, size_t ws_size, hipStream_t stream) {
    static int grid = 0;
    if (grid == 0) {
        if (n_in != 20 || in_sizes[0] != MPROMPT * DM || out_size != (int)OUT_TOTAL || ws_size < WS_END) {
            fprintf(stderr, "kernel_launch: shape mismatch: n_in %d, in0 %d, out %d (want %zu), ws %zu (want %zu); nothing launched\n", n_in, n_in > 0 ? in_sizes[0] : -1, out_size, (size_t)OUT_TOTAL, ws_size, (size_t)WS_END); grid = -1; return; }
        int dev = 0, cus = 0, per_cu = 0;
        if (hipGetDevice(&dev) != hipSuccess || hipDeviceGetAttribute(&cus, hipDeviceAttributeMultiprocessorCount, dev) != hipSuccess) { fprintf(stderr, "kernel_launch: device query failed\n"); grid = -1; return; }
        if (hipFuncSetAttribute((const void*)hybrid_fwd, hipFuncAttributeMaxDynamicSharedMemorySize, LDS_BYTES) != hipSuccess) { fprintf(stderr, "kernel_launch: hipFuncSetAttribute failed\n"); grid = -1; return; }
        if (hipOccupancyMaxActiveBlocksPerMultiprocessor(&per_cu, (const void*)hybrid_fwd, NWAVES * 64, LDS_BYTES) != hipSuccess || per_cu < 1)
            fprintf(stderr, "kernel_launch: note: occupancy query reports %d workgroups per CU\n", per_cu);
        (void)hipGetLastError();
        grid = cus;
    }
    if (grid < 0) return;
    if (hipMemsetAsync((char*)d_ws + WS_CTL, 0, CTL_ZERO_BYTES, stream) != hipSuccess) { fprintf(stderr, "kernel_launch: memset failed\n"); return; }
    Args a{};
    for (int i = 0; i < 20; ++i) a.in[i] = (const float*)d_in[i];
    a.out = (float*)d_out; a.ws = (unsigned char*)d_ws;

    hipLaunchKernelGGL(hybrid_fwd, dim3(grid), dim3(NWAVES * 64), LDS_BYTES, stream, a);
    const hipError_t le = hipPeekAtLastError();
    if (le != hipSuccess) fprintf(stderr, "kernel_launch: launch failed: %s\n", hipGetErrorName(le));
}
```

```cpp
#include <hip/hip_runtime.h>
#include <cstdio>
#include <cstdint>

namespace pg8 {
#define PG8_LAS __attribute__((address_space(3)))
typedef unsigned short bf16_t;
typedef short bf16x8 __attribute__((ext_vector_type(8)));
typedef float f32x4 __attribute__((ext_vector_type(4)));
typedef unsigned u32x4 __attribute__((ext_vector_type(4)));
constexpr int BM = 256, BK = 64, HALF = 128, HTB = HALF * BK * 2  , STAGE_BYTES = 8 * HTB, NXCD = 8, WGM = 8;

__host__ __device__ __forceinline__ int lds_byte(int r, int c) { const int st = (r >> 4) * 2 + (c >> 5), rr = r & 15, cc = c & 31, ob = rr * 64 + cc * 2; return st * 1024 + (ob ^ (((ob >> 9) & 1) << 5)); }
__host__ __device__ __forceinline__ void stage_rc(int b, int& R, int& C) { const int st = b / 1024, sb = b % 1024, swz = sb ^ (((sb >> 9) & 1) << 5); R = (st >> 1) * 16 + swz / 64; C = (st & 1) * 32 + (swz % 64) / 2; }
__host__ __device__ __forceinline__ int perm32(int rho) { const int n = rho >> 4, i = rho & 15; return 8 * (i >> 2) + 4 * n + (i & 3); }

__device__ __forceinline__ int lane_id_v() { int l; asm volatile("v_mbcnt_lo_u32_b32 %0, -1, 0\n\tv_mbcnt_hi_u32_b32 %0, -1, %0" : "=v"(l)); return l; }
__device__ __forceinline__ unsigned partner32(unsigned x) { unsigned a = x, b = x; asm volatile("" : "+v"(a)); asm volatile("" : "+v"(b)); auto rr = __builtin_amdgcn_permlane32_swap(a, b, false, false); return rr[0] ^ rr[1] ^ x; }
struct Unit { int pm, pn; };
struct Gemm { const bf16_t* A; const bf16_t* Bt; int M, N, K; };

struct StaticOrder {
    int nM, nN, nwg, G, c;
    __host__ __device__ void init(int M, int N, int G_, int c_) { nM = M / BM; nN = N / BM; nwg = nM * nN; G = G_; c = c_; }
    __host__ __device__ bool next(int i, Unit& u) const {
        const long L = (long)i * G + c; if (L >= nwg) return false;
        int wgid = (int)L; { const int q = nwg / NXCD, r = nwg % NXCD, xcd = wgid % NXCD, off = wgid / NXCD; wgid = (xcd < r ? xcd * (q + 1) : r * (q + 1) + (xcd - r) * q) + off; }
        const int nig = WGM * nN, gid = wgid / nig, fm = gid * WGM, gsz = (nM - fm) < WGM ? (nM - fm) : WGM;
        u.pm = fm + ((wgid % nig) % gsz); u.pn = (wgid % nig) / gsz; return true;
    }
    __device__ __forceinline__ void a_ready(const Unit&) const {}
    __device__ __forceinline__ void done(const Unit&) const {}
};

typedef float f32x2 __attribute__((ext_vector_type(2)));
typedef __bf16 bf16x2_t __attribute__((ext_vector_type(2)));
typedef _Float16 f16x2_t __attribute__((ext_vector_type(2)));
typedef _Float16 f16x8_t __attribute__((ext_vector_type(8)));
__device__ __forceinline__ unsigned pk_bf16(float lo, float hi) { f32x2 v = {lo, hi}; return __builtin_bit_cast(unsigned, __builtin_convertvector(v, bf16x2_t)); }
__device__ __forceinline__ unsigned pk_f16(float lo, float hi) { f32x2 v = {lo, hi}; return __builtin_bit_cast(unsigned, __builtin_convertvector(v, f16x2_t)); }
__device__ __forceinline__ float bf_lo(unsigned w) { return __builtin_bit_cast(float, w << 16); }
__device__ __forceinline__ float bf_hi(unsigned w) { return __builtin_bit_cast(float, w & 0xffff0000u); }
template <bool F16> __device__ __forceinline__ f32x4 mma16(bf16x8 a, bf16x8 b, f32x4 c) {
    if constexpr (F16) return __builtin_amdgcn_mfma_f32_16x16x32_f16(__builtin_bit_cast(f16x8_t, a), __builtin_bit_cast(f16x8_t, b), c, 0, 0, 0);
    else return __builtin_amdgcn_mfma_f32_16x16x32_bf16(a, b, c, 0, 0, 0);
}
constexpr int F8_WSHIFT = 6;
#ifndef F8_SCALE_ARG
#define F8_SCALE_ARG 0
#endif
typedef int i32x4_t __attribute__((ext_vector_type(4)));
typedef int i32x8_t __attribute__((ext_vector_type(8)));
__device__ __forceinline__ f32x4 mma8(bf16x8 a0, bf16x8 a1, bf16x8 b0, bf16x8 b1, f32x4 c) {
    const i32x8_t A = __builtin_shufflevector(__builtin_bit_cast(i32x4_t, a0), __builtin_bit_cast(i32x4_t, a1), 0, 1, 2, 3, 4, 5, 6, 7);
    const i32x8_t B = __builtin_shufflevector(__builtin_bit_cast(i32x4_t, b0), __builtin_bit_cast(i32x4_t, b1), 0, 1, 2, 3, 4, 5, 6, 7);
    asm volatile("v_mfma_f32_16x16x128_f8f6f4 %0, %1, %2, %0" : "+v"(c) : "v"(A), "v"(B));
    return c;
}
__device__ __forceinline__ unsigned long long pack8_fp8(const f32x4 a, const f32x4 b) {
    int w0 = __builtin_amdgcn_cvt_pk_fp8_f32(a[0], a[1], 0, false); w0 = __builtin_amdgcn_cvt_pk_fp8_f32(a[2], a[3], w0, true);
    int w1 = __builtin_amdgcn_cvt_pk_fp8_f32(b[0], b[1], 0, false); w1 = __builtin_amdgcn_cvt_pk_fp8_f32(b[2], b[3], w1, true);
    return (unsigned long long)(unsigned)w0 | ((unsigned long long)(unsigned)w1 << 32);
}
__device__ __forceinline__ float gelu_tanh(float x) { const float y = x * (-2.3022081981f - 0.1029432396f * (x * x)); return x * __builtin_amdgcn_rcpf(1.f + __builtin_amdgcn_exp2f(y)); }
__device__ __forceinline__ float sigmoidf_(float x) { return __builtin_amdgcn_rcpf(1.f + __builtin_amdgcn_exp2f(-1.4426950409f * x)); }
__device__ __forceinline__ u32x4 pack8_bf16(const f32x4 a, const f32x4 b) { u32x4 w; w.x = pk_bf16(a[0], a[1]); w.y = pk_bf16(a[2], a[3]); w.z = pk_bf16(b[0], b[1]); w.w = pk_bf16(b[2], b[3]); return w; }
__device__ __forceinline__ u32x4 pack8_f16(const f32x4 a, const f32x4 b) { u32x4 w; w.x = pk_f16(a[0], a[1]); w.y = pk_f16(a[2], a[3]); w.z = pk_f16(b[0], b[1]); w.w = pk_f16(b[2], b[3]); return w; }
__device__ __forceinline__ float sq4(const f32x4 a) { return (a[0] * a[0] + a[1] * a[1]) + (a[2] * a[2] + a[3] * a[3]); }

constexpr float QSCALE = 0.125f * 1.4426950408889634f;
struct EpiIn {
    static constexpr bool PERM = true, AFTER_DRAIN = false, MID = false;
    bf16_t *Q, *KV, *U, *VS, *RATIO, *SB; float* SS1; float *outKp, *outVp, *outKs, *outVs;
    __device__ __forceinline__ void operator()(const f32x4 (&acc)[2][2][4][2], const Unit& u, int wr, int wc, int, int) const {
        const int lane_ = lane_id_v(), fr = lane_ & 15, fq = lane_ >> 4;
        const int pn = u.pn, rowb = u.pm * BM + wr * 64 + fr, cl = wc * 32 + 8 * fq;
        if (pn < 4) {
#pragma unroll
            for (int ai = 0; ai < 2; ++ai)
#pragma unroll
                for (int m = 0; m < 4; ++m) { bf16_t* rp = Q + (size_t)(rowb + ai * HALF + m * 16) * 1024 + pn * 256 + cl;
#pragma unroll
                    for (int bj = 0; bj < 2; ++bj) *(u32x4*)(rp + bj * HALF) = pack8_bf16(acc[ai][bj][m][0] * QSCALE, acc[ai][bj][m][1] * QSCALE); }
        } else if (pn == 4) {
#pragma unroll
            for (int ai = 0; ai < 2; ++ai)
#pragma unroll
                for (int m = 0; m < 4; ++m) { bf16_t* rp = KV + (size_t)(rowb + ai * HALF + m * 16) * 256 + cl;
#pragma unroll
                    for (int bj = 0; bj < 2; ++bj) *(u32x4*)(rp + bj * HALF) = pack8_bf16(acc[ai][bj][m][0], acc[ai][bj][m][1]); }
            if (u.pm < 64 && (u.pm & 7) == 7) {
#pragma unroll
                for (int m = 0; m < 4; ++m) { const size_t o = (size_t)((u.pm >> 3) * 128 + wr * 64 + m * 16 + fr) * 128 + cl;
                    __builtin_nontemporal_store(acc[1][0][m][0], (f32x4*)(outKp + o)); __builtin_nontemporal_store(acc[1][0][m][1], (f32x4*)(outKp + o + 4));
                    __builtin_nontemporal_store(acc[1][1][m][0], (f32x4*)(outVp + o)); __builtin_nontemporal_store(acc[1][1][m][1], (f32x4*)(outVp + o + 4)); }
            }
            if (u.pm == 64) {
#pragma unroll
                for (int m = 0; m < 4; ++m) { const size_t o = (size_t)(wr * 64 + m * 16 + fr) * 128 + cl;
                    __builtin_nontemporal_store(acc[0][0][m][0], (f32x4*)(outKs + o)); __builtin_nontemporal_store(acc[0][0][m][1], (f32x4*)(outKs + o + 4));
                    __builtin_nontemporal_store(acc[0][1][m][0], (f32x4*)(outVs + o)); __builtin_nontemporal_store(acc[0][1][m][1], (f32x4*)(outVs + o + 4)); }
            }
        } else if (pn < 13) {
            const bool isv = pn >= 9; bf16_t* base = isv ? VS : U; const int ct = (isv ? pn - 9 : pn - 5) * 256 + cl;
#pragma unroll
            for (int ai = 0; ai < 2; ++ai)
#pragma unroll
                for (int m = 0; m < 4; ++m) { const int row = rowb + ai * HALF + m * 16; bf16_t* rp = base + (size_t)row * 1024 + ct; float s = 0.f;
#pragma unroll
                    for (int bj = 0; bj < 2; ++bj) { f32x4 a = acc[ai][bj][m][0], b = acc[ai][bj][m][1];
#pragma unroll
                        for (int e = 0; e < 4; ++e) { a[e] = gelu_tanh(a[e]); b[e] = gelu_tanh(b[e]); }
                        s += sq4(a) + sq4(b); *(u32x4*)(rp + bj * HALF) = pack8_bf16(a, b); }
                    if (isv) { s += __shfl_xor(s, 16); s += __shfl_xor(s, 32); if (fq == 0) SS1[(size_t)row * 16 + (pn - 9) * 4 + wc] = s; } }
        } else {
            const int ct = (pn - 13) * 128 + cl;
#pragma unroll
            for (int ai = 0; ai < 2; ++ai)
#pragma unroll
                for (int m = 0; m < 4; ++m) { const size_t o = (size_t)(rowb + ai * HALF + m * 16) * 2048 + ct; f32x4 ra, rb, sa, sb2;
#pragma unroll
                    for (int e = 0; e < 4; ++e) {
                        const float eb0 = 1.f + __builtin_amdgcn_exp2f(-1.4426950409f * acc[ai][1][m][0][e]), eb1 = 1.f + __builtin_amdgcn_exp2f(-1.4426950409f * acc[ai][1][m][1][e]);
                        const float ea0 = 1.f + __builtin_amdgcn_exp2f(-1.4426950409f * acc[ai][0][m][0][e]), ea1 = 1.f + __builtin_amdgcn_exp2f(-1.4426950409f * acc[ai][0][m][1][e]);
                        sa[e] = __builtin_amdgcn_rcpf(eb0); sb2[e] = __builtin_amdgcn_rcpf(eb1); ra[e] = eb0 * __builtin_amdgcn_rcpf(ea0); rb[e] = eb1 * __builtin_amdgcn_rcpf(ea1); }
                    *(u32x4*)(RATIO + o) = pack8_bf16(ra, rb); *(u32x4*)(SB + o) = pack8_bf16(sa, sb2); }
        }
    }
};
struct EpiMerge {
    static constexpr bool PERM = true, AFTER_DRAIN = false, MID = true;
    const bf16_t *RATIO, *SB; bf16_t* H;
    __device__ __forceinline__ void mid(f32x4 (&acc)[2][2][4][2], const Unit& u, int wr, int wc, int, int) const {
        const int lane_ = lane_id_v(), fr = lane_ & 15, fq = lane_ >> 4;
        const int rowb = u.pm * BM + wr * 64 + fr, col = u.pn * 256 + wc * 32 + 8 * fq;
        u32x4 w[2][4][2];
#pragma unroll
        for (int ai = 0; ai < 2; ++ai)
#pragma unroll
            for (int m = 0; m < 4; ++m)
#pragma unroll
                for (int bj = 0; bj < 2; ++bj) w[ai][m][bj] = __builtin_nontemporal_load((const u32x4*)(RATIO + (size_t)(rowb + ai * HALF + m * 16) * 2048 + col + bj * HALF));
        asm volatile("" ::: "memory");
#pragma unroll
        for (int ai = 0; ai < 2; ++ai)
#pragma unroll
            for (int m = 0; m < 4; ++m)
#pragma unroll
                for (int bj = 0; bj < 2; ++bj) { const u32x4 v = w[ai][m][bj];
                    acc[ai][bj][m][0] *= (f32x4){bf_lo(v.x), bf_hi(v.x), bf_lo(v.y), bf_hi(v.y)}; acc[ai][bj][m][1] *= (f32x4){bf_lo(v.z), bf_hi(v.z), bf_lo(v.w), bf_hi(v.w)}; }
        asm volatile("" ::: "memory");
    }
    __device__ __forceinline__ void operator()(const f32x4 (&acc)[2][2][4][2], const Unit& u, int wr, int wc, int, int) const {
        const int lane_ = lane_id_v(), fr = lane_ & 15, fq = lane_ >> 4;
        const int rowb = u.pm * BM + wr * 64 + fr, col = u.pn * 256 + wc * 32 + 8 * fq;
        u32x4 w[2][4][2];
#pragma unroll
        for (int ai = 0; ai < 2; ++ai)
#pragma unroll
            for (int m = 0; m < 4; ++m)
#pragma unroll
                for (int bj = 0; bj < 2; ++bj) w[ai][m][bj] = __builtin_nontemporal_load((const u32x4*)(SB + (size_t)(rowb + ai * HALF + m * 16) * 2048 + col + bj * HALF));
        asm volatile("" ::: "memory");
#pragma unroll
        for (int ai = 0; ai < 2; ++ai) {
#pragma unroll
            for (int m = 0; m < 4; ++m)
#pragma unroll
                for (int bj = 0; bj < 2; ++bj) { const size_t o = (size_t)(rowb + ai * HALF + m * 16) * 2048 + col + bj * HALF; const u32x4 v = w[ai][m][bj];
                    *(u32x4*)(H + o) = pack8_bf16(acc[ai][bj][m][0] * (f32x4){bf_lo(v.x), bf_hi(v.x), bf_lo(v.y), bf_hi(v.y)}, acc[ai][bj][m][1] * (f32x4){bf_lo(v.z), bf_hi(v.z), bf_lo(v.w), bf_hi(v.w)}); }
            asm volatile("" ::: "memory");
        }
    }
};
#ifndef EPI_OUT_ROWS
#define EPI_OUT_ROWS 4
#endif
struct EpiOut {
    static constexpr bool PERM = true, AFTER_DRAIN = false, MID = false;
    const float *xp, *xs; bf16_t* XH; float* SS2; unsigned char* XH8;
    __device__ __forceinline__ void operator()(const f32x4 (&acc)[2][2][4][2], const Unit& u, int wr, int wc, int, int) const {
        const int lane_ = lane_id_v(), fr = lane_ & 15, fq = lane_ >> 4;
        const int rowb = u.pm * BM + wr * 64 + fr, col = u.pn * 256 + wc * 32 + 8 * fq;
#pragma unroll
        for (int ai = 0; ai < 2; ++ai)
#pragma unroll
            for (int mp = 0; mp < 4; mp += EPI_OUT_ROWS) {
                f32x4 xv[EPI_OUT_ROWS][2][2];
#pragma unroll
                for (int mm = 0; mm < EPI_OUT_ROWS; ++mm) { const int row = rowb + ai * HALF + (mp + mm) * 16; const float* xr = row < 16384 ? xp + (size_t)row * 2048 : (row < 16512 ? xs + (size_t)(row - 16384) * 2048 : nullptr);
#pragma unroll
                    for (int bj = 0; bj < 2; ++bj) { if (xr) { xv[mm][bj][0] = __builtin_nontemporal_load((const f32x4*)(xr + col + bj * HALF)); xv[mm][bj][1] = __builtin_nontemporal_load((const f32x4*)(xr + col + bj * HALF + 4)); } else { xv[mm][bj][0] = (f32x4){0.f, 0.f, 0.f, 0.f}; xv[mm][bj][1] = (f32x4){0.f, 0.f, 0.f, 0.f}; } } }
                asm volatile("" ::: "memory");
#pragma unroll
                for (int mm = 0; mm < EPI_OUT_ROWS; ++mm) { const int m = mp + mm, row = rowb + ai * HALF + m * 16; float s = 0.f;
#pragma unroll
                    for (int bj = 0; bj < 2; ++bj) { const f32x4 a = acc[ai][bj][m][0] + xv[mm][bj][0], b = acc[ai][bj][m][1] + xv[mm][bj][1];
                        s += sq4(a) + sq4(b); *(u32x4*)(XH + (size_t)row * 2048 + col + bj * HALF) = pack8_f16(a, b);
                        if (row < 16384) *(unsigned long long*)(XH8 + (size_t)row * 2048 + col + bj * HALF) = pack8_fp8(a, b); }
                    s += __shfl_xor(s, 16); s += __shfl_xor(s, 32); if (fq == 0) SS2[(size_t)row * 32 + u.pn * 4 + wc] = s; }
                asm volatile("" ::: "memory");
            }
    }
};
struct EpiQ {
    static constexpr bool PERM = true, AFTER_DRAIN = false, MID = false;
    bf16_t* QP; float sc;
    __device__ __forceinline__ void operator()(const f32x4 (&acc)[2][2][4][2], const Unit& u, int wr, int wc, int, int) const {
        const int lane_ = lane_id_v(), fr = lane_ & 15, fq = lane_ >> 4;
        const int rowb = u.pm * BM + wr * 64 + fr, col = u.pn * 256 + wc * 32 + 8 * fq;
#pragma unroll
        for (int ai = 0; ai < 2; ++ai)
#pragma unroll
            for (int m = 0; m < 4; ++m)
#pragma unroll
                for (int bj = 0; bj < 2; ++bj) *(u32x4*)(QP + (size_t)(rowb + ai * HALF + m * 16) * 2048 + col + bj * HALF) = pack8_f16(acc[ai][bj][m][0] * sc, acc[ai][bj][m][1] * sc);
    }
};
template <class Epi, class Sched, bool ALIGN_EPI = false, bool SP2 = false, bool F16 = false, bool F8 = false>
__device__ __forceinline__ void gemm_phase(PG8_LAS unsigned char* lds, const Gemm g, const Sched& S, const Epi& E, const int wid_in) {
    const int lane = lane_id_v(), wid = wid_in, tid = wid * 64 + lane, wr = wid >> 2, wc = wid & 3, fr = lane & 15, fq = lane >> 4;
    const int K = g.K, nt = K / BK;
    unsigned voffA[2], voffB[2];
#pragma unroll
    for (int i = 0; i < 2; ++i) { int R, C; stage_rc(tid * 16 + i * 8192, R, C); const int Rb = Epi::PERM ? ((R & ~31) + perm32(R & 31)) : R;
        voffA[i] = (unsigned)(R * K + C) * 2u; voffB[i] = (unsigned)(Rb * K + C) * 2u; }
    const size_t kstep = (size_t)(BK * 2);
    const size_t hstep = (size_t)HALF * K * 2;
    const size_t tstep = 2 * hstep;
    const unsigned ldsw = (unsigned)wid * 1024u;
    const int aoff = lds_byte(wr * 64 + fr, fq * 8), boff = lds_byte(wc * 32 + fr, fq * 8);
#define PG8_SA(b, h) (((b) * 2 + (h)) * HTB)
#define PG8_SB(b, h) ((4 + (b) * 2 + (h)) * HTB)
#define PG8_STAGE(bufoff, gbase, voff) do { _Pragma("unroll") for (int _i = 0; _i < 2; ++_i) \
        __builtin_amdgcn_global_load_lds((const unsigned*)((const char*)(gbase) + (voff)[_i]), (PG8_LAS unsigned*)(lds + (bufoff) + ldsw + _i * 8192), 16, 0, 0); } while (0)
#define PG8_LDA(dst, b, h) do { _Pragma("unroll") for (int m = 0; m < 4; ++m) _Pragma("unroll") for (int k = 0; k < 2; ++k) dst[m][k] = *(const PG8_LAS bf16x8*)(lds + PG8_SA(b, h) + aoff + m * 2048 + k * 1024); } while (0)
#define PG8_LDB(dst, b, h) do { _Pragma("unroll") for (int n = 0; n < 2; ++n) _Pragma("unroll") for (int k = 0; k < 2; ++k) dst[n][k] = *(const PG8_LAS bf16x8*)(lds + PG8_SB(b, h) + boff + n * 2048 + k * 1024); } while (0)
#define PG8_MMA(ai, bj, At, Bt) do { __builtin_amdgcn_s_setprio(1); _Pragma("unroll") for (int m = 0; m < 4; ++m) _Pragma("unroll") for (int n = 0; n < 2; ++n) { \
        if constexpr (F8) acc[ai][bj][m][n] = mma8(Bt[n][0], Bt[n][1], At[m][0], At[m][1], acc[ai][bj][m][n]); \
        else { _Pragma("unroll") for (int k = 0; k < 2; ++k) acc[ai][bj][m][n] = mma16<F16>(Bt[n][k], At[m][k], acc[ai][bj][m][n]); } } __builtin_amdgcn_s_setprio(0); } while (0)
#define PG8_WAIT_V(n) asm volatile("s_waitcnt vmcnt(" #n ")" ::: "memory")
#define PG8_WAIT_L(n) asm volatile("s_waitcnt lgkmcnt(" #n ")" ::: "memory")
#define PG8_BAR __builtin_amdgcn_s_barrier()
#define PG8_SCHED __builtin_amdgcn_sched_barrier(0)
    Unit cur, nxt; int ui = 0;
    if (!S.next(0, cur)) return;
    f32x4 acc[2][2][4][2];
#pragma unroll
    for (int a = 0; a < 2; ++a)
#pragma unroll
        for (int b = 0; b < 2; ++b)
#pragma unroll
            for (int m = 0; m < 4; ++m)
#pragma unroll
                for (int n = 0; n < 2; ++n) acc[a][b][m][n] = (f32x4){0.f, 0.f, 0.f, 0.f};
    bf16x8 At[4][2], B0[2][2], B1[2][2];
    const char* cA = (const char*)g.A + (size_t)cur.pm * tstep; const char* cB = (const char*)g.Bt + (size_t)cur.pn * tstep;
    S.a_ready(cur);
    if constexpr (SP2) {
        PG8_STAGE(PG8_SB(0, 0), cB, voffB); PG8_STAGE(PG8_SB(0, 1), cB + hstep, voffB); PG8_STAGE(PG8_SA(0, 0), cA, voffA); PG8_STAGE(PG8_SA(0, 1), cA + hstep, voffA);
        if (wr == 1) PG8_BAR;
        PG8_WAIT_V(2); PG8_BAR;
        PG8_STAGE(PG8_SB(1, 0), cB + kstep, voffB); PG8_STAGE(PG8_SA(1, 0), cA + kstep, voffA); PG8_STAGE(PG8_SB(1, 1), cB + hstep + kstep, voffB);
        PG8_WAIT_V(6); PG8_BAR;
    } else {
        PG8_STAGE(PG8_SB(0, 0), cB, voffB); PG8_STAGE(PG8_SA(0, 0), cA, voffA); PG8_STAGE(PG8_SB(0, 1), cB + hstep, voffB); PG8_STAGE(PG8_SA(0, 1), cA + hstep, voffA);
        if (wr == 1) PG8_BAR;
        PG8_WAIT_V(4); PG8_BAR;
        PG8_STAGE(PG8_SB(1, 0), cB + kstep, voffB); PG8_STAGE(PG8_SA(1, 0), cA + kstep, voffA); PG8_STAGE(PG8_SB(1, 1), cB + hstep + kstep, voffB);
        PG8_WAIT_V(6); PG8_BAR;
    }
    for (;;) {
        const bool has_next = S.next(ui + 1, nxt);
        const char* nA = has_next ? (const char*)g.A + (size_t)nxt.pm * tstep : cA; const char* nB = has_next ? (const char*)g.Bt + (size_t)nxt.pn * tstep : cB;
        for (int t = 0; t < nt; t += 2) {
            const bool last = (t == nt - 2);
            const char* a1 = cA + (size_t)(t + 1) * kstep;
            const char* a2 = last ? nA : cA + (size_t)(t + 2) * kstep; const char* b2 = last ? nB : cB + (size_t)(t + 2) * kstep;
            const char* a3 = a2 + kstep; const char* b3 = b2 + kstep;
            if (last && has_next) S.a_ready(nxt);
            if constexpr (Epi::MID) { if (t == (nt >> 1)) E.mid(acc, cur, wr, wc, fr, fq); }
            if constexpr (SP2) {
            PG8_LDB(B0, 0, 0); PG8_LDB(B1, 0, 1); PG8_SCHED; PG8_LDA(At, 0, 0); PG8_STAGE(PG8_SA(1, 1), a1 + hstep, voffA);
            PG8_WAIT_V(8); PG8_WAIT_L(0); PG8_BAR; PG8_MMA(0, 0, At, B0); PG8_MMA(0, 1, At, B1); PG8_BAR; PG8_SCHED;
            PG8_LDA(At, 0, 1); PG8_STAGE(PG8_SB(0, 0), b2, voffB); PG8_STAGE(PG8_SB(0, 1), b2 + hstep, voffB); PG8_STAGE(PG8_SA(0, 0), a2, voffA);
            PG8_WAIT_V(8); PG8_WAIT_L(0); PG8_BAR; PG8_MMA(1, 0, At, B0); PG8_MMA(1, 1, At, B1); PG8_BAR; PG8_SCHED;
            PG8_LDB(B0, 1, 0); PG8_LDB(B1, 1, 1); PG8_SCHED; PG8_LDA(At, 1, 0); PG8_STAGE(PG8_SA(0, 1), a2 + hstep, voffA);
            PG8_WAIT_V(8); PG8_WAIT_L(0); PG8_BAR; PG8_MMA(0, 0, At, B0); PG8_MMA(0, 1, At, B1); PG8_BAR; PG8_SCHED;
            PG8_LDA(At, 1, 1); PG8_STAGE(PG8_SB(1, 0), b3, voffB); PG8_STAGE(PG8_SB(1, 1), b3 + hstep, voffB); PG8_STAGE(PG8_SA(1, 0), a3, voffA);
            PG8_WAIT_V(8); PG8_WAIT_L(0); PG8_BAR; PG8_MMA(1, 0, At, B0); PG8_MMA(1, 1, At, B1); PG8_BAR; PG8_SCHED;
            } else {
            PG8_LDB(B0, 0, 0); PG8_SCHED; PG8_LDA(At, 0, 0); PG8_STAGE(PG8_SA(1, 1), a1 + hstep, voffA);
            PG8_WAIT_L(8); PG8_BAR; PG8_WAIT_L(0); PG8_MMA(0, 0, At, B0); PG8_BAR; PG8_SCHED;
            PG8_LDB(B1, 0, 1); PG8_STAGE(PG8_SB(0, 0), b2, voffB);
            PG8_BAR; PG8_WAIT_L(0); PG8_MMA(0, 1, At, B1); PG8_BAR;
            PG8_LDA(At, 0, 1); PG8_STAGE(PG8_SA(0, 0), a2, voffA);
            PG8_BAR; PG8_WAIT_L(0); PG8_MMA(1, 0, At, B0); PG8_BAR; PG8_SCHED;
            PG8_STAGE(PG8_SB(0, 1), b2 + hstep, voffB);
            PG8_WAIT_V(6); PG8_BAR; PG8_MMA(1, 1, At, B1); PG8_BAR;
            PG8_LDB(B0, 1, 0); PG8_SCHED; PG8_LDA(At, 1, 0); PG8_STAGE(PG8_SA(0, 1), a2 + hstep, voffA);
            PG8_WAIT_L(8); PG8_BAR; PG8_WAIT_L(0); PG8_MMA(0, 0, At, B0); PG8_BAR; PG8_SCHED;
            PG8_LDB(B1, 1, 1); PG8_STAGE(PG8_SB(1, 0), b3, voffB);
            PG8_BAR; PG8_WAIT_L(0); PG8_MMA(0, 1, At, B1); PG8_BAR;
            PG8_LDA(At, 1, 1); PG8_STAGE(PG8_SA(1, 0), a3, voffA);
            PG8_BAR; PG8_WAIT_L(0); PG8_MMA(1, 0, At, B0); PG8_BAR; PG8_SCHED;
            PG8_STAGE(PG8_SB(1, 1), b3 + hstep, voffB);
            PG8_WAIT_V(6); PG8_BAR; PG8_MMA(1, 1, At, B1); PG8_BAR;
            }
        }
        if constexpr (F8) asm volatile("s_nop 15\n\ts_nop 15" ::: "memory");
        if constexpr (ALIGN_EPI) { if (wr == 0) PG8_BAR; }
        if constexpr (!Epi::AFTER_DRAIN) { E(acc, cur, wr, wc, fr, fq); S.done(cur); }
        if (!has_next) break;
#pragma unroll
        for (int a = 0; a < 2; ++a)
#pragma unroll
            for (int b = 0; b < 2; ++b)
#pragma unroll
                for (int m = 0; m < 4; ++m)
#pragma unroll
                    for (int n = 0; n < 2; ++n) acc[a][b][m][n] = (f32x4){0.f, 0.f, 0.f, 0.f};
        cur = nxt; cA = nA; cB = nB; ++ui;
        if constexpr (ALIGN_EPI) { if (wr == 1) PG8_BAR; }
    }
    PG8_WAIT_V(0);
    if constexpr (!ALIGN_EPI) { if (wr == 0) PG8_BAR; }
    PG8_BAR;
    if constexpr (Epi::AFTER_DRAIN) { E.fused(acc, cur, wr, wc, fr, fq, lds, wid, lane); S.done(cur); }
#undef PG8_SA
#undef PG8_SB
#undef PG8_STAGE
#undef PG8_LDA
#undef PG8_LDB
#undef PG8_MMA
#undef PG8_WAIT_V
#undef PG8_WAIT_L
#undef PG8_BAR
#undef PG8_SCHED
}
}
#define GAS __attribute__((address_space(1)))
#define LAS __attribute__((address_space(3)))
typedef unsigned short bf16;
typedef unsigned v4u __attribute__((ext_vector_type(4)));
typedef float f32x4 __attribute__((ext_vector_type(4)));
typedef short bf16x8 __attribute__((ext_vector_type(8)));
typedef GAS unsigned gu32;
typedef GAS unsigned long long gu64;
#define RLX_AGENT __ATOMIC_RELAXED, __HIP_MEMORY_SCOPE_AGENT
#define LDS_WAIT() asm volatile("s_waitcnt lgkmcnt(0)" ::: "memory")
#define VM_WAIT() asm volatile("s_waitcnt vmcnt(0)" ::: "memory")
__device__ __forceinline__ unsigned long long rt() { return __builtin_amdgcn_s_memrealtime(); }
__device__ __forceinline__ unsigned f2bf(float f) { unsigned u = __builtin_bit_cast(unsigned, f); return (u + 0x7fffu + ((u >> 16) & 1u)) >> 16; }
__device__ __forceinline__ unsigned pk2(float lo, float hi) { return f2bf(lo) | (f2bf(hi) << 16); }

#define XB_TMO      128
#define XB_XCNT(j)  (256  + 64 * (j))
#define XB_XSUB(j)  (1280 + 64 * (j))
#define XB_XGEN(j)  (2304 + 64 * (j))
#define XB_TOP      3328
#define XB_TOPGEN   3392
#define XCD_BAR_WORDS 3456
#ifdef DEBUG_ORACLE
#define XB_SPIN_CAP (1u << 27)
#else
#define XB_SPIN_CAP (1u << 18)
#endif

__device__ __forceinline__ unsigned xb_ld(unsigned* p)              { return __hip_atomic_load(p, __ATOMIC_RELAXED, __HIP_MEMORY_SCOPE_AGENT); }
__device__ __forceinline__ unsigned xb_add(unsigned* p, unsigned v) { return __hip_atomic_fetch_add(p, v, __ATOMIC_RELAXED, __HIP_MEMORY_SCOPE_AGENT); }
__device__ __forceinline__ unsigned xb_xcc_id() { return (unsigned)__builtin_amdgcn_s_getreg((3 << 11) | 20) & 0xFu; }
#define XB_SPIN(cond, bar) do { unsigned _sp = 0; while (cond) { __builtin_amdgcn_s_sleep(1); \
    if ((++_sp & 255u) == 0u) { if (xb_ld(&(bar)[XB_TMO])) break; if (_sp > XB_SPIN_CAP) { atomicAdd(&(bar)[XB_TMO], 1u); break; } } } } while (0)

struct XcdBarrier {
    unsigned* bar; unsigned x;
    volatile LAS unsigned* st;
};

__device__ __forceinline__ XcdBarrier xcd_barrier_post(unsigned* bar, volatile LAS unsigned* st) {
    XcdBarrier b; b.bar = bar; b.x = xb_xcc_id(); b.st = st;
    if (threadIdx.x == 0) (void)xb_add(&bar[XB_XCNT(b.x)], 1u);
    return b;
}
__device__ __forceinline__ void xcd_barrier_complete(unsigned* bar, unsigned x, unsigned& nloc, unsigned& nx) {
    const unsigned G = gridDim.x * gridDim.y * gridDim.z;
    unsigned sum, cnt, mine, sp = 0u;
    for (;;) {
        sum = 0u; cnt = 0u; mine = 0u;
#pragma unroll
        for (unsigned j = 0; j < 16; ++j) { const unsigned c = xb_ld(&bar[XB_XCNT(j)]); sum += c; cnt += (c > 0u) ? 1u : 0u; mine = (j == x) ? c : mine; }
        if (sum == G) break;
        __builtin_amdgcn_s_sleep(1);
        if ((++sp & 255u) == 0u) { if (xb_ld(&bar[XB_TMO])) break; if (sp > XB_SPIN_CAP) { atomicAdd(&bar[XB_TMO], 1u); break; } }
    }
    nloc = mine > 0u ? mine : 1u; nx = cnt > 0u ? cnt : 1u;
}

__device__ __forceinline__ void xcd_barrier(const XcdBarrier& b) {
    asm volatile("s_waitcnt vmcnt(0)" ::: "memory");
    __syncthreads();
    if (threadIdx.x == 0) {
        unsigned* bar = b.bar;
        __builtin_amdgcn_s_waitcnt(0);
        unsigned nloc = b.st[0], nx = b.st[1];
        if (nloc == 0u) { xcd_barrier_complete(bar, b.x, nloc, nx); b.st[0] = nloc; b.st[1] = nx; }
        const unsigned old = xb_add(&bar[XB_XSUB(b.x)], 1u);
        const unsigned gen = old / nloc;
        if (old + 1u == (gen + 1u) * nloc) {
            __builtin_amdgcn_fence(__ATOMIC_RELEASE, "agent");
            asm volatile("s_waitcnt vmcnt(0)" ::: "memory");
            const unsigned og = xb_add(&bar[XB_TOP], 1u);
            const unsigned tg = og / nx;
            if (og + 1u == (tg + 1u) * nx) xb_add(&bar[XB_TOPGEN], 1u);
            else XB_SPIN(xb_ld(&bar[XB_TOPGEN]) == tg, bar);
            __builtin_amdgcn_fence(__ATOMIC_ACQUIRE, "agent");
            xb_add(&bar[XB_XGEN(b.x)], 1u);
            asm volatile("s_waitcnt vmcnt(0)" ::: "memory");
        } else {
            XB_SPIN(xb_ld(&bar[XB_XGEN(b.x)]) == gen, bar);
            __builtin_amdgcn_fence(__ATOMIC_ACQUIRE, "agent");
            asm volatile("s_waitcnt vmcnt(0)" ::: "memory");
        }
    }
    __syncthreads();
}
constexpr int NWAVES = 8, NTHR = 512;
constexpr int DM = 2048, SEQ = 2048, NBATCH = 8, TDEC = 16, MPROMPT = NBATCH * SEQ  , MSAMPLE = NBATCH * TDEC  , MREAL = MPROMPT + MSAMPLE  , MPAD = 16640  ;
constexpr int DIN = 7424, DATTN = 1024, DSGU = 1024, WINDOW = 128, CHUNK = 64, NHEADS = 16, HD = 64;
constexpr int NEXP = 16384, PEER_H = 8, PEER_K = 16;
#ifndef PEER_FP4
#define PEER_FP4 1
#endif
#ifndef PEER_FP6
#define PEER_FP6 (!PEER_FP4)
#endif
constexpr float PEER_SU = 64.f, PEER_SV = 16.f;
constexpr float EPS = 1e-6f, LOG2E = 1.4426950408889634f;
constexpr size_t OUT_Y = 0, OUT_KP = (size_t)MREAL * DM, OUT_VP = OUT_KP + 131072, OUT_KS = OUT_VP + 131072, OUT_VS = OUT_KS + 16384, OUT_SGU = OUT_VS + 16384, OUT_TOTAL = OUT_SGU + 131072;
constexpr size_t MiB = 1u << 20;
constexpr size_t WS_CTL = 0, CTL_ZERO_BYTES = 64 * 1024;
constexpr size_t WS_WIN = 1 * MiB;
constexpr size_t WS_WAB = 30 * MiB;
constexpr size_t WS_WOUT = 38 * MiB;
constexpr size_t WS_WQ = 46 * MiB;
constexpr size_t WS_KEYS = 54 * MiB;
constexpr size_t WS_WSM = 54 * MiB + 512 * 1024;
constexpr size_t WS_SS1 = 55 * MiB;
constexpr size_t WS_SS2 = 57 * MiB;
constexpr size_t WS_EU = 60 * MiB, WS_EV = 124 * MiB;
constexpr size_t WS_WQ8 = 128 * MiB, WS_XH8 = 132 * MiB;
constexpr size_t WS_RA = 188 * MiB;
constexpr size_t WS_RB = 253 * MiB;
constexpr size_t WS_Q = WS_RB, WS_KV = WS_Q + (size_t)MPAD * 1024 * 2, WS_U = WS_KV + (size_t)MPAD * 256 * 2, WS_VS = WS_U + (size_t)MPAD * 1024 * 2;
constexpr size_t WS_RC = 359 * MiB;
constexpr size_t WS_RATIO = WS_RC, WS_SB = WS_RC + 65 * MiB, WS_END = WS_RC + 130 * MiB;
static_assert(WS_VS + (size_t)MPAD * 1024 * 2 <= WS_RC && WS_END == 489 * MiB, "d_ws map");
constexpr int CW_BAR = 4096;
constexpr int RING_OFF = 0, RING_BYTES = 131072;
constexpr int LDSCTL_OFF = RING_BYTES, MISC_OFF = LDSCTL_OFF + 320;
constexpr int LDS_BYTES = 147456;
struct Frame {
    LAS unsigned char* lds; volatile LAS unsigned* MISC; gu32* ctl;
    int wave, vcu, G;
    const float *x_prompt, *x_sample, *cache_k, *cache_v, *norm_mix_g, *w_in, *sgu_norm_g, *sgu_w_s, *sgu_b_s, *sinks, *rel_tab, *w_pa, *w_pb, *w_out, *norm_ffn_g, *w_query, *sub_keys, *exp_u, *exp_v, *norm_final_g;
    float* out; unsigned char* ws;
};
__device__ __forceinline__ float wave_sum(float v) {
#pragma unroll
    for (int o = 1; o < 64; o <<= 1) v += __shfl_xor(v, o);
    return v;
}
__device__ __forceinline__ unsigned pkb(float lo, float hi) { return pg8::pk_bf16(lo, hi); }
__device__ __forceinline__ unsigned pkh(float lo, float hi) { return pg8::pk_f16(lo, hi); }
template <bool F16>
__device__ __forceinline__ void p0_transpose_item(const float* W, int N, bf16* WT, int kpitch, int koff, int drow0, int k0, int n0, const float* kscale, LAS float* scr, int lane, unsigned char* WT8 = nullptr) {
    float wv[32];
#pragma unroll
    for (int i = 0; i < 32; ++i) { const int kk = 2 * i + (lane >> 5); wv[i] = __builtin_nontemporal_load(W + (size_t)(k0 + kk) * N + n0 + (lane & 31)); }
#pragma unroll
    for (int i = 0; i < 32; ++i) { const int kk = 2 * i + (lane >> 5); scr[kk * 33 + (lane & 31)] = wv[i]; }
    LDS_WAIT(); asm volatile("" ::: "memory");
    const int c = lane & 7;
    float sc[8];
#pragma unroll
    for (int q = 0; q < 8; ++q) sc[q] = kscale ? kscale[k0 + 8 * c + q] : 1.f;
#pragma unroll
    for (int j = 0; j < 4; ++j) { const int n = (lane >> 3) + 8 * j; const LAS float* s = scr + (8 * c) * 33 + n;
        float v[8];
#pragma unroll
        for (int q = 0; q < 8; ++q) v[q] = s[q * 33] * sc[q];
        v4u o;
        if (F16) { o.x = pkh(v[0], v[1]); o.y = pkh(v[2], v[3]); o.z = pkh(v[4], v[5]); o.w = pkh(v[6], v[7]); }
        else     { o.x = pkb(v[0], v[1]); o.y = pkb(v[2], v[3]); o.z = pkb(v[4], v[5]); o.w = pkb(v[6], v[7]); }
        *(GAS v4u*)(WT + (size_t)(drow0 + n) * kpitch + koff + k0 + 8 * c) = o;
        if (WT8) { constexpr float WS_ = (float)(1 << pg8::F8_WSHIFT); *(GAS unsigned long long*)(WT8 + (size_t)(drow0 + n) * 2048 + k0 + 8 * c) = pg8::pack8_fp8((f32x4){v[0] * WS_, v[1] * WS_, v[2] * WS_, v[3] * WS_}, (f32x4){v[4] * WS_, v[5] * WS_, v[6] * WS_, v[7] * WS_}); } }
    LDS_WAIT(); asm volatile("" ::: "memory");
}
__device__ __forceinline__ int win_row_of_col(int n) {
    if (n < 3328) return n;
    if (n < 5376) { const int q = n - 3328; return 3328 + (q >> 7) * 256 + (q & 127); }
    const int q = n - 5376; return 3328 + (q >> 7) * 256 + 128 + (q & 127);
}
__device__ __forceinline__ void rms_row_to_bf16(const float* xrow, const float* g, bf16* orow, int lane) {
    const GAS f32x4* xr = (const GAS f32x4*)xrow + lane; const GAS f32x4* gr = (const GAS f32x4*)g + lane;
    f32x4 v[8]; float s = 0.f;
#pragma unroll
    for (int j = 0; j < 8; ++j) { v[j] = xr[64 * j]; s += (v[j].x * v[j].x + v[j].y * v[j].y) + (v[j].z * v[j].z + v[j].w * v[j].w); }
    const float r = 1.0f / sqrtf(wave_sum(s) * (1.f / DM) + EPS);
    GAS unsigned long long* o8 = (GAS unsigned long long*)orow + lane;
#pragma unroll
    for (int j = 0; j < 8; ++j) { const f32x4 gg = gr[64 * j]; o8[64 * j] = (unsigned long long)pkb(v[j].x * r * gg.x, v[j].y * r * gg.y) | ((unsigned long long)pkb(v[j].z * r * gg.z, v[j].w * r * gg.w) << 32); }
}
__device__ __forceinline__ void p0_transposes(Frame& F, int first, int last, int gw, int NGW) {
    const int lane = pg8::lane_id_v();
    LAS float* scr = (LAS float*)(F.lds + RING_OFF + F.wave * 16384);
    bf16* WIN = (bf16*)(F.ws + WS_WIN); bf16* WAB = (bf16*)(F.ws + WS_WAB); bf16* WOUT = (bf16*)(F.ws + WS_WOUT); bf16* WQ = (bf16*)(F.ws + WS_WQ);
    constexpr int I_IN = 32 * 232, I_PA = 16 * 64, I_OUT = 32 * 64;
    for (int it = first + gw; it < last; it += NGW) {
        int r = it;
        if (r < I_IN) { const int kb = r / 232, nb = r % 232; p0_transpose_item<false>(F.w_in, DIN, WIN, 2048, 0, win_row_of_col(32 * nb), 64 * kb, 32 * nb, nullptr, scr, lane); continue; } r -= I_IN;
        if (r < I_PA) { const int kb = r / 64, nb = r % 64; p0_transpose_item<false>(F.w_pa, 2048, WAB, 2048, 0, 32 * nb, 64 * kb, 32 * nb, nullptr, scr, lane); continue; } r -= I_PA;
        if (r < I_PA) { const int kb = r / 64, nb = r % 64; p0_transpose_item<false>(F.w_pb, 2048, WAB, 2048, 1024, 32 * nb, 64 * kb, 32 * nb, nullptr, scr, lane); continue; } r -= I_PA;
        if (r < I_OUT) { const int kb = r / 64, nb = r % 64; p0_transpose_item<false>(F.w_out, 2048, WOUT, 2048, 0, 32 * nb, 64 * kb, 32 * nb, nullptr, scr, lane); continue; } r -= I_OUT;
        { const int kb = r / 64, nb = r % 64; p0_transpose_item<true>(F.w_query, 2048, WQ, 2048, 0, 32 * nb, 64 * kb, 32 * nb, F.norm_ffn_g, scr, lane, F.ws + WS_WQ8); }
    }
}
__device__ __forceinline__ void p0_expert_tables(Frame& F, int rank, int nranks) {
    const int lane = pg8::lane_id_v(), tid = F.wave * 64 + lane;
    const size_t gt = (size_t)rank * NTHR + tid, NT = (size_t)nranks * NTHR;
#if PEER_FP4
    { unsigned char* EU4 = F.ws + WS_EU; float* EUS = (float*)(F.ws + WS_EU + 16 * MiB); unsigned char* EV4 = F.ws + WS_EU + 32 * MiB; float* EVS = (float*)(F.ws + WS_EU + 48 * MiB);
        const int gwv = rank * NWAVES + F.wave, nwv = nranks * NWAVES;
        for (int row = gwv; row < NEXP; row += nwv) { const size_t c = (size_t)row * 64 + lane; float fu[32], fv[32]; float mu = 0.f, mv = 0.f;
#pragma unroll
            for (int q = 0; q < 8; ++q) { const size_t eo = (size_t)row * DM + q * 256 + lane * 4;
                const f32x4 a = __builtin_nontemporal_load((const GAS f32x4*)(F.exp_u + eo)) * *(const GAS f32x4*)(F.norm_ffn_g + q * 256 + lane * 4); const f32x4 p = __builtin_nontemporal_load((const GAS f32x4*)(F.exp_v + eo));
#pragma unroll
                for (int e = 0; e < 4; ++e) { fu[4 * q + e] = a[e]; fv[4 * q + e] = p[e]; mu = fmaxf(mu, fabsf(a[e])); mv = fmaxf(mv, fabsf(p[e])); } }
#pragma unroll
            for (int o = 1; o < 64; o <<= 1) { mu = fmaxf(mu, __shfl_xor(mu, o)); mv = fmaxf(mv, __shfl_xor(mv, o)); }
            const float su = fmaxf(mu, 1e-30f) * (1.0f / 6.0f), sv = fmaxf(mv, 1e-30f) * (1.0f / 6.0f), iu = 1.0f / su, iv = 1.0f / sv;
            v4u wu, wv;
#pragma unroll
            for (int q = 0; q < 4; ++q) { unsigned a = 0u, b2 = 0u;
                a = __builtin_amdgcn_cvt_scalef32_pk_fp4_f32(a, fu[8 * q + 0] * iu, fu[8 * q + 1] * iu, 1.0f, 0); a = __builtin_amdgcn_cvt_scalef32_pk_fp4_f32(a, fu[8 * q + 2] * iu, fu[8 * q + 3] * iu, 1.0f, 1);
                a = __builtin_amdgcn_cvt_scalef32_pk_fp4_f32(a, fu[8 * q + 4] * iu, fu[8 * q + 5] * iu, 1.0f, 2); a = __builtin_amdgcn_cvt_scalef32_pk_fp4_f32(a, fu[8 * q + 6] * iu, fu[8 * q + 7] * iu, 1.0f, 3);
                b2 = __builtin_amdgcn_cvt_scalef32_pk_fp4_f32(b2, fv[8 * q + 0] * iv, fv[8 * q + 1] * iv, 1.0f, 0); b2 = __builtin_amdgcn_cvt_scalef32_pk_fp4_f32(b2, fv[8 * q + 2] * iv, fv[8 * q + 3] * iv, 1.0f, 1);
                b2 = __builtin_amdgcn_cvt_scalef32_pk_fp4_f32(b2, fv[8 * q + 4] * iv, fv[8 * q + 5] * iv, 1.0f, 2); b2 = __builtin_amdgcn_cvt_scalef32_pk_fp4_f32(b2, fv[8 * q + 6] * iv, fv[8 * q + 7] * iv, 1.0f, 3);
                wu[q] = a; wv[q] = b2; }
            __builtin_nontemporal_store(wu, (GAS v4u*)(EU4 + c * 16)); __builtin_nontemporal_store(wv, (GAS v4u*)(EV4 + c * 16)); if (lane == 0) { EUS[row] = su; EVS[row] = sv; } } }
#elif PEER_FP6
    { unsigned char* EU6 = F.ws + WS_EU; unsigned char* EV6 = F.ws + WS_EU + 32 * MiB;
        typedef _Float16 h32v __attribute__((ext_vector_type(32))); typedef unsigned u6v __attribute__((ext_vector_type(6)));
        for (size_t c = gt; c < (size_t)NEXP * 64; c += NT) { const int d0 = (int)((c * 32) & (DM - 1)); h32v hu, hv;
#pragma unroll
            for (int q = 0; q < 8; ++q) { const f32x4 a = *(const GAS f32x4*)(F.exp_u + c * 32 + q * 4) * *(const GAS f32x4*)(F.norm_ffn_g + d0 + q * 4) * PEER_SU; const f32x4 p = *(const GAS f32x4*)(F.exp_v + c * 32 + q * 4) * PEER_SV;
                hu[4 * q] = (_Float16)a.x; hu[4 * q + 1] = (_Float16)a.y; hu[4 * q + 2] = (_Float16)a.z; hu[4 * q + 3] = (_Float16)a.w; hv[4 * q] = (_Float16)p.x; hv[4 * q + 1] = (_Float16)p.y; hv[4 * q + 2] = (_Float16)p.z; hv[4 * q + 3] = (_Float16)p.w; }
            const u6v pu = __builtin_amdgcn_cvt_scalef32_pk32_fp6_f16(hu, 1.0f), pv = __builtin_amdgcn_cvt_scalef32_pk32_fp6_f16(hv, 1.0f);
            typedef unsigned u2v __attribute__((ext_vector_type(2)));
            GAS u2v* du = (GAS u2v*)(EU6 + c * 24); GAS u2v* dv = (GAS u2v*)(EV6 + c * 24);
            du[0] = (u2v){pu[0], pu[1]}; du[1] = (u2v){pu[2], pu[3]}; du[2] = (u2v){pu[4], pu[5]}; dv[0] = (u2v){pv[0], pv[1]}; dv[1] = (u2v){pv[2], pv[3]}; dv[2] = (u2v){pv[4], pv[5]}; } }
#endif
}
#ifndef P0_LATE_W
#define P0_LATE_W 1
#endif
#ifndef P0_PIPE
#define P0_PIPE 1
#endif
__device__ __forceinline__ void p0_prologue(Frame& F) {
    const int lane = pg8::lane_id_v(), tid = F.wave * 64 + lane;
    const int gw = F.vcu * NWAVES + F.wave, NGW = F.G * NWAVES;
#if P0_LATE_W
    p0_transposes(F, 0, 32 * 232, gw, NGW);
#else
    p0_transposes(F, 0, 32 * 232 + 2 * 16 * 64 + 2 * 32 * 64, gw, NGW);
#endif
    bf16* XN = (bf16*)(F.ws + WS_RA);
#if P0_PIPE
    {
        f32x4 v[8], nx[8];
        const GAS f32x4* gr = (const GAS f32x4*)F.norm_mix_g + lane;
        int m = gw;
        if (m < MREAL) { const GAS f32x4* xr = (const GAS f32x4*)((m < MPROMPT) ? F.x_prompt + (size_t)m * DM : F.x_sample + (size_t)(m - MPROMPT) * DM) + lane;
#pragma unroll
            for (int j = 0; j < 8; ++j) v[j] = __builtin_nontemporal_load(xr + 64 * j); }
        for (; m < MPAD; m += NGW) {
            const int mn = m + NGW;
            if (mn < MREAL) { const GAS f32x4* xr = (const GAS f32x4*)((mn < MPROMPT) ? F.x_prompt + (size_t)mn * DM : F.x_sample + (size_t)(mn - MPROMPT) * DM) + lane;
#pragma unroll
                for (int j = 0; j < 8; ++j) nx[j] = __builtin_nontemporal_load(xr + 64 * j); }
            if (m < MREAL) {
                float s = 0.f;
#pragma unroll
                for (int j = 0; j < 8; ++j) s += (v[j].x * v[j].x + v[j].y * v[j].y) + (v[j].z * v[j].z + v[j].w * v[j].w);
                const float r = 1.0f / sqrtf(wave_sum(s) * (1.f / DM) + EPS);
                GAS unsigned long long* o8 = (GAS unsigned long long*)(XN + (size_t)m * DM) + lane;
#pragma unroll
                for (int j = 0; j < 8; ++j) { const f32x4 gg = gr[64 * j]; o8[64 * j] = (unsigned long long)pkb(v[j].x * r * gg.x, v[j].y * r * gg.y) | ((unsigned long long)pkb(v[j].z * r * gg.z, v[j].w * r * gg.w) << 32); }
            } else { GAS v4u* o = (GAS v4u*)(XN + (size_t)m * DM) + lane;
#pragma unroll
                for (int j = 0; j < 4; ++j) o[64 * j] = (v4u){0u, 0u, 0u, 0u}; }
#pragma unroll
            for (int j = 0; j < 8; ++j) v[j] = nx[j];
        }
    }
#else
    for (int m = gw; m < MPAD; m += NGW) {
        if (m < MPROMPT) rms_row_to_bf16(F.x_prompt + (size_t)m * DM, F.norm_mix_g, XN + (size_t)m * DM, lane);
        else if (m < MREAL) rms_row_to_bf16(F.x_sample + (size_t)(m - MPROMPT) * DM, F.norm_mix_g, XN + (size_t)m * DM, lane);
        else { GAS v4u* o = (GAS v4u*)(XN + (size_t)m * DM) + lane;
#pragma unroll
            for (int j = 0; j < 4; ++j) o[64 * j] = (v4u){0u, 0u, 0u, 0u}; }
    }
#endif
    const size_t gt = (size_t)F.vcu * NTHR + tid, NT = (size_t)F.G * NTHR;
    { bf16* KH = (bf16*)(F.ws + WS_KEYS);
        for (size_t c = gt; c < 262144 / 8; c += NT) { const f32x4 a = *(const GAS f32x4*)(F.sub_keys + c * 8), b = *(const GAS f32x4*)(F.sub_keys + c * 8 + 4);
            *(GAS v4u*)(KH + c * 8) = (v4u){pkh(a.x, a.y), pkh(a.z, a.w), pkh(b.x, b.y), pkh(b.z, b.w)}; } }
    { bf16* WSM = (bf16*)(F.ws + WS_WSM);
        for (size_t c = gt; c < 131072 / 8; c += NT) { f32x4 a = *(const GAS f32x4*)(F.sgu_w_s + c * 8), b = *(const GAS f32x4*)(F.sgu_w_s + c * 8 + 4);
            const int t = (int)((c * 8) >> 7) & 127, s0 = (int)(c * 8) & 127;
#pragma unroll
            for (int e = 0; e < 4; ++e) { if (s0 + e > t) a[e] = 0.f; if (s0 + 4 + e > t) b[e] = 0.f; }
            *(GAS v4u*)(WSM + c * 8) = (v4u){pkb(a.x, a.y), pkb(a.z, a.w), pkb(b.x, b.y), pkb(b.z, b.w)}; } }
}
typedef float f32x16 __attribute__((ext_vector_type(16)));
typedef short s16x4 __attribute__((ext_vector_type(4)));
typedef short v4i16_t __attribute__((ext_vector_type(4)));
__device__ __forceinline__ int crow(int r, int hi) { return (r & 3) + 8 * (r >> 2) + 4 * hi; }
__device__ __forceinline__ s16x4 vtr(const LAS unsigned char* p) { return __builtin_bit_cast(s16x4, __builtin_amdgcn_ds_read_tr16_b64_v4i16((LAS v4i16_t*)p)); }
__device__ __forceinline__ bf16 bf1(float x) { return (bf16)(pkb(x, 0.f) & 0xffffu); }
__device__ __forceinline__ float bf2f(bf16 b) { return __builtin_bit_cast(float, (unsigned)b << 16); }
__device__ __forceinline__ float half_max(float m) { return fmaxf(m, __builtin_bit_cast(float, pg8::partner32(__builtin_bit_cast(unsigned, m)))); }
__device__ __forceinline__ float half_sum(float m) { return m + __builtin_bit_cast(float, pg8::partner32(__builtin_bit_cast(unsigned, m))); }
constexpr int P2_KL = 0, P2_VL = 24576, P2_BIAS = 49152, P2_OST = 65536, P2_GL = 0, P2_RL = 32768, P2_SST = 65536;
constexpr int N_ATT_UNITS = 512 + 16, N_SGU_UNITS = 1024 + 64;

struct AttnDesc { int b, c, kvh, qrow0, nqb, jlo, jhi; bool sample; };
__device__ __forceinline__ AttnDesc attn_desc(int uid) { AttnDesc d; d.sample = uid >= 512; d.c = 0;
    if (!d.sample) { d.b = uid >> 6; d.c = (uid >> 1) & 31; d.kvh = uid & 1; d.qrow0 = d.b * SEQ + d.c * CHUNK; d.nqb = 2; d.jlo = 128 - 64 * d.c; if (d.jlo < 0) d.jlo = 0; d.jhi = 192; }
    else { const int s = uid - 512; d.b = s >> 1; d.kvh = s & 1; d.qrow0 = MPROMPT + d.b * TDEC; d.nqb = 1; d.jlo = 0; d.jhi = 144; }
    return d; }
__device__ __forceinline__ void attn_kv_load(Frame& F, const AttnDesc& d, int, v4u (&kq)[3], v4u (&vq)[3]) {
    const int tid = F.wave * 64 + pg8::lane_id_v();
    const bf16* KV = (const bf16*)(F.ws + WS_KV);
#pragma unroll
    for (int i = 0; i < 3; ++i) { const int idx = tid + 512 * i, key = idx >> 3, ch = idx & 7; kq[i] = (v4u){0u, 0u, 0u, 0u}; vq[i] = (v4u){0u, 0u, 0u, 0u};
        if (!d.sample) { const int pos = d.c * CHUNK - WINDOW + key; if (pos >= 0) { const bf16* rp = KV + (size_t)(d.b * SEQ + pos) * 256 + d.kvh * 64 + ch * 8; kq[i] = *(const GAS v4u*)rp; vq[i] = *(const GAS v4u*)(rp + 128); } }
        else if (key < 128) { const size_t o = ((size_t)(d.b * WINDOW + key) * 2 + d.kvh) * 64 + ch * 8;
            const f32x4 a = *(const GAS f32x4*)(F.cache_k + o), a2 = *(const GAS f32x4*)(F.cache_k + o + 4), p = *(const GAS f32x4*)(F.cache_v + o), p2 = *(const GAS f32x4*)(F.cache_v + o + 4);
            kq[i] = (v4u){pkb(a.x, a.y), pkb(a.z, a.w), pkb(a2.x, a2.y), pkb(a2.z, a2.w)}; vq[i] = (v4u){pkb(p.x, p.y), pkb(p.z, p.w), pkb(p2.x, p2.y), pkb(p2.z, p2.w)}; }
        else if (key < 144) { const bf16* rp = KV + (size_t)(MPROMPT + d.b * TDEC + key - 128) * 256 + d.kvh * 64 + ch * 8; kq[i] = *(const GAS v4u*)rp; vq[i] = *(const GAS v4u*)(rp + 128); } }
}
__device__ __forceinline__ void attn_kv_store(Frame& F, int, const v4u (&kq)[3], const v4u (&vq)[3]) {
    const int tid = F.wave * 64 + pg8::lane_id_v();
    LAS unsigned char* KL = F.lds + P2_KL; LAS unsigned char* VL = F.lds + P2_VL;
#pragma unroll
    for (int i = 0; i < 3; ++i) { const int idx = tid + 512 * i, key = idx >> 3, ch = idx & 7; *(LAS v4u*)(KL + ch * 3072 + key * 16) = kq[i]; *(LAS v4u*)(VL + (ch >> 2) * 12288 + key * 64 + (ch & 3) * 16) = vq[i]; }
}
template <bool MASK> __device__ __forceinline__ void attn_compute(Frame& F, const AttnDesc& d, bf16x8 (&qr)[4]) {
    const int lane = pg8::lane_id_v();
    const int w = F.wave, r = lane & 31, h = lane >> 5;
    LAS unsigned char* KL = F.lds + P2_KL; LAS unsigned char* VL = F.lds + P2_VL; const LAS float* BL = (const LAS float*)(F.lds + P2_BIAS); LAS unsigned char* OST = F.lds + P2_OST + w * 4096;
    const bf16* Q = (const bf16*)(F.ws + WS_Q); bf16* OS = (bf16*)(F.ws + WS_RA);
    const int hd = d.kvh * 8 + w; const float sink2 = F.sinks[hd] * LOG2E; const LAS float* bl = BL + hd * 256;
    const int vlane = (4 * h + ((lane & 15) >> 2)) * 64 + (((lane >> 4) & 1) * 16 + (lane & 3) * 4) * 2;
    for (int qb = 0; qb < d.nqb; ++qb) {
        const int qi = qb * 32 + r;
        f32x16 S[6];
#pragma unroll
        for (int kb = 0; kb < 6; ++kb) { f32x16 a = {};
#pragma unroll
            for (int ks = 0; ks < 4; ++ks) { const bf16x8 kf = *(const LAS bf16x8*)(KL + (2 * ks + h) * 3072 + (kb * 32 + r) * 16); a = __builtin_amdgcn_mfma_f32_32x32x16_bf16(kf, qr[ks], a, 0, 0, 0); }
            S[kb] = a; asm volatile("" ::: "memory"); }
        if (qb + 1 < d.nqb) { const int qrow_n = d.qrow0 + (qb + 1) * 32 + r;
#pragma unroll
            for (int ks = 0; ks < 4; ++ks) qr[ks] = __builtin_nontemporal_load((const GAS bf16x8*)(Q + (size_t)qrow_n * 1024 + hd * 64 + ks * 16 + h * 8)); }
        float mx = -1e30f;
        const LAS float* blq = bl + (63 - qi + 4 * h);
        if (MASK) {
#pragma unroll
            for (int kb = 0; kb < 6; ++kb)
#pragma unroll
                for (int i = 0; i < 16; ++i) { const int j = kb * 32 + crow(i, h); float t = S[kb][i] + blq[kb * 32 + (i & 3) + 8 * (i >> 2)]; t = (j >= d.jlo && j < d.jhi) ? t : -1e30f; S[kb][i] = t; mx = fmaxf(mx, t); }
        } else {
#pragma unroll
            for (int kb = 0; kb < 6; ++kb)
#pragma unroll
                for (int i = 0; i < 16; ++i) { const float t = S[kb][i] + blq[kb * 32 + (i & 3) + 8 * (i >> 2)]; S[kb][i] = t; mx = fmaxf(mx, t); }
        }
        mx = fmaxf(half_max(mx), sink2);
        float l = 0.f;
#pragma unroll
        for (int kb = 0; kb < 6; ++kb)
#pragma unroll
            for (int i = 0; i < 16; ++i) { const float e = __builtin_amdgcn_exp2f(S[kb][i] - mx); S[kb][i] = e; l += e; }
        l = half_sum(l) + __builtin_amdgcn_exp2f(sink2 - mx);
        const float inv = 1.0f / l;
        f32x16 O[2]; O[0] = f32x16{}; O[1] = f32x16{};
#pragma unroll
        for (int kb = 0; kb < 6; ++kb)
#pragma unroll
            for (int s2 = 0; s2 < 2; ++s2) { v4u wv; wv.x = pkb(S[kb][8 * s2 + 0] * inv, S[kb][8 * s2 + 1] * inv); wv.y = pkb(S[kb][8 * s2 + 2] * inv, S[kb][8 * s2 + 3] * inv);
                wv.z = pkb(S[kb][8 * s2 + 4] * inv, S[kb][8 * s2 + 5] * inv); wv.w = pkb(S[kb][8 * s2 + 6] * inv, S[kb][8 * s2 + 7] * inv); const bf16x8 pa = __builtin_bit_cast(bf16x8, wv);
#pragma unroll
                for (int db = 0; db < 2; ++db) { const LAS unsigned char* vp = VL + db * 12288 + (kb * 32 + s2 * 16) * 64 + vlane; const s16x4 lo = vtr(vp), hi = vtr(vp + 8 * 64);
                    const bf16x8 vf = (bf16x8){lo[0], lo[1], lo[2], lo[3], hi[0], hi[1], hi[2], hi[3]}; O[db] = __builtin_amdgcn_mfma_f32_32x32x16_bf16(pa, vf, O[db], 0, 0, 0); } }
#pragma unroll
        for (int db = 0; db < 2; ++db)
#pragma unroll
            for (int i = 0; i < 16; ++i) *(LAS bf16*)(OST + (crow(i, h) * 64 + db * 32 + r) * 2) = bf1(O[db][i]);
        LDS_WAIT(); asm volatile("" ::: "memory");
#pragma unroll
        for (int it = 0; it < 4; ++it) { const int row = it * 8 + (lane >> 3), ch = lane & 7; const v4u v = *(const LAS v4u*)(OST + row * 128 + ch * 16);
            if (!d.sample || row < TDEC) *(GAS v4u*)(OS + (size_t)(d.qrow0 + qb * 32 + row) * 2048 + hd * 64 + ch * 8) = v; }
        LDS_WAIT(); asm volatile("" ::: "memory");
    }
}
__device__ __forceinline__ void attn_q_load0(Frame& F, const AttnDesc& d, bf16x8 (&qr)[4]) {
    const int lane = pg8::lane_id_v(), r = lane & 31, h = lane >> 5; const bf16* Q = (const bf16*)(F.ws + WS_Q); const int hd = d.kvh * 8 + F.wave;
    const int qrow = d.qrow0 + (d.sample ? (r & 15) : r);
#pragma unroll
    for (int ks = 0; ks < 4; ++ks) qr[ks] = __builtin_nontemporal_load((const GAS bf16x8*)(Q + (size_t)qrow * 1024 + hd * 64 + ks * 16 + h * 8));
}
__device__ __forceinline__ void p2_bias_table(Frame& F) {
    LAS float* BLw = (LAS float*)(F.lds + P2_BIAS);
    { const int e0 = F.wave * 64 + pg8::lane_id_v(); float bv[8];
#pragma unroll
        for (int i = 0; i < 8; ++i) { const int e = e0 + i * NTHR, hh = e >> 8, idx = e & 255, rel = idx - 191, n = rel < 0 ? -rel : rel;
            const int v = n < 8 ? n : (n < 12 ? 8 : n < 16 ? 9 : n < 23 ? 10 : n < 32 ? 11 : n < 46 ? 12 : n < 64 ? 13 : n < 91 ? 14 : 15);
            bv[i] = F.rel_tab[((rel > 0 ? 16 : 0) + v) * 16 + hh]; }
#pragma unroll
        for (int i = 0; i < 8; ++i) { const int e = e0 + i * NTHR; BLw[e] = ((e & 255) < 255) ? bv[i] * LOG2E : 0.f; } }
}
__device__ __forceinline__ void attn_units(Frame& F) {
    int u = F.vcu; if (u >= N_ATT_UNITS) return;
    v4u kq[3], vq[3]; bf16x8 qr[4];
    { const AttnDesc d0 = attn_desc(u); attn_kv_load(F, d0, 0, kq, vq); attn_q_load0(F, d0, qr); }
    p2_bias_table(F);
    for (;;) {
        attn_kv_store(F, 0, kq, vq);
        LDS_WAIT(); __builtin_amdgcn_s_barrier(); asm volatile("" ::: "memory");
        const int un = u + F.G; const bool has = un < N_ATT_UNITS;
        bf16x8 qn[4];
        if (has) { const AttnDesc dn = attn_desc(un); attn_kv_load(F, dn, 0, kq, vq); attn_q_load0(F, dn, qn); }
        { const AttnDesc d = attn_desc(u); if (d.jlo == 0 && d.jhi == 192) attn_compute<false>(F, d, qr); else attn_compute<true>(F, d, qr); }
        LDS_WAIT(); __builtin_amdgcn_s_barrier(); asm volatile("" ::: "memory");
        if (!has) break;
        u = un;
#pragma unroll
        for (int i = 0; i < 4; ++i) qr[i] = qn[i];
    }
}

struct SguOps { v4u gvq[4]; float ssp[4]; bf16x8 af[8]; v4u uq[4]; float bs[4]; f32x4 sg0, sg1; };
__device__ __forceinline__ void sgu_load(Frame& F, const int uid, SguOps& R) {
    const int lane = pg8::lane_id_v(), w = F.wave, tid = w * 64 + lane, r = lane & 31, h = lane >> 5;
    LAS unsigned char* GL = F.lds + P2_GL;
    const bf16* VS = (const bf16*)(F.ws + WS_VS); const bf16* U = (const bf16*)(F.ws + WS_U); const bf16* WSM = (const bf16*)(F.ws + WS_WSM); const float* SS1 = (const float*)(F.ws + WS_SS1); bf16* OS = (bf16*)(F.ws + WS_RA);
    const bool sample = uid >= 1024; int b, g, row0, nv;
    if (!sample) { b = uid >> 7; const int blk = (uid >> 3) & 15; g = uid & 7; row0 = b * SEQ + blk * 128; nv = 128; }
    else { const int s = uid - 1024; b = s >> 3; g = s & 7; row0 = MPROMPT + b * TDEC; nv = TDEC; }
    const int wr = w >> 1, wc = w & 1; const bool active = 32 * wr < nv; const int nks = 2 * (wr + 1);
    const int er = lane >> 3, ec = (lane & 7) * 8;
    (void)GL; (void)VS; (void)U; (void)WSM; (void)SS1; (void)OS; (void)b; (void)r; (void)h; (void)tid; (void)nks; (void)er; (void)ec; (void)active;
#pragma unroll
    for (int i = 0; i < 4; ++i) { const int idx = tid + 512 * i, s = idx >> 4, ch = idx & 15; R.gvq[i] = (v4u){0u, 0u, 0u, 0u}; R.ssp[i] = 0.f;
        if (s < nv) { R.gvq[i] = __builtin_nontemporal_load((const GAS v4u*)(VS + (size_t)(row0 + s) * 1024 + g * 128 + ch * 8)); R.ssp[i] = SS1[(size_t)(row0 + s) * 16 + ch]; } }
    if (active) {
#pragma unroll
        for (int ks = 0; ks < 8; ++ks) { R.af[ks] = (bf16x8){0, 0, 0, 0, 0, 0, 0, 0}; if (ks < nks) R.af[ks] = *(const GAS bf16x8*)(WSM + (size_t)(g * 128 + 32 * wr + r) * 128 + 16 * ks + 8 * h); }
        R.sg0 = *(const GAS f32x4*)(F.sgu_norm_g + g * 128 + 64 * wc + ec); R.sg1 = *(const GAS f32x4*)(F.sgu_norm_g + g * 128 + 64 * wc + ec + 4);
#pragma unroll
        for (int c = 0; c < 4; ++c) { const int t = 32 * wr + 8 * c + er; R.uq[c] = (v4u){0u, 0u, 0u, 0u}; R.bs[c] = F.sgu_b_s[g * 128 + t];
            if (t < nv) R.uq[c] = __builtin_nontemporal_load((const GAS v4u*)(U + (size_t)(row0 + t) * 1024 + g * 128 + 64 * wc + ec)); }
    }
}
__device__ __forceinline__ void sgu_process(Frame& F, const int uid, SguOps& R) {
    const int lane = pg8::lane_id_v(), w = F.wave, tid = w * 64 + lane, r = lane & 31, h = lane >> 5;
    LAS unsigned char* GL = F.lds + P2_GL;
    const bf16* VS = (const bf16*)(F.ws + WS_VS); const bf16* U = (const bf16*)(F.ws + WS_U); const bf16* WSM = (const bf16*)(F.ws + WS_WSM); const float* SS1 = (const float*)(F.ws + WS_SS1); bf16* OS = (bf16*)(F.ws + WS_RA);
    const bool sample = uid >= 1024; int b, g, row0, nv;
    if (!sample) { b = uid >> 7; const int blk = (uid >> 3) & 15; g = uid & 7; row0 = b * SEQ + blk * 128; nv = 128; }
    else { const int s = uid - 1024; b = s >> 3; g = s & 7; row0 = MPROMPT + b * TDEC; nv = TDEC; }
    const int wr = w >> 1, wc = w & 1; const bool active = 32 * wr < nv; const int nks = 2 * (wr + 1);
    const int er = lane >> 3, ec = (lane & 7) * 8;
    (void)GL; (void)VS; (void)U; (void)WSM; (void)SS1; (void)OS; (void)b; (void)r; (void)h; (void)tid; (void)nks; (void)er; (void)ec; (void)active;
#pragma unroll
    for (int i = 0; i < 4; ++i) { const int idx = tid + 512 * i, s = idx >> 4, ch = idx & 15; v4u o = (v4u){0u, 0u, 0u, 0u};
        float ss = R.ssp[i];
        ss += __builtin_bit_cast(float, __builtin_amdgcn_ds_swizzle(__builtin_bit_cast(int, ss), (1 << 10) | 0x1f)); ss += __builtin_bit_cast(float, __builtin_amdgcn_ds_swizzle(__builtin_bit_cast(int, ss), (2 << 10) | 0x1f));
        ss += __builtin_bit_cast(float, __builtin_amdgcn_ds_swizzle(__builtin_bit_cast(int, ss), (4 << 10) | 0x1f)); ss += __builtin_bit_cast(float, __builtin_amdgcn_ds_swizzle(__builtin_bit_cast(int, ss), (8 << 10) | 0x1f));
        if (s < nv) {
            const float rr = 1.0f / sqrtf(ss * (1.f / DSGU) + EPS); const v4u wv = R.gvq[i];
            float f[8] = {pg8::bf_lo(wv.x) * rr, pg8::bf_hi(wv.x) * rr, pg8::bf_lo(wv.y) * rr, pg8::bf_hi(wv.y) * rr, pg8::bf_lo(wv.z) * rr, pg8::bf_hi(wv.z) * rr, pg8::bf_lo(wv.w) * rr, pg8::bf_hi(wv.w) * rr};
            o = (v4u){pkb(f[0], f[1]), pkb(f[2], f[3]), pkb(f[4], f[5]), pkb(f[6], f[7])};
            if (sample) { const f32x4 g0 = *(const GAS f32x4*)(F.sgu_norm_g + g * 128 + ch * 8), g1 = *(const GAS f32x4*)(F.sgu_norm_g + g * 128 + ch * 8 + 4); float* dst = F.out + OUT_SGU + (size_t)(b * TDEC + s) * 1024 + g * 128 + ch * 8;
                *(GAS f32x4*)dst = (f32x4){f[0] * g0.x, f[1] * g0.y, f[2] * g0.z, f[3] * g0.w}; *(GAS f32x4*)(dst + 4) = (f32x4){f[4] * g1.x, f[5] * g1.y, f[6] * g1.z, f[7] * g1.w}; } }
        *(LAS v4u*)(GL + (ch >> 2) * 8192 + s * 64 + (ch & 3) * 16) = o; }
    LDS_WAIT(); __builtin_amdgcn_s_barrier(); asm volatile("" ::: "memory");
    if (active) {
        f32x16 acc[2]; acc[0] = f32x16{}; acc[1] = f32x16{};
        const int glane = (8 * h + ((lane & 15) >> 2)) * 64 + (((lane >> 4) & 1) * 16 + (lane & 3) * 4) * 2;
#pragma unroll
        for (int ks = 0; ks < 8; ++ks) if (ks < nks) {
#pragma unroll
            for (int cb = 0; cb < 2; ++cb) { const LAS unsigned char* gp = GL + (2 * wc + cb) * 8192 + (16 * ks) * 64 + glane; const s16x4 lo = vtr(gp), hi = vtr(gp + 4 * 64);
                const bf16x8 bb = (bf16x8){lo[0], lo[1], lo[2], lo[3], hi[0], hi[1], hi[2], hi[3]}; acc[cb] = __builtin_amdgcn_mfma_f32_32x32x16_bf16(R.af[ks], bb, acc[cb], 0, 0, 0); } }
        LAS float* STG = (LAS float*)(F.lds + P2_SST + w * 8192);
#pragma unroll
        for (int cb = 0; cb < 2; ++cb)
#pragma unroll
            for (int i = 0; i < 16; ++i) STG[crow(i, h) * 64 + 32 * cb + r] = acc[cb][i];
        LDS_WAIT(); asm volatile("" ::: "memory");
#pragma unroll
        for (int c = 0; c < 4; ++c) { const int t = 32 * wr + 8 * c + er;
            const f32x4 a0 = *(const LAS f32x4*)(STG + (8 * c + er) * 64 + ec), a1 = *(const LAS f32x4*)(STG + (8 * c + er) * 64 + ec + 4); const v4u uw = R.uq[c]; const float bb = R.bs[c];
            const v4u o = {pkb(pg8::bf_lo(uw.x) * (a0.x * R.sg0.x + bb), pg8::bf_hi(uw.x) * (a0.y * R.sg0.y + bb)), pkb(pg8::bf_lo(uw.y) * (a0.z * R.sg0.z + bb), pg8::bf_hi(uw.y) * (a0.w * R.sg0.w + bb)),
                           pkb(pg8::bf_lo(uw.z) * (a1.x * R.sg1.x + bb), pg8::bf_hi(uw.z) * (a1.y * R.sg1.y + bb)), pkb(pg8::bf_lo(uw.w) * (a1.z * R.sg1.z + bb), pg8::bf_hi(uw.w) * (a1.w * R.sg1.w + bb))};
            if (t < nv) *(GAS v4u*)(OS + (size_t)(row0 + t) * 2048 + 1024 + g * 128 + 64 * wc + ec) = o; }
    }
    LDS_WAIT(); __builtin_amdgcn_s_barrier(); asm volatile("" ::: "memory");
}
__device__ __forceinline__ int sgu_uid(const Frame& F, const int k) {
    const int u0 = F.G - 1 - F.vcu;
    if (F.G == 256 && F.vcu < 16) return k < 2 ? u0 + k * 256 : -1;
    if (F.G == 256 && F.vcu < 32) return k < 4 ? u0 + k * 256 : (k == 4 ? 1023 - (F.vcu - 16) : -1);
    if (F.G == 256 && F.vcu < 48) return k < 4 ? u0 + k * 256 : (k == 4 ? 767 - (F.vcu - 32) : -1);
    const int u = u0 + k * F.G; return u < N_SGU_UNITS ? u : -1;
}
__device__ __forceinline__ void sgu_units(Frame& F) {
    SguOps A, B; int k = 0, ua = sgu_uid(F, 0);
    if (ua >= 0) sgu_load(F, ua, A);
    while (ua >= 0) {
        const int ub = sgu_uid(F, k + 1); if (ub >= 0) sgu_load(F, ub, B);
        sgu_process(F, ua, A);
        if (ub < 0) break;
        ua = sgu_uid(F, k + 2); if (ua >= 0) sgu_load(F, ua, A);
        sgu_process(F, ub, B);
        k += 2;
    }
}


#ifndef STAGGER
#define STAGGER 1
#endif
__device__ __forceinline__ void p2_mixers(Frame& F) {
    attn_units(F);
    sgu_units(F);
#if P0_LATE_W
    __syncthreads();
    if (F.G == 256) { if (F.vcu >= 48) p0_transposes(F, 32 * 232, 32 * 232 + 2 * 16 * 64 + (STAGGER ? 0 : 2 * 32 * 64), (F.vcu - 48) * NWAVES + F.wave, 208 * NWAVES); }
    else p0_transposes(F, 32 * 232, 32 * 232 + 2 * 16 * 64 + 2 * 32 * 64, F.vcu * NWAVES + F.wave, F.G * NWAVES);
#endif
}
constexpr size_t WS_SS2S = WS_SS2 + (size_t)MPROMPT * 32 * 4;
struct SkMerge { const bf16 *RATIO, *SB; bf16* H;
    __device__ __forceinline__ void mid(f32x4& acc, int row, int col) const { const unsigned long long w = *(const GAS unsigned long long*)(RATIO + (size_t)row * 2048 + col); const unsigned lo = (unsigned)w, hi = (unsigned)(w >> 32);
        acc *= (f32x4){pg8::bf_lo(lo), pg8::bf_hi(lo), pg8::bf_lo(hi), pg8::bf_hi(hi)}; }
    __device__ __forceinline__ void fin(const f32x4 acc, int row, int col, int, int) const { const unsigned long long w = *(const GAS unsigned long long*)(SB + (size_t)row * 2048 + col); const unsigned lo = (unsigned)w, hi = (unsigned)(w >> 32);
        const f32x4 v = acc * (f32x4){pg8::bf_lo(lo), pg8::bf_hi(lo), pg8::bf_lo(hi), pg8::bf_hi(hi)};
        *(GAS unsigned long long*)(H + (size_t)row * 2048 + col) = (unsigned long long)pkb(v.x, v.y) | ((unsigned long long)pkb(v.z, v.w) << 32); } };
struct SkOut { const float* xs; bf16* XH; float* SS2S;
    __device__ __forceinline__ void mid(f32x4&, int, int) const {}
    __device__ __forceinline__ void fin(const f32x4 acc, int row, int col, int part, int fq) const { const f32x4 v = acc + *(const GAS f32x4*)(xs + (size_t)(row - MPROMPT) * 2048 + col);
        *(GAS unsigned long long*)(XH + (size_t)row * 2048 + col) = (unsigned long long)pkh(v.x, v.y) | ((unsigned long long)pkh(v.z, v.w) << 32);
        float s = (v.x * v.x + v.y * v.y) + (v.z * v.z + v.w * v.w); s += __shfl_xor(s, 16); s += __shfl_xor(s, 32);
        if (fq == 0) SS2S[(size_t)(row - MPROMPT) * 128 + part] = s; } };
struct SkQ { bf16* QP;
    __device__ __forceinline__ void mid(f32x4&, int, int) const {}
    __device__ __forceinline__ void fin(const f32x4 acc, int row, int col, int, int) const { *(GAS unsigned long long*)(QP + (size_t)row * 2048 + col) = (unsigned long long)pkh(acc.x, acc.y) | ((unsigned long long)pkh(acc.z, acc.w) << 32); } };
template <bool F16, bool MID, class Epi>
__device__ __forceinline__ void skinny_gemm(Frame& F, const bf16* A, const bf16* Bt, const Epi& E) {
    const int lane = pg8::lane_id_v(), w = F.wave, fr = lane & 15, fq = lane >> 4;
    LAS f32x4* part = (LAS f32x4*)(F.lds + RING_OFF);
    for (int job = F.vcu; job < 256; job += F.G) {
        const int rb = job & 3, cb = job >> 2;
        const bf16* ap = A + (size_t)(MPROMPT + 32 * rb + fr) * 2048 + 256 * w + 8 * fq;
        const bf16* bp = Bt + (size_t)(32 * cb + fr) * 2048 + 256 * w + 8 * fq;
        bf16x8 a0[8], a1[8], b0[8], b1[8];
#pragma unroll
        for (int u = 0; u < 8; ++u) { a0[u] = *(const GAS bf16x8*)(ap + 32 * u); a1[u] = *(const GAS bf16x8*)(ap + 16 * 2048 + 32 * u); b0[u] = *(const GAS bf16x8*)(bp + 32 * u); b1[u] = *(const GAS bf16x8*)(bp + 16 * 2048 + 32 * u); }
        f32x4 c00 = {0.f, 0.f, 0.f, 0.f}, c01 = c00, c10 = c00, c11 = c00;
#pragma unroll
        for (int u = 0; u < 8; ++u) { c00 = pg8::mma16<F16>(b0[u], a0[u], c00); c01 = pg8::mma16<F16>(b1[u], a0[u], c01); c10 = pg8::mma16<F16>(b0[u], a1[u], c10); c11 = pg8::mma16<F16>(b1[u], a1[u], c11); }
        __syncthreads();
        part[(w * 4 + 0) * 64 + lane] = c00; part[(w * 4 + 1) * 64 + lane] = c01; part[(w * 4 + 2) * 64 + lane] = c10; part[(w * 4 + 3) * 64 + lane] = c11;
        __syncthreads();
        if (w < 4) {
            f32x4 s1 = part[(0 * 4 + w) * 64 + lane], s2 = part[(4 * 4 + w) * 64 + lane];
#pragma unroll
            for (int ww = 1; ww < 4; ++ww) { s1 += part[(ww * 4 + w) * 64 + lane]; s2 += part[((ww + 4) * 4 + w) * 64 + lane]; }
            const int row = MPROMPT + 32 * rb + 16 * (w >> 1) + fr, col = 32 * cb + 16 * (w & 1) + 4 * fq;
            if (MID) E.mid(s1, row, col);
            E.fin(s1 + s2, row, col, cb * 2 + (w & 1), fq);
        }
    }
}
typedef _Float16 f16x8v __attribute__((ext_vector_type(8)));
__device__ __forceinline__ int enc_f(float f) { const int b = __builtin_bit_cast(int, f); return b ^ ((b >> 31) & 0x7fffffff); }
__device__ __forceinline__ float dec_f(int k) { return __builtin_bit_cast(float, k ^ ((k >> 31) & 0x7fffffff)); }
__device__ __forceinline__ int imax_(int a, int b) { return a > b ? a : b; }
__device__ __forceinline__ int imin_(int a, int b) { return a < b ? a : b; }
#define P6_CE(a, b) do { const int mx_ = imax_(a, b), mn_ = imin_(a, b); a = mx_; b = mn_; } while (0)
__device__ __forceinline__ void sort16_desc(int (&v)[16]) {
#pragma unroll
    for (int k = 2; k <= 16; k <<= 1)
#pragma unroll
        for (int j = k >> 1; j > 0; j >>= 1)
#pragma unroll
            for (int i = 0; i < 16; ++i) { const int l = i ^ j; if (l > i) { if ((i & k) == 0) P6_CE(v[i], v[l]); else P6_CE(v[l], v[i]); } }
}
__device__ __forceinline__ void bitonic_merge16_desc(int (&v)[16]) {
#pragma unroll
    for (int j = 8; j > 0; j >>= 1)
#pragma unroll
        for (int i = 0; i < 16; ++i) { const int l = i ^ j; if (l > i) P6_CE(v[i], v[l]); }
}
__device__ __forceinline__ void merge_top16(int (&T)[16], const int (&N)[16]) {
#pragma unroll
    for (int i = 0; i < 16; ++i) T[i] = imax_(T[i], N[15 - i]);
    bitonic_merge16_desc(T);
}
__device__ __forceinline__ int half_partner(int x) { return (int)pg8::partner32((unsigned)x); }
struct CandTab { int ci[64], cj[64]; };
__host__ __device__ constexpr CandTab make_cand() { CandTab t{}; int n = 0; for (int i = 0; i < 16; ++i) for (int j = 0; j < 16; ++j) if ((i + 1) * (j + 1) <= 16) { t.ci[n] = i; t.cj[n] = j; ++n; } for (; n < 64; ++n) { t.ci[n] = -1; t.cj[n] = -1; } return t; }
constexpr CandTab CAND = make_cand();
constexpr int P6_SC = 0;

constexpr int P6_KEYS = 65536;
__device__ __forceinline__ void p6_job(Frame& F, const int job) {
    const int lane = pg8::lane_id_v(), w = F.wave, r = lane & 31, h = lane >> 5;
    const bf16* QP = (const bf16*)(F.ws + WS_SB); const bf16* KH = (const bf16*)(F.ws + WS_KEYS); const float* SS2 = (const float*)(F.ws + WS_SS2);
    unsigned long long* SEL = (unsigned long long*)(F.ws + WS_RA);
    LAS int* SC = (LAS int*)(F.lds + P6_SC + w * 8192);
    constexpr int NTILE = MREAL / 32, NGRP = (NTILE + 7) / 8, NJOB = NGRP * 8;
    {
        const int hq = job & 7, tile = (job >> 3) * 8 + w;
        { const int tid = w * 64 + lane;
#pragma unroll
            for (int i = 0; i < 8; ++i) { const int idx = tid + 512 * i, p = idx >> 11, n = (idx >> 4) & 127, c = idx & 15;
                *(LAS v4u*)(F.lds + P6_KEYS + p * 32768 + c * 2048 + n * 16) = *(const GAS v4u*)(KH + ((size_t)((hq * 2 + p) * 128 + n)) * 128 + c * 8); } }
        __syncthreads();
        if (tile < NTILE) {
        const int t = tile * 32 + r;
        int AB[2][16];
#pragma unroll
        for (int p = 0; p < 2; ++p) {
            f16x8v qf[8];
#pragma unroll
            for (int ks = 0; ks < 8; ++ks) qf[ks] = *(const GAS f16x8v*)(QP + (size_t)t * 2048 + hq * 256 + p * 128 + ks * 16 + h * 8);
            int T[16];
#pragma unroll
            for (int nb = 0; nb < 4; ++nb) {
                f32x16 acc = {};
                const LAS unsigned char* kp = F.lds + P6_KEYS + p * 32768 + h * 2048 + (nb * 32 + r) * 16;
#pragma unroll
                for (int ks = 0; ks < 8; ++ks) { const f16x8v kf = *(const LAS f16x8v*)(kp + ks * 4096); acc = __builtin_amdgcn_mfma_f32_32x32x16_f16(kf, qf[ks], acc, 0, 0, 0); }
                int N[16];
#pragma unroll
                for (int i = 0; i < 16; ++i) N[i] = (enc_f(acc[i]) & ~127) | (nb * 32 + crow(i, h));
                sort16_desc(N);
                if (nb == 0) {
#pragma unroll
                    for (int i = 0; i < 16; ++i) T[i] = N[i];
                } else merge_top16(T, N);
            }
            int P[16];
#pragma unroll
            for (int i = 0; i < 16; ++i) P[i] = half_partner(T[i]);
            merge_top16(T, P);
#pragma unroll
            for (int i = 0; i < 16; ++i) AB[p][i] = T[i];
        }
#pragma unroll
        for (int i = 0; i < 16; ++i) { SC[i * 64 + lane] = AB[0][i] & 127; SC[(16 + i) * 64 + lane] = AB[1][i] & 127; }
        float fa[16], fb[16];
#pragma unroll
        for (int i = 0; i < 16; ++i) { fa[i] = dec_f(AB[0][i] & ~127); fb[i] = dec_f(AB[1][i] & ~127); }
        int W[16];
#pragma unroll
        for (int g = 0; g < 4; ++g) {
            int N[16];
#pragma unroll
            for (int c = 0; c < 16; ++c) { const int ci = CAND.ci[g * 16 + c], cj = CAND.cj[g * 16 + c]; N[c] = ci >= 0 ? ((enc_f(fa[ci >= 0 ? ci : 0] + fb[cj >= 0 ? cj : 0]) & ~255) | (ci * 16 + cj)) : (int)0x80000000; }
            sort16_desc(N);
            if (g == 0) {
#pragma unroll
                for (int i = 0; i < 16; ++i) W[i] = N[i];
            } else merge_top16(W, N);
        }
        float ssum = 0.f;
        if (tile >= MPROMPT / 32) { const GAS f32x4* sp = (const GAS f32x4*)((const float*)(F.ws + WS_SS2S) + (size_t)(t - MPROMPT) * 128);
#pragma unroll 16
            for (int i = 0; i < 32; ++i) { const f32x4 v = sp[i]; ssum += (v.x + v.y) + (v.z + v.w); } }
        else { const GAS f32x4* sp = (const GAS f32x4*)(SS2 + (size_t)t * 32);
#pragma unroll
            for (int i = 0; i < 8; ++i) { const f32x4 v = sp[i]; ssum += (v.x + v.y) + (v.z + v.w); } }
        const float rt = 1.0f / sqrtf(ssum * (1.f / DM) + EPS);
        LDS_WAIT(); asm volatile("" ::: "memory");
        float gk[16]; int ek[16]; float Z = 0.f; const float c0 = dec_f(W[0] & ~255);
#pragma unroll
        for (int k = 0; k < 16; ++k) { const int code = W[k] & 255, ii = code >> 4, jj = code & 15; const int n0 = SC[ii * 64 + lane], n1 = SC[(16 + jj) * 64 + lane];
            ek[k] = n0 * 128 + n1; gk[k] = __builtin_amdgcn_exp2f((dec_f(W[k] & ~255) - c0) * rt * LOG2E); Z += gk[k]; }
        const float iz = 1.0f / Z;
        unsigned long long* dst = SEL + ((size_t)t * 8 + hq) * 16 + 8 * h;
#pragma unroll
        for (int k = 0; k < 8; k += 2) { const int e0 = h ? ek[k + 8] : ek[k], e1 = h ? ek[k + 9] : ek[k + 1]; const float g0 = (h ? gk[k + 8] : gk[k]) * iz, g1 = (h ? gk[k + 9] : gk[k + 1]) * iz;
            __hip_atomic_store(dst + k, (unsigned long long)(unsigned)e0 | ((unsigned long long)__builtin_bit_cast(unsigned, g0) << 32), RLX_AGENT);
            __hip_atomic_store(dst + k + 1, (unsigned long long)(unsigned)e1 | ((unsigned long long)__builtin_bit_cast(unsigned, g1) << 32), RLX_AGENT); }
        LDS_WAIT(); asm volatile("" ::: "memory");
        }
    }
}
__device__ __forceinline__ void p6_topk(Frame& F) {
    constexpr int NJOB = ((MREAL / 32 + 7) / 8) * 8;
    for (int job = F.vcu; job < NJOB; job += F.G) { p6_job(F, job); __syncthreads(); }
}
typedef _Float16 h2v __attribute__((ext_vector_type(2)));
constexpr int P7_RED = 0, P7_PART = LDSCTL_OFF;
#ifndef P7_UNR
#define P7_UNR (PEER_FP4 ? 16 : 8)
#endif
template <int M> __device__ __forceinline__ float xor_lane(float x) {
    if constexpr (M == 32) return __builtin_bit_cast(float, pg8::partner32(__builtin_bit_cast(unsigned, x)));
    else return __builtin_bit_cast(float, __builtin_amdgcn_ds_swizzle(__builtin_bit_cast(int, x), (M << 10) | 0x1f));
}
__device__ __forceinline__ float wave_sum_sw(float v) { v += xor_lane<1>(v); v += xor_lane<2>(v); v += xor_lane<4>(v); v += xor_lane<8>(v); v += xor_lane<16>(v); v += xor_lane<32>(v); return v; }
#if PEER_FP4
#ifndef P7_MFMA_U
#define P7_MFMA_U 1
#endif
typedef int v8i_t __attribute__((ext_vector_type(8)));
__device__ __forceinline__ void p7_gather(Frame& F) {
    const int lane = pg8::lane_id_v(), w = F.wave;
    const bf16* XH = (const bf16*)(F.ws + WS_RATIO); const unsigned char* EU4 = F.ws + WS_EU; const float* EUS = (const float*)(F.ws + WS_EU + 16 * MiB); const unsigned char* EV4 = F.ws + WS_EU + 32 * MiB; const float* EVS = (const float*)(F.ws + WS_EU + 48 * MiB);
    const unsigned long long* SEL = (const unsigned long long*)(F.ws + WS_RA);
    int it = 0;
#ifdef P7_ACTIVE_PER_XCD
    if ((F.vcu & 31) >= P7_ACTIVE_PER_XCD) return;
    const int rank_ = (F.vcu >> 5) * P7_ACTIVE_PER_XCD + (F.vcu & 31), nrank_ = 8 * P7_ACTIVE_PER_XCD;
#else
    const int rank_ = F.vcu, nrank_ = F.G;
#endif
    for (int t = rank_; t < MREAL; t += nrank_, ++it) {
        LAS float* RED = (LAS float*)(F.lds + P7_RED + (it & 1) * 65536); LAS float* PART = (LAS float*)(F.lds + P7_PART + (it & 1) * 32);
        const unsigned long long sel = SEL[((size_t)t * 8 + w) * 16 + (lane >> 2)];
        const int eidx = (int)(unsigned)sel; const float gate = __builtin_bit_cast(float, (unsigned)(sel >> 32));
        const float su_l = EUS[eidx], sv_l = EVS[eidx];
        unsigned xw[16];
#pragma unroll
        for (int q = 0; q < 8; ++q) { const unsigned long long v = *(const GAS unsigned long long*)(XH + (size_t)t * DM + q * 256 + lane * 4); xw[2 * q] = (unsigned)v; xw[2 * q + 1] = (unsigned)(v >> 32); }
#if P7_MFMA_U
        v8i_t xb;
        { typedef _Float16 h32x __attribute__((ext_vector_type(32))); typedef unsigned u6x __attribute__((ext_vector_type(6))); h32x hx;
#pragma unroll
          for (int i = 0; i < 16; ++i) { const h2v p = __builtin_bit_cast(h2v, xw[i]); hx[2 * i] = p[0]; hx[2 * i + 1] = p[1]; }
          const u6x px = __builtin_amdgcn_cvt_scalef32_pk32_fp6_f16(hx, 1.0f);
          xb = (v8i_t){(int)px[0], (int)px[1], (int)px[2], (int)px[3], (int)px[4], (int)px[5], 0, 0}; }
        float mk[4];
#pragma unroll
        for (int r4 = 0; r4 < 4; ++r4) mk[r4] = ((lane >> 4) == ((lane & 15) >> 2) && (lane & 3) == r4) ? 1.f : 0.f;
#endif
        float ssum = 0.f;
#pragma unroll
        for (int i = 0; i < 16; ++i) { const h2v hv = __builtin_bit_cast(h2v, xw[i]); ssum = __builtin_amdgcn_fdot2(hv, hv, ssum, false); }
        ssum = wave_sum_sw(ssum);
        const float rt = 1.0f / sqrtf(ssum * (1.f / DM) + EPS);
        float dp[16];
#pragma unroll
        for (int k0 = 0; k0 < 16; k0 += P7_UNR) {
            v4u ur[P7_UNR];
#pragma unroll
            for (int kk = 0; kk < P7_UNR; ++kk) { const int e = __builtin_amdgcn_readlane(eidx, 4 * (k0 + kk)); ur[kk] = *(const GAS v4u*)(EU4 + (size_t)e * 1024 + lane * 16); }
#if P7_MFMA_U
#pragma unroll
            for (int kk = 0; kk < P7_UNR; ++kk) { const v8i_t A = {(int)ur[kk].x, (int)ur[kk].y, (int)ur[kk].z, (int)ur[kk].w, 0, 0, 0, 0};
                const f32x4 d = __builtin_amdgcn_mfma_scale_f32_16x16x128_f8f6f4(A, xb, (f32x4){0.f, 0.f, 0.f, 0.f}, 4  , 2  , 0, 127, 0, 127);
                dp[k0 + kk] = (d[0] * mk[0] + d[1] * mk[1]) + (d[2] * mk[2] + d[3] * mk[3]); }
#else
#pragma unroll
            for (int kk = 0; kk < P7_UNR; ++kk) { float a = 0.f;
#pragma unroll
                for (int q = 0; q < 4; ++q) { const unsigned wq = ur[kk][q];
                    a = __builtin_amdgcn_fdot2(__builtin_amdgcn_cvt_scalef32_pk_f16_fp4(wq, 1.0f, 0), __builtin_bit_cast(h2v, xw[4 * q + 0]), a, false); a = __builtin_amdgcn_fdot2(__builtin_amdgcn_cvt_scalef32_pk_f16_fp4(wq, 1.0f, 1), __builtin_bit_cast(h2v, xw[4 * q + 1]), a, false);
                    a = __builtin_amdgcn_fdot2(__builtin_amdgcn_cvt_scalef32_pk_f16_fp4(wq, 1.0f, 2), __builtin_bit_cast(h2v, xw[4 * q + 2]), a, false); a = __builtin_amdgcn_fdot2(__builtin_amdgcn_cvt_scalef32_pk_f16_fp4(wq, 1.0f, 3), __builtin_bit_cast(h2v, xw[4 * q + 3]), a, false); }
                dp[k0 + kk] = a;
                }
#endif
#pragma unroll
            for (int kk = 0; kk < P7_UNR; ++kk) asm volatile("" : "+v"(dp[k0 + kk]) :: "memory");
        }
#define P7_TR(C, M) do { const bool up_ = (lane & (M)) != 0; _Pragma("unroll") for (int i = 0; i < (C) / 2; ++i) { const float keep_ = up_ ? dp[i + (C) / 2] : dp[i], send_ = up_ ? dp[i] : dp[i + (C) / 2]; dp[i] = keep_ + xor_lane<(M)>(send_); } } while (0)
        P7_TR(16, 32); P7_TR(8, 16); P7_TR(4, 8); P7_TR(2, 4);
#undef P7_TR
        float dk = dp[0]; dk += xor_lane<2>(dk); dk += xor_lane<1>(dk);
        const float hval = gate * pg8::gelu_tanh(dk * su_l * rt) * sv_l;
        h2v o2[16];
#pragma unroll
        for (int e = 0; e < 16; ++e) o2[e] = (h2v){(_Float16)0.f, (_Float16)0.f};
#pragma unroll
        for (int k0 = 0; k0 < 16; k0 += P7_UNR) {
            v4u vr[P7_UNR];
#pragma unroll
            for (int kk = 0; kk < P7_UNR; ++kk) { const int e = __builtin_amdgcn_readlane(eidx, 4 * (k0 + kk)); vr[kk] = *(const GAS v4u*)(EV4 + (size_t)e * 1024 + lane * 16); }
#pragma unroll
            for (int kk = 0; kk < P7_UNR; ++kk) { const float hk = __builtin_bit_cast(float, __builtin_amdgcn_readlane(__builtin_bit_cast(int, hval), 4 * (k0 + kk))) * 256.0f; const _Float16 hh = (_Float16)hk; const h2v hk2 = {hh, hh};
#pragma unroll
                for (int q = 0; q < 4; ++q) { const unsigned wq = vr[kk][q];
                    o2[4 * q + 0] = __builtin_elementwise_fma(__builtin_bit_cast(h2v, __builtin_amdgcn_cvt_scalef32_pk_f16_fp4(wq, 1.0f, 0)), hk2, o2[4 * q + 0]); o2[4 * q + 1] = __builtin_elementwise_fma(__builtin_bit_cast(h2v, __builtin_amdgcn_cvt_scalef32_pk_f16_fp4(wq, 1.0f, 1)), hk2, o2[4 * q + 1]);
                    o2[4 * q + 2] = __builtin_elementwise_fma(__builtin_bit_cast(h2v, __builtin_amdgcn_cvt_scalef32_pk_f16_fp4(wq, 1.0f, 2)), hk2, o2[4 * q + 2]); o2[4 * q + 3] = __builtin_elementwise_fma(__builtin_bit_cast(h2v, __builtin_amdgcn_cvt_scalef32_pk_f16_fp4(wq, 1.0f, 3)), hk2, o2[4 * q + 3]); } }
#pragma unroll
            for (int q = 0; q < 2; ++q) asm volatile("" : "+v"(o2[8 * q]), "+v"(o2[8 * q + 1]), "+v"(o2[8 * q + 2]), "+v"(o2[8 * q + 3]), "+v"(o2[8 * q + 4]), "+v"(o2[8 * q + 5]), "+v"(o2[8 * q + 6]), "+v"(o2[8 * q + 7]) :: "memory");
        }
#pragma unroll
        for (int q = 0; q < 8; ++q) *(LAS f32x4*)(RED + w * 2048 + q * 256 + lane * 4) = (f32x4){(float)o2[2 * q][0], (float)o2[2 * q][1], (float)o2[2 * q + 1][0], (float)o2[2 * q + 1][1]} * (1.0f / 256.0f);
        __syncthreads();
        const int col = w * 256 + lane * 4, soff = col;
        f32x4 sum = *(const LAS f32x4*)(RED + soff);
#pragma unroll
        for (int ww = 1; ww < 8; ++ww) sum += *(const LAS f32x4*)(RED + ww * 2048 + soff);
        { const unsigned long long xq = *(const GAS unsigned long long*)(XH + (size_t)t * DM + col); const unsigned x0 = (unsigned)xq, x1 = (unsigned)(xq >> 32); const h2v p0 = __builtin_bit_cast(h2v, x0), p1 = __builtin_bit_cast(h2v, x1);
            sum += (f32x4){(float)p0[0], (float)p0[1], (float)p1[0], (float)p1[1]}; }
        float sq = (sum.x * sum.x + sum.y * sum.y) + (sum.z * sum.z + sum.w * sum.w); sq = wave_sum_sw(sq);
        if (lane == 0) PART[w] = sq;
        __syncthreads();
        float tot = 0.f;
#pragma unroll
        for (int ww = 0; ww < 8; ++ww) tot += PART[ww];
        const float rf = 1.0f / sqrtf(tot * (1.f / DM) + EPS);
        const f32x4 gf = *(const GAS f32x4*)(F.norm_final_g + col);
        *(GAS f32x4*)(F.out + OUT_Y + (size_t)t * DM + col) = sum * rf * gf;
    }
}
#elif PEER_FP6
typedef _Float16 h32v __attribute__((ext_vector_type(32)));
typedef unsigned u6v __attribute__((ext_vector_type(6)));
typedef unsigned u2v __attribute__((ext_vector_type(2)));
__device__ __forceinline__ u6v ld_row6(const unsigned char* p) { const GAS u2v* q = (const GAS u2v*)p; const u2v a = q[0], b = q[1], c = q[2]; return (u6v){a.x, a.y, b.x, b.y, c.x, c.y}; }
__device__ __forceinline__ void p7_gather(Frame& F) {
    const int lane = pg8::lane_id_v(), w = F.wave;
    const bf16* XH = (const bf16*)(F.ws + WS_RATIO); const unsigned char* EU6 = F.ws + WS_EU; const unsigned char* EV6 = F.ws + WS_EU + 32 * MiB;
    const unsigned long long* SEL = (const unsigned long long*)(F.ws + WS_RA);
    int it = 0;
    for (int t = F.vcu; t < MREAL; t += F.G, ++it) {
        LAS float* RED = (LAS float*)(F.lds + P7_RED + (it & 1) * 65536); LAS float* PART = (LAS float*)(F.lds + P7_PART + (it & 1) * 32);
        const unsigned long long sel = SEL[((size_t)t * 8 + w) * 16 + (lane >> 2)];
        const int eidx = (int)(unsigned)sel; const float gate = __builtin_bit_cast(float, (unsigned)(sel >> 32));
        unsigned xw[16];
#pragma unroll
        for (int q = 0; q < 4; ++q) { const v4u v = *(const GAS v4u*)(XH + (size_t)t * DM + lane * 32 + q * 8); xw[4 * q] = v.x; xw[4 * q + 1] = v.y; xw[4 * q + 2] = v.z; xw[4 * q + 3] = v.w; }
        float ssum = 0.f;
#pragma unroll
        for (int i = 0; i < 16; ++i) { const h2v hv = __builtin_bit_cast(h2v, xw[i]); ssum = __builtin_amdgcn_fdot2(hv, hv, ssum, false); }
        ssum = wave_sum_sw(ssum);
        const float rt = 1.0f / sqrtf(ssum * (1.f / DM) + EPS);
        float dp[16];
#pragma unroll
        for (int k0 = 0; k0 < 16; k0 += P7_UNR) {
            u6v ur[P7_UNR];
#pragma unroll
            for (int kk = 0; kk < P7_UNR; ++kk) { const int e = __builtin_amdgcn_readlane(eidx, 4 * (k0 + kk)); ur[kk] = ld_row6(EU6 + (size_t)e * 1536 + lane * 24); }
#pragma unroll
            for (int kk = 0; kk < P7_UNR; ++kk) { const h32v d = __builtin_amdgcn_cvt_scalef32_pk32_f16_fp6(ur[kk], 1.0f); float a = 0.f;
#pragma unroll
                for (int i = 0; i < 16; ++i) { const h2v dd = {d[2 * i], d[2 * i + 1]}; a = __builtin_amdgcn_fdot2(dd, __builtin_bit_cast(h2v, xw[i]), a, false); }
                dp[k0 + kk] = a; }
#pragma unroll
            for (int kk = 0; kk < P7_UNR; ++kk) asm volatile("" : "+v"(dp[k0 + kk]) :: "memory");
        }
#define P7_TR(C, M) do { const bool up_ = (lane & (M)) != 0; _Pragma("unroll") for (int i = 0; i < (C) / 2; ++i) { const float keep_ = up_ ? dp[i + (C) / 2] : dp[i], send_ = up_ ? dp[i] : dp[i + (C) / 2]; dp[i] = keep_ + xor_lane<(M)>(send_); } } while (0)
        P7_TR(16, 32); P7_TR(8, 16); P7_TR(4, 8); P7_TR(2, 4);
#undef P7_TR
        float dk = dp[0]; dk += xor_lane<2>(dk); dk += xor_lane<1>(dk);
        const float hval = gate * pg8::gelu_tanh(dk * rt * (1.0f / PEER_SU)) * (1.0f / PEER_SV);
        float o[32];
#pragma unroll
        for (int e = 0; e < 32; ++e) o[e] = 0.f;
#pragma unroll
        for (int k0 = 0; k0 < 16; k0 += P7_UNR) {
            u6v vr[P7_UNR];
#pragma unroll
            for (int kk = 0; kk < P7_UNR; ++kk) { const int e = __builtin_amdgcn_readlane(eidx, 4 * (k0 + kk)); vr[kk] = ld_row6(EV6 + (size_t)e * 1536 + lane * 24); }
#pragma unroll
            for (int kk = 0; kk < P7_UNR; ++kk) { const float hk = __builtin_bit_cast(float, __builtin_amdgcn_readlane(__builtin_bit_cast(int, hval), 4 * (k0 + kk))); const h32v d = __builtin_amdgcn_cvt_scalef32_pk32_f16_fp6(vr[kk], 1.0f);
#pragma unroll
                for (int e = 0; e < 32; ++e) o[e] = __builtin_fmaf((float)d[e], hk, o[e]); }
#pragma unroll
            for (int q = 0; q < 4; ++q) asm volatile("" : "+v"(o[8 * q]), "+v"(o[8 * q + 1]), "+v"(o[8 * q + 2]), "+v"(o[8 * q + 3]), "+v"(o[8 * q + 4]), "+v"(o[8 * q + 5]), "+v"(o[8 * q + 6]), "+v"(o[8 * q + 7]) :: "memory");
        }
        { const int L = lane;
#pragma unroll
            for (int q = 0; q < 8; ++q) *(LAS f32x4*)(RED + w * 2048 + L * 32 + ((q + L) & 7) * 4) = (f32x4){o[4 * q], o[4 * q + 1], o[4 * q + 2], o[4 * q + 3]}; }
        __syncthreads();
        const int col = w * 256 + lane * 4; const int Lb = col >> 5, qb = (col >> 2) & 7, soff = Lb * 32 + ((qb + Lb) & 7) * 4;
        f32x4 sum = *(const LAS f32x4*)(RED + soff);
#pragma unroll
        for (int ww = 1; ww < 8; ++ww) sum += *(const LAS f32x4*)(RED + ww * 2048 + soff);
        { const unsigned long long xq = *(const GAS unsigned long long*)(XH + (size_t)t * DM + col); const unsigned x0 = (unsigned)xq, x1 = (unsigned)(xq >> 32); const h2v p0 = __builtin_bit_cast(h2v, x0), p1 = __builtin_bit_cast(h2v, x1);
            sum += (f32x4){(float)p0[0], (float)p0[1], (float)p1[0], (float)p1[1]}; }
        float sq = (sum.x * sum.x + sum.y * sum.y) + (sum.z * sum.z + sum.w * sum.w); sq = wave_sum_sw(sq);
        if (lane == 0) PART[w] = sq;
        __syncthreads();
        float tot = 0.f;
#pragma unroll
        for (int ww = 0; ww < 8; ++ww) tot += PART[ww];
        const float rf = 1.0f / sqrtf(tot * (1.f / DM) + EPS);
        const f32x4 gf = *(const GAS f32x4*)(F.norm_final_g + col);
        *(GAS f32x4*)(F.out + OUT_Y + (size_t)t * DM + col) = sum * rf * gf;
    }
}
#else
#error "PEER expert tables: PEER_FP4 or PEER_FP6"
#endif
#ifndef PQ_MERGE
#define PQ_MERGE PEER_FP4
#endif
#if PQ_MERGE
constexpr int CW_QUEUE = 8192, CW_GCNT = 8256;
constexpr int Q_NITEM = 520 + MREAL;
static_assert(MREAL == 16512 && (CW_GCNT + 65) * 4 <= (int)CTL_ZERO_BYTES, "queue layout");
__device__ __forceinline__ int q_decode(const int idx) { return idx < 520 ? ~idx : idx - 520; }
__device__ __forceinline__ unsigned q_ready(unsigned* gcnt, const int g, int& upto, const int lane) {
    if (g >= upto) { const unsigned c = xb_ld(&gcnt[lane]), c64 = xb_ld(&gcnt[64]); const unsigned long long m = __ballot(c >= 8u);
        int n = (m == ~0ull) ? 64 : __builtin_ctzll(~m); if (n == 64 && c64 >= 8u) n = 65; upto = n; }
    return g < upto ? 8u : 0u;
}
__device__ __forceinline__ void p67_queue(Frame& F) {
    const int w = F.wave;
    unsigned* qctr = (unsigned*)(F.ctl + CW_QUEUE); unsigned* gcnt = (unsigned*)(F.ctl + CW_GCNT); unsigned* bar = (unsigned*)(F.ctl + CW_BAR);
    volatile LAS int* LQ = (volatile LAS int*)(F.lds + LDSCTL_OFF + 128);
    const bf16* XH = (const bf16*)(F.ws + WS_RATIO); const unsigned char* EU4 = F.ws + WS_EU; const float* EUS = (const float*)(F.ws + WS_EU + 16 * MiB); const unsigned char* EV4 = F.ws + WS_EU + 32 * MiB; const float* EVS = (const float*)(F.ws + WS_EU + 48 * MiB);
    unsigned long long* SEL = (unsigned long long*)(F.ws + WS_RA);
    int idx = F.vcu, slot = 0, ntok = 0, rdy_upto = 0; int ready = q_decode(idx) < 0 ? 1 : 0;
    while (idx < Q_NITEM) {
        const int lane = pg8::lane_id_v();
        unsigned nxr = 0u; if (w == 0 && lane == 0) nxr = xb_add(qctr, 1u);
        int nx = Q_NITEM; unsigned nrdy = 8u;
        const int item = q_decode(idx);
        if (item < 0) {
            const int job = ~item;
            p6_job(F, job);
            VM_WAIT();
            if (w == 0) { nx = (int)F.G + __builtin_amdgcn_readfirstlane((int)nxr); if (nx < Q_NITEM) { const int ni = q_decode(nx); if (ni >= 0) nrdy = q_ready(gcnt, ni >> 8, rdy_upto, lane); }
                if (lane == 0) { LQ[(slot ^ 1) * 2] = nx; LQ[(slot ^ 1) * 2 + 1] = nrdy >= 8u ? 1 : 0; } }
            __syncthreads();
            if (w == 0 && lane == 0) (void)xb_add(&gcnt[job >> 3], 1u);
        } else {
            const int t = item;
            if (!ready) { XB_SPIN(xb_ld(&gcnt[t >> 8]) < 8u, bar); }
            LAS float* RED = (LAS float*)(F.lds + P7_RED + (ntok & 1) * 65536); LAS float* PART = (LAS float*)(F.lds + P7_PART + (ntok & 1) * 32);
            const unsigned long long sel = __hip_atomic_load(SEL + ((size_t)t * 8 + w) * 16 + (lane >> 2), RLX_AGENT);
            const int eidx = (int)(unsigned)sel; const float gate = __builtin_bit_cast(float, (unsigned)(sel >> 32));
            const float su_l = EUS[eidx], sv_l = EVS[eidx];
            unsigned xw[16];
#pragma unroll
            for (int q = 0; q < 8; ++q) { const unsigned long long v = *(const GAS unsigned long long*)(XH + (size_t)t * DM + q * 256 + lane * 4); xw[2 * q] = (unsigned)v; xw[2 * q + 1] = (unsigned)(v >> 32); }
#if P7_MFMA_U
            v8i_t xb;
            { typedef _Float16 h32x __attribute__((ext_vector_type(32))); typedef unsigned u6x __attribute__((ext_vector_type(6))); h32x hx;
#pragma unroll
              for (int i = 0; i < 16; ++i) { const h2v p = __builtin_bit_cast(h2v, xw[i]); hx[2 * i] = p[0]; hx[2 * i + 1] = p[1]; }
              const u6x px = __builtin_amdgcn_cvt_scalef32_pk32_fp6_f16(hx, 1.0f);
              xb = (v8i_t){(int)px[0], (int)px[1], (int)px[2], (int)px[3], (int)px[4], (int)px[5], 0, 0}; }
            float mk[4];
#pragma unroll
            for (int r4 = 0; r4 < 4; ++r4) mk[r4] = ((lane >> 4) == ((lane & 15) >> 2) && (lane & 3) == r4) ? 1.f : 0.f;
#endif
            float ssum = 0.f;
#pragma unroll
            for (int i = 0; i < 16; ++i) { const h2v hv = __builtin_bit_cast(h2v, xw[i]); ssum = __builtin_amdgcn_fdot2(hv, hv, ssum, false); }
            ssum = wave_sum_sw(ssum);
            const float rt = 1.0f / sqrtf(ssum * (1.f / DM) + EPS);
            float dp[16];
#pragma unroll
            for (int k0 = 0; k0 < 16; k0 += P7_UNR) {
                v4u ur[P7_UNR];
#pragma unroll
                for (int kk = 0; kk < P7_UNR; ++kk) { const int e = __builtin_amdgcn_readlane(eidx, 4 * (k0 + kk)); ur[kk] = *(const GAS v4u*)(EU4 + (size_t)e * 1024 + lane * 16); }
#if P7_MFMA_U
#pragma unroll
                for (int kk = 0; kk < P7_UNR; ++kk) { const v8i_t A = {(int)ur[kk].x, (int)ur[kk].y, (int)ur[kk].z, (int)ur[kk].w, 0, 0, 0, 0};
                    const f32x4 d = __builtin_amdgcn_mfma_scale_f32_16x16x128_f8f6f4(A, xb, (f32x4){0.f, 0.f, 0.f, 0.f}, 4  , 2  , 0, 127, 0, 127);
                    dp[k0 + kk] = (d[0] * mk[0] + d[1] * mk[1]) + (d[2] * mk[2] + d[3] * mk[3]); }
#else
#pragma unroll
                for (int kk = 0; kk < P7_UNR; ++kk) { float a = 0.f;
#pragma unroll
                    for (int q = 0; q < 4; ++q) { const unsigned wq = ur[kk][q];
                        a = __builtin_amdgcn_fdot2(__builtin_amdgcn_cvt_scalef32_pk_f16_fp4(wq, 1.0f, 0), __builtin_bit_cast(h2v, xw[4 * q + 0]), a, false); a = __builtin_amdgcn_fdot2(__builtin_amdgcn_cvt_scalef32_pk_f16_fp4(wq, 1.0f, 1), __builtin_bit_cast(h2v, xw[4 * q + 1]), a, false);
                        a = __builtin_amdgcn_fdot2(__builtin_amdgcn_cvt_scalef32_pk_f16_fp4(wq, 1.0f, 2), __builtin_bit_cast(h2v, xw[4 * q + 2]), a, false); a = __builtin_amdgcn_fdot2(__builtin_amdgcn_cvt_scalef32_pk_f16_fp4(wq, 1.0f, 3), __builtin_bit_cast(h2v, xw[4 * q + 3]), a, false); }
                    dp[k0 + kk] = a;
                    }
#endif
#pragma unroll
                for (int kk = 0; kk < P7_UNR; ++kk) asm volatile("" : "+v"(dp[k0 + kk]) :: "memory");
            }
            if (w == 0) { nx = (int)F.G + __builtin_amdgcn_readfirstlane((int)nxr); if (nx < Q_NITEM) { const int ni = q_decode(nx); if (ni >= 0) nrdy = q_ready(gcnt, ni >> 8, rdy_upto, lane); } }
#define P7_TR(C, M) do { const bool up_ = (lane & (M)) != 0; _Pragma("unroll") for (int i = 0; i < (C) / 2; ++i) { const float keep_ = up_ ? dp[i + (C) / 2] : dp[i], send_ = up_ ? dp[i] : dp[i + (C) / 2]; dp[i] = keep_ + xor_lane<(M)>(send_); } } while (0)
            P7_TR(16, 32); P7_TR(8, 16); P7_TR(4, 8); P7_TR(2, 4);
#undef P7_TR
            float dk = dp[0]; dk += xor_lane<2>(dk); dk += xor_lane<1>(dk);
            const float hval = gate * pg8::gelu_tanh(dk * su_l * rt) * sv_l;
            unsigned long long xq = 0ull; f32x4 gf = {0.f, 0.f, 0.f, 0.f};
            h2v o2[16];
#pragma unroll
            for (int e = 0; e < 16; ++e) o2[e] = (h2v){(_Float16)0.f, (_Float16)0.f};
#pragma unroll
            for (int k0 = 0; k0 < 16; k0 += P7_UNR) {
                v4u vr[P7_UNR];
#pragma unroll
                for (int kk = 0; kk < P7_UNR; ++kk) { const int e = __builtin_amdgcn_readlane(eidx, 4 * (k0 + kk)); vr[kk] = *(const GAS v4u*)(EV4 + (size_t)e * 1024 + lane * 16); }
                if (k0 == 0) { xq = *(const GAS unsigned long long*)(XH + (size_t)t * DM + w * 256 + lane * 4); gf = *(const GAS f32x4*)(F.norm_final_g + w * 256 + lane * 4); }
#pragma unroll
                for (int kk = 0; kk < P7_UNR; ++kk) { const float hk = __builtin_bit_cast(float, __builtin_amdgcn_readlane(__builtin_bit_cast(int, hval), 4 * (k0 + kk))) * 256.0f; const _Float16 hh = (_Float16)hk; const h2v hk2 = {hh, hh};
#pragma unroll
                    for (int q = 0; q < 4; ++q) { const unsigned wq = vr[kk][q];
                        o2[4 * q + 0] = __builtin_elementwise_fma(__builtin_bit_cast(h2v, __builtin_amdgcn_cvt_scalef32_pk_f16_fp4(wq, 1.0f, 0)), hk2, o2[4 * q + 0]); o2[4 * q + 1] = __builtin_elementwise_fma(__builtin_bit_cast(h2v, __builtin_amdgcn_cvt_scalef32_pk_f16_fp4(wq, 1.0f, 1)), hk2, o2[4 * q + 1]);
                        o2[4 * q + 2] = __builtin_elementwise_fma(__builtin_bit_cast(h2v, __builtin_amdgcn_cvt_scalef32_pk_f16_fp4(wq, 1.0f, 2)), hk2, o2[4 * q + 2]); o2[4 * q + 3] = __builtin_elementwise_fma(__builtin_bit_cast(h2v, __builtin_amdgcn_cvt_scalef32_pk_f16_fp4(wq, 1.0f, 3)), hk2, o2[4 * q + 3]); } }
#pragma unroll
                for (int q = 0; q < 2; ++q) asm volatile("" : "+v"(o2[8 * q]), "+v"(o2[8 * q + 1]), "+v"(o2[8 * q + 2]), "+v"(o2[8 * q + 3]), "+v"(o2[8 * q + 4]), "+v"(o2[8 * q + 5]), "+v"(o2[8 * q + 6]), "+v"(o2[8 * q + 7]) :: "memory");
            }
#pragma unroll
            for (int q = 0; q < 8; ++q) *(LAS f32x4*)(RED + w * 2048 + q * 256 + lane * 4) = (f32x4){(float)o2[2 * q][0], (float)o2[2 * q][1], (float)o2[2 * q + 1][0], (float)o2[2 * q + 1][1]} * (1.0f / 256.0f);
            __syncthreads();
            const int col = w * 256 + lane * 4, soff = col;
            f32x4 sum = *(const LAS f32x4*)(RED + soff);
#pragma unroll
            for (int ww = 1; ww < 8; ++ww) sum += *(const LAS f32x4*)(RED + ww * 2048 + soff);
            { const unsigned x0 = (unsigned)xq, x1 = (unsigned)(xq >> 32); const h2v p0 = __builtin_bit_cast(h2v, x0), p1 = __builtin_bit_cast(h2v, x1);
                sum += (f32x4){(float)p0[0], (float)p0[1], (float)p1[0], (float)p1[1]}; }
            float sq = (sum.x * sum.x + sum.y * sum.y) + (sum.z * sum.z + sum.w * sum.w); sq = wave_sum_sw(sq);
            if (lane == 0) PART[w] = sq;
            if (w == 0 && lane == 0) { LQ[(slot ^ 1) * 2] = nx; LQ[(slot ^ 1) * 2 + 1] = nrdy >= 8u ? 1 : 0; }
            __syncthreads();
            float tot = 0.f;
#pragma unroll
            for (int ww = 0; ww < 8; ++ww) tot += PART[ww];
            const float rf = 1.0f / sqrtf(tot * (1.f / DM) + EPS);
            __builtin_nontemporal_store(sum * rf * gf, (GAS f32x4*)(F.out + OUT_Y + (size_t)t * DM + col));
        }
        slot ^= 1; ++ntok;
        idx = __builtin_amdgcn_readfirstlane(LQ[slot * 2]); ready = __builtin_amdgcn_readfirstlane(LQ[slot * 2 + 1]);
    }
}
#endif
#ifndef P5_FP8
#define P5_FP8 1
#endif
#ifndef STG_3CLASS
#define STG_3CLASS 0
#endif
#ifndef STG_LATE_ITEMS
#define STG_LATE_ITEMS 2048
#endif
#ifndef P5_SP2
#define P5_SP2 true
#endif
struct Args { const float* in[20]; float* out; unsigned char* ws; };
__global__ void __launch_bounds__(NWAVES * 64, 2) hybrid_fwd(Args args) {
    extern __shared__ __attribute__((aligned(16))) unsigned char lds[];
    Frame F;
    F.lds = (LAS unsigned char*)lds;
    F.MISC = (volatile LAS unsigned*)(F.lds + MISC_OFF);
    F.wave = __builtin_amdgcn_readfirstlane(threadIdx.x >> 6);
    F.G = gridDim.x; { const int bx = blockIdx.x; F.vcu = (F.G % 8 == 0) ? (bx % 8) * (F.G / 8) + bx / 8 : bx; }
    F.ws = args.ws; F.out = args.out; F.ctl = (gu32*)(args.ws + WS_CTL);
    F.x_prompt = args.in[0]; F.x_sample = args.in[1]; F.cache_k = args.in[2]; F.cache_v = args.in[3]; F.norm_mix_g = args.in[4]; F.w_in = args.in[5]; F.sgu_norm_g = args.in[6];
    F.sgu_w_s = args.in[7]; F.sgu_b_s = args.in[8]; F.sinks = args.in[9]; F.rel_tab = args.in[10]; F.w_pa = args.in[11]; F.w_pb = args.in[12]; F.w_out = args.in[13]; F.norm_ffn_g = args.in[14];
    F.w_query = args.in[15]; F.sub_keys = args.in[16]; F.exp_u = args.in[17]; F.exp_v = args.in[18]; F.norm_final_g = args.in[19];
    for (int u = threadIdx.x; u < (LDS_BYTES - LDSCTL_OFF) / 4; u += NWAVES * 64) ((LAS unsigned*)(F.lds + LDSCTL_OFF))[u] = 0u;
    __syncthreads();
    XcdBarrier bar = xcd_barrier_post((unsigned*)(F.ctl + CW_BAR), F.MISC + 8);
    unsigned char* ws = args.ws;
    p0_prologue(F);
    xcd_barrier(bar);
    {
        pg8::Gemm g{(const bf16*)(ws + WS_RA), (const bf16*)(ws + WS_WIN), MPAD, DIN, DM}; pg8::StaticOrder S; S.init(MPAD, DIN, F.G, (int)blockIdx.x);
        pg8::EpiIn E{(bf16*)(ws + WS_Q), (bf16*)(ws + WS_KV), (bf16*)(ws + WS_U), (bf16*)(ws + WS_VS), (bf16*)(ws + WS_RATIO), (bf16*)(ws + WS_SB), (float*)(ws + WS_SS1),
                     F.out + OUT_KP, F.out + OUT_VP, F.out + OUT_KS, F.out + OUT_VS};
        pg8::gemm_phase<pg8::EpiIn, pg8::StaticOrder, true, true, false>(F.lds + RING_OFF, g, S, E, F.wave);
        constexpr int NU = (MPAD / 256) * (DIN / 256); const int full = NU % (int)F.G;
        if (NU > (int)F.G && full > 0) { if ((int)blockIdx.x >= full) p0_expert_tables(F, (int)blockIdx.x - full, (int)F.G - full); }
        else p0_expert_tables(F, F.vcu, F.G);
    }
    xcd_barrier(bar);
    p2_mixers(F);
    xcd_barrier(bar);
    {
        pg8::Gemm g{(const bf16*)(ws + WS_RA), (const bf16*)(ws + WS_WAB), MPROMPT, DM, DM}; pg8::StaticOrder S; S.init(MPROMPT, DM, F.G, (int)blockIdx.x);
        pg8::EpiMerge E{(const bf16*)(ws + WS_RATIO), (const bf16*)(ws + WS_SB), (bf16*)(ws + WS_RB)};
        const SkMerge SE{(const bf16*)(ws + WS_RATIO), (const bf16*)(ws + WS_SB), (bf16*)(ws + WS_RB)};
        const bool stg = STAGGER && F.G == 256, late = stg && (F.vcu & 1); constexpr int TO = 32 * 232 + 2 * 16 * 64;
        const bool skfirst = late || (stg && STG_3CLASS && (F.vcu & 2));
        if (late) p0_transposes(F, TO, TO + STG_LATE_ITEMS, (F.vcu >> 1) * NWAVES + F.wave, 128 * NWAVES);
        if (skfirst) { skinny_gemm<false, true>(F, (const bf16*)(ws + WS_RA), (const bf16*)(ws + WS_WAB), SE); __syncthreads(); }
        pg8::gemm_phase<pg8::EpiMerge, pg8::StaticOrder, true, true, false>(F.lds + RING_OFF, g, S, E, F.wave);
        if (!skfirst) skinny_gemm<false, true>(F, (const bf16*)(ws + WS_RA), (const bf16*)(ws + WS_WAB), SE);
        if (!late) {
            if (stg && STG_LATE_ITEMS < 2048) { __syncthreads(); p0_transposes(F, TO + STG_LATE_ITEMS, TO + 2048, (F.vcu >> 1) * NWAVES + F.wave, 128 * NWAVES); } }
    }
    xcd_barrier(bar);
    {
        pg8::Gemm g{(const bf16*)(ws + WS_RB), (const bf16*)(ws + WS_WOUT), MPROMPT, DM, DM}; pg8::StaticOrder S; S.init(MPROMPT, DM, F.G, (int)blockIdx.x);
        pg8::EpiOut E{F.x_prompt, F.x_sample, (bf16*)(ws + WS_RATIO), (float*)(ws + WS_SS2), ws + WS_XH8};
        const SkOut SE{F.x_sample, (bf16*)(ws + WS_RATIO), (float*)(ws + WS_SS2S)};
        const bool stg = STAGGER && F.G == 256, late = stg && (F.vcu & 1); constexpr int TQ = 32 * 232 + 2 * 16 * 64 + 32 * 64;
        const bool skfirst = late || (stg && STG_3CLASS && (F.vcu & 2));
        if (late) p0_transposes(F, TQ, TQ + STG_LATE_ITEMS, (F.vcu >> 1) * NWAVES + F.wave, 128 * NWAVES);
        if (skfirst) { skinny_gemm<false, false>(F, (const bf16*)(ws + WS_RB), (const bf16*)(ws + WS_WOUT), SE); __syncthreads(); }
        pg8::gemm_phase<pg8::EpiOut, pg8::StaticOrder, true, true, false>(F.lds + RING_OFF, g, S, E, F.wave);
        if (!skfirst) skinny_gemm<false, false>(F, (const bf16*)(ws + WS_RB), (const bf16*)(ws + WS_WOUT), SE);
        if (!late) {
            if (stg && STG_LATE_ITEMS < 2048) { __syncthreads(); p0_transposes(F, TQ + STG_LATE_ITEMS, TQ + 2048, (F.vcu >> 1) * NWAVES + F.wave, 128 * NWAVES); } }
    }
    xcd_barrier(bar);
    {
        const SkQ SE{(bf16*)(ws + WS_SB)}; const bool p5late = STAGGER && F.G == 256 && (F.vcu & 1);
        if (p5late) { skinny_gemm<true, false>(F, (const bf16*)(ws + WS_RATIO), (const bf16*)(ws + WS_WQ), SE); __syncthreads(); }
#if P5_FP8
        pg8::Gemm g{(const bf16*)(ws + WS_XH8), (const bf16*)(ws + WS_WQ8), MPROMPT, DM, DM / 2}; pg8::StaticOrder S; S.init(MPROMPT, DM, F.G, (int)blockIdx.x);
        pg8::EpiQ E{(bf16*)(ws + WS_SB), 1.0f / (float)(1 << pg8::F8_WSHIFT)};
        pg8::gemm_phase<pg8::EpiQ, pg8::StaticOrder, true, P5_SP2, false, true>(F.lds + RING_OFF, g, S, E, F.wave);
#else
        pg8::Gemm g{(const bf16*)(ws + WS_RATIO), (const bf16*)(ws + WS_WQ), MPROMPT, DM, DM}; pg8::StaticOrder S; S.init(MPROMPT, DM, F.G, (int)blockIdx.x);
        pg8::EpiQ E{(bf16*)(ws + WS_SB), 1.0f};
        pg8::gemm_phase<pg8::EpiQ, pg8::StaticOrder, true, true, true>(F.lds + RING_OFF, g, S, E, F.wave);
#endif
        if (!p5late) skinny_gemm<true, false>(F, (const bf16*)(ws + WS_RATIO), (const bf16*)(ws + WS_WQ), SE);
    }
    xcd_barrier(bar);
#if PQ_MERGE
    p67_queue(F);
#else
    p6_topk(F);
    xcd_barrier(bar);
    p7_gather(F);
#endif
}

extern "C" void kernel_launch(void* const* d_in, const int* in_sizes, int n_in, void* d_out, int out_size, void* d_ws, size_t ws_size, hipStream_t stream) {
    static int grid = 0;
    if (grid == 0) {
        if (n_in != 20 || in_sizes[0] != MPROMPT * DM || out_size != (int)OUT_TOTAL || ws_size < WS_END) {
            fprintf(stderr, "kernel_launch: shape mismatch: n_in %d, in0 %d, out %d (want %zu), ws %zu (want %zu); nothing launched\n", n_in, n_in > 0 ? in_sizes[0] : -1, out_size, (size_t)OUT_TOTAL, ws_size, (size_t)WS_END); grid = -1; return; }
        int dev = 0, cus = 0, per_cu = 0;
        if (hipGetDevice(&dev) != hipSuccess || hipDeviceGetAttribute(&cus, hipDeviceAttributeMultiprocessorCount, dev) != hipSuccess) { fprintf(stderr, "kernel_launch: device query failed\n"); grid = -1; return; }
        if (hipFuncSetAttribute((const void*)hybrid_fwd, hipFuncAttributeMaxDynamicSharedMemorySize, LDS_BYTES) != hipSuccess) { fprintf(stderr, "kernel_launch: hipFuncSetAttribute failed\n"); grid = -1; return; }
        if (hipOccupancyMaxActiveBlocksPerMultiprocessor(&per_cu, (const void*)hybrid_fwd, NWAVES * 64, LDS_BYTES) != hipSuccess || per_cu < 1)
            fprintf(stderr, "kernel_launch: note: occupancy query reports %d workgroups per CU\n", per_cu);
        (void)hipGetLastError();
        grid = cus;
    }
    if (grid < 0) return;
    if (hipMemsetAsync((char*)d_ws + WS_CTL, 0, CTL_ZERO_BYTES, stream) != hipSuccess) { fprintf(stderr, "kernel_launch: memset failed\n"); return; }
    Args a{};
    for (int i = 0; i < 20; ++i) a.in[i] = (const float*)d_in[i];
    a.out = (float*)d_out; a.ws = (unsigned char*)d_ws;

    hipLaunchKernelGGL(hybrid_fwd, dim3(grid), dim3(NWAVES * 64), LDS_BYTES, stream, a);
    const hipError_t le = hipPeekAtLastError();
    if (le != hipSuccess) fprintf(stderr, "kernel_launch: launch failed: %s\n", hipGetErrorName(le));
}
```
